# Optimizing an MI355X kernel written in HIP

```python
import jax, jax.numpy as jnp
from jax import lax
import numpy as np

D_MODEL = 1024
BATCH = 4
SEQ = 8192
DEPTH = 4

GRID_W = 64
CTX_LEN = 256
ROPE_THETA = 10000.0
Q_BLOCK = 128
EPS = 1e-6

MLA_HEADS = 6
MLA_NOPE = 64
MLA_ROPE = 32
MLA_V = 64
MLA_Q_RANK = 256
MLA_KV_RANK = 128
GQA_HEADS = 6
GQA_KV_HEADS = 2
GQA_HEAD_DIM = 64
CONV_WIDTH = 256
D_FF = 4 * D_MODEL

MLA_OUT = MLA_HEADS * MLA_V
GQA_OUT = GQA_HEADS * GQA_HEAD_DIM
MIX_WIDTH = MLA_OUT + GQA_OUT + CONV_WIDTH
GQA_KV_W = GQA_KV_HEADS * GQA_HEAD_DIM

KV_COLS = MLA_KV_RANK + MLA_ROPE + 2 * GQA_KV_W
Q_COLS = MLA_Q_RANK + GQA_HEADS * GQA_HEAD_DIM
IN_COLS = KV_COLS + Q_COLS + 3 * CONV_WIDTH

ALPHA = (2.0 * DEPTH) ** 0.25
BETA = (8.0 * DEPTH) ** -0.25
N_MOD = 6

kernel_name = "hybrid_mla_gqa_shortconv_dit_trunk"


def layer_norm(x, g, b):
    xf = x.astype(jnp.float32)
    mu = xf.mean(-1, keepdims=True)
    var = jnp.square(xf - mu).mean(-1, keepdims=True)
    return ((xf - mu) * lax.rsqrt(var + EPS)).astype(x.dtype) * g + b


def rms_norm(x, g):
    xf = x.astype(jnp.float32)
    return (xf * lax.rsqrt(jnp.square(xf).mean(-1, keepdims=True) + EPS)).astype(x.dtype) * g


def axial_rope(row, col, dim):
    n_freq = dim // 4
    inv = ROPE_THETA ** (-jnp.arange(n_freq, dtype=jnp.float32) / n_freq)
    ang = jnp.concatenate([row[:, None].astype(jnp.float32) * inv,
                           col[:, None].astype(jnp.float32) * inv], axis=-1)
    return jnp.cos(ang), jnp.sin(ang)


def apply_rope(x, cs):
    cos = cs[0][None, :, None, :].astype(x.dtype)
    sin = cs[1][None, :, None, :].astype(x.dtype)
    x1, x2 = x[..., 0::2], x[..., 1::2]
    return jnp.stack([x1 * cos - x2 * sin, x1 * sin + x2 * cos], axis=-1).reshape(x.shape)


def block_attention(q, k, v, n_kv):
    B, S, H, dq = q.shape
    dv = v.shape[-1]
    G = H // n_kv
    nb = S // Q_BLOCK
    scale = dq ** -0.5
    qb = jnp.moveaxis(q.reshape(B, nb, Q_BLOCK, n_kv, G, dq), 1, 0)

    def one_block(qblk):
        s = jnp.einsum('bqkgd,blkd->bkgql', qblk, k).astype(jnp.float32) * scale
        p = jax.nn.softmax(s, axis=-1).astype(v.dtype)
        return jnp.einsum('bkgql,blkd->bqkgd', p, v)

    o = lax.map(one_block, qb)
    return jnp.moveaxis(o, 0, 1).reshape(B, S, H * dv)


def short_conv(u, w):
    up = jnp.pad(u, ((0, 0), (1, 1), (0, 0)))
    return up[:, :-2] * w[0] + up[:, 1:-1] * w[1] + up[:, 2:] * w[2]


def kv_side(h, g_ckv, w_ukv, g_kn, ropes):
    B, L, _ = h.shape
    o = 0
    c_kv = h[..., o:o + MLA_KV_RANK]; o += MLA_KV_RANK
    k_pe = h[..., o:o + MLA_ROPE].reshape(B, L, 1, MLA_ROPE); o += MLA_ROPE
    g_k = h[..., o:o + GQA_KV_W].reshape(B, L, GQA_KV_HEADS, GQA_HEAD_DIM); o += GQA_KV_W
    g_v = h[..., o:o + GQA_KV_W].reshape(B, L, GQA_KV_HEADS, GQA_HEAD_DIM)
    kv = (rms_norm(c_kv, g_ckv) @ w_ukv).reshape(B, L, MLA_HEADS, MLA_NOPE + MLA_V)
    k_nope, m_v = kv[..., :MLA_NOPE], kv[..., MLA_NOPE:]
    g_k = rms_norm(g_k, g_kn)
    if ropes is not None:
        k_pe = apply_rope(k_pe, ropes[0])
        g_k = apply_rope(g_k, ropes[1])
    m_k = jnp.concatenate([k_nope, jnp.broadcast_to(k_pe, (B, L, MLA_HEADS, MLA_ROPE))], axis=-1)
    return (m_k, m_v, g_k, g_v)


def mixer_out(h, kv, g_cq, w_uq, g_qn, w_conv, w_o, ropes):
    B, L, _ = h.shape
    hq = h[..., KV_COLS:KV_COLS + Q_COLS]
    mq = (rms_norm(hq[..., :MLA_Q_RANK], g_cq) @ w_uq).reshape(B, L, MLA_HEADS, MLA_NOPE + MLA_ROPE)
    q_nope, q_pe = mq[..., :MLA_NOPE], mq[..., MLA_NOPE:]
    gq = rms_norm(hq[..., MLA_Q_RANK:].reshape(B, L, GQA_HEADS, GQA_HEAD_DIM), g_qn)
    if ropes is not None:
        q_pe = apply_rope(q_pe, ropes[0])
        gq = apply_rope(gq, ropes[1])
    mq = jnp.concatenate([q_nope, q_pe], axis=-1)
    mo = block_attention(mq, kv[0], kv[1], MLA_HEADS)
    go = block_attention(gq, kv[2], kv[3], GQA_KV_HEADS)
    hc = h[..., KV_COLS + Q_COLS:]
    ch = hc[..., :CONV_WIDTH]
    cb = hc[..., CONV_WIDTH:2 * CONV_WIDTH]
    cc = hc[..., 2 * CONV_WIDTH:]
    co = cb * short_conv(cc * ch, w_conv)
    return jnp.concatenate([mo, go, co], axis=-1) @ w_o


def sq_relu_mlp(u, w1, w2):
    return jnp.square(jax.nn.relu(u @ w1)) @ w2


def setup_inputs(seed: int = 0) -> dict:
    key = jax.random.key(seed)
    ks = jax.random.split(key, 24)
    nrm = jax.random.normal
    f32 = jnp.float32
    d = D_MODEL
    return {
        "x": nrm(ks[0], (BATCH, SEQ, d), f32),
        "c": nrm(ks[1], (BATCH, d), f32),
        "ctx": nrm(ks[2], (BATCH, CTX_LEN, d), f32),
        "c_ctx": nrm(ks[3], (d,), f32),
        "w_ada": nrm(ks[4], (DEPTH, d, N_MOD * d), f32) * (0.5 * d ** -0.5),
        "b_ada": nrm(ks[5], (DEPTH, N_MOD * d), f32) * 0.01,
        "w_in": nrm(ks[6], (DEPTH, d, IN_COLS), f32) * d ** -0.5,
        "g_cq": 1.0 + 0.1 * nrm(ks[7], (DEPTH, MLA_Q_RANK), f32),
        "w_uq": nrm(ks[8], (DEPTH, MLA_Q_RANK, MLA_HEADS * (MLA_NOPE + MLA_ROPE)), f32) * MLA_Q_RANK ** -0.5,
        "g_ckv": 1.0 + 0.1 * nrm(ks[9], (DEPTH, MLA_KV_RANK), f32),
        "w_ukv": nrm(ks[10], (DEPTH, MLA_KV_RANK, MLA_HEADS * (MLA_NOPE + MLA_V)), f32) * MLA_KV_RANK ** -0.5,
        "g_qn": 1.0 + 0.1 * nrm(ks[11], (DEPTH, GQA_HEAD_DIM), f32),
        "g_kn": 1.0 + 0.1 * nrm(ks[12], (DEPTH, GQA_HEAD_DIM), f32),
        "w_conv": nrm(ks[13], (DEPTH, 3, CONV_WIDTH), f32) * 3.0 ** -0.5,
        "w_o": nrm(ks[14], (DEPTH, MIX_WIDTH, d), f32) * (BETA * MIX_WIDTH ** -0.5),
        "ln1_g": 1.0 + 0.1 * nrm(ks[15], (DEPTH, d), f32),
        "ln1_b": 0.02 * nrm(ks[16], (DEPTH, d), f32),
        "w_mlp1": nrm(ks[17], (DEPTH, d, D_FF), f32) * d ** -0.5,
        "w_mlp2": nrm(ks[18], (DEPTH, D_FF, d), f32) * (BETA * D_FF ** -0.5),
        "ln2_g": 1.0 + 0.1 * nrm(ks[19], (DEPTH, d), f32),
        "ln2_b": 0.02 * nrm(ks[20], (DEPTH, d), f32),
    }


def reference(x, c, ctx, c_ctx, w_ada, b_ada, w_in, g_cq, w_uq, g_ckv, w_ukv, g_qn, g_kn,
              w_conv, w_o, ln1_g, ln1_b, w_mlp1, w_mlp2, ln2_g, ln2_b):
    B, S, D = x.shape
    ROWS = S // GRID_W
    row = jnp.broadcast_to(jnp.arange(ROWS)[:, None], (ROWS, GRID_W)).reshape(-1)
    col = jnp.broadcast_to(jnp.arange(GRID_W)[None, :], (ROWS, GRID_W)).reshape(-1)
    ropes = (axial_rope(row, col, MLA_ROPE), axial_rope(row, col, GQA_HEAD_DIM))

    z = ctx
    sc = jax.nn.silu(c)
    sz = jax.nn.silu(c_ctx)
    for l in range(DEPTH):
        update_ctx = l < DEPTH - 1
        mx = (sc @ w_ada[l] + b_ada[l]).reshape(B, N_MOD, D)[:, :, None, :]
        mz = (sz @ w_ada[l] + b_ada[l]).reshape(N_MOD, D)

        u_z = z * (1.0 + mz[1]) + mz[0]
        h_z = u_z @ w_in[l] if update_ctx else u_z @ w_in[l][:, :KV_COLS]
        kv_z = kv_side(h_z[..., :KV_COLS], g_ckv[l], w_ukv[l], g_kn[l], None)

        u_x = x * (1.0 + mx[:, 1]) + mx[:, 0]
        h_x = u_x @ w_in[l]
        kv_x = kv_side(h_x[..., :KV_COLS], g_ckv[l], w_ukv[l], g_kn[l], ropes)
        kv_all = tuple(jnp.concatenate([a, b], axis=1) for a, b in zip(kv_z, kv_x))
        y_x = mixer_out(h_x, kv_all, g_cq[l], w_uq[l], g_qn[l], w_conv[l], w_o[l], ropes)
        x = layer_norm(ALPHA * x + mx[:, 2] * y_x, ln1_g[l], ln1_b[l])
        y_x = sq_relu_mlp(x * (1.0 + mx[:, 4]) + mx[:, 3], w_mlp1[l], w_mlp2[l])
        x = layer_norm(ALPHA * x + mx[:, 5] * y_x, ln2_g[l], ln2_b[l])

        if update_ctx:
            y_z = mixer_out(h_z, kv_z, g_cq[l], w_uq[l], g_qn[l], w_conv[l], w_o[l], None)
            z = layer_norm(ALPHA * z + mz[2] * y_z, ln1_g[l], ln1_b[l])
            y_z = sq_relu_mlp(z * (1.0 + mz[4]) + mz[3], w_mlp1[l], w_mlp2[l])
            z = layer_norm(ALPHA * z + mz[5] * y_z, ln2_g[l], ln2_b[l])
    return x
```

```cpp
#include <hip/hip_runtime.h>
#include <hip/hip_cooperative_groups.h>
#include <cstdio>
#include <cstdint>
namespace cg = cooperative_groups;

constexpr int DM = 1024, NBATCH = 4, SEQ = 8192, DEPTH = 4, CTX = 256, DFF = 4096;
constexpr int LTOK = CTX + SEQ;
constexpr int MROWS = NBATCH * LTOK;
constexpr int IN_COLS = 1824, HP = 2048;
constexpr float LN_EPS = 1e-6f;
constexpr float ALPHA = 1.6817928305074290f;
namespace pg8 {
#define PG8_LAS __attribute__((address_space(3)))
typedef unsigned short bf16_t;
typedef short bf16x8 __attribute__((ext_vector_type(8)));
typedef float f32x4 __attribute__((ext_vector_type(4)));
typedef unsigned u32x4 __attribute__((ext_vector_type(4)));
constexpr int BM = 256, BK = 64, HALF = 128, HTB = HALF * BK * 2  , STAGE_BYTES = 8 * HTB, NXCD = 8, WGM = 8;

__host__ __device__ __forceinline__ int lds_byte(int r, int c) { const int st = (r >> 4) * 2 + (c >> 5), rr = r & 15, cc = c & 31, ob = rr * 64 + cc * 2; return st * 1024 + (ob ^ (((ob >> 9) & 1) << 5)); }
__host__ __device__ __forceinline__ void stage_rc(int b, int& R, int& C) { const int st = b / 1024, sb = b % 1024, swz = sb ^ (((sb >> 9) & 1) << 5); R = (st >> 1) * 16 + swz / 64; C = (st & 1) * 32 + (swz % 64) / 2; }
__host__ __device__ __forceinline__ int perm32(int rho) { const int n = rho >> 4, i = rho & 15; return 8 * (i >> 2) + 4 * n + (i & 3); }

struct Unit { int pm, pn; };
struct Gemm { const bf16_t* A; const bf16_t* Bt; int M, N, K; };

struct StaticOrder {
    int nM, nN, nwg, G, c;
    __host__ __device__ void init(int M, int N, int G_, int c_) { nM = M / BM; nN = N / BM; nwg = nM * nN; G = G_; c = c_; }
    __host__ __device__ bool next(int i, Unit& u) const {
        const long L = (long)i * G + c; if (L >= nwg) return false;
        int wgid = (int)L; { const int q = nwg / NXCD, r = nwg % NXCD, xcd = wgid % NXCD, off = wgid / NXCD; wgid = (xcd < r ? xcd * (q + 1) : r * (q + 1) + (xcd - r) * q) + off; }
        const int nig = WGM * nN, gid = wgid / nig, fm = gid * WGM, gsz = (nM - fm) < WGM ? (nM - fm) : WGM;
        u.pm = fm + ((wgid % nig) % gsz); u.pn = (wgid % nig) / gsz; return true;
    }
    __device__ __forceinline__ void a_ready(const Unit&) const {}
    __device__ __forceinline__ void done(const Unit&) const {}
};

__device__ __forceinline__ unsigned cvt_pk_bf16(float lo, float hi) { unsigned r; asm volatile("v_cvt_pk_bf16_f32 %0, %1, %2" : "=v"(r) : "v"(lo), "v"(hi)); return r; }
__device__ __forceinline__ int lane_id_asm() { int l; asm volatile("v_mbcnt_lo_u32_b32 %0, -1, 0\n\tv_mbcnt_hi_u32_b32 %0, -1, %0" : "=v"(l)); return l; }
typedef float f32x2 __attribute__((ext_vector_type(2)));
template <int ACT  > struct EpiStore {
    static constexpr bool PERM = true, AFTER_DRAIN = false;
    bf16_t* O; int ldc;
    __device__ __forceinline__ void operator()(const f32x4 (&acc)[2][2][4][2], const Unit& u, int wr, int wc, int fr, int fq) const {
        const int row0 = u.pm * BM + wr * 64 + fr; const int col0 = u.pn * BM + wc * 32 + 8 * fq;
#pragma unroll
        for (int ai = 0; ai < 2; ++ai)
#pragma unroll
            for (int m = 0; m < 4; ++m) { bf16_t* rowp = O + (size_t)(row0 + ai * HALF + m * 16) * ldc + col0;
#pragma unroll
                for (int bj = 0; bj < 2; ++bj) { f32x4 v0 = acc[ai][bj][m][0], v1 = acc[ai][bj][m][1];
                    if (ACT == 1) {
#pragma unroll
                        for (int e = 0; e < 4; ++e) { float a = fmaxf(v0[e], 0.f), b = fmaxf(v1[e], 0.f); v0[e] = a * a; v1[e] = b * b; } }
                    u32x4 w; w.x = cvt_pk_bf16(v0[0], v0[1]); w.y = cvt_pk_bf16(v0[2], v0[3]); w.z = cvt_pk_bf16(v1[0], v1[1]); w.w = cvt_pk_bf16(v1[2], v1[3]);
                    *(u32x4*)(rowp + bj * HALF) = w; } }
    }
};
struct EpiUQ {
    static constexpr bool PERM = true, AFTER_DRAIN = false;
    bf16_t* MQ; const float* ropeM;
    __device__ __forceinline__ void operator()(const f32x4 (&acc)[2][2][4][2], const Unit& u, int wr, int wc, int fr, int fq) const {
        const int row0 = u.pm * BM + wr * 64 + fr;
#pragma unroll
        for (int bj = 0; bj < 2; ++bj) {
            const int c = u.pn * BM + bj * HALF + wc * 32 + 8 * fq;
            if (c >= 576) continue;
            const int d = c % 96; const bool isrope = d >= 64; const int i0 = (d - 64) >> 1;
#pragma unroll
            for (int ai = 0; ai < 2; ++ai)
#pragma unroll
                for (int m = 0; m < 4; ++m) { const int row = row0 + ai * HALF + m * 16; const int ib = row % 8448;
                    f32x4 v0 = acc[ai][bj][m][0], v1 = acc[ai][bj][m][1];
                    if (isrope && ib >= 256) { const f32x4* rp = (const f32x4*)(ropeM + ((size_t)(ib - 256) * 16 + i0) * 2);
                        const f32x4 r0 = rp[0], r1 = rp[1];
                        f32x4 a, b;
                        a[0] = v0[0] * r0[0] - v0[1] * r0[1]; a[1] = v0[0] * r0[1] + v0[1] * r0[0];
                        a[2] = v0[2] * r0[2] - v0[3] * r0[3]; a[3] = v0[2] * r0[3] + v0[3] * r0[2];
                        b[0] = v1[0] * r1[0] - v1[1] * r1[1]; b[1] = v1[0] * r1[1] + v1[1] * r1[0];
                        b[2] = v1[2] * r1[2] - v1[3] * r1[3]; b[3] = v1[2] * r1[3] + v1[3] * r1[2];
                        v0 = a; v1 = b; }
                    u32x4 w; w.x = cvt_pk_bf16(v0[0], v0[1]); w.y = cvt_pk_bf16(v0[2], v0[3]); w.z = cvt_pk_bf16(v1[0], v1[1]); w.w = cvt_pk_bf16(v1[2], v1[3]);
                    *(u32x4*)(MQ + (size_t)row * 576 + c) = w; }
        }
    }
};
struct EpiUKV {
    static constexpr bool PERM = true, AFTER_DRAIN = false;
    bf16_t* MK; bf16_t* MV;
    __device__ __forceinline__ void operator()(const f32x4 (&acc)[2][2][4][2], const Unit& u, int wr, int wc, int fr, int fq) const {
        const int row0 = u.pm * BM + wr * 64 + fr;
#pragma unroll
        for (int bj = 0; bj < 2; ++bj) {
            const int head = u.pn * 2 + bj; const int d = wc * 32 + 8 * fq;
            bf16_t* base = (d < 64) ? (MK + head * 64 + d) : (MV + head * 64 + d - 64);
#pragma unroll
            for (int ai = 0; ai < 2; ++ai)
#pragma unroll
                for (int m = 0; m < 4; ++m) { const int row = row0 + ai * HALF + m * 16;
                    const f32x4 v0 = acc[ai][bj][m][0], v1 = acc[ai][bj][m][1];
                    u32x4 w; w.x = cvt_pk_bf16(v0[0], v0[1]); w.y = cvt_pk_bf16(v0[2], v0[3]); w.z = cvt_pk_bf16(v1[0], v1[1]); w.w = cvt_pk_bf16(v1[2], v1[3]);
                    *(u32x4*)(base + (size_t)row * 384) = w; }
        }
    }
};
template <class Epi, class Sched, bool ALIGN_EPI = false, bool SP2 = false>
__device__ __forceinline__ void gemm_phase(PG8_LAS unsigned char* lds, const Gemm g, const Sched& S, const Epi& E, const int wave_in) {
    const int tid_l_ = wave_in * 64 + lane_id_asm();
    const int tid = tid_l_, wid = __builtin_amdgcn_readfirstlane(tid >> 6), lane = tid & 63, wr = wid >> 2, wc = wid & 3, fr = lane & 15, fq = lane >> 4;
    const int K = g.K, nt = K / BK;
    unsigned voffA[2], voffB[2];
#pragma unroll
    for (int i = 0; i < 2; ++i) { int R, C; stage_rc(tid * 16 + i * 8192, R, C); const int Rb = Epi::PERM ? ((R & ~31) + perm32(R & 31)) : R;
        voffA[i] = (unsigned)(R * K + C) * 2u; voffB[i] = (unsigned)(Rb * K + C) * 2u; }
    const size_t kstep = (size_t)(BK * 2);
    const size_t hstep = (size_t)HALF * K * 2;
    const size_t tstep = 2 * hstep;
    const unsigned ldsw = (unsigned)wid * 1024u;
    const int aoff = lds_byte(wr * 64 + fr, fq * 8), boff = lds_byte(wc * 32 + fr, fq * 8);
#define PG8_SA(b, h) (((b) * 2 + (h)) * HTB)
#define PG8_SB(b, h) ((4 + (b) * 2 + (h)) * HTB)
#define PG8_STAGE(bufoff, gbase, voff) do { _Pragma("unroll") for (int _i = 0; _i < 2; ++_i) \
        __builtin_amdgcn_global_load_lds((const unsigned*)((const char*)(gbase) + (voff)[_i]), (PG8_LAS unsigned*)(lds + (bufoff) + ldsw + _i * 8192), 16, 0, 0); } while (0)
#define PG8_LDA(dst, b, h) do { _Pragma("unroll") for (int m = 0; m < 4; ++m) _Pragma("unroll") for (int k = 0; k < 2; ++k) dst[m][k] = *(const PG8_LAS bf16x8*)(lds + PG8_SA(b, h) + aoff + m * 2048 + k * 1024); } while (0)
#define PG8_LDB(dst, b, h) do { _Pragma("unroll") for (int n = 0; n < 2; ++n) _Pragma("unroll") for (int k = 0; k < 2; ++k) dst[n][k] = *(const PG8_LAS bf16x8*)(lds + PG8_SB(b, h) + boff + n * 2048 + k * 1024); } while (0)
#define PG8_MMA(ai, bj, At, Bt) do { __builtin_amdgcn_s_setprio(1); _Pragma("unroll") for (int m = 0; m < 4; ++m) _Pragma("unroll") for (int n = 0; n < 2; ++n) _Pragma("unroll") for (int k = 0; k < 2; ++k) \
        acc[ai][bj][m][n] = __builtin_amdgcn_mfma_f32_16x16x32_bf16(Bt[n][k], At[m][k], acc[ai][bj][m][n], 0, 0, 0); __builtin_amdgcn_s_setprio(0); } while (0)
#define PG8_WAIT_V(n) asm volatile("s_waitcnt vmcnt(" #n ")" ::: "memory")
#define PG8_WAIT_L(n) asm volatile("s_waitcnt lgkmcnt(" #n ")" ::: "memory")
#define PG8_BAR __builtin_amdgcn_s_barrier()
#define PG8_SCHED __builtin_amdgcn_sched_barrier(0)
    Unit cur, nxt; int ui = 0;
    if (!S.next(0, cur)) return;
    f32x4 acc[2][2][4][2];
#pragma unroll
    for (int a = 0; a < 2; ++a)
#pragma unroll
        for (int b = 0; b < 2; ++b)
#pragma unroll
            for (int m = 0; m < 4; ++m)
#pragma unroll
                for (int n = 0; n < 2; ++n) acc[a][b][m][n] = (f32x4){0.f, 0.f, 0.f, 0.f};
    bf16x8 At[4][2], B0[2][2], B1[2][2];
    const char* cA = (const char*)g.A + (size_t)cur.pm * tstep; const char* cB = (const char*)g.Bt + (size_t)cur.pn * tstep;
    S.a_ready(cur);
    if constexpr (SP2) {
        PG8_STAGE(PG8_SB(0, 0), cB, voffB); PG8_STAGE(PG8_SB(0, 1), cB + hstep, voffB); PG8_STAGE(PG8_SA(0, 0), cA, voffA); PG8_STAGE(PG8_SA(0, 1), cA + hstep, voffA);
        if (wr == 1) PG8_BAR;
        PG8_WAIT_V(2); PG8_BAR;
        PG8_STAGE(PG8_SB(1, 0), cB + kstep, voffB); PG8_STAGE(PG8_SA(1, 0), cA + kstep, voffA); PG8_STAGE(PG8_SB(1, 1), cB + hstep + kstep, voffB);
        PG8_WAIT_V(6); PG8_BAR;
    } else {
        PG8_STAGE(PG8_SB(0, 0), cB, voffB); PG8_STAGE(PG8_SA(0, 0), cA, voffA); PG8_STAGE(PG8_SB(0, 1), cB + hstep, voffB); PG8_STAGE(PG8_SA(0, 1), cA + hstep, voffA);
        if (wr == 1) PG8_BAR;
        PG8_WAIT_V(4); PG8_BAR;
        PG8_STAGE(PG8_SB(1, 0), cB + kstep, voffB); PG8_STAGE(PG8_SA(1, 0), cA + kstep, voffA); PG8_STAGE(PG8_SB(1, 1), cB + hstep + kstep, voffB);
        PG8_WAIT_V(6); PG8_BAR;
    }
    for (;;) {
        const bool has_next = S.next(ui + 1, nxt);
        const char* nA = has_next ? (const char*)g.A + (size_t)nxt.pm * tstep : cA; const char* nB = has_next ? (const char*)g.Bt + (size_t)nxt.pn * tstep : cB;
        for (int t = 0; t < nt; t += 2) {
            const bool last = (t == nt - 2);
            const char* a1 = cA + (size_t)(t + 1) * kstep;
            const char* a2 = last ? nA : cA + (size_t)(t + 2) * kstep; const char* b2 = last ? nB : cB + (size_t)(t + 2) * kstep;
            const char* a3 = a2 + kstep; const char* b3 = b2 + kstep;
            if (last && has_next) S.a_ready(nxt);
            if constexpr (SP2) {
            PG8_LDB(B0, 0, 0); PG8_LDB(B1, 0, 1); PG8_SCHED; PG8_LDA(At, 0, 0); PG8_STAGE(PG8_SA(1, 1), a1 + hstep, voffA);
            PG8_WAIT_V(8); PG8_WAIT_L(0); PG8_BAR; PG8_MMA(0, 0, At, B0); PG8_MMA(0, 1, At, B1); PG8_BAR; PG8_SCHED;
            PG8_LDA(At, 0, 1); PG8_STAGE(PG8_SB(0, 0), b2, voffB); PG8_STAGE(PG8_SB(0, 1), b2 + hstep, voffB); PG8_STAGE(PG8_SA(0, 0), a2, voffA);
            PG8_WAIT_V(8); PG8_WAIT_L(0); PG8_BAR; PG8_MMA(1, 0, At, B0); PG8_MMA(1, 1, At, B1); PG8_BAR; PG8_SCHED;
            PG8_LDB(B0, 1, 0); PG8_LDB(B1, 1, 1); PG8_SCHED; PG8_LDA(At, 1, 0); PG8_STAGE(PG8_SA(0, 1), a2 + hstep, voffA);
            PG8_WAIT_V(8); PG8_WAIT_L(0); PG8_BAR; PG8_MMA(0, 0, At, B0); PG8_MMA(0, 1, At, B1); PG8_BAR; PG8_SCHED;
            PG8_LDA(At, 1, 1); PG8_STAGE(PG8_SB(1, 0), b3, voffB); PG8_STAGE(PG8_SB(1, 1), b3 + hstep, voffB); PG8_STAGE(PG8_SA(1, 0), a3, voffA);
            PG8_WAIT_V(8); PG8_WAIT_L(0); PG8_BAR; PG8_MMA(1, 0, At, B0); PG8_MMA(1, 1, At, B1); PG8_BAR; PG8_SCHED;
            } else {
            PG8_LDB(B0, 0, 0); PG8_SCHED; PG8_LDA(At, 0, 0); PG8_STAGE(PG8_SA(1, 1), a1 + hstep, voffA);
            PG8_WAIT_L(8); PG8_BAR; PG8_WAIT_L(0); PG8_MMA(0, 0, At, B0); PG8_BAR; PG8_SCHED;
            PG8_LDB(B1, 0, 1); PG8_STAGE(PG8_SB(0, 0), b2, voffB);
            PG8_BAR; PG8_WAIT_L(0); PG8_MMA(0, 1, At, B1); PG8_BAR;
            PG8_LDA(At, 0, 1); PG8_STAGE(PG8_SA(0, 0), a2, voffA);
            PG8_BAR; PG8_WAIT_L(0); PG8_MMA(1, 0, At, B0); PG8_BAR; PG8_SCHED;
            PG8_STAGE(PG8_SB(0, 1), b2 + hstep, voffB);
            PG8_WAIT_V(6); PG8_BAR; PG8_MMA(1, 1, At, B1); PG8_BAR;
            PG8_LDB(B0, 1, 0); PG8_SCHED; PG8_LDA(At, 1, 0); PG8_STAGE(PG8_SA(0, 1), a2 + hstep, voffA);
            PG8_WAIT_L(8); PG8_BAR; PG8_WAIT_L(0); PG8_MMA(0, 0, At, B0); PG8_BAR; PG8_SCHED;
            PG8_LDB(B1, 1, 1); PG8_STAGE(PG8_SB(1, 0), b3, voffB);
            PG8_BAR; PG8_WAIT_L(0); PG8_MMA(0, 1, At, B1); PG8_BAR;
            PG8_LDA(At, 1, 1); PG8_STAGE(PG8_SA(1, 0), a3, voffA);
            PG8_BAR; PG8_WAIT_L(0); PG8_MMA(1, 0, At, B0); PG8_BAR; PG8_SCHED;
            PG8_STAGE(PG8_SB(1, 1), b3 + hstep, voffB);
            PG8_WAIT_V(6); PG8_BAR; PG8_MMA(1, 1, At, B1); PG8_BAR;
            }
        }
        if constexpr (ALIGN_EPI) { if (wr == 0) PG8_BAR; }
        if constexpr (!Epi::AFTER_DRAIN) { const int le_ = lane_id_asm(); E(acc, cur, wr, wc, le_ & 15, le_ >> 4); S.done(cur); }
        if (!has_next) break;
#pragma unroll
        for (int a = 0; a < 2; ++a)
#pragma unroll
            for (int b = 0; b < 2; ++b)
#pragma unroll
                for (int m = 0; m < 4; ++m)
#pragma unroll
                    for (int n = 0; n < 2; ++n) acc[a][b][m][n] = (f32x4){0.f, 0.f, 0.f, 0.f};
        cur = nxt; cA = nA; cB = nB; ++ui;
        if constexpr (ALIGN_EPI) { if (wr == 1) PG8_BAR; }
    }
    PG8_WAIT_V(0);
    if constexpr (!ALIGN_EPI) { if (wr == 0) PG8_BAR; }
    PG8_BAR;
    if constexpr (Epi::AFTER_DRAIN) { E.fused(acc, cur, wr, wc, fr, fq, lds, wid, lane); S.done(cur); }
#undef PG8_SA
#undef PG8_SB
#undef PG8_STAGE
#undef PG8_LDA
#undef PG8_LDB
#undef PG8_MMA
#undef PG8_WAIT_V
#undef PG8_WAIT_L
#undef PG8_BAR
#undef PG8_SCHED
}
}

namespace att {
typedef unsigned short bf16_t;
using bf16x8 = __attribute__((ext_vector_type(8))) short;
using s16x4  = __attribute__((ext_vector_type(4))) short;
using f32x16 = __attribute__((ext_vector_type(16))) float;
using u32x4  = __attribute__((ext_vector_type(4))) unsigned;
constexpr int NW = 8, QBLK = 32, KVBLK = 64;
constexpr float THR = 8.f;
constexpr int SHM_V = 16384, SHM_K = 16384;
#define KSWZ(row, colB) ((row) * 256 + ((colB) ^ (((row) & 7) << 4)))
#define SBAR() __builtin_amdgcn_sched_barrier(0)
__device__ __forceinline__ int crow(int r, int hi) { return (r & 3) + 8 * (r >> 2) + 4 * hi; }
__device__ __forceinline__ unsigned cvtpk(float lo, float hi) { unsigned r; asm volatile("v_cvt_pk_bf16_f32 %0, %1, %2" : "=v"(r) : "v"(lo), "v"(hi)); return r; }

template <int DQ> __device__ __forceinline__ void partialSM(f32x16& p0, f32x16& p1, float& m_reg, float& mn, float& alpha) {
  constexpr float SCALE = (DQ == 96) ? 0.10206207261596575f : 0.125f;
  constexpr float C = SCALE * 1.4426950408889634f;
  float pmax = p0[0];
#pragma unroll
  for (int r = 1; r < 16; ++r) pmax = fmaxf(pmax, p0[r]);
#pragma unroll
  for (int r = 0; r < 16; ++r) pmax = fmaxf(pmax, p1[r]);
  { auto rr = __builtin_amdgcn_permlane32_swap(__float_as_uint(pmax), __float_as_uint(pmax), false, false);
    pmax = fmaxf(__uint_as_float(rr[0]), __uint_as_float(rr[1])); }
  if (__builtin_expect(__all(pmax - m_reg <= THR / SCALE), 1)) { mn = m_reg; alpha = 1.f; }
  else { mn = fmaxf(m_reg, pmax); alpha = __builtin_amdgcn_exp2f((m_reg - mn) * C); m_reg = mn; }
  float mnC = -mn * C;
#pragma unroll
  for (int r = 0; r < 16; ++r) p0[r] = fmaf(p0[r], C, mnC);
#pragma unroll
  for (int r = 0; r < 16; ++r) p1[r] = fmaf(p1[r], C, mnC);
#pragma unroll
  for (int r = 0; r < 16; ++r) p0[r] = __builtin_amdgcn_exp2f(p0[r]);
}
__device__ __forceinline__ void finishSM(f32x16& p0, f32x16& p1, float alpha, float& l_reg, bf16x8& pa0, bf16x8& pa1, bf16x8& pa2, bf16x8& pa3) {
#pragma unroll
  for (int r = 0; r < 16; ++r) p1[r] = __builtin_amdgcn_exp2f(p1[r]);
  float ps = 0;
#pragma unroll
  for (int r = 0; r < 16; ++r) ps += p0[r];
#pragma unroll
  for (int r = 0; r < 16; ++r) ps += p1[r];
  { auto rr = __builtin_amdgcn_permlane32_swap(__float_as_uint(ps), __float_as_uint(ps), false, false);
    ps = __uint_as_float(rr[0]) + __uint_as_float(rr[1]); }
  l_reg = l_reg * alpha + ps;
#define PK4(P, BASE, OUT) do { unsigned a0 = cvtpk(P[BASE + 0], P[BASE + 1]), a1 = cvtpk(P[BASE + 2], P[BASE + 3]);   \
    unsigned b0 = cvtpk(P[BASE + 4], P[BASE + 5]), b1 = cvtpk(P[BASE + 6], P[BASE + 7]);                              \
    auto r0 = __builtin_amdgcn_permlane32_swap(a0, b0, false, false); auto r1 = __builtin_amdgcn_permlane32_swap(a1, b1, false, false); \
    u32x4 w = {r0[0], r1[0], r0[1], r1[1]}; OUT = *reinterpret_cast<bf16x8*>(&w); } while (0)
  PK4(p0, 0, pa0); PK4(p0, 8, pa1); PK4(p1, 0, pa2); PK4(p1, 8, pa3);
#undef PK4
}
template <int DQ> __device__ __forceinline__ void qkt(f32x16& p0, f32x16& p1, const char* Ks, const bf16x8* qr, int r32, int hi) {
  p0 = f32x16{}; p1 = f32x16{};
#pragma unroll
  for (int d0 = 0; d0 < DQ / 16; ++d0) { int cb = (d0 * 16 + hi * 8) * 2;
    bf16x8 b0 = *reinterpret_cast<const bf16x8*>(Ks + KSWZ(r32, cb));
    bf16x8 b1 = *reinterpret_cast<const bf16x8*>(Ks + KSWZ(32 + r32, cb));
    p0 = __builtin_amdgcn_mfma_f32_32x32x16_bf16(b0, qr[d0], p0, 0, 0, 0);
    p1 = __builtin_amdgcn_mfma_f32_32x32x16_bf16(b1, qr[d0], p1, 0, 0, 0); }
}
__device__ __forceinline__ int v_st(int k, int c) { const int kk = (k & ~0xC) | ((k & 4) << 1) | ((k & 8) >> 1); return ((kk >> 3) * 4 + (c >> 5)) * 512 + ((kk & 7) * 32 + (c & 31)) * 2; }
__device__ __forceinline__ int v_rd_base(int lane) { return ((lane & 3) << 3) | (((lane >> 2) & 3) << 6) | (((lane >> 4) & 1) << 5) | (((lane >> 5) & 1) << 8); }
constexpr int v_rd_off(int d0, int ks, int half) { return d0 * 512 + ks * 4096 + half * 2048; }
template <int OFF> __device__ __forceinline__ s16x4 tr_read(int vb) {
  s16x4 r; asm volatile("ds_read_b64_tr_b16 %0, %1 offset:%2" : "=&v"(r) : "v"(vb), "i"(OFF) : "memory"); return r;
}
template <int D0> __device__ __forceinline__ void pv_one(f32x16& od, int vb, bf16x8 pa0, bf16x8 pa1, bf16x8 pa2, bf16x8 pa3) {
  const s16x4 l0 = tr_read<v_rd_off(D0, 0, 0)>(vb), h0 = tr_read<v_rd_off(D0, 0, 1)>(vb), l1 = tr_read<v_rd_off(D0, 1, 0)>(vb), h1 = tr_read<v_rd_off(D0, 1, 1)>(vb);
  const s16x4 l2 = tr_read<v_rd_off(D0, 2, 0)>(vb), h2 = tr_read<v_rd_off(D0, 2, 1)>(vb), l3 = tr_read<v_rd_off(D0, 3, 0)>(vb), h3 = tr_read<v_rd_off(D0, 3, 1)>(vb);
  asm volatile("s_waitcnt lgkmcnt(0)" ::: "memory"); SBAR();
#define PK(L, H) (bf16x8){L[0], L[1], L[2], L[3], H[0], H[1], H[2], H[3]}
  od = __builtin_amdgcn_mfma_f32_32x32x16_bf16(pa0, PK(l0, h0), od, 0, 0, 0);
  od = __builtin_amdgcn_mfma_f32_32x32x16_bf16(pa1, PK(l1, h1), od, 0, 0, 0);
  od = __builtin_amdgcn_mfma_f32_32x32x16_bf16(pa2, PK(l2, h2), od, 0, 0, 0);
  od = __builtin_amdgcn_mfma_f32_32x32x16_bf16(pa3, PK(l3, h3), od, 0, 0, 0);
#undef PK
}
__device__ __forceinline__ void pv_d0(f32x16* o, int vb, bf16x8 pa0, bf16x8 pa1, bf16x8 pa2, bf16x8 pa3) {
  pv_one<0>(o[0], vb, pa0, pa1, pa2, pa3); pv_one<1>(o[1], vb, pa0, pa1, pa2, pa3);
}

template <int DQ>
__device__ __forceinline__ void attn_unit(const bf16_t* __restrict__ Qb, const bf16_t* __restrict__ Kh, const bf16_t* __restrict__ Kpe, const bf16_t* __restrict__ Vh,
                                          bf16_t* __restrict__ Ob, int seq, char* lds, const int wave_in) {
  constexpr int LDQ = (DQ == 96) ? 576 : 384, LDK = (DQ == 96) ? 384 : 128, LDO = 1024, ND = DQ / 16;
  const int tid = wave_in * 64 + pg8::lane_id_asm(), wid = wave_in, lane = tid & 63, r32 = lane & 31, hi = lane >> 5;
  char* V_lds = lds; char* K_lds = lds + 2 * SHM_V;
  float* ws = (float*)(lds + 2 * SHM_V + 2 * SHM_K) + wid * 64; float* li_l = ws; float* al_l = ws + 32;
  float m_reg = -1e30f, l_reg = 0; f32x16 o[2] = {}; bf16x8 qr[ND];
  const bf16_t* Qw = Qb + (unsigned)((wid * QBLK + r32) * LDQ + hi * 8);
#pragma unroll
  for (int d0 = 0; d0 < ND; ++d0) qr[d0] = *reinterpret_cast<const bf16x8*>(Qw + d0 * 16);
  const int sr = tid >> 3, sc = (tid & 7) * 8;
  const int pr = (tid >> 2) & 63, pc = (tid & 3) * 8;
  const int vst = v_st(sr, sc), kst = KSWZ(sr, sc * 2), pst = KSWZ(pr, (64 + pc) * 2);
  const int vb0 = (int)(uintptr_t)V_lds + v_rd_base(lane);
  struct { bf16x8 vs, ks, ps; } sr_[2];
  const unsigned voff = (unsigned)(sr * LDK + sc), poff = (unsigned)(pr * 32 + pc);
#define SLOAD(i, k0) do { const bf16_t* Vt_ = Vh + (size_t)(k0) * LDK; const bf16_t* Kt_ = Kh + (size_t)(k0) * LDK; \
    sr_[i].vs = *reinterpret_cast<const bf16x8*>(Vt_ + voff); sr_[i].ks = *reinterpret_cast<const bf16x8*>(Kt_ + voff); \
    if constexpr (DQ == 96) { const bf16_t* Pt_ = Kpe + (size_t)(k0) * 32; sr_[i].ps = *reinterpret_cast<const bf16x8*>(Pt_ + poff); } } while (0)
#define SWRITE(b, i) do { *(bf16x8*)(V_lds + (b) * SHM_V + vst) = sr_[i].vs; *(bf16x8*)(K_lds + (b) * SHM_K + kst) = sr_[i].ks; \
    if constexpr (DQ == 96) { if (tid < 256) *(bf16x8*)(K_lds + (b) * SHM_K + pst) = sr_[i].ps; } } while (0)
#define SWAIT() do { if constexpr (DQ == 96) asm volatile("s_waitcnt vmcnt(3)" ::: "memory"); else asm volatile("s_waitcnt vmcnt(2)" ::: "memory"); } while (0)
#define RESC(a) do { if (__any((a) < 1.f)) { if (hi == 0) al_l[r32] = (a); asm volatile("s_waitcnt lgkmcnt(0)" ::: "memory"); \
    _Pragma("unroll") for (int d = 0; d < 2; ++d) _Pragma("unroll") for (int r = 0; r < 16; ++r) o[d][r] *= al_l[crow(r, hi)]; } } while (0)
  f32x16 pA0, pA1, pB0, pB1; float mnA, mnB, alA, alB; bf16x8 pa0, pa1, pa2, pa3; const int NT = seq / KVBLK;
  constexpr int SE = 0, SO = 1;
  SLOAD(SE, 0); asm volatile("s_waitcnt vmcnt(0)" ::: "memory"); SWRITE(0, SE); __syncthreads();
  qkt<DQ>(pA0, pA1, K_lds, qr, r32, hi); partialSM<DQ>(pA0, pA1, m_reg, mnA, alA);
  SLOAD(SO, KVBLK); if (2 < NT) SLOAD(SE, 2 * KVBLK);
  SWAIT(); SWRITE(1, SO); __syncthreads();
  for (int j = 1; j + 1 < NT; j += 2) {
    SBAR(); qkt<DQ>(pB0, pB1, K_lds + SHM_K, qr, r32, hi);
    finishSM(pA0, pA1, alA, l_reg, pa0, pa1, pa2, pa3); SBAR();
    SLOAD(SO, (j + 2) * KVBLK); SBAR();
    pv_d0(o, vb0, pa0, pa1, pa2, pa3); partialSM<DQ>(pB0, pB1, m_reg, mnB, alB);
    __syncthreads(); SWAIT(); SWRITE(0, SE);
    RESC(alB); __syncthreads();
    SBAR(); qkt<DQ>(pA0, pA1, K_lds, qr, r32, hi);
    finishSM(pB0, pB1, alB, l_reg, pa0, pa1, pa2, pa3); SBAR();
    if (j + 3 < NT) SLOAD(SE, (j + 3) * KVBLK); SBAR();
    pv_d0(o, vb0 + SHM_V, pa0, pa1, pa2, pa3); partialSM<DQ>(pA0, pA1, m_reg, mnA, alA);
    __syncthreads(); SWAIT(); SWRITE(1, SO);
    RESC(alA); __syncthreads();
  }
  SBAR(); qkt<DQ>(pB0, pB1, K_lds + SHM_K, qr, r32, hi);
  finishSM(pA0, pA1, alA, l_reg, pa0, pa1, pa2, pa3); SBAR();
  pv_d0(o, vb0, pa0, pa1, pa2, pa3); partialSM<DQ>(pB0, pB1, m_reg, mnB, alB);
  __syncthreads(); RESC(alB);
  finishSM(pB0, pB1, alB, l_reg, pa0, pa1, pa2, pa3); SBAR();
  pv_d0(o, vb0 + SHM_V, pa0, pa1, pa2, pa3);
  if (hi == 0) li_l[r32] = l_reg; asm volatile("s_waitcnt lgkmcnt(0)" ::: "memory");
  float rli[16];
#pragma unroll
  for (int r = 0; r < 16; ++r) rli[r] = __builtin_amdgcn_rcpf(li_l[crow(r, hi)]);
  bf16_t* Ow = Ob + (long)(wid * QBLK) * LDO;
#pragma unroll
  for (int r = 0; r < 16; ++r) { int orow = crow(r, hi);
#pragma unroll
    for (int d0 = 0; d0 < 2; ++d0) { const float v = o[d0][r] * rli[r]; Ow[(long)orow * LDO + d0 * 32 + r32] = (bf16_t)(cvtpk(v, v) & 0xffffu); } }
  __syncthreads();
#undef SLOAD
#undef SWRITE
#undef SWAIT
#undef RESC
}
#undef SBAR
}

typedef unsigned short bf16_t;
typedef float f32x4 __attribute__((ext_vector_type(4)));
typedef float f32x2 __attribute__((ext_vector_type(2)));
typedef unsigned u32x2 __attribute__((ext_vector_type(2)));
typedef unsigned u32x4 __attribute__((ext_vector_type(4)));
#define LAS __attribute__((address_space(3)))
constexpr size_t MiB = 1u << 20;
constexpr size_t WS_MOD = 1 * MiB, WS_ROPEM = 2 * MiB, WS_ROPEG = 3 * MiB, WS_Z = 5 * MiB;
constexpr size_t WS_WIN = 10 * MiB, WS_WUQ = 26 * MiB, WS_WUKV = 28 * MiB, WS_WO = 29 * MiB, WS_W1 = 37 * MiB, WS_W2 = 69 * MiB;
constexpr size_t WS_U = 101 * MiB, WS_Y = 167 * MiB, WS_OV = 233 * MiB;
constexpr size_t WS_HM = WS_OV, WS_H = WS_OV, WS_MQ = WS_OV, WS_MK = 271 * MiB, WS_MV = 296 * MiB;
constexpr size_t WS_CKV = 365 * MiB, WS_CQ = 374 * MiB, WS_KPE = 391 * MiB, WS_GK = 394 * MiB, WS_GV = 403 * MiB, WS_GQ = 412 * MiB, WS_O = 437 * MiB, WS_END = 503 * MiB;
static_assert(WS_MQ + (size_t)MROWS * 576 * 2 <= WS_MK && WS_MK + (size_t)MROWS * 384 * 2 <= WS_MV && WS_MV + (size_t)MROWS * 384 * 2 <= WS_H + (size_t)MROWS * HP * 2, "overlay");
static_assert(WS_H + (size_t)MROWS * HP * 2 <= WS_CKV && WS_CKV + (size_t)MROWS * 256 <= WS_CQ && WS_CQ + (size_t)MROWS * 512 <= WS_KPE && WS_KPE + (size_t)MROWS * 64 <= WS_GK, "map1");
static_assert(WS_GK + (size_t)MROWS * 256 <= WS_GV && WS_GV + (size_t)MROWS * 256 <= WS_GQ && WS_GQ + (size_t)MROWS * 768 <= WS_O && WS_O + (size_t)MROWS * 2048 <= WS_END, "map2");
static_assert(WS_HM + (size_t)MROWS * DFF * 2 <= WS_END, "map3");
constexpr int LDS_BYTES = 135168;

struct Params { const float* in[21]; float* out; unsigned char* ws; };
enum { I_X = 0, I_C, I_CTX, I_CCTX, I_WADA, I_BADA, I_WIN, I_GCQ, I_WUQ, I_GCKV, I_WUKV, I_GQN, I_GKN, I_WCONV, I_WO, I_LN1G, I_LN1B, I_W1, I_W2, I_LN2G, I_LN2B };

__device__ __forceinline__ float shx(float v, int lane, int o) { return __int_as_float(__builtin_amdgcn_ds_bpermute((lane ^ o) << 2, __float_as_int(v))); }
__device__ __forceinline__ float wave_sum(float v, int lane) {
#pragma unroll
    for (int o = 1; o < 64; o <<= 1) v += shx(v, lane, o);
    return v;
}
__device__ __forceinline__ float half_sum(float v, int lane) {
#pragma unroll
    for (int o = 1; o < 32; o <<= 1) v += shx(v, lane, o);
    return v;
}
__device__ __forceinline__ unsigned pk2(float lo, float hi) { unsigned r; asm volatile("v_cvt_pk_bf16_f32 %0, %1, %2" : "=v"(r) : "v"(lo), "v"(hi)); return r; }
__device__ __forceinline__ float bflo(unsigned w) { return __uint_as_float(w << 16); }
__device__ __forceinline__ float bfhi(unsigned w) { return __uint_as_float(w & 0xffff0000u); }

__device__ __forceinline__ void transpose_item(const float* W, int K, int N, bf16_t* WT, LAS float* scr, int item, int lane) {
    const int nblk = N / 32, kb = item / nblk, nb = item % nblk, k0 = 64 * kb, n0 = 32 * nb;
#pragma unroll 8
    for (int i = 0; i < 32; ++i) { const int kk = 2 * i + (lane >> 5); scr[kk * 33 + (lane & 31)] = W[(size_t)(k0 + kk) * N + n0 + (lane & 31)]; }
    asm volatile("s_waitcnt lgkmcnt(0)" ::: "memory");
    const int c = lane & 7;
#pragma unroll
    for (int j = 0; j < 4; ++j) { const int n = (lane >> 3) + 8 * j; const LAS float* s = scr + (8 * c) * 33 + n;
        u32x4 o; o.x = pk2(s[0 * 33], s[1 * 33]); o.y = pk2(s[2 * 33], s[3 * 33]); o.z = pk2(s[4 * 33], s[5 * 33]); o.w = pk2(s[6 * 33], s[7 * 33]);
        *(u32x4*)(WT + (size_t)(n0 + n) * K + k0 + 8 * c) = o; }
    asm volatile("s_waitcnt lgkmcnt(0)" ::: "memory");
}

struct RowInfo { int b, i, v; bool isctx; };
__device__ __forceinline__ RowInfo row_info(int m) { RowInfo r; r.b = m / LTOK; r.i = m - r.b * LTOK; r.isctx = r.i < CTX; r.v = r.isctx ? 4 : r.b; return r; }

__global__ void __launch_bounds__(512, 2) fwd_megakernel(Params p) {
    extern __shared__ __attribute__((aligned(16))) unsigned char lds[];
    cg::grid_group grid = cg::this_grid();
    const int wave = __builtin_amdgcn_readfirstlane(threadIdx.x >> 6);
    const int G = gridDim.x, bx = blockIdx.x;
    const int vcu = (G % 8 == 0) ? (bx % 8) * (G / 8) + bx / 8 : bx;
    const int gw = bx * 8 + wave, NGW = G * 8;
#define KP() ({ const __attribute__((address_space(4))) Params* k_ = (const __attribute__((address_space(4))) Params*)__builtin_amdgcn_kernarg_segment_ptr(); asm volatile("" : "+s"(k_)); k_; })
#define WSB() ((unsigned char*)KP()->ws)
#define DEFWS(w) \
    float* MOD = (float*)((w) + WS_MOD); float* ROPEM = (float*)((w) + WS_ROPEM); float* ROPEG = (float*)((w) + WS_ROPEG); float* Z = (float*)((w) + WS_Z); \
    bf16_t* WIN = (bf16_t*)((w) + WS_WIN); bf16_t* WUQ = (bf16_t*)((w) + WS_WUQ); bf16_t* WUKV = (bf16_t*)((w) + WS_WUKV); bf16_t* WO = (bf16_t*)((w) + WS_WO); \
    bf16_t* W1 = (bf16_t*)((w) + WS_W1); bf16_t* W2 = (bf16_t*)((w) + WS_W2); \
    bf16_t* U = (bf16_t*)((w) + WS_U); bf16_t* Y = (bf16_t*)((w) + WS_Y); bf16_t* HM = (bf16_t*)((w) + WS_HM); bf16_t* H = (bf16_t*)((w) + WS_H); \
    bf16_t* MQ = (bf16_t*)((w) + WS_MQ); bf16_t* MK = (bf16_t*)((w) + WS_MK); bf16_t* MV = (bf16_t*)((w) + WS_MV); \
    bf16_t* CKV = (bf16_t*)((w) + WS_CKV); bf16_t* CQ = (bf16_t*)((w) + WS_CQ); bf16_t* KPE = (bf16_t*)((w) + WS_KPE); \
    bf16_t* GK = (bf16_t*)((w) + WS_GK); bf16_t* GV = (bf16_t*)((w) + WS_GV); bf16_t* GQ = (bf16_t*)((w) + WS_GQ); bf16_t* OC = (bf16_t*)((w) + WS_O); \
    (void)MOD; (void)ROPEM; (void)ROPEG; (void)Z; (void)WIN; (void)WUQ; (void)WUKV; (void)WO; (void)W1; (void)W2; (void)U; (void)Y; (void)HM; (void)H; (void)MQ; (void)MK; (void)MV; \
    (void)CKV; (void)CQ; (void)KPE; (void)GK; (void)GV; (void)GQ; (void)OC;

    {
        DEFWS(WSB())
        const int lane = pg8::lane_id_asm(), tid = wave * 64 + lane;
        LAS float* scr = (LAS float*)((LAS unsigned char*)lds + wave * 16384);
        constexpr int I_IN = 16 * 57, I_UQ = 4 * 18, I_UKV = 2 * 24, I_O = 16 * 32, I_1 = 16 * 128, I_2 = 64 * 32, PER = I_IN + I_UQ + I_UKV + I_O + I_1 + I_2;
        for (int it = gw; it < DEPTH * PER; it += NGW) {
            const int l = it / PER; int r = it - l * PER;
            if (r < I_IN) { transpose_item(KP()->in[I_WIN] + (size_t)l * DM * IN_COLS, DM, IN_COLS, WIN + (size_t)l * HP * DM, scr, r, lane); continue; } r -= I_IN;
            if (r < I_UQ) { transpose_item(KP()->in[I_WUQ] + (size_t)l * 256 * 576, 256, 576, WUQ + (size_t)l * 768 * 256, scr, r, lane); continue; } r -= I_UQ;
            if (r < I_UKV) { transpose_item(KP()->in[I_WUKV] + (size_t)l * 128 * 768, 128, 768, WUKV + (size_t)l * 768 * 128, scr, r, lane); continue; } r -= I_UKV;
            if (r < I_O) { transpose_item(KP()->in[I_WO] + (size_t)l * DM * DM, DM, DM, WO + (size_t)l * DM * DM, scr, r, lane); continue; } r -= I_O;
            if (r < I_1) { transpose_item(KP()->in[I_W1] + (size_t)l * DM * DFF, DM, DFF, W1 + (size_t)l * DFF * DM, scr, r, lane); continue; } r -= I_1;
            transpose_item(KP()->in[I_W2] + (size_t)l * DFF * DM, DFF, DM, W2 + (size_t)l * DM * DFF, scr, r, lane);
        }
        const int gt = bx * 512 + tid, NGT = G * 512;
        for (int idx = gt; idx < DEPTH * 224 * 128; idx += NGT) { const int l = idx / (224 * 128), r = idx % (224 * 128);
            *(u32x4*)(WIN + ((size_t)l * HP + IN_COLS) * DM + (size_t)r * 8) = (u32x4){0u, 0u, 0u, 0u}; }
        for (int idx = gt; idx < DEPTH * 192 * 32; idx += NGT) { const int l = idx / (192 * 32), r = idx % (192 * 32);
            *(u32x4*)(WUQ + ((size_t)l * 768 + 576) * 256 + (size_t)r * 8) = (u32x4){0u, 0u, 0u, 0u}; }
        for (int idx = gt; idx < SEQ * 16; idx += NGT) { const int pos = idx >> 4, i = idx & 15; const int rw = pos >> 6, cl = pos & 63;
            const float inv = powf(10000.f, -(float)(i & 7) / 8.f); const float ang = (float)(i < 8 ? rw : cl) * inv;
            ROPEM[2 * idx] = cosf(ang); ROPEM[2 * idx + 1] = sinf(ang); }
        for (int idx = gt; idx < SEQ * 32; idx += NGT) { const int pos = idx >> 5, i = idx & 31; const int rw = pos >> 6, cl = pos & 63;
            const float inv = powf(10000.f, -(float)(i & 15) / 16.f); const float ang = (float)(i < 16 ? rw : cl) * inv;
            ROPEG[2 * idx] = cosf(ang); ROPEG[2 * idx + 1] = sinf(ang); }
        __syncthreads();
        float* sil = (float*)lds;
        float* part = (float*)lds + 5 * 1024;
        { const float* c_in = KP()->in[I_C]; const float* cc_in = KP()->in[I_CCTX];
        for (int idx = tid; idx < 5 * 1024; idx += 512) { const int v = idx >> 10, k = idx & 1023; const float c = (v < 4) ? c_in[v * 1024 + k] : cc_in[k]; sil[idx] = c / (1.f + __expf(-c)); } }
        const float* wada_ = KP()->in[I_WADA]; const float* bada_ = KP()->in[I_BADA];
        __syncthreads();
        for (int it = bx; it < DEPTH * 96; it += G) { const int l = it / 96, jb = it % 96; const int j = jb * 64 + lane;
            const float* wp = wada_ + ((size_t)l * DM + wave * 128) * 6144 + j;
            float a0 = 0, a1 = 0, a2 = 0, a3 = 0, a4 = 0;
#pragma unroll 8
            for (int k = 0; k < 128; ++k) { const float w = wp[(size_t)k * 6144]; const int kk = wave * 128 + k;
                a0 += sil[kk] * w; a1 += sil[1024 + kk] * w; a2 += sil[2048 + kk] * w; a3 += sil[3072 + kk] * w; a4 += sil[4096 + kk] * w; }
            part[(wave * 5 + 0) * 64 + lane] = a0; part[(wave * 5 + 1) * 64 + lane] = a1; part[(wave * 5 + 2) * 64 + lane] = a2; part[(wave * 5 + 3) * 64 + lane] = a3; part[(wave * 5 + 4) * 64 + lane] = a4;
            __syncthreads();
            if (tid < 320) { const int v = tid >> 6, c = tid & 63; float s = bada_[l * 6144 + jb * 64 + c];
#pragma unroll
                for (int w = 0; w < 8; ++w) s += part[(w * 5 + v) * 64 + c];
                MOD[((size_t)l * 5 + v) * 6144 + jb * 64 + c] = s; }
            __syncthreads();
        }
    }
    grid.sync();
    { DEFWS(WSB())
    const int lane = pg8::lane_id_asm(); const float* xin_ = KP()->in[I_X]; const float* cin_ = KP()->in[I_CTX];
    for (int m = gw; m < MROWS; m += NGW) { const RowInfo ri = row_info(m);
        const float* xr = ri.isctx ? cin_ + ((size_t)ri.b * CTX + ri.i) * DM : xin_ + ((size_t)ri.b * SEQ + ri.i - CTX) * DM;
        const float* md = MOD + (size_t)ri.v * 6144;
#pragma unroll
        for (int j = 0; j < 4; ++j) { const int col = 4 * lane + 256 * j; const f32x4 x = *(const f32x4*)(xr + col), sh = *(const f32x4*)(md + col), sc = *(const f32x4*)(md + 1024 + col);
            const f32x4 u = x * (1.f + sc) + sh; u32x2 w; w.x = pk2(u[0], u[1]); w.y = pk2(u[2], u[3]); *(u32x2*)(U + (size_t)m * DM + col) = w; }
    } }
    grid.sync();

#pragma unroll 1
    for (int l = 0; l < DEPTH; ++l) {
        { DEFWS(WSB()) pg8::Gemm g{U, WIN + (size_t)l * HP * DM, MROWS, HP, DM}; pg8::StaticOrder S; S.init(MROWS, HP, G, bx);
          pg8::EpiStore<0> E{H, HP};
          pg8::gemm_phase<pg8::EpiStore<0>, pg8::StaticOrder, true, true>((LAS unsigned char*)lds, g, S, E, wave); }
        grid.sync();
        {
            DEFWS(WSB())
            const int lane = pg8::lane_id_asm();
            const f32x2* gckv = (const f32x2*)(KP()->in[I_GCKV] + l * 128); const f32x2* gkn = (const f32x2*)(KP()->in[I_GKN] + l * 64);
            const f32x2* gcq = (const f32x2*)(KP()->in[I_GCQ] + l * 256); const f32x2* gqn = (const f32x2*)(KP()->in[I_GQN] + l * 64);
            const f32x2* wc0 = (const f32x2*)(KP()->in[I_WCONV] + (size_t)l * 768); const f32x2* wc1 = wc0 + 128; const f32x2* wc2 = wc0 + 256;
            const f32x2* rM = (const f32x2*)ROPEM; const f32x2* rG = (const f32x2*)ROPEG;
            for (int m = gw; m < MROWS; m += NGW) { const RowInfo ri = row_info(m); const bool lat = !ri.isctx; const int pos = ri.i - CTX;
                const unsigned* hr = (const unsigned*)(H + (size_t)m * HP);
                {
                    const unsigned w = hr[lane]; const float a = bflo(w), b = bfhi(w); const float r = rsqrtf(wave_sum(a * a + b * b, lane) * (1.f / 128.f) + LN_EPS); const f32x2 g = gckv[lane];
                    ((unsigned*)(CKV + (size_t)m * 128))[lane] = pk2(a * r * g.x, b * r * g.y); }
                if (lane < 16) {
                    const unsigned w = hr[64 + lane]; float a = bflo(w), b = bfhi(w);
                    if (lat) { const f32x2 cs = rM[pos * 16 + lane]; const float a2 = a * cs.x - b * cs.y, b2 = a * cs.y + b * cs.x; a = a2; b = b2; }
                    ((unsigned*)(KPE + (size_t)m * 32))[lane] = pk2(a, b); }
                {
                    const unsigned w = hr[80 + lane]; float a = bflo(w), b = bfhi(w); const float r = rsqrtf(half_sum(a * a + b * b, lane) * (1.f / 64.f) + LN_EPS); const f32x2 g = gkn[lane & 31];
                    a = a * r * g.x; b = b * r * g.y;
                    if (lat) { const f32x2 cs = rG[pos * 32 + (lane & 31)]; const float a2 = a * cs.x - b * cs.y, b2 = a * cs.y + b * cs.x; a = a2; b = b2; }
                    ((unsigned*)(GK + (size_t)m * 128))[lane] = pk2(a, b); }
                ((unsigned*)(GV + (size_t)m * 128))[lane] = hr[144 + lane];
                {
                    const unsigned w0 = hr[208 + lane], w1 = hr[272 + lane]; const float a0 = bflo(w0), b0 = bfhi(w0), a1 = bflo(w1), b1 = bfhi(w1);
                    const float r = rsqrtf(wave_sum(a0 * a0 + b0 * b0 + a1 * a1 + b1 * b1, lane) * (1.f / 256.f) + LN_EPS); const f32x2 g0 = gcq[lane], g1 = gcq[64 + lane];
                    unsigned* o = (unsigned*)(CQ + (size_t)m * 256); o[lane] = pk2(a0 * r * g0.x, b0 * r * g0.y); o[64 + lane] = pk2(a1 * r * g1.x, b1 * r * g1.y); }
#pragma unroll
                for (int j = 0; j < 3; ++j) {
                    const unsigned w = hr[336 + 64 * j + lane]; float a = bflo(w), b = bfhi(w); const float r = rsqrtf(half_sum(a * a + b * b, lane) * (1.f / 64.f) + LN_EPS); const f32x2 g = gqn[lane & 31];
                    a = a * r * g.x; b = b * r * g.y;
                    if (lat) { const f32x2 cs = rG[pos * 32 + (lane & 31)]; const float a2 = a * cs.x - b * cs.y, b2 = a * cs.y + b * cs.x; a = a2; b = b2; }
                    ((unsigned*)(GQ + (size_t)m * 384))[64 * j + lane] = pk2(a, b); }
                {
                    const int seqlen = lat ? SEQ : CTX, t = lat ? pos : ri.i; const bool hp = t > 0, hn = t + 1 < seqlen;
                    const unsigned* hm1 = hr - HP / 2; const unsigned* hp1 = hr + HP / 2;
#pragma unroll
                    for (int j = 0; j < 2; ++j) { const int ix = lane + 64 * j;
                        const unsigned c0 = hr[528 + ix], k0 = hr[784 + ix], bb = hr[656 + ix];
                        const unsigned cm = hp ? hm1[528 + ix] : 0u, km = hp ? hm1[784 + ix] : 0u, cn = hn ? hp1[528 + ix] : 0u, kn = hn ? hp1[784 + ix] : 0u;
                        const f32x2 w0 = wc0[ix], w1 = wc1[ix], w2 = wc2[ix];
                        const float oa = bflo(bb) * (w0.x * bflo(cm) * bflo(km) + w1.x * bflo(c0) * bflo(k0) + w2.x * bflo(cn) * bflo(kn));
                        const float ob = bfhi(bb) * (w0.y * bfhi(cm) * bfhi(km) + w1.y * bfhi(c0) * bfhi(k0) + w2.y * bfhi(cn) * bfhi(kn));
                        ((unsigned*)(OC + (size_t)m * DM))[384 + ix] = pk2(oa, ob); }
                }
            }
        }
        grid.sync();
        { DEFWS(WSB()) pg8::Gemm g{CQ, WUQ + (size_t)l * 768 * 256, MROWS, 768, 256}; pg8::StaticOrder S; S.init(MROWS, 768, G, bx);
          pg8::EpiUQ E{MQ, ROPEM};
          pg8::gemm_phase<pg8::EpiUQ, pg8::StaticOrder, true, false>((LAS unsigned char*)lds, g, S, E, wave); }
        { DEFWS(WSB()) pg8::Gemm g{CKV, WUKV + (size_t)l * 768 * 128, MROWS, 768, 128}; pg8::StaticOrder S; S.init(MROWS, 768, G, bx);
          pg8::EpiUKV E{MK, MV};
          pg8::gemm_phase<pg8::EpiUKV, pg8::StaticOrder, true, false>((LAS unsigned char*)lds, g, S, E, wave); }
        grid.sync();
        {
            DEFWS(WSB())
            const int nrounds = (l < DEPTH - 1) ? 7 : 6;
            for (int i = 0; i < nrounds; ++i) {
                int type, b, h, qrow0, seq;
                if (i < 6) { const int u = vcu + 256 * i; type = u / 768; const int rem = u % 768; b = rem / 192; h = (rem >> 5) % 6; const int qb = rem & 31; qrow0 = b * LTOK + CTX + qb * 256; seq = LTOK; }
                else { if (vcu >= 48) break; type = vcu / 24; b = (vcu % 24) / 6; h = vcu % 6; qrow0 = b * LTOK; seq = CTX; }
                const size_t kr = (size_t)b * LTOK;
                if (type == 0) att::attn_unit<96>(MQ + (size_t)qrow0 * 576 + h * 96, MK + kr * 384 + h * 64, KPE + kr * 32, MV + kr * 384 + h * 64, OC + (size_t)qrow0 * DM + h * 64, seq, (char*)lds, wave);
                else att::attn_unit<64>(GQ + (size_t)qrow0 * 384 + h * 64, GK + kr * 128 + (h / 3) * 64, nullptr, GV + kr * 128 + (h / 3) * 64, OC + (size_t)qrow0 * DM + 384 + h * 64, seq, (char*)lds, wave);
            }
        }
        grid.sync();
        { DEFWS(WSB()) pg8::Gemm g{OC, WO + (size_t)l * DM * DM, MROWS, DM, DM}; pg8::StaticOrder S; S.init(MROWS, DM, G, bx);
          pg8::EpiStore<0> E{Y, DM};
          pg8::gemm_phase<pg8::EpiStore<0>, pg8::StaticOrder, true, true>((LAS unsigned char*)lds, g, S, E, wave); }
        grid.sync();
#pragma unroll 1
        for (int which = 0; which < 2; ++which) {
            {
                DEFWS(WSB())
                const int lane = pg8::lane_id_asm();
                const float* lg = KP()->in[which ? I_LN2G : I_LN1G] + l * DM; const float* lb = KP()->in[which ? I_LN2B : I_LN1B] + l * DM;
                const float* xin_ = KP()->in[I_X]; const float* cin_ = KP()->in[I_CTX]; float* out_ = KP()->out;
                const bool first = (l == 0 && which == 0); const bool wantu = !(which == 1 && l == DEPTH - 1);
                for (int m = gw; m < MROWS; m += NGW) { const RowInfo ri = row_info(m);
                    const size_t zoff = ((size_t)ri.b * CTX + ri.i) * DM, xoff = ((size_t)ri.b * SEQ + ri.i - CTX) * DM;
                    const float* xo = ri.isctx ? (first ? cin_ + zoff : Z + zoff) : (first ? xin_ + xoff : out_ + xoff);
                    float* xn = ri.isctx ? Z + zoff : out_ + xoff;
                    const float* md = MOD + ((size_t)l * 5 + ri.v) * 6144; const float* gate = md + (which ? 5 : 2) * 1024;
                    const float* md2 = which ? MOD + ((size_t)(wantu ? l + 1 : l) * 5 + ri.v) * 6144 : md + 3 * 1024;
                    f32x4 t[4]; float s = 0.f;
#pragma unroll
                    for (int j = 0; j < 4; ++j) { const int col = 4 * lane + 256 * j; const f32x4 x = *(const f32x4*)(xo + col), gt = *(const f32x4*)(gate + col);
                        const u32x2 yw = *(const u32x2*)(Y + (size_t)m * DM + col); const f32x4 y = {bflo(yw.x), bfhi(yw.x), bflo(yw.y), bfhi(yw.y)};
                        t[j] = ALPHA * x + gt * y; s += (t[j][0] + t[j][1]) + (t[j][2] + t[j][3]); }
                    const float mean = wave_sum(s, lane) * (1.f / DM); float s2 = 0.f;
#pragma unroll
                    for (int j = 0; j < 4; ++j) { t[j] = t[j] - mean; s2 += (t[j][0] * t[j][0] + t[j][1] * t[j][1]) + (t[j][2] * t[j][2] + t[j][3] * t[j][3]); }
                    const float rstd = rsqrtf(wave_sum(s2, lane) * (1.f / DM) + LN_EPS);
#pragma unroll
                    for (int j = 0; j < 4; ++j) { const int col = 4 * lane + 256 * j; const f32x4 g4 = *(const f32x4*)(lg + col), b4 = *(const f32x4*)(lb + col);
                        const f32x4 xv = t[j] * rstd * g4 + b4; *(f32x4*)(xn + col) = xv;
                        if (wantu) { const f32x4 sh = *(const f32x4*)(md2 + col), sc = *(const f32x4*)(md2 + 1024 + col); const f32x4 u = xv * (1.f + sc) + sh;
                            u32x2 w; w.x = pk2(u[0], u[1]); w.y = pk2(u[2], u[3]); *(u32x2*)(U + (size_t)m * DM + col) = w; } }
                }
            }
            if (which == 1) { if (l < DEPTH - 1) grid.sync(); break; }
            grid.sync();
            { DEFWS(WSB()) pg8::Gemm g{U, W1 + (size_t)l * DFF * DM, MROWS, DFF, DM}; pg8::StaticOrder S; S.init(MROWS, DFF, G, bx);
              pg8::EpiStore<1> E{HM, DFF};
              pg8::gemm_phase<pg8::EpiStore<1>, pg8::StaticOrder, true, true>((LAS unsigned char*)lds, g, S, E, wave); }
            grid.sync();
            { DEFWS(WSB()) pg8::Gemm g{HM, W2 + (size_t)l * DM * DFF, MROWS, DM, DFF}; pg8::StaticOrder S; S.init(MROWS, DM, G, bx);
              pg8::EpiStore<0> E{Y, DM};
              pg8::gemm_phase<pg8::EpiStore<0>, pg8::StaticOrder, true, true>((LAS unsigned char*)lds, g, S, E, wave); }
            grid.sync();
        }
    }
}

extern "C" void kernel_launch(void* const* d_in, const int* in_sizes, int n_in, void* d_out, int out_size, void* d_ws, size_t ws_size, hipStream_t stream) {
    static int grid = 0;
    if (grid == 0) {
        if (n_in != 21 || in_sizes[0] != NBATCH * SEQ * DM || out_size != NBATCH * SEQ * DM || ws_size < WS_END) {
            fprintf(stderr, "kernel_launch: shape mismatch n_in %d in0 %d out %d ws %zu (need %zu)\n", n_in, n_in > 0 ? in_sizes[0] : -1, out_size, ws_size, (size_t)WS_END); grid = -1; return; }
        int dev = 0, cus = 0, per_cu = 0;
        hipGetDevice(&dev); hipDeviceGetAttribute(&cus, hipDeviceAttributeMultiprocessorCount, dev);
        if (hipFuncSetAttribute((const void*)fwd_megakernel, hipFuncAttributeMaxDynamicSharedMemorySize, LDS_BYTES) != hipSuccess) { fprintf(stderr, "kernel_launch: hipFuncSetAttribute failed\n"); grid = -1; return; }
        if (hipOccupancyMaxActiveBlocksPerMultiprocessor(&per_cu, (const void*)fwd_megakernel, 512, LDS_BYTES) != hipSuccess || per_cu < 1) { fprintf(stderr, "kernel_launch: occupancy query says %d\n", per_cu); per_cu = 1; }
        (void)hipGetLastError();
        grid = cus;
        fprintf(stderr, "kernel_launch: grid %d (per_cu %d)\n", grid, per_cu);
    }
    if (grid < 0) return;
    Params p{};
    for (int i = 0; i < 21; ++i) p.in[i] = (const float*)d_in[i];
    p.out = (float*)d_out; p.ws = (unsigned char*)d_ws;
    void* args[] = {&p};
    hipError_t e = hipLaunchCooperativeKernel((const void*)fwd_megakernel, dim3(grid), dim3(512), args, LDS_BYTES, stream);
    if (e != hipSuccess) fprintf(stderr, "kernel_launch: cooperative launch failed: %s (grid %d)\n", hipGetErrorString(e), grid);
}
```

```cpp
#include <hip/hip_runtime.h>
#include <hip/hip_cooperative_groups.h>
#include <cstdio>
#include <cstdint>
namespace cg = cooperative_groups;

constexpr int DM = 1024, NBATCH = 4, SEQ = 8192, DEPTH = 4, CTX = 256, DFF = 4096;
constexpr int LTOK = CTX + SEQ;
constexpr int MROWS = NBATCH * LTOK;
constexpr int IN_COLS = 1824, HP = 2048;
constexpr float LN_EPS = 1e-6f;
constexpr float ALPHA = 1.6817928305074290f;
namespace pg8 {
#define PG8_LAS __attribute__((address_space(3)))
typedef unsigned short bf16_t;
typedef short bf16x8 __attribute__((ext_vector_type(8)));
typedef float f32x4 __attribute__((ext_vector_type(4)));
typedef unsigned u32x4 __attribute__((ext_vector_type(4)));
constexpr int BM = 256, BK = 64, HALF = 128, HTB = HALF * BK * 2  , STAGE_BYTES = 8 * HTB, NXCD = 8, WGM = 8;

__host__ __device__ __forceinline__ int lds_byte(int r, int c) { const int st = (r >> 4) * 2 + (c >> 5), rr = r & 15, cc = c & 31, ob = rr * 64 + cc * 2; return st * 1024 + (ob ^ (((ob >> 9) & 1) << 5)); }
__host__ __device__ __forceinline__ void stage_rc(int b, int& R, int& C) { const int st = b / 1024, sb = b % 1024, swz = sb ^ (((sb >> 9) & 1) << 5); R = (st >> 1) * 16 + swz / 64; C = (st & 1) * 32 + (swz % 64) / 2; }
__host__ __device__ __forceinline__ int perm32(int rho) { const int n = rho >> 4, i = rho & 15; return 8 * (i >> 2) + 4 * n + (i & 3); }

struct Unit { int pm, pn; };
struct Gemm { const bf16_t* A; const bf16_t* Bt; int M, N, K; };

struct StaticOrder {
    int nM, nN, nwg, G, c;
    __host__ __device__ void init(int M, int N, int G_, int c_) { nM = M / BM; nN = N / BM; nwg = nM * nN; G = G_; c = c_; }
    __host__ __device__ bool next(int i, Unit& u) const {
        const long L = (long)i * G + c; if (L >= nwg) return false;
        int wgid = (int)L; { const int q = nwg / NXCD, r = nwg % NXCD, xcd = wgid % NXCD, off = wgid / NXCD; wgid = (xcd < r ? xcd * (q + 1) : r * (q + 1) + (xcd - r) * q) + off; }
        const int nig = WGM * nN, gid = wgid / nig, fm = gid * WGM, gsz = (nM - fm) < WGM ? (nM - fm) : WGM;
        u.pm = fm + ((wgid % nig) % gsz); u.pn = (wgid % nig) / gsz; return true;
    }
    __device__ __forceinline__ void a_ready(const Unit&) const {}
    __device__ __forceinline__ void done(const Unit&) const {}
};

__device__ __forceinline__ unsigned cvt_pk_bf16(float lo, float hi) { unsigned r; asm volatile("v_cvt_pk_bf16_f32 %0, %1, %2" : "=v"(r) : "v"(lo), "v"(hi)); return r; }
__device__ __forceinline__ int lane_id_asm() { int l; asm volatile("v_mbcnt_lo_u32_b32 %0, -1, 0\n\tv_mbcnt_hi_u32_b32 %0, -1, %0" : "=v"(l)); return l; }
typedef float f32x2 __attribute__((ext_vector_type(2)));
template <int ACT  > struct EpiStore {
    static constexpr bool PERM = true, AFTER_DRAIN = false;
    bf16_t* O; int ldc;
    __device__ __forceinline__ void operator()(const f32x4 (&acc)[2][2][4][2], const Unit& u, int wr, int wc, int fr, int fq) const {
        const int row0 = u.pm * BM + wr * 64 + fr; const int col0 = u.pn * BM + wc * 32 + 8 * fq;
#pragma unroll
        for (int ai = 0; ai < 2; ++ai)
#pragma unroll
            for (int m = 0; m < 4; ++m) { bf16_t* rowp = O + (size_t)(row0 + ai * HALF + m * 16) * ldc + col0;
#pragma unroll
                for (int bj = 0; bj < 2; ++bj) { f32x4 v0 = acc[ai][bj][m][0], v1 = acc[ai][bj][m][1];
                    if (ACT == 1) {
#pragma unroll
                        for (int e = 0; e < 4; ++e) { float a = fmaxf(v0[e], 0.f), b = fmaxf(v1[e], 0.f); v0[e] = a * a; v1[e] = b * b; } }
                    u32x4 w; w.x = cvt_pk_bf16(v0[0], v0[1]); w.y = cvt_pk_bf16(v0[2], v0[3]); w.z = cvt_pk_bf16(v1[0], v1[1]); w.w = cvt_pk_bf16(v1[2], v1[3]);
                    *(u32x4*)(rowp + bj * HALF) = w; } }
    }
};
struct EpiUQ {
    static constexpr bool PERM = true, AFTER_DRAIN = false;
    bf16_t* MQ; const float* ropeM; float qscale;
    __device__ __forceinline__ void operator()(const f32x4 (&acc)[2][2][4][2], const Unit& u, int wr, int wc, int fr, int fq) const {
        const int row0 = u.pm * BM + wr * 64 + fr;
        const int pt = u.pm % 33; const bool lat = pt != 0; const int pos0 = (pt - 1) * 256 + wr * 64 + fr;
#pragma unroll
        for (int bj = 0; bj < 2; ++bj) {
            const int c = u.pn * BM + bj * HALF + wc * 32 + 8 * fq;
            if (c >= 576) continue;
            const int d = c % 96; const bool isrope = (d >= 64) && lat; const int i0 = (d - 64) >> 1;
#pragma unroll
            for (int ai = 0; ai < 2; ++ai)
#pragma unroll
                for (int m = 0; m < 4; ++m) { const int row = row0 + ai * HALF + m * 16;
                    f32x4 v0 = acc[ai][bj][m][0], v1 = acc[ai][bj][m][1];
                    if (isrope) { const f32x4* rp = (const f32x4*)(ropeM + ((size_t)(pos0 + ai * HALF + m * 16) * 16 + i0) * 2);
                        const f32x4 r0 = rp[0], r1 = rp[1];
                        f32x4 a, b;
                        a[0] = v0[0] * r0[0] - v0[1] * r0[1]; a[1] = v0[0] * r0[1] + v0[1] * r0[0];
                        a[2] = v0[2] * r0[2] - v0[3] * r0[3]; a[3] = v0[2] * r0[3] + v0[3] * r0[2];
                        b[0] = v1[0] * r1[0] - v1[1] * r1[1]; b[1] = v1[0] * r1[1] + v1[1] * r1[0];
                        b[2] = v1[2] * r1[2] - v1[3] * r1[3]; b[3] = v1[2] * r1[3] + v1[3] * r1[2];
                        v0 = a; v1 = b; }
                    v0 = v0 * qscale; v1 = v1 * qscale;
                    u32x4 w; w.x = cvt_pk_bf16(v0[0], v0[1]); w.y = cvt_pk_bf16(v0[2], v0[3]); w.z = cvt_pk_bf16(v1[0], v1[1]); w.w = cvt_pk_bf16(v1[2], v1[3]);
                    *(u32x4*)(MQ + (size_t)row * 576 + c) = w; }
        }
    }
};
struct EpiUKV {
    static constexpr bool PERM = true, AFTER_DRAIN = false;
    bf16_t* MK; bf16_t* MV;
    __device__ __forceinline__ void operator()(const f32x4 (&acc)[2][2][4][2], const Unit& u, int wr, int wc, int fr, int fq) const {
        const int row0 = u.pm * BM + wr * 64 + fr;
#pragma unroll
        for (int bj = 0; bj < 2; ++bj) {
            const int head = u.pn * 2 + bj; const int d = wc * 32 + 8 * fq;
            bf16_t* base = (d < 64) ? (MK + head * 64 + d) : (MV + head * 64 + d - 64);
#pragma unroll
            for (int ai = 0; ai < 2; ++ai)
#pragma unroll
                for (int m = 0; m < 4; ++m) { const int row = row0 + ai * HALF + m * 16;
                    const f32x4 v0 = acc[ai][bj][m][0], v1 = acc[ai][bj][m][1];
                    u32x4 w; w.x = cvt_pk_bf16(v0[0], v0[1]); w.y = cvt_pk_bf16(v0[2], v0[3]); w.z = cvt_pk_bf16(v1[0], v1[1]); w.w = cvt_pk_bf16(v1[2], v1[3]);
                    *(u32x4*)(base + (size_t)row * 384) = w; }
        }
    }
};
template <class Epi, class Sched, bool ALIGN_EPI = false, bool SP2 = false>
__device__ __forceinline__ void gemm_phase(PG8_LAS unsigned char* lds, const Gemm g, const Sched& S, const Epi& E, const int wave_in) {
    const int tid_l_ = wave_in * 64 + lane_id_asm();
    const int tid = tid_l_, wid = __builtin_amdgcn_readfirstlane(tid >> 6), lane = tid & 63, wr = wid >> 2, wc = wid & 3, fr = lane & 15, fq = lane >> 4;
    const int K = g.K, nt = K / BK;
    unsigned voffA[2], voffB[2];
#pragma unroll
    for (int i = 0; i < 2; ++i) { int R, C; stage_rc(tid * 16 + i * 8192, R, C); const int Rb = Epi::PERM ? ((R & ~31) + perm32(R & 31)) : R;
        voffA[i] = (unsigned)(R * K + C) * 2u; voffB[i] = (unsigned)(Rb * K + C) * 2u; }
    const size_t kstep = (size_t)(BK * 2);
    const size_t hstep = (size_t)HALF * K * 2;
    const size_t tstep = 2 * hstep;
    const unsigned ldsw = (unsigned)wid * 1024u;
    const int aoff = lds_byte(wr * 64 + fr, fq * 8), boff = lds_byte(wc * 32 + fr, fq * 8);
#define PG8_SA(b, h) (((b) * 2 + (h)) * HTB)
#define PG8_SB(b, h) ((4 + (b) * 2 + (h)) * HTB)
#define PG8_STAGE(bufoff, gbase, voff) do { _Pragma("unroll") for (int _i = 0; _i < 2; ++_i) \
        __builtin_amdgcn_global_load_lds((const unsigned*)((const char*)(gbase) + (voff)[_i]), (PG8_LAS unsigned*)(lds + (bufoff) + ldsw + _i * 8192), 16, 0, 0); } while (0)
#define PG8_LDA(dst, b, h) do { _Pragma("unroll") for (int m = 0; m < 4; ++m) _Pragma("unroll") for (int k = 0; k < 2; ++k) dst[m][k] = *(const PG8_LAS bf16x8*)(lds + PG8_SA(b, h) + aoff + m * 2048 + k * 1024); } while (0)
#define PG8_LDB(dst, b, h) do { _Pragma("unroll") for (int n = 0; n < 2; ++n) _Pragma("unroll") for (int k = 0; k < 2; ++k) dst[n][k] = *(const PG8_LAS bf16x8*)(lds + PG8_SB(b, h) + boff + n * 2048 + k * 1024); } while (0)
#define PG8_MMA(ai, bj, At, Bt) do { __builtin_amdgcn_s_setprio(1); _Pragma("unroll") for (int m = 0; m < 4; ++m) _Pragma("unroll") for (int n = 0; n < 2; ++n) _Pragma("unroll") for (int k = 0; k < 2; ++k) \
        acc[ai][bj][m][n] = __builtin_amdgcn_mfma_f32_16x16x32_bf16(Bt[n][k], At[m][k], acc[ai][bj][m][n], 0, 0, 0); __builtin_amdgcn_s_setprio(0); } while (0)
#define PG8_WAIT_V(n) asm volatile("s_waitcnt vmcnt(" #n ")" ::: "memory")
#define PG8_WAIT_L(n) asm volatile("s_waitcnt lgkmcnt(" #n ")" ::: "memory")
#define PG8_BAR __builtin_amdgcn_s_barrier()
#define PG8_SCHED __builtin_amdgcn_sched_barrier(0)
    Unit cur, nxt; int ui = 0;
    if (!S.next(0, cur)) return;
    f32x4 acc[2][2][4][2];
#pragma unroll
    for (int a = 0; a < 2; ++a)
#pragma unroll
        for (int b = 0; b < 2; ++b)
#pragma unroll
            for (int m = 0; m < 4; ++m)
#pragma unroll
                for (int n = 0; n < 2; ++n) acc[a][b][m][n] = (f32x4){0.f, 0.f, 0.f, 0.f};
    bf16x8 At[4][2], B0[2][2], B1[2][2];
    const char* cA = (const char*)g.A + (size_t)cur.pm * tstep; const char* cB = (const char*)g.Bt + (size_t)cur.pn * tstep;
    S.a_ready(cur);
    if constexpr (SP2) {
        PG8_STAGE(PG8_SB(0, 0), cB, voffB); PG8_STAGE(PG8_SB(0, 1), cB + hstep, voffB); PG8_STAGE(PG8_SA(0, 0), cA, voffA); PG8_STAGE(PG8_SA(0, 1), cA + hstep, voffA);
        if (wr == 1) PG8_BAR;
        PG8_WAIT_V(2); PG8_BAR;
        PG8_STAGE(PG8_SB(1, 0), cB + kstep, voffB); PG8_STAGE(PG8_SA(1, 0), cA + kstep, voffA); PG8_STAGE(PG8_SB(1, 1), cB + hstep + kstep, voffB);
        PG8_WAIT_V(6); PG8_BAR;
    } else {
        PG8_STAGE(PG8_SB(0, 0), cB, voffB); PG8_STAGE(PG8_SA(0, 0), cA, voffA); PG8_STAGE(PG8_SB(0, 1), cB + hstep, voffB); PG8_STAGE(PG8_SA(0, 1), cA + hstep, voffA);
        if (wr == 1) PG8_BAR;
        PG8_WAIT_V(4); PG8_BAR;
        PG8_STAGE(PG8_SB(1, 0), cB + kstep, voffB); PG8_STAGE(PG8_SA(1, 0), cA + kstep, voffA); PG8_STAGE(PG8_SB(1, 1), cB + hstep + kstep, voffB);
        PG8_WAIT_V(6); PG8_BAR;
    }
    for (;;) {
        const bool has_next = S.next(ui + 1, nxt);
        const char* nA = has_next ? (const char*)g.A + (size_t)nxt.pm * tstep : cA; const char* nB = has_next ? (const char*)g.Bt + (size_t)nxt.pn * tstep : cB;
        for (int t = 0; t < nt; t += 2) {
            const bool last = (t == nt - 2);
            const char* a1 = cA + (size_t)(t + 1) * kstep;
            const char* a2 = last ? nA : cA + (size_t)(t + 2) * kstep; const char* b2 = last ? nB : cB + (size_t)(t + 2) * kstep;
            const char* a3 = a2 + kstep; const char* b3 = b2 + kstep;
            if (last && has_next) S.a_ready(nxt);
            if constexpr (SP2) {
            PG8_LDB(B0, 0, 0); PG8_LDB(B1, 0, 1); PG8_SCHED; PG8_LDA(At, 0, 0); PG8_STAGE(PG8_SA(1, 1), a1 + hstep, voffA);
            PG8_WAIT_V(8); PG8_WAIT_L(0); PG8_BAR; PG8_MMA(0, 0, At, B0); PG8_MMA(0, 1, At, B1); PG8_BAR; PG8_SCHED;
            PG8_LDA(At, 0, 1); PG8_STAGE(PG8_SB(0, 0), b2, voffB); PG8_STAGE(PG8_SB(0, 1), b2 + hstep, voffB); PG8_STAGE(PG8_SA(0, 0), a2, voffA);
            PG8_WAIT_V(8); PG8_WAIT_L(0); PG8_BAR; PG8_MMA(1, 0, At, B0); PG8_MMA(1, 1, At, B1); PG8_BAR; PG8_SCHED;
            PG8_LDB(B0, 1, 0); PG8_LDB(B1, 1, 1); PG8_SCHED; PG8_LDA(At, 1, 0); PG8_STAGE(PG8_SA(0, 1), a2 + hstep, voffA);
            PG8_WAIT_V(8); PG8_WAIT_L(0); PG8_BAR; PG8_MMA(0, 0, At, B0); PG8_MMA(0, 1, At, B1); PG8_BAR; PG8_SCHED;
            PG8_LDA(At, 1, 1); PG8_STAGE(PG8_SB(1, 0), b3, voffB); PG8_STAGE(PG8_SB(1, 1), b3 + hstep, voffB); PG8_STAGE(PG8_SA(1, 0), a3, voffA);
            PG8_WAIT_V(8); PG8_WAIT_L(0); PG8_BAR; PG8_MMA(1, 0, At, B0); PG8_MMA(1, 1, At, B1); PG8_BAR; PG8_SCHED;
            } else {
            PG8_LDB(B0, 0, 0); PG8_SCHED; PG8_LDA(At, 0, 0); PG8_STAGE(PG8_SA(1, 1), a1 + hstep, voffA);
            PG8_WAIT_L(8); PG8_BAR; PG8_WAIT_L(0); PG8_MMA(0, 0, At, B0); PG8_BAR; PG8_SCHED;
            PG8_LDB(B1, 0, 1); PG8_STAGE(PG8_SB(0, 0), b2, voffB);
            PG8_BAR; PG8_WAIT_L(0); PG8_MMA(0, 1, At, B1); PG8_BAR;
            PG8_LDA(At, 0, 1); PG8_STAGE(PG8_SA(0, 0), a2, voffA);
            PG8_BAR; PG8_WAIT_L(0); PG8_MMA(1, 0, At, B0); PG8_BAR; PG8_SCHED;
            PG8_STAGE(PG8_SB(0, 1), b2 + hstep, voffB);
            PG8_WAIT_V(6); PG8_BAR; PG8_MMA(1, 1, At, B1); PG8_BAR;
            PG8_LDB(B0, 1, 0); PG8_SCHED; PG8_LDA(At, 1, 0); PG8_STAGE(PG8_SA(0, 1), a2 + hstep, voffA);
            PG8_WAIT_L(8); PG8_BAR; PG8_WAIT_L(0); PG8_MMA(0, 0, At, B0); PG8_BAR; PG8_SCHED;
            PG8_LDB(B1, 1, 1); PG8_STAGE(PG8_SB(1, 0), b3, voffB);
            PG8_BAR; PG8_WAIT_L(0); PG8_MMA(0, 1, At, B1); PG8_BAR;
            PG8_LDA(At, 1, 1); PG8_STAGE(PG8_SA(1, 0), a3, voffA);
            PG8_BAR; PG8_WAIT_L(0); PG8_MMA(1, 0, At, B0); PG8_BAR; PG8_SCHED;
            PG8_STAGE(PG8_SB(1, 1), b3 + hstep, voffB);
            PG8_WAIT_V(6); PG8_BAR; PG8_MMA(1, 1, At, B1); PG8_BAR;
            }
        }
        if constexpr (ALIGN_EPI) { if (wr == 0) PG8_BAR; }
        if constexpr (!Epi::AFTER_DRAIN) { const int le_ = lane_id_asm(); E(acc, cur, wr, wc, le_ & 15, le_ >> 4); S.done(cur); }
        if (!has_next) break;
#pragma unroll
        for (int a = 0; a < 2; ++a)
#pragma unroll
            for (int b = 0; b < 2; ++b)
#pragma unroll
                for (int m = 0; m < 4; ++m)
#pragma unroll
                    for (int n = 0; n < 2; ++n) acc[a][b][m][n] = (f32x4){0.f, 0.f, 0.f, 0.f};
        cur = nxt; cA = nA; cB = nB; ++ui;
        if constexpr (ALIGN_EPI) { if (wr == 1) PG8_BAR; }
    }
    PG8_WAIT_V(0);
    if constexpr (!ALIGN_EPI) { if (wr == 0) PG8_BAR; }
    PG8_BAR;
    if constexpr (Epi::AFTER_DRAIN) { E.fused(acc, cur, wr, wc, fr, fq, lds, wid, lane); S.done(cur); }
#undef PG8_SA
#undef PG8_SB
#undef PG8_STAGE
#undef PG8_LDA
#undef PG8_LDB
#undef PG8_MMA
#undef PG8_WAIT_V
#undef PG8_WAIT_L
#undef PG8_BAR
#undef PG8_SCHED
}
}

namespace att {
typedef unsigned short bf16_t;
using bf16x8 = __attribute__((ext_vector_type(8))) short;
using s16x4  = __attribute__((ext_vector_type(4))) short;
using f32x16 = __attribute__((ext_vector_type(16))) float;
using u32x4  = __attribute__((ext_vector_type(4))) unsigned;
constexpr int NW = 8, QBLK = 32, KVBLK = 64;
constexpr float THR = 8.f;
constexpr int SHM_V = 16384, SHM_K = 16384;
#define KSWZ(row, colB) ((row) * 256 + ((colB) ^ (((row) & 7) << 4)))
#define SBAR() __builtin_amdgcn_sched_barrier(0)
__device__ __forceinline__ int crow(int r, int hi) { return (r & 3) + 8 * (r >> 2) + 4 * hi; }
__device__ __forceinline__ unsigned cvtpk(float lo, float hi) { unsigned r; asm volatile("v_cvt_pk_bf16_f32 %0, %1, %2" : "=v"(r) : "v"(lo), "v"(hi)); return r; }

constexpr float THRL = 11.0f;
template <bool FIRST> __device__ __forceinline__ void partialSM(f32x16& p0, f32x16& p1, float& m_reg, f32x16& negm, float& alpha) {
  float pmax = fmaxf(fmaxf(p0[0], p0[1]), p1[0]);
#pragma unroll
  for (int r = 2; r < 16; r += 2) pmax = fmaxf(fmaxf(pmax, p0[r]), p0[r + 1]);
#pragma unroll
  for (int r = 1; r < 15; r += 2) pmax = fmaxf(fmaxf(pmax, p1[r]), p1[r + 1]);
  pmax = fmaxf(pmax, p1[15]);
  { auto rr = __builtin_amdgcn_permlane32_swap(__float_as_uint(pmax), __float_as_uint(pmax), false, false);
    pmax = fmaxf(__uint_as_float(rr[0]), __uint_as_float(rr[1])); }
  alpha = 1.f;
  if (FIRST || !__builtin_expect(__all(pmax <= THRL), 1)) {
    const float dl = FIRST ? pmax : fmaxf(pmax, 0.f);
    m_reg += dl;
#pragma unroll
    for (int r = 0; r < 16; ++r) { p0[r] -= dl; p1[r] -= dl; }
#pragma unroll
    for (int r = 0; r < 16; ++r) negm[r] = -m_reg;
    if (!FIRST) alpha = __builtin_amdgcn_exp2f(-dl);
  }
#pragma unroll
  for (int r = 0; r < 16; ++r) p0[r] = __builtin_amdgcn_exp2f(p0[r]);
}
__device__ __forceinline__ void finishSM(f32x16& p0, f32x16& p1, float alpha, float& l_reg, bf16x8& pa0, bf16x8& pa1, bf16x8& pa2, bf16x8& pa3) {
#pragma unroll
  for (int r = 0; r < 16; ++r) p1[r] = __builtin_amdgcn_exp2f(p1[r]);
  float ps = 0;
#pragma unroll
  for (int r = 0; r < 16; ++r) ps += p0[r];
#pragma unroll
  for (int r = 0; r < 16; ++r) ps += p1[r];
  { auto rr = __builtin_amdgcn_permlane32_swap(__float_as_uint(ps), __float_as_uint(ps), false, false);
    ps = __uint_as_float(rr[0]) + __uint_as_float(rr[1]); }
  l_reg = l_reg * alpha + ps;
#define PK4(P, BASE, OUT) do { unsigned a0 = cvtpk(P[BASE + 0], P[BASE + 1]), a1 = cvtpk(P[BASE + 2], P[BASE + 3]);   \
    unsigned b0 = cvtpk(P[BASE + 4], P[BASE + 5]), b1 = cvtpk(P[BASE + 6], P[BASE + 7]);                              \
    auto r0 = __builtin_amdgcn_permlane32_swap(a0, b0, false, false); auto r1 = __builtin_amdgcn_permlane32_swap(a1, b1, false, false); \
    u32x4 w = {r0[0], r1[0], r0[1], r1[1]}; OUT = *reinterpret_cast<bf16x8*>(&w); } while (0)
  PK4(p0, 0, pa0); PK4(p0, 8, pa1); PK4(p1, 0, pa2); PK4(p1, 8, pa3);
#undef PK4
}
template <int DQ> __device__ __forceinline__ void qkt(f32x16& p0, f32x16& p1, const char* Ks, const bf16x8* qr, const f32x16& negm, int r32, int hi) {
#pragma unroll
  for (int d0 = 0; d0 < DQ / 16; ++d0) { int cb = (d0 * 16 + hi * 8) * 2;
    bf16x8 b0 = *reinterpret_cast<const bf16x8*>(Ks + KSWZ(r32, cb));
    bf16x8 b1 = *reinterpret_cast<const bf16x8*>(Ks + KSWZ(32 + r32, cb));
    if (d0 == 0) { p0 = __builtin_amdgcn_mfma_f32_32x32x16_bf16(b0, qr[0], negm, 0, 0, 0); p1 = __builtin_amdgcn_mfma_f32_32x32x16_bf16(b1, qr[0], negm, 0, 0, 0); }
    else { p0 = __builtin_amdgcn_mfma_f32_32x32x16_bf16(b0, qr[d0], p0, 0, 0, 0); p1 = __builtin_amdgcn_mfma_f32_32x32x16_bf16(b1, qr[d0], p1, 0, 0, 0); } }
}
__device__ __forceinline__ int v_st(int k, int c) { const int kk = (k & ~0xC) | ((k & 4) << 1) | ((k & 8) >> 1); return ((kk >> 3) * 4 + (c >> 5)) * 512 + ((kk & 7) * 32 + (c & 31)) * 2; }
__device__ __forceinline__ int v_rd_base(int lane) { return ((lane & 3) << 3) | (((lane >> 2) & 3) << 6) | (((lane >> 4) & 1) << 5) | (((lane >> 5) & 1) << 8); }
constexpr int v_rd_off(int d0, int ks, int half) { return d0 * 512 + ks * 4096 + half * 2048; }
template <int OFF> __device__ __forceinline__ s16x4 tr_read(int vb) {
  s16x4 r; asm volatile("ds_read_b64_tr_b16 %0, %1 offset:%2" : "=&v"(r) : "v"(vb), "i"(OFF) : "memory"); return r;
}
template <int D0> __device__ __forceinline__ void pv_one(f32x16& od, int vb, bf16x8 pa0, bf16x8 pa1, bf16x8 pa2, bf16x8 pa3) {
  const s16x4 l0 = tr_read<v_rd_off(D0, 0, 0)>(vb), h0 = tr_read<v_rd_off(D0, 0, 1)>(vb), l1 = tr_read<v_rd_off(D0, 1, 0)>(vb), h1 = tr_read<v_rd_off(D0, 1, 1)>(vb);
  const s16x4 l2 = tr_read<v_rd_off(D0, 2, 0)>(vb), h2 = tr_read<v_rd_off(D0, 2, 1)>(vb), l3 = tr_read<v_rd_off(D0, 3, 0)>(vb), h3 = tr_read<v_rd_off(D0, 3, 1)>(vb);
  asm volatile("s_waitcnt lgkmcnt(0)" ::: "memory"); SBAR();
#define PK(L, H) (bf16x8){L[0], L[1], L[2], L[3], H[0], H[1], H[2], H[3]}
  od = __builtin_amdgcn_mfma_f32_32x32x16_bf16(pa0, PK(l0, h0), od, 0, 0, 0);
  od = __builtin_amdgcn_mfma_f32_32x32x16_bf16(pa1, PK(l1, h1), od, 0, 0, 0);
  od = __builtin_amdgcn_mfma_f32_32x32x16_bf16(pa2, PK(l2, h2), od, 0, 0, 0);
  od = __builtin_amdgcn_mfma_f32_32x32x16_bf16(pa3, PK(l3, h3), od, 0, 0, 0);
#undef PK
}
__device__ __forceinline__ void pv_d0(f32x16* o, int vb, bf16x8 pa0, bf16x8 pa1, bf16x8 pa2, bf16x8 pa3) {
  pv_one<0>(o[0], vb, pa0, pa1, pa2, pa3); pv_one<1>(o[1], vb, pa0, pa1, pa2, pa3);
}

template <int DQ>
__device__ __forceinline__ void attn_unit(const bf16_t* __restrict__ Qb, const bf16_t* __restrict__ Kh, const bf16_t* __restrict__ Kpe, const bf16_t* __restrict__ Vh,
                                          bf16_t* __restrict__ Ob, int seq, char* lds, const int wave_in) {
  constexpr int LDQ = (DQ == 96) ? 576 : 384, LDK = (DQ == 96) ? 384 : 128, LDO = 1024, ND = DQ / 16;
  const int tid = wave_in * 64 + pg8::lane_id_asm(), wid = wave_in, lane = tid & 63, r32 = lane & 31, hi = lane >> 5;
  char* V_lds = lds; char* K_lds = lds + 2 * SHM_V;
  float* ws = (float*)(lds + 2 * SHM_V + 2 * SHM_K) + wid * 64; float* li_l = ws; float* al_l = ws + 32;
  float m_reg = 0.f, l_reg = 0; f32x16 o[2] = {}; f32x16 negm = {}; bf16x8 qr[ND];
  const bf16_t* Qw = Qb + (unsigned)((wid * QBLK + r32) * LDQ + hi * 8);
#pragma unroll
  for (int d0 = 0; d0 < ND; ++d0) qr[d0] = *reinterpret_cast<const bf16x8*>(Qw + d0 * 16);
  const int sr = tid >> 3, sc = (tid & 7) * 8;
  const int pr = (tid >> 2) & 63, pc = (tid & 3) * 8;
  const int vst = v_st(sr, sc), kst = KSWZ(sr, sc * 2), pst = KSWZ(pr, (64 + pc) * 2);
  const int vb0 = (int)(uintptr_t)V_lds + v_rd_base(lane);
  struct { bf16x8 vs, ks, ps; } sr_[2];
  const unsigned voff = (unsigned)(sr * LDK + sc), poff = (unsigned)(pr * 32 + pc);
#define SLOAD(i, k0) do { const bf16_t* Vt_ = Vh + (size_t)(k0) * LDK; const bf16_t* Kt_ = Kh + (size_t)(k0) * LDK; \
    sr_[i].vs = *reinterpret_cast<const bf16x8*>(Vt_ + voff); sr_[i].ks = *reinterpret_cast<const bf16x8*>(Kt_ + voff); \
    if constexpr (DQ == 96) { const bf16_t* Pt_ = Kpe + (size_t)(k0) * 32; sr_[i].ps = *reinterpret_cast<const bf16x8*>(Pt_ + poff); } } while (0)
#define SWRITE(b, i) do { *(bf16x8*)(V_lds + (b) * SHM_V + vst) = sr_[i].vs; *(bf16x8*)(K_lds + (b) * SHM_K + kst) = sr_[i].ks; \
    if constexpr (DQ == 96) { if (tid < 256) *(bf16x8*)(K_lds + (b) * SHM_K + pst) = sr_[i].ps; } } while (0)
#define SWAIT() do { if constexpr (DQ == 96) asm volatile("s_waitcnt vmcnt(3)" ::: "memory"); else asm volatile("s_waitcnt vmcnt(2)" ::: "memory"); } while (0)
#define RESC(a) do { if (__any((a) < 1.f)) { if (hi == 0) al_l[r32] = (a); asm volatile("s_waitcnt lgkmcnt(0)" ::: "memory"); \
    _Pragma("unroll") for (int d = 0; d < 2; ++d) _Pragma("unroll") for (int r = 0; r < 16; ++r) o[d][r] *= al_l[crow(r, hi)]; } } while (0)
  f32x16 pA0, pA1, pB0, pB1; float alA, alB; bf16x8 pa0, pa1, pa2, pa3; const int NT = seq / KVBLK;
  constexpr int SE = 0, SO = 1;
  SLOAD(SE, 0); asm volatile("s_waitcnt vmcnt(0)" ::: "memory"); SWRITE(0, SE); __syncthreads();
  qkt<DQ>(pA0, pA1, K_lds, qr, negm, r32, hi); partialSM<true>(pA0, pA1, m_reg, negm, alA);
  SLOAD(SO, KVBLK); if (2 < NT) SLOAD(SE, 2 * KVBLK);
  SWAIT(); SWRITE(1, SO); __syncthreads();
  for (int j = 1; j + 1 < NT; j += 2) {
    SBAR(); qkt<DQ>(pB0, pB1, K_lds + SHM_K, qr, negm, r32, hi);
    finishSM(pA0, pA1, alA, l_reg, pa0, pa1, pa2, pa3); SBAR();
    SLOAD(SO, (j + 2) * KVBLK); SBAR();
    pv_d0(o, vb0, pa0, pa1, pa2, pa3); partialSM<false>(pB0, pB1, m_reg, negm, alB);
    __syncthreads(); SWAIT(); SWRITE(0, SE);
    RESC(alB); __syncthreads();
    SBAR(); qkt<DQ>(pA0, pA1, K_lds, qr, negm, r32, hi);
    finishSM(pB0, pB1, alB, l_reg, pa0, pa1, pa2, pa3); SBAR();
    if (j + 3 < NT) SLOAD(SE, (j + 3) * KVBLK); SBAR();
    pv_d0(o, vb0 + SHM_V, pa0, pa1, pa2, pa3); partialSM<false>(pA0, pA1, m_reg, negm, alA);
    __syncthreads(); SWAIT(); SWRITE(1, SO);
    RESC(alA); __syncthreads();
  }
  SBAR(); qkt<DQ>(pB0, pB1, K_lds + SHM_K, qr, negm, r32, hi);
  finishSM(pA0, pA1, alA, l_reg, pa0, pa1, pa2, pa3); SBAR();
  pv_d0(o, vb0, pa0, pa1, pa2, pa3); partialSM<false>(pB0, pB1, m_reg, negm, alB);
  __syncthreads(); RESC(alB);
  finishSM(pB0, pB1, alB, l_reg, pa0, pa1, pa2, pa3); SBAR();
  pv_d0(o, vb0 + SHM_V, pa0, pa1, pa2, pa3);
  if (hi == 0) li_l[r32] = l_reg; asm volatile("s_waitcnt lgkmcnt(0)" ::: "memory");
  float rli[16];
#pragma unroll
  for (int r = 0; r < 16; ++r) rli[r] = __builtin_amdgcn_rcpf(li_l[crow(r, hi)]);
  bf16_t* Ow = Ob + (long)(wid * QBLK) * LDO;
#pragma unroll
  for (int r = 0; r < 16; ++r) { int orow = crow(r, hi);
#pragma unroll
    for (int d0 = 0; d0 < 2; ++d0) { const float v = o[d0][r] * rli[r]; Ow[(long)orow * LDO + d0 * 32 + r32] = (bf16_t)(cvtpk(v, v) & 0xffffu); } }
  __syncthreads();
#undef SLOAD
#undef SWRITE
#undef SWAIT
#undef RESC
}
#undef SBAR
}

typedef unsigned short bf16_t;
typedef float f32x4 __attribute__((ext_vector_type(4)));
typedef float f32x2 __attribute__((ext_vector_type(2)));
typedef unsigned u32x2 __attribute__((ext_vector_type(2)));
typedef unsigned u32x4 __attribute__((ext_vector_type(4)));
#define LAS __attribute__((address_space(3)))
constexpr size_t MiB = 1u << 20;
constexpr size_t WS_MOD = 1 * MiB, WS_ROPEM = 2 * MiB, WS_ROPEG = 3 * MiB, WS_Z = 5 * MiB;
constexpr size_t WS_WIN = 10 * MiB, WS_WUQ = 26 * MiB, WS_WUKV = 28 * MiB, WS_WO = 29 * MiB, WS_W1 = 37 * MiB, WS_W2 = 69 * MiB;
constexpr size_t WS_U = 101 * MiB, WS_Y = 167 * MiB, WS_OV = 233 * MiB;
constexpr size_t WS_HM = WS_OV, WS_H = WS_OV, WS_MQ = WS_OV, WS_MK = 271 * MiB, WS_MV = 296 * MiB;
constexpr size_t WS_CKV = 365 * MiB, WS_CQ = 374 * MiB, WS_KPE = 391 * MiB, WS_GK = 394 * MiB, WS_GV = 403 * MiB, WS_GQ = 412 * MiB, WS_O = 437 * MiB, WS_END = 503 * MiB;
static_assert(WS_MQ + (size_t)MROWS * 576 * 2 <= WS_MK && WS_MK + (size_t)MROWS * 384 * 2 <= WS_MV && WS_MV + (size_t)MROWS * 384 * 2 <= WS_H + (size_t)MROWS * HP * 2, "overlay");
static_assert(WS_H + (size_t)MROWS * HP * 2 <= WS_CKV && WS_CKV + (size_t)MROWS * 256 <= WS_CQ && WS_CQ + (size_t)MROWS * 512 <= WS_KPE && WS_KPE + (size_t)MROWS * 64 <= WS_GK, "map1");
static_assert(WS_GK + (size_t)MROWS * 256 <= WS_GV && WS_GV + (size_t)MROWS * 256 <= WS_GQ && WS_GQ + (size_t)MROWS * 768 <= WS_O && WS_O + (size_t)MROWS * 2048 <= WS_END, "map2");
static_assert(WS_HM + (size_t)MROWS * DFF * 2 <= WS_END, "map3");
#ifndef ATT_REPS
#define ATT_REPS 1
#endif
#ifndef GEMM_REPS
#define GEMM_REPS 1
#endif
constexpr float QSC64 = 0.125f * 1.4426950408889634f, QSC96 = 0.10206207261596575f * 1.4426950408889634f;
constexpr int LDS_BYTES = 135168;

struct Params { const float* in[21]; float* out; unsigned char* ws; };
enum { I_X = 0, I_C, I_CTX, I_CCTX, I_WADA, I_BADA, I_WIN, I_GCQ, I_WUQ, I_GCKV, I_WUKV, I_GQN, I_GKN, I_WCONV, I_WO, I_LN1G, I_LN1B, I_W1, I_W2, I_LN2G, I_LN2B };

__device__ __forceinline__ float shx(float v, int lane, int o) { return __int_as_float(__builtin_amdgcn_ds_bpermute((lane ^ o) << 2, __float_as_int(v))); }
__device__ __forceinline__ float wave_sum(float v, int lane) {
#pragma unroll
    for (int o = 1; o < 64; o <<= 1) v += shx(v, lane, o);
    return v;
}
__device__ __forceinline__ float half_sum(float v, int lane) {
#pragma unroll
    for (int o = 1; o < 32; o <<= 1) v += shx(v, lane, o);
    return v;
}
__device__ __forceinline__ unsigned pk2(float lo, float hi) { unsigned r; asm volatile("v_cvt_pk_bf16_f32 %0, %1, %2" : "=v"(r) : "v"(lo), "v"(hi)); return r; }
__device__ __forceinline__ float bflo(unsigned w) { return __uint_as_float(w << 16); }
__device__ __forceinline__ float bfhi(unsigned w) { return __uint_as_float(w & 0xffff0000u); }

__device__ __forceinline__ void transpose_item(const float* W, int K, int N, bf16_t* WT, LAS float* scr, int item, int lane) {
    const int nblk = N / 32, kb = item / nblk, nb = item % nblk, k0 = 64 * kb, n0 = 32 * nb;
#pragma unroll 8
    for (int i = 0; i < 32; ++i) { const int kk = 2 * i + (lane >> 5); scr[kk * 33 + (lane & 31)] = W[(size_t)(k0 + kk) * N + n0 + (lane & 31)]; }
    asm volatile("s_waitcnt lgkmcnt(0)" ::: "memory");
    const int c = lane & 7;
#pragma unroll
    for (int j = 0; j < 4; ++j) { const int n = (lane >> 3) + 8 * j; const LAS float* s = scr + (8 * c) * 33 + n;
        u32x4 o; o.x = pk2(s[0 * 33], s[1 * 33]); o.y = pk2(s[2 * 33], s[3 * 33]); o.z = pk2(s[4 * 33], s[5 * 33]); o.w = pk2(s[6 * 33], s[7 * 33]);
        *(u32x4*)(WT + (size_t)(n0 + n) * K + k0 + 8 * c) = o; }
    asm volatile("s_waitcnt lgkmcnt(0)" ::: "memory");
}

struct RowInfo { int b, i, v; bool isctx; };
__device__ __forceinline__ RowInfo row_info(int m) { RowInfo r; r.b = m / LTOK; r.i = m - r.b * LTOK; r.isctx = r.i < CTX; r.v = r.isctx ? 4 : r.b; return r; }

__global__ void __launch_bounds__(512, 2) fwd_megakernel(Params p) {
    extern __shared__ __attribute__((aligned(16))) unsigned char lds[];
    cg::grid_group grid = cg::this_grid();
    const int wave = __builtin_amdgcn_readfirstlane(threadIdx.x >> 6);
    const int G = gridDim.x, bx = blockIdx.x;
    const int vcu = (G % 8 == 0) ? (bx % 8) * (G / 8) + bx / 8 : bx;
    const int gw = bx * 8 + wave, NGW = G * 8;
#define KP() ({ const __attribute__((address_space(4))) Params* k_ = (const __attribute__((address_space(4))) Params*)__builtin_amdgcn_kernarg_segment_ptr(); asm volatile("" : "+s"(k_)); k_; })
#define WSB() ((unsigned char*)KP()->ws)
#define DEFWS(w) \
    float* MOD = (float*)((w) + WS_MOD); float* ROPEM = (float*)((w) + WS_ROPEM); float* ROPEG = (float*)((w) + WS_ROPEG); float* Z = (float*)((w) + WS_Z); \
    bf16_t* WIN = (bf16_t*)((w) + WS_WIN); bf16_t* WUQ = (bf16_t*)((w) + WS_WUQ); bf16_t* WUKV = (bf16_t*)((w) + WS_WUKV); bf16_t* WO = (bf16_t*)((w) + WS_WO); \
    bf16_t* W1 = (bf16_t*)((w) + WS_W1); bf16_t* W2 = (bf16_t*)((w) + WS_W2); \
    bf16_t* U = (bf16_t*)((w) + WS_U); bf16_t* Y = (bf16_t*)((w) + WS_Y); bf16_t* HM = (bf16_t*)((w) + WS_HM); bf16_t* H = (bf16_t*)((w) + WS_H); \
    bf16_t* MQ = (bf16_t*)((w) + WS_MQ); bf16_t* MK = (bf16_t*)((w) + WS_MK); bf16_t* MV = (bf16_t*)((w) + WS_MV); \
    bf16_t* CKV = (bf16_t*)((w) + WS_CKV); bf16_t* CQ = (bf16_t*)((w) + WS_CQ); bf16_t* KPE = (bf16_t*)((w) + WS_KPE); \
    bf16_t* GK = (bf16_t*)((w) + WS_GK); bf16_t* GV = (bf16_t*)((w) + WS_GV); bf16_t* GQ = (bf16_t*)((w) + WS_GQ); bf16_t* OC = (bf16_t*)((w) + WS_O); \
    (void)MOD; (void)ROPEM; (void)ROPEG; (void)Z; (void)WIN; (void)WUQ; (void)WUKV; (void)WO; (void)W1; (void)W2; (void)U; (void)Y; (void)HM; (void)H; (void)MQ; (void)MK; (void)MV; \
    (void)CKV; (void)CQ; (void)KPE; (void)GK; (void)GV; (void)GQ; (void)OC;

    {
        DEFWS(WSB())
        const int lane = pg8::lane_id_asm(), tid = wave * 64 + lane;
        LAS float* scr = (LAS float*)((LAS unsigned char*)lds + wave * 16384);
        constexpr int I_IN = 16 * 57, I_UQ = 4 * 18, I_UKV = 2 * 24, I_O = 16 * 32, I_1 = 16 * 128, I_2 = 64 * 32, PER = I_IN + I_UQ + I_UKV + I_O + I_1 + I_2;
        for (int it = gw; it < DEPTH * PER; it += NGW) {
            const int l = it / PER; int r = it - l * PER;
            if (r < I_IN) { transpose_item(KP()->in[I_WIN] + (size_t)l * DM * IN_COLS, DM, IN_COLS, WIN + (size_t)l * HP * DM, scr, r, lane); continue; } r -= I_IN;
            if (r < I_UQ) { transpose_item(KP()->in[I_WUQ] + (size_t)l * 256 * 576, 256, 576, WUQ + (size_t)l * 768 * 256, scr, r, lane); continue; } r -= I_UQ;
            if (r < I_UKV) { transpose_item(KP()->in[I_WUKV] + (size_t)l * 128 * 768, 128, 768, WUKV + (size_t)l * 768 * 128, scr, r, lane); continue; } r -= I_UKV;
            if (r < I_O) { transpose_item(KP()->in[I_WO] + (size_t)l * DM * DM, DM, DM, WO + (size_t)l * DM * DM, scr, r, lane); continue; } r -= I_O;
            if (r < I_1) { transpose_item(KP()->in[I_W1] + (size_t)l * DM * DFF, DM, DFF, W1 + (size_t)l * DFF * DM, scr, r, lane); continue; } r -= I_1;
            transpose_item(KP()->in[I_W2] + (size_t)l * DFF * DM, DFF, DM, W2 + (size_t)l * DM * DFF, scr, r, lane);
        }
        const int gt = bx * 512 + tid, NGT = G * 512;
        for (int idx = gt; idx < DEPTH * 224 * 128; idx += NGT) { const int l = idx / (224 * 128), r = idx % (224 * 128);
            *(u32x4*)(WIN + ((size_t)l * HP + IN_COLS) * DM + (size_t)r * 8) = (u32x4){0u, 0u, 0u, 0u}; }
        for (int idx = gt; idx < DEPTH * 192 * 32; idx += NGT) { const int l = idx / (192 * 32), r = idx % (192 * 32);
            *(u32x4*)(WUQ + ((size_t)l * 768 + 576) * 256 + (size_t)r * 8) = (u32x4){0u, 0u, 0u, 0u}; }
        for (int idx = gt; idx < SEQ * 16; idx += NGT) { const int pos = idx >> 4, i = idx & 15; const int rw = pos >> 6, cl = pos & 63;
            const float inv = powf(10000.f, -(float)(i & 7) / 8.f); const float ang = (float)(i < 8 ? rw : cl) * inv;
            ROPEM[2 * idx] = cosf(ang); ROPEM[2 * idx + 1] = sinf(ang); }
        for (int idx = gt; idx < SEQ * 32; idx += NGT) { const int pos = idx >> 5, i = idx & 31; const int rw = pos >> 6, cl = pos & 63;
            const float inv = powf(10000.f, -(float)(i & 15) / 16.f); const float ang = (float)(i < 16 ? rw : cl) * inv;
            ROPEG[2 * idx] = cosf(ang); ROPEG[2 * idx + 1] = sinf(ang); }
        __syncthreads();
        float* sil = (float*)lds;
        float* part = (float*)lds + 5 * 1024;
        { const float* c_in = KP()->in[I_C]; const float* cc_in = KP()->in[I_CCTX];
        for (int idx = tid; idx < 5 * 1024; idx += 512) { const int v = idx >> 10, k = idx & 1023; const float c = (v < 4) ? c_in[v * 1024 + k] : cc_in[k]; sil[idx] = c / (1.f + __expf(-c)); } }
        const float* wada_ = KP()->in[I_WADA]; const float* bada_ = KP()->in[I_BADA];
        __syncthreads();
        for (int it = bx; it < DEPTH * 96; it += G) { const int l = it / 96, jb = it % 96; const int j = jb * 64 + lane;
            const float* wp = wada_ + ((size_t)l * DM + wave * 128) * 6144 + j;
            float a0 = 0, a1 = 0, a2 = 0, a3 = 0, a4 = 0;
#pragma unroll 8
            for (int k = 0; k < 128; ++k) { const float w = wp[(size_t)k * 6144]; const int kk = wave * 128 + k;
                a0 += sil[kk] * w; a1 += sil[1024 + kk] * w; a2 += sil[2048 + kk] * w; a3 += sil[3072 + kk] * w; a4 += sil[4096 + kk] * w; }
            part[(wave * 5 + 0) * 64 + lane] = a0; part[(wave * 5 + 1) * 64 + lane] = a1; part[(wave * 5 + 2) * 64 + lane] = a2; part[(wave * 5 + 3) * 64 + lane] = a3; part[(wave * 5 + 4) * 64 + lane] = a4;
            __syncthreads();
            if (tid < 320) { const int v = tid >> 6, c = tid & 63; float s = bada_[l * 6144 + jb * 64 + c];
#pragma unroll
                for (int w = 0; w < 8; ++w) s += part[(w * 5 + v) * 64 + c];
                MOD[((size_t)l * 5 + v) * 6144 + jb * 64 + c] = s; }
            __syncthreads();
        }
    }
    grid.sync();
    { DEFWS(WSB())
    const int lane = pg8::lane_id_asm(); const float* xin_ = KP()->in[I_X]; const float* cin_ = KP()->in[I_CTX];
    for (int m = gw; m < MROWS; m += NGW) { const RowInfo ri = row_info(m);
        const float* xr = ri.isctx ? cin_ + ((size_t)ri.b * CTX + ri.i) * DM : xin_ + ((size_t)ri.b * SEQ + ri.i - CTX) * DM;
        const float* md = MOD + (size_t)ri.v * 6144;
#pragma unroll
        for (int j = 0; j < 4; ++j) { const int col = 4 * lane + 256 * j; const f32x4 x = *(const f32x4*)(xr + col), sh = *(const f32x4*)(md + col), sc = *(const f32x4*)(md + 1024 + col);
            const f32x4 u = x * (1.f + sc) + sh; u32x2 w; w.x = pk2(u[0], u[1]); w.y = pk2(u[2], u[3]); *(u32x2*)(U + (size_t)m * DM + col) = w; }
    } }
    grid.sync();

#pragma unroll 1
    for (int l = 0; l < DEPTH; ++l) {
        { DEFWS(WSB()) pg8::Gemm g{U, WIN + (size_t)l * HP * DM, MROWS, HP, DM}; pg8::StaticOrder S; S.init(MROWS, HP, G, bx);
          pg8::EpiStore<0> E{H, HP};
          for (int r_ = 0; r_ < GEMM_REPS; ++r_) pg8::gemm_phase<pg8::EpiStore<0>, pg8::StaticOrder, true, true>((LAS unsigned char*)lds, g, S, E, wave); }
        grid.sync();
        {
            DEFWS(WSB())
            const int lane = pg8::lane_id_asm();
            const f32x2* gckv = (const f32x2*)(KP()->in[I_GCKV] + l * 128); const f32x2* gkn = (const f32x2*)(KP()->in[I_GKN] + l * 64);
            const f32x2* gcq = (const f32x2*)(KP()->in[I_GCQ] + l * 256); const f32x2* gqn = (const f32x2*)(KP()->in[I_GQN] + l * 64);
            const f32x2* wc0 = (const f32x2*)(KP()->in[I_WCONV] + (size_t)l * 768); const f32x2* wc1 = wc0 + 128; const f32x2* wc2 = wc0 + 256;
            const f32x2* rM = (const f32x2*)ROPEM; const f32x2* rG = (const f32x2*)ROPEG;
            for (int m = gw; m < MROWS; m += NGW) { const RowInfo ri = row_info(m); const bool lat = !ri.isctx; const int pos = ri.i - CTX;
                const unsigned* hr = (const unsigned*)(H + (size_t)m * HP);
                {
                    const unsigned w = hr[lane]; const float a = bflo(w), b = bfhi(w); const float r = rsqrtf(wave_sum(a * a + b * b, lane) * (1.f / 128.f) + LN_EPS); const f32x2 g = gckv[lane];
                    ((unsigned*)(CKV + (size_t)m * 128))[lane] = pk2(a * r * g.x, b * r * g.y); }
                if (lane < 16) {
                    const unsigned w = hr[64 + lane]; float a = bflo(w), b = bfhi(w);
                    if (lat) { const f32x2 cs = rM[pos * 16 + lane]; const float a2 = a * cs.x - b * cs.y, b2 = a * cs.y + b * cs.x; a = a2; b = b2; }
                    ((unsigned*)(KPE + (size_t)m * 32))[lane] = pk2(a, b); }
                {
                    const unsigned w = hr[80 + lane]; float a = bflo(w), b = bfhi(w); const float r = rsqrtf(half_sum(a * a + b * b, lane) * (1.f / 64.f) + LN_EPS); const f32x2 g = gkn[lane & 31];
                    a = a * r * g.x; b = b * r * g.y;
                    if (lat) { const f32x2 cs = rG[pos * 32 + (lane & 31)]; const float a2 = a * cs.x - b * cs.y, b2 = a * cs.y + b * cs.x; a = a2; b = b2; }
                    ((unsigned*)(GK + (size_t)m * 128))[lane] = pk2(a, b); }
                ((unsigned*)(GV + (size_t)m * 128))[lane] = hr[144 + lane];
                {
                    const unsigned w0 = hr[208 + lane], w1 = hr[272 + lane]; const float a0 = bflo(w0), b0 = bfhi(w0), a1 = bflo(w1), b1 = bfhi(w1);
                    const float r = rsqrtf(wave_sum(a0 * a0 + b0 * b0 + a1 * a1 + b1 * b1, lane) * (1.f / 256.f) + LN_EPS); const f32x2 g0 = gcq[lane], g1 = gcq[64 + lane];
                    unsigned* o = (unsigned*)(CQ + (size_t)m * 256); o[lane] = pk2(a0 * r * g0.x, b0 * r * g0.y); o[64 + lane] = pk2(a1 * r * g1.x, b1 * r * g1.y); }
#pragma unroll
                for (int j = 0; j < 3; ++j) {
                    const unsigned w = hr[336 + 64 * j + lane]; float a = bflo(w), b = bfhi(w); const float r = rsqrtf(half_sum(a * a + b * b, lane) * (1.f / 64.f) + LN_EPS); const f32x2 g = gqn[lane & 31];
                    a = a * r * g.x; b = b * r * g.y;
                    if (lat) { const f32x2 cs = rG[pos * 32 + (lane & 31)]; const float a2 = a * cs.x - b * cs.y, b2 = a * cs.y + b * cs.x; a = a2; b = b2; }
                    ((unsigned*)(GQ + (size_t)m * 384))[64 * j + lane] = pk2(a * QSC64, b * QSC64); }
                {
                    const int seqlen = lat ? SEQ : CTX, t = lat ? pos : ri.i; const bool hp = t > 0, hn = t + 1 < seqlen;
                    const unsigned* hm1 = hr - HP / 2; const unsigned* hp1 = hr + HP / 2;
#pragma unroll
                    for (int j = 0; j < 2; ++j) { const int ix = lane + 64 * j;
                        const unsigned c0 = hr[528 + ix], k0 = hr[784 + ix], bb = hr[656 + ix];
                        const unsigned cm = hp ? hm1[528 + ix] : 0u, km = hp ? hm1[784 + ix] : 0u, cn = hn ? hp1[528 + ix] : 0u, kn = hn ? hp1[784 + ix] : 0u;
                        const f32x2 w0 = wc0[ix], w1 = wc1[ix], w2 = wc2[ix];
                        const float oa = bflo(bb) * (w0.x * bflo(cm) * bflo(km) + w1.x * bflo(c0) * bflo(k0) + w2.x * bflo(cn) * bflo(kn));
                        const float ob = bfhi(bb) * (w0.y * bfhi(cm) * bfhi(km) + w1.y * bfhi(c0) * bfhi(k0) + w2.y * bfhi(cn) * bfhi(kn));
                        ((unsigned*)(OC + (size_t)m * DM))[384 + ix] = pk2(oa, ob); }
                }
            }
        }
        grid.sync();
        { DEFWS(WSB()) pg8::Gemm g{CQ, WUQ + (size_t)l * 768 * 256, MROWS, 768, 256}; pg8::StaticOrder S; S.init(MROWS, 768, G, bx);
          pg8::EpiUQ E{MQ, ROPEM, QSC96};
          for (int r_ = 0; r_ < GEMM_REPS; ++r_) pg8::gemm_phase<pg8::EpiUQ, pg8::StaticOrder, true, false>((LAS unsigned char*)lds, g, S, E, wave); }
        { DEFWS(WSB()) pg8::Gemm g{CKV, WUKV + (size_t)l * 768 * 128, MROWS, 768, 128}; pg8::StaticOrder S; S.init(MROWS, 768, G, bx);
          pg8::EpiUKV E{MK, MV};
          for (int r_ = 0; r_ < GEMM_REPS; ++r_) pg8::gemm_phase<pg8::EpiUKV, pg8::StaticOrder, true, false>((LAS unsigned char*)lds, g, S, E, wave); }
        grid.sync();
        {
            DEFWS(WSB())
            const int nrounds = (l < DEPTH - 1) ? 7 : 6;
            for (int i_ = 0; i_ < nrounds * ATT_REPS; ++i_) { const int i = (ATT_REPS == 1) ? i_ : (i_ % nrounds);
                int type, b, h, qrow0, seq;
                if (i < 6) { const int u = vcu + 256 * i; type = u / 768; const int rem = u % 768; b = rem / 192; h = (rem >> 5) % 6; const int qb = rem & 31; qrow0 = b * LTOK + CTX + qb * 256; seq = LTOK; }
                else { if (vcu >= 48) continue; type = vcu / 24; b = (vcu % 24) / 6; h = vcu % 6; qrow0 = b * LTOK; seq = CTX; }
                const size_t kr = (size_t)b * LTOK;
                if (type == 0) att::attn_unit<96>(MQ + (size_t)qrow0 * 576 + h * 96, MK + kr * 384 + h * 64, KPE + kr * 32, MV + kr * 384 + h * 64, OC + (size_t)qrow0 * DM + h * 64, seq, (char*)lds, wave);
                else att::attn_unit<64>(GQ + (size_t)qrow0 * 384 + h * 64, GK + kr * 128 + (h / 3) * 64, nullptr, GV + kr * 128 + (h / 3) * 64, OC + (size_t)qrow0 * DM + 384 + h * 64, seq, (char*)lds, wave);
            }
        }
        grid.sync();
        { DEFWS(WSB()) pg8::Gemm g{OC, WO + (size_t)l * DM * DM, MROWS, DM, DM}; pg8::StaticOrder S; S.init(MROWS, DM, G, bx);
          pg8::EpiStore<0> E{Y, DM};
          for (int r_ = 0; r_ < GEMM_REPS; ++r_) pg8::gemm_phase<pg8::EpiStore<0>, pg8::StaticOrder, true, true>((LAS unsigned char*)lds, g, S, E, wave); }
        grid.sync();
#pragma unroll 1
        for (int which = 0; which < 2; ++which) {
            {
                DEFWS(WSB())
                const int lane = pg8::lane_id_asm();
                const float* lg = KP()->in[which ? I_LN2G : I_LN1G] + l * DM; const float* lb = KP()->in[which ? I_LN2B : I_LN1B] + l * DM;
                const float* xin_ = KP()->in[I_X]; const float* cin_ = KP()->in[I_CTX]; float* out_ = KP()->out;
                const bool first = (l == 0 && which == 0); const bool wantu = !(which == 1 && l == DEPTH - 1);
                for (int m = gw; m < MROWS; m += NGW) { const RowInfo ri = row_info(m);
                    const size_t zoff = ((size_t)ri.b * CTX + ri.i) * DM, xoff = ((size_t)ri.b * SEQ + ri.i - CTX) * DM;
                    const float* xo = ri.isctx ? (first ? cin_ + zoff : Z + zoff) : (first ? xin_ + xoff : out_ + xoff);
                    float* xn = ri.isctx ? Z + zoff : out_ + xoff;
                    const float* md = MOD + ((size_t)l * 5 + ri.v) * 6144; const float* gate = md + (which ? 5 : 2) * 1024;
                    const float* md2 = which ? MOD + ((size_t)(wantu ? l + 1 : l) * 5 + ri.v) * 6144 : md + 3 * 1024;
                    f32x4 t[4]; float s = 0.f;
#pragma unroll
                    for (int j = 0; j < 4; ++j) { const int col = 4 * lane + 256 * j; const f32x4 x = *(const f32x4*)(xo + col), gt = *(const f32x4*)(gate + col);
                        const u32x2 yw = *(const u32x2*)(Y + (size_t)m * DM + col); const f32x4 y = {bflo(yw.x), bfhi(yw.x), bflo(yw.y), bfhi(yw.y)};
                        t[j] = ALPHA * x + gt * y; s += (t[j][0] + t[j][1]) + (t[j][2] + t[j][3]); }
                    const float mean = wave_sum(s, lane) * (1.f / DM); float s2 = 0.f;
#pragma unroll
                    for (int j = 0; j < 4; ++j) { t[j] = t[j] - mean; s2 += (t[j][0] * t[j][0] + t[j][1] * t[j][1]) + (t[j][2] * t[j][2] + t[j][3] * t[j][3]); }
                    const float rstd = rsqrtf(wave_sum(s2, lane) * (1.f / DM) + LN_EPS);
#pragma unroll
                    for (int j = 0; j < 4; ++j) { const int col = 4 * lane + 256 * j; const f32x4 g4 = *(const f32x4*)(lg + col), b4 = *(const f32x4*)(lb + col);
                        const f32x4 xv = t[j] * rstd * g4 + b4; *(f32x4*)(xn + col) = xv;
                        if (wantu) { const f32x4 sh = *(const f32x4*)(md2 + col), sc = *(const f32x4*)(md2 + 1024 + col); const f32x4 u = xv * (1.f + sc) + sh;
                            u32x2 w; w.x = pk2(u[0], u[1]); w.y = pk2(u[2], u[3]); *(u32x2*)(U + (size_t)m * DM + col) = w; } }
                }
            }
            if (which == 1) { if (l < DEPTH - 1) grid.sync(); break; }
            grid.sync();
            { DEFWS(WSB()) pg8::Gemm g{U, W1 + (size_t)l * DFF * DM, MROWS, DFF, DM}; pg8::StaticOrder S; S.init(MROWS, DFF, G, bx);
              pg8::EpiStore<1> E{HM, DFF};
              for (int r_ = 0; r_ < GEMM_REPS; ++r_) pg8::gemm_phase<pg8::EpiStore<1>, pg8::StaticOrder, true, true>((LAS unsigned char*)lds, g, S, E, wave); }
            grid.sync();
            { DEFWS(WSB()) pg8::Gemm g{HM, W2 + (size_t)l * DM * DFF, MROWS, DM, DFF}; pg8::StaticOrder S; S.init(MROWS, DM, G, bx);
              pg8::EpiStore<0> E{Y, DM};
              for (int r_ = 0; r_ < GEMM_REPS; ++r_) pg8::gemm_phase<pg8::EpiStore<0>, pg8::StaticOrder, true, true>((LAS unsigned char*)lds, g, S, E, wave); }
            grid.sync();
        }
    }
}

extern "C" void kernel_launch(void* const* d_in, const int* in_sizes, int n_in, void* d_out, int out_size, void* d_ws, size_t ws_size, hipStream_t stream) {
    static int grid = 0;
    if (grid == 0) {
        if (n_in != 21 || in_sizes[0] != NBATCH * SEQ * DM || out_size != NBATCH * SEQ * DM || ws_size < WS_END) {
            fprintf(stderr, "kernel_launch: shape mismatch n_in %d in0 %d out %d ws %zu (need %zu)\n", n_in, n_in > 0 ? in_sizes[0] : -1, out_size, ws_size, (size_t)WS_END); grid = -1; return; }
        int dev = 0, cus = 0, per_cu = 0;
        hipGetDevice(&dev); hipDeviceGetAttribute(&cus, hipDeviceAttributeMultiprocessorCount, dev);
        if (hipFuncSetAttribute((const void*)fwd_megakernel, hipFuncAttributeMaxDynamicSharedMemorySize, LDS_BYTES) != hipSuccess) { fprintf(stderr, "kernel_launch: hipFuncSetAttribute failed\n"); grid = -1; return; }
        if (hipOccupancyMaxActiveBlocksPerMultiprocessor(&per_cu, (const void*)fwd_megakernel, 512, LDS_BYTES) != hipSuccess || per_cu < 1) { fprintf(stderr, "kernel_launch: occupancy query says %d\n", per_cu); per_cu = 1; }
        (void)hipGetLastError();
        grid = cus;
        fprintf(stderr, "kernel_launch: grid %d (per_cu %d)\n", grid, per_cu);
    }
    if (grid < 0) return;
    Params p{};
    for (int i = 0; i < 21; ++i) p.in[i] = (const float*)d_in[i];
    p.out = (float*)d_out; p.ws = (unsigned char*)d_ws;
    void* args[] = {&p};
    hipError_t e = hipLaunchCooperativeKernel((const void*)fwd_megakernel, dim3(grid), dim3(512), args, LDS_BYTES, stream);
    if (e != hipSuccess) fprintf(stderr, "kernel_launch: cooperative launch failed: %s (grid %d)\n", hipGetErrorString(e), grid);
}
```

```cpp
#include <hip/hip_runtime.h>
#include <hip/hip_cooperative_groups.h>
#include <cstdio>
#include <cstdint>
namespace cg = cooperative_groups;

constexpr int DM = 1024, NBATCH = 4, SEQ = 8192, DEPTH = 4, CTX = 256, DFF = 4096;
constexpr int LTOK = CTX + SEQ;
constexpr int MROWS = NBATCH * LTOK;
constexpr int IN_COLS = 1824, HP = 2048;
constexpr float LN_EPS = 1e-6f;
constexpr float ALPHA = 1.6817928305074290f;
namespace pg8 {
#define PG8_LAS __attribute__((address_space(3)))
typedef unsigned short bf16_t;
typedef short bf16x8 __attribute__((ext_vector_type(8)));
typedef float f32x4 __attribute__((ext_vector_type(4)));
typedef unsigned u32x4 __attribute__((ext_vector_type(4)));
constexpr int BM = 256, BK = 64, HALF = 128, HTB = HALF * BK * 2  , STAGE_BYTES = 8 * HTB, NXCD = 8, WGM = 8;

__host__ __device__ __forceinline__ int lds_byte(int r, int c) { const int st = (r >> 4) * 2 + (c >> 5), rr = r & 15, cc = c & 31, ob = rr * 64 + cc * 2; return st * 1024 + (ob ^ (((ob >> 9) & 1) << 5)); }
__host__ __device__ __forceinline__ void stage_rc(int b, int& R, int& C) { const int st = b / 1024, sb = b % 1024, swz = sb ^ (((sb >> 9) & 1) << 5); R = (st >> 1) * 16 + swz / 64; C = (st & 1) * 32 + (swz % 64) / 2; }
__host__ __device__ __forceinline__ int perm32(int rho) { const int n = rho >> 4, i = rho & 15; return 8 * (i >> 2) + 4 * n + (i & 3); }

struct Unit { int pm, pn, pk; };
struct Gemm { const bf16_t* A; const bf16_t* Bt; int M, N, K, ld; };

struct StaticOrder {
    int nM, nN, nwg, G, c;
    __host__ __device__ void init(int M, int N, int G_, int c_) { nM = M / BM; nN = N / BM; nwg = nM * nN; G = G_; c = c_; }
    __host__ __device__ bool next(int i, Unit& u) const {
        const long L = (long)i * G + c; if (L >= nwg) return false;
        int wgid = (int)L; { const int q = nwg / NXCD, r = nwg % NXCD, xcd = wgid % NXCD, off = wgid / NXCD; wgid = (xcd < r ? xcd * (q + 1) : r * (q + 1) + (xcd - r) * q) + off; }
        const int nig = WGM * nN, gid = wgid / nig, fm = gid * WGM, gsz = (nM - fm) < WGM ? (nM - fm) : WGM;
        u.pm = fm + ((wgid % nig) % gsz); u.pn = (wgid % nig) / gsz; u.pk = 0; return true;
    }
    __device__ __forceinline__ void a_ready(const Unit&) const {}
    __device__ __forceinline__ void done(const Unit&) const {}
};

__device__ __forceinline__ unsigned cvt_pk_bf16(float lo, float hi) { unsigned r; asm volatile("v_cvt_pk_bf16_f32 %0, %1, %2" : "=v"(r) : "v"(lo), "v"(hi)); return r; }
__device__ __forceinline__ int lane_id_asm() { int l; asm volatile("v_mbcnt_lo_u32_b32 %0, -1, 0\n\tv_mbcnt_hi_u32_b32 %0, -1, %0" : "=v"(l)); return l; }
typedef float f32x2 __attribute__((ext_vector_type(2)));
template <int ACT  > struct EpiStore {
    static constexpr bool PERM = true, AFTER_DRAIN = false;
    bf16_t* O; int ldc;
    __device__ __forceinline__ void operator()(const f32x4 (&acc)[2][2][4][2], const Unit& u, int wr, int wc, int fr, int fq) const {
        const int row0 = u.pm * BM + wr * 64 + fr; const int col0 = u.pn * BM + wc * 32 + 8 * fq;
#pragma unroll
        for (int ai = 0; ai < 2; ++ai)
#pragma unroll
            for (int m = 0; m < 4; ++m) { bf16_t* rowp = O + (size_t)(row0 + ai * HALF + m * 16) * ldc + col0;
#pragma unroll
                for (int bj = 0; bj < 2; ++bj) { f32x4 v0 = acc[ai][bj][m][0], v1 = acc[ai][bj][m][1];
                    if (ACT == 1) {
#pragma unroll
                        for (int e = 0; e < 4; ++e) { float a = fmaxf(v0[e], 0.f), b = fmaxf(v1[e], 0.f); v0[e] = a * a; v1[e] = b * b; } }
                    u32x4 w; w.x = cvt_pk_bf16(v0[0], v0[1]); w.y = cvt_pk_bf16(v0[2], v0[3]); w.z = cvt_pk_bf16(v1[0], v1[1]); w.w = cvt_pk_bf16(v1[2], v1[3]);
                    *(u32x4*)(rowp + bj * HALF) = w; } }
    }
};
struct EpiUQ {
    static constexpr bool PERM = true, AFTER_DRAIN = false;
    bf16_t* MQ; const float* ropeM; float qscale;
    __device__ __forceinline__ void operator()(const f32x4 (&acc)[2][2][4][2], const Unit& u, int wr, int wc, int fr, int fq) const {
        const int row0 = u.pm * BM + wr * 64 + fr;
        const int pt = u.pm % 33; const bool lat = pt != 0; const int pos0 = (pt - 1) * 256 + wr * 64 + fr;
#pragma unroll
        for (int bj = 0; bj < 2; ++bj) {
            const int c = u.pn * BM + bj * HALF + wc * 32 + 8 * fq;
            if (c >= 576) continue;
            const int d = c % 96; const bool isrope = (d >= 64) && lat; const int i0 = (d - 64) >> 1;
#pragma unroll
            for (int ai = 0; ai < 2; ++ai)
#pragma unroll
                for (int m = 0; m < 4; ++m) { const int row = row0 + ai * HALF + m * 16;
                    f32x4 v0 = acc[ai][bj][m][0], v1 = acc[ai][bj][m][1];
                    if (isrope) { const f32x4* rp = (const f32x4*)(ropeM + ((size_t)(pos0 + ai * HALF + m * 16) * 16 + i0) * 2);
                        const f32x4 r0 = rp[0], r1 = rp[1];
                        f32x4 a, b;
                        a[0] = v0[0] * r0[0] - v0[1] * r0[1]; a[1] = v0[0] * r0[1] + v0[1] * r0[0];
                        a[2] = v0[2] * r0[2] - v0[3] * r0[3]; a[3] = v0[2] * r0[3] + v0[3] * r0[2];
                        b[0] = v1[0] * r1[0] - v1[1] * r1[1]; b[1] = v1[0] * r1[1] + v1[1] * r1[0];
                        b[2] = v1[2] * r1[2] - v1[3] * r1[3]; b[3] = v1[2] * r1[3] + v1[3] * r1[2];
                        v0 = a; v1 = b; }
                    v0 = v0 * qscale; v1 = v1 * qscale;
                    u32x4 w; w.x = cvt_pk_bf16(v0[0], v0[1]); w.y = cvt_pk_bf16(v0[2], v0[3]); w.z = cvt_pk_bf16(v1[0], v1[1]); w.w = cvt_pk_bf16(v1[2], v1[3]);
                    *(u32x4*)(MQ + (size_t)row * 576 + c) = w; }
        }
    }
};
struct EpiUKV {
    static constexpr bool PERM = true, AFTER_DRAIN = false;
    bf16_t* MK; bf16_t* MV;
    __device__ __forceinline__ void operator()(const f32x4 (&acc)[2][2][4][2], const Unit& u, int wr, int wc, int fr, int fq) const {
        const int row0 = u.pm * BM + wr * 64 + fr;
#pragma unroll
        for (int bj = 0; bj < 2; ++bj) {
            const int head = u.pn * 2 + bj; const int d = wc * 32 + 8 * fq;
            bf16_t* base = (d < 64) ? (MK + head * 64 + d) : (MV + head * 64 + d - 64);
#pragma unroll
            for (int ai = 0; ai < 2; ++ai)
#pragma unroll
                for (int m = 0; m < 4; ++m) { const int row = row0 + ai * HALF + m * 16;
                    const f32x4 v0 = acc[ai][bj][m][0], v1 = acc[ai][bj][m][1];
                    u32x4 w; w.x = cvt_pk_bf16(v0[0], v0[1]); w.y = cvt_pk_bf16(v0[2], v0[3]); w.z = cvt_pk_bf16(v1[0], v1[1]); w.w = cvt_pk_bf16(v1[2], v1[3]);
                    *(u32x4*)(base + (size_t)row * 384) = w; }
        }
    }
};
struct RowOrder {
    StaticOrder S0; bool latonly;
    __host__ __device__ void init(int N, int G_, int c_, bool latonly_) { latonly = latonly_; S0.init(latonly_ ? 128 * BM : 132 * BM, N, G_, c_); }
    __host__ __device__ bool next(int i, Unit& u) const { if (!S0.next(i, u)) return false; if (latonly) u.pm = u.pm + u.pm / 32 + 1; return true; }
    __device__ __forceinline__ void a_ready(const Unit&) const {}
    __device__ __forceinline__ void done(const Unit&) const {}
};
struct CtxSplitOrder {
    int nN, KS, total, G, c;
    __host__ __device__ void init(int N, int KS_, int G_, int c_) { nN = N / BM; KS = KS_; total = 4 * nN * KS_; G = G_; c = c_; }
    __host__ __device__ bool next(int i, Unit& u) const { const int L = i * G + c; if (L >= total) return false; u.pk = L % KS; const int t = L / KS; u.pn = t % nN; u.pm = 33 * (t / nN); return true; }
    __device__ __forceinline__ void a_ready(const Unit&) const {}
    __device__ __forceinline__ void done(const Unit&) const {}
};
struct EpiPart {
    static constexpr bool PERM = false, AFTER_DRAIN = false;
    float* P; int ldc; size_t kstride;
    __device__ __forceinline__ void operator()(const f32x4 (&acc)[2][2][4][2], const Unit& u, int wr, int wc, int fr, int fq) const {
        float* base = P + (size_t)u.pk * kstride + (size_t)((u.pm / 33) * BM + wr * 64 + fr) * ldc + u.pn * BM + wc * 32 + 4 * fq;
#pragma unroll
        for (int ai = 0; ai < 2; ++ai)
#pragma unroll
            for (int m = 0; m < 4; ++m)
#pragma unroll
                for (int bj = 0; bj < 2; ++bj)
#pragma unroll
                    for (int n = 0; n < 2; ++n) *(f32x4*)(base + (size_t)(ai * HALF + m * 16) * ldc + bj * HALF + n * 16) = acc[ai][bj][m][n];
    }
};
template <class Epi, class Sched, bool ALIGN_EPI = false, bool SP2 = false>
__device__ __forceinline__ void gemm_phase(PG8_LAS unsigned char* lds, const Gemm g, const Sched& S, const Epi& E, const int wave_in) {
    const int tid_l_ = wave_in * 64 + lane_id_asm();
    const int tid = tid_l_, wid = __builtin_amdgcn_readfirstlane(tid >> 6), lane = tid & 63, wr = wid >> 2, wc = wid & 3, fr = lane & 15, fq = lane >> 4;
    const int K = g.K, nt = K / BK;
    unsigned voffA[2], voffB[2];
#pragma unroll
    for (int i = 0; i < 2; ++i) { int R, C; stage_rc(tid * 16 + i * 8192, R, C); const int Rb = Epi::PERM ? ((R & ~31) + perm32(R & 31)) : R;
        voffA[i] = (unsigned)(R * g.ld + C) * 2u; voffB[i] = (unsigned)(Rb * g.ld + C) * 2u; }
    const size_t kstep = (size_t)(BK * 2);
    const size_t hstep = (size_t)HALF * g.ld * 2;
    const size_t tstep = 2 * hstep;
    const unsigned ldsw = (unsigned)wid * 1024u;
    const int aoff = lds_byte(wr * 64 + fr, fq * 8), boff = lds_byte(wc * 32 + fr, fq * 8);
#define PG8_SA(b, h) (((b) * 2 + (h)) * HTB)
#define PG8_SB(b, h) ((4 + (b) * 2 + (h)) * HTB)
#define PG8_STAGE(bufoff, gbase, voff) do { _Pragma("unroll") for (int _i = 0; _i < 2; ++_i) \
        __builtin_amdgcn_global_load_lds((const unsigned*)((const char*)(gbase) + (voff)[_i]), (PG8_LAS unsigned*)(lds + (bufoff) + ldsw + _i * 8192), 16, 0, 0); } while (0)
#define PG8_LDA(dst, b, h) do { _Pragma("unroll") for (int m = 0; m < 4; ++m) _Pragma("unroll") for (int k = 0; k < 2; ++k) dst[m][k] = *(const PG8_LAS bf16x8*)(lds + PG8_SA(b, h) + aoff + m * 2048 + k * 1024); } while (0)
#define PG8_LDB(dst, b, h) do { _Pragma("unroll") for (int n = 0; n < 2; ++n) _Pragma("unroll") for (int k = 0; k < 2; ++k) dst[n][k] = *(const PG8_LAS bf16x8*)(lds + PG8_SB(b, h) + boff + n * 2048 + k * 1024); } while (0)
#define PG8_MMA(ai, bj, At, Bt) do { __builtin_amdgcn_s_setprio(1); _Pragma("unroll") for (int m = 0; m < 4; ++m) _Pragma("unroll") for (int n = 0; n < 2; ++n) _Pragma("unroll") for (int k = 0; k < 2; ++k) \
        acc[ai][bj][m][n] = __builtin_amdgcn_mfma_f32_16x16x32_bf16(Bt[n][k], At[m][k], acc[ai][bj][m][n], 0, 0, 0); __builtin_amdgcn_s_setprio(0); } while (0)
#define PG8_WAIT_V(n) asm volatile("s_waitcnt vmcnt(" #n ")" ::: "memory")
#define PG8_WAIT_L(n) asm volatile("s_waitcnt lgkmcnt(" #n ")" ::: "memory")
#define PG8_BAR __builtin_amdgcn_s_barrier()
#define PG8_SCHED __builtin_amdgcn_sched_barrier(0)
    Unit cur, nxt; int ui = 0;
    if (!S.next(0, cur)) return;
    f32x4 acc[2][2][4][2];
#pragma unroll
    for (int a = 0; a < 2; ++a)
#pragma unroll
        for (int b = 0; b < 2; ++b)
#pragma unroll
            for (int m = 0; m < 4; ++m)
#pragma unroll
                for (int n = 0; n < 2; ++n) acc[a][b][m][n] = (f32x4){0.f, 0.f, 0.f, 0.f};
    bf16x8 At[4][2], B0[2][2], B1[2][2];
    const char* cA = (const char*)g.A + (size_t)cur.pm * tstep + (size_t)cur.pk * K * 2; const char* cB = (const char*)g.Bt + (size_t)cur.pn * tstep + (size_t)cur.pk * K * 2;
    S.a_ready(cur);
    if constexpr (SP2) {
        PG8_STAGE(PG8_SB(0, 0), cB, voffB); PG8_STAGE(PG8_SB(0, 1), cB + hstep, voffB); PG8_STAGE(PG8_SA(0, 0), cA, voffA); PG8_STAGE(PG8_SA(0, 1), cA + hstep, voffA);
        if (wr == 1) PG8_BAR;
        PG8_WAIT_V(2); PG8_BAR;
        PG8_STAGE(PG8_SB(1, 0), cB + kstep, voffB); PG8_STAGE(PG8_SA(1, 0), cA + kstep, voffA); PG8_STAGE(PG8_SB(1, 1), cB + hstep + kstep, voffB);
        PG8_WAIT_V(6); PG8_BAR;
    } else {
        PG8_STAGE(PG8_SB(0, 0), cB, voffB); PG8_STAGE(PG8_SA(0, 0), cA, voffA); PG8_STAGE(PG8_SB(0, 1), cB + hstep, voffB); PG8_STAGE(PG8_SA(0, 1), cA + hstep, voffA);
        if (wr == 1) PG8_BAR;
        PG8_WAIT_V(4); PG8_BAR;
        PG8_STAGE(PG8_SB(1, 0), cB + kstep, voffB); PG8_STAGE(PG8_SA(1, 0), cA + kstep, voffA); PG8_STAGE(PG8_SB(1, 1), cB + hstep + kstep, voffB);
        PG8_WAIT_V(6); PG8_BAR;
    }
    for (;;) {
        const bool has_next = S.next(ui + 1, nxt);
        const char* nA = has_next ? (const char*)g.A + (size_t)nxt.pm * tstep + (size_t)nxt.pk * K * 2 : cA; const char* nB = has_next ? (const char*)g.Bt + (size_t)nxt.pn * tstep + (size_t)nxt.pk * K * 2 : cB;
        for (int t = 0; t < nt; t += 2) {
            const bool last = (t == nt - 2);
            const char* a1 = cA + (size_t)(t + 1) * kstep;
            const char* a2 = last ? nA : cA + (size_t)(t + 2) * kstep; const char* b2 = last ? nB : cB + (size_t)(t + 2) * kstep;
            const char* a3 = a2 + kstep; const char* b3 = b2 + kstep;
            if (last && has_next) S.a_ready(nxt);
            if constexpr (SP2) {
            PG8_LDB(B0, 0, 0); PG8_LDB(B1, 0, 1); PG8_SCHED; PG8_LDA(At, 0, 0); PG8_STAGE(PG8_SA(1, 1), a1 + hstep, voffA);
            PG8_WAIT_V(8); PG8_WAIT_L(0); PG8_BAR; PG8_MMA(0, 0, At, B0); PG8_MMA(0, 1, At, B1); PG8_BAR; PG8_SCHED;
            PG8_LDA(At, 0, 1); PG8_STAGE(PG8_SB(0, 0), b2, voffB); PG8_STAGE(PG8_SB(0, 1), b2 + hstep, voffB); PG8_STAGE(PG8_SA(0, 0), a2, voffA);
            PG8_WAIT_V(8); PG8_WAIT_L(0); PG8_BAR; PG8_MMA(1, 0, At, B0); PG8_MMA(1, 1, At, B1); PG8_BAR; PG8_SCHED;
            PG8_LDB(B0, 1, 0); PG8_LDB(B1, 1, 1); PG8_SCHED; PG8_LDA(At, 1, 0); PG8_STAGE(PG8_SA(0, 1), a2 + hstep, voffA);
            PG8_WAIT_V(8); PG8_WAIT_L(0); PG8_BAR; PG8_MMA(0, 0, At, B0); PG8_MMA(0, 1, At, B1); PG8_BAR; PG8_SCHED;
            PG8_LDA(At, 1, 1); PG8_STAGE(PG8_SB(1, 0), b3, voffB); PG8_STAGE(PG8_SB(1, 1), b3 + hstep, voffB); PG8_STAGE(PG8_SA(1, 0), a3, voffA);
            PG8_WAIT_V(8); PG8_WAIT_L(0); PG8_BAR; PG8_MMA(1, 0, At, B0); PG8_MMA(1, 1, At, B1); PG8_BAR; PG8_SCHED;
            } else {
            PG8_LDB(B0, 0, 0); PG8_SCHED; PG8_LDA(At, 0, 0); PG8_STAGE(PG8_SA(1, 1), a1 + hstep, voffA);
            PG8_WAIT_L(8); PG8_BAR; PG8_WAIT_L(0); PG8_MMA(0, 0, At, B0); PG8_BAR; PG8_SCHED;
            PG8_LDB(B1, 0, 1); PG8_STAGE(PG8_SB(0, 0), b2, voffB);
            PG8_BAR; PG8_WAIT_L(0); PG8_MMA(0, 1, At, B1); PG8_BAR;
            PG8_LDA(At, 0, 1); PG8_STAGE(PG8_SA(0, 0), a2, voffA);
            PG8_BAR; PG8_WAIT_L(0); PG8_MMA(1, 0, At, B0); PG8_BAR; PG8_SCHED;
            PG8_STAGE(PG8_SB(0, 1), b2 + hstep, voffB);
            PG8_WAIT_V(6); PG8_BAR; PG8_MMA(1, 1, At, B1); PG8_BAR;
            PG8_LDB(B0, 1, 0); PG8_SCHED; PG8_LDA(At, 1, 0); PG8_STAGE(PG8_SA(0, 1), a2 + hstep, voffA);
            PG8_WAIT_L(8); PG8_BAR; PG8_WAIT_L(0); PG8_MMA(0, 0, At, B0); PG8_BAR; PG8_SCHED;
            PG8_LDB(B1, 1, 1); PG8_STAGE(PG8_SB(1, 0), b3, voffB);
            PG8_BAR; PG8_WAIT_L(0); PG8_MMA(0, 1, At, B1); PG8_BAR;
            PG8_LDA(At, 1, 1); PG8_STAGE(PG8_SA(1, 0), a3, voffA);
            PG8_BAR; PG8_WAIT_L(0); PG8_MMA(1, 0, At, B0); PG8_BAR; PG8_SCHED;
            PG8_STAGE(PG8_SB(1, 1), b3 + hstep, voffB);
            PG8_WAIT_V(6); PG8_BAR; PG8_MMA(1, 1, At, B1); PG8_BAR;
            }
        }
        if constexpr (ALIGN_EPI) { if (wr == 0) PG8_BAR; }
        if constexpr (!Epi::AFTER_DRAIN) { const int le_ = lane_id_asm(); E(acc, cur, wr, wc, le_ & 15, le_ >> 4); S.done(cur); }
        if (!has_next) break;
#pragma unroll
        for (int a = 0; a < 2; ++a)
#pragma unroll
            for (int b = 0; b < 2; ++b)
#pragma unroll
                for (int m = 0; m < 4; ++m)
#pragma unroll
                    for (int n = 0; n < 2; ++n) acc[a][b][m][n] = (f32x4){0.f, 0.f, 0.f, 0.f};
        cur = nxt; cA = nA; cB = nB; ++ui;
        if constexpr (ALIGN_EPI) { if (wr == 1) PG8_BAR; }
    }
    PG8_WAIT_V(0);
    if constexpr (!ALIGN_EPI) { if (wr == 0) PG8_BAR; }
    PG8_BAR;
    if constexpr (Epi::AFTER_DRAIN) { E.fused(acc, cur, wr, wc, fr, fq, lds, wid, lane); S.done(cur); }
#undef PG8_SA
#undef PG8_SB
#undef PG8_STAGE
#undef PG8_LDA
#undef PG8_LDB
#undef PG8_MMA
#undef PG8_WAIT_V
#undef PG8_WAIT_L
#undef PG8_BAR
#undef PG8_SCHED
}
}

namespace att {
typedef unsigned short bf16_t;
using bf16x8 = __attribute__((ext_vector_type(8))) short;
using s16x4  = __attribute__((ext_vector_type(4))) short;
using f32x16 = __attribute__((ext_vector_type(16))) float;
using u32x4  = __attribute__((ext_vector_type(4))) unsigned;
constexpr int NW = 8, QBLK = 32, KVBLK = 64;
constexpr float THR = 8.f;
constexpr int SHM_V = 16384, SHM_K = 16384;
#define KSWZ(row, colB) ((row) * 256 + ((colB) ^ (((row) & 7) << 4)))
#define SBAR() __builtin_amdgcn_sched_barrier(0)
__device__ __forceinline__ int crow(int r, int hi) { return (r & 3) + 8 * (r >> 2) + 4 * hi; }
__device__ __forceinline__ unsigned cvtpk(float lo, float hi) { unsigned r; asm volatile("v_cvt_pk_bf16_f32 %0, %1, %2" : "=v"(r) : "v"(lo), "v"(hi)); return r; }

constexpr float THRL = 11.0f;
template <bool FIRST> __device__ __forceinline__ void partialSM(f32x16& p0, f32x16& p1, float& m_reg, f32x16& negm, float& alpha) {
  float pmax = fmaxf(fmaxf(p0[0], p0[1]), p1[0]);
#pragma unroll
  for (int r = 2; r < 16; r += 2) pmax = fmaxf(fmaxf(pmax, p0[r]), p0[r + 1]);
#pragma unroll
  for (int r = 1; r < 15; r += 2) pmax = fmaxf(fmaxf(pmax, p1[r]), p1[r + 1]);
  pmax = fmaxf(pmax, p1[15]);
  { auto rr = __builtin_amdgcn_permlane32_swap(__float_as_uint(pmax), __float_as_uint(pmax), false, false);
    pmax = fmaxf(__uint_as_float(rr[0]), __uint_as_float(rr[1])); }
  alpha = 1.f;
  if (FIRST || !__builtin_expect(__all(pmax <= THRL), 1)) {
    const float dl = FIRST ? pmax : fmaxf(pmax, 0.f);
    m_reg += dl;
#pragma unroll
    for (int r = 0; r < 16; ++r) { p0[r] -= dl; p1[r] -= dl; }
#pragma unroll
    for (int r = 0; r < 16; ++r) negm[r] = -m_reg;
    if (!FIRST) alpha = __builtin_amdgcn_exp2f(-dl);
  }
#pragma unroll
  for (int r = 0; r < 16; ++r) p0[r] = __builtin_amdgcn_exp2f(p0[r]);
}
__device__ __forceinline__ void finishSM(f32x16& p0, f32x16& p1, float alpha, float& l_reg, bf16x8& pa0, bf16x8& pa1, bf16x8& pa2, bf16x8& pa3) {
#pragma unroll
  for (int r = 0; r < 16; ++r) p1[r] = __builtin_amdgcn_exp2f(p1[r]);
  float ps = 0;
#pragma unroll
  for (int r = 0; r < 16; ++r) ps += p0[r];
#pragma unroll
  for (int r = 0; r < 16; ++r) ps += p1[r];
  { auto rr = __builtin_amdgcn_permlane32_swap(__float_as_uint(ps), __float_as_uint(ps), false, false);
    ps = __uint_as_float(rr[0]) + __uint_as_float(rr[1]); }
  l_reg = l_reg * alpha + ps;
#define PK4(P, BASE, OUT) do { unsigned a0 = cvtpk(P[BASE + 0], P[BASE + 1]), a1 = cvtpk(P[BASE + 2], P[BASE + 3]);   \
    unsigned b0 = cvtpk(P[BASE + 4], P[BASE + 5]), b1 = cvtpk(P[BASE + 6], P[BASE + 7]);                              \
    auto r0 = __builtin_amdgcn_permlane32_swap(a0, b0, false, false); auto r1 = __builtin_amdgcn_permlane32_swap(a1, b1, false, false); \
    u32x4 w = {r0[0], r1[0], r0[1], r1[1]}; OUT = *reinterpret_cast<bf16x8*>(&w); } while (0)
  PK4(p0, 0, pa0); PK4(p0, 8, pa1); PK4(p1, 0, pa2); PK4(p1, 8, pa3);
#undef PK4
}
template <int DQ> __device__ __forceinline__ void qkt(f32x16& p0, f32x16& p1, const char* Ks, const bf16x8* qr, const f32x16& negm, int r32, int hi) {
#pragma unroll
  for (int d0 = 0; d0 < DQ / 16; ++d0) { int cb = (d0 * 16 + hi * 8) * 2;
    bf16x8 b0 = *reinterpret_cast<const bf16x8*>(Ks + KSWZ(r32, cb));
    bf16x8 b1 = *reinterpret_cast<const bf16x8*>(Ks + KSWZ(32 + r32, cb));
    if (d0 == 0) { p0 = __builtin_amdgcn_mfma_f32_32x32x16_bf16(b0, qr[0], negm, 0, 0, 0); p1 = __builtin_amdgcn_mfma_f32_32x32x16_bf16(b1, qr[0], negm, 0, 0, 0); }
    else { p0 = __builtin_amdgcn_mfma_f32_32x32x16_bf16(b0, qr[d0], p0, 0, 0, 0); p1 = __builtin_amdgcn_mfma_f32_32x32x16_bf16(b1, qr[d0], p1, 0, 0, 0); } }
}
__device__ __forceinline__ int v_st(int k, int c) { const int kk = (k & ~0xC) | ((k & 4) << 1) | ((k & 8) >> 1); return ((kk >> 3) * 4 + (c >> 5)) * 512 + ((kk & 7) * 32 + (c & 31)) * 2; }
__device__ __forceinline__ int v_rd_base(int lane) { return ((lane & 3) << 3) | (((lane >> 2) & 3) << 6) | (((lane >> 4) & 1) << 5) | (((lane >> 5) & 1) << 8); }
constexpr int v_rd_off(int d0, int ks, int half) { return d0 * 512 + ks * 4096 + half * 2048; }
template <int OFF> __device__ __forceinline__ s16x4 tr_read(int vb) {
  s16x4 r; asm volatile("ds_read_b64_tr_b16 %0, %1 offset:%2" : "=&v"(r) : "v"(vb), "i"(OFF) : "memory"); return r;
}
template <int D0> __device__ __forceinline__ void pv_one(f32x16& od, int vb, bf16x8 pa0, bf16x8 pa1, bf16x8 pa2, bf16x8 pa3) {
  const s16x4 l0 = tr_read<v_rd_off(D0, 0, 0)>(vb), h0 = tr_read<v_rd_off(D0, 0, 1)>(vb), l1 = tr_read<v_rd_off(D0, 1, 0)>(vb), h1 = tr_read<v_rd_off(D0, 1, 1)>(vb);
  const s16x4 l2 = tr_read<v_rd_off(D0, 2, 0)>(vb), h2 = tr_read<v_rd_off(D0, 2, 1)>(vb), l3 = tr_read<v_rd_off(D0, 3, 0)>(vb), h3 = tr_read<v_rd_off(D0, 3, 1)>(vb);
  asm volatile("s_waitcnt lgkmcnt(0)" ::: "memory"); SBAR();
#define PK(L, H) (bf16x8){L[0], L[1], L[2], L[3], H[0], H[1], H[2], H[3]}
  od = __builtin_amdgcn_mfma_f32_32x32x16_bf16(pa0, PK(l0, h0), od, 0, 0, 0);
  od = __builtin_amdgcn_mfma_f32_32x32x16_bf16(pa1, PK(l1, h1), od, 0, 0, 0);
  od = __builtin_amdgcn_mfma_f32_32x32x16_bf16(pa2, PK(l2, h2), od, 0, 0, 0);
  od = __builtin_amdgcn_mfma_f32_32x32x16_bf16(pa3, PK(l3, h3), od, 0, 0, 0);
#undef PK
}
__device__ __forceinline__ void pv_d0(f32x16* o, int vb, bf16x8 pa0, bf16x8 pa1, bf16x8 pa2, bf16x8 pa3) {
  pv_one<0>(o[0], vb, pa0, pa1, pa2, pa3); pv_one<1>(o[1], vb, pa0, pa1, pa2, pa3);
}

template <int DQ>
__device__ __forceinline__ void attn_unit(const bf16_t* __restrict__ Qb, const bf16_t* __restrict__ Kh, const bf16_t* __restrict__ Kpe, const bf16_t* __restrict__ Vh,
                                          bf16_t* __restrict__ Ob, int seq, char* lds, const int wave_in) {
  constexpr int LDQ = (DQ == 96) ? 576 : 384, LDK = (DQ == 96) ? 384 : 128, LDO = 1024, ND = DQ / 16;
  const int tid = wave_in * 64 + pg8::lane_id_asm(), wid = wave_in, lane = tid & 63, r32 = lane & 31, hi = lane >> 5;
  char* V_lds = lds; char* K_lds = lds + 2 * SHM_V;
  float* ws = (float*)(lds + 2 * SHM_V + 2 * SHM_K) + wid * 64; float* li_l = ws; float* al_l = ws + 32;
  float m_reg = 0.f, l_reg = 0; f32x16 o[2] = {}; f32x16 negm = {}; bf16x8 qr[ND];
  const bf16_t* Qw = Qb + (unsigned)((wid * QBLK + r32) * LDQ + hi * 8);
#pragma unroll
  for (int d0 = 0; d0 < ND; ++d0) qr[d0] = *reinterpret_cast<const bf16x8*>(Qw + d0 * 16);
  const int sr = tid >> 3, sc = (tid & 7) * 8;
  const int pr = (tid >> 2) & 63, pc = (tid & 3) * 8;
  const int vst = v_st(sr, sc), kst = KSWZ(sr, sc * 2), pst = KSWZ(pr, (64 + pc) * 2);
  const int vb0 = (int)(uintptr_t)V_lds + v_rd_base(lane);
  struct { bf16x8 vs, ks, ps; } sr_[2];
  const unsigned voff = (unsigned)(sr * LDK + sc), poff = (unsigned)(pr * 32 + pc);
#define SLOAD(i, k0) do { const bf16_t* Vt_ = Vh + (size_t)(k0) * LDK; const bf16_t* Kt_ = Kh + (size_t)(k0) * LDK; \
    sr_[i].vs = *reinterpret_cast<const bf16x8*>(Vt_ + voff); sr_[i].ks = *reinterpret_cast<const bf16x8*>(Kt_ + voff); \
    if constexpr (DQ == 96) { const bf16_t* Pt_ = Kpe + (size_t)(k0) * 32; sr_[i].ps = *reinterpret_cast<const bf16x8*>(Pt_ + poff); } } while (0)
#define SWRITE(b, i) do { *(bf16x8*)(V_lds + (b) * SHM_V + vst) = sr_[i].vs; *(bf16x8*)(K_lds + (b) * SHM_K + kst) = sr_[i].ks; \
    if constexpr (DQ == 96) { if (tid < 256) *(bf16x8*)(K_lds + (b) * SHM_K + pst) = sr_[i].ps; } } while (0)
#define SWAIT() do { if constexpr (DQ == 96) asm volatile("s_waitcnt vmcnt(3)" ::: "memory"); else asm volatile("s_waitcnt vmcnt(2)" ::: "memory"); } while (0)
#define RESC(a) do { if (__any((a) < 1.f)) { if (hi == 0) al_l[r32] = (a); asm volatile("s_waitcnt lgkmcnt(0)" ::: "memory"); \
    _Pragma("unroll") for (int d = 0; d < 2; ++d) _Pragma("unroll") for (int r = 0; r < 16; ++r) o[d][r] *= al_l[crow(r, hi)]; } } while (0)
  f32x16 pA0, pA1, pB0, pB1; float alA, alB; bf16x8 pa0, pa1, pa2, pa3; const int NT = seq / KVBLK;
  constexpr int SE = 0, SO = 1;
  SLOAD(SE, 0); asm volatile("s_waitcnt vmcnt(0)" ::: "memory"); SWRITE(0, SE); __syncthreads();
  qkt<DQ>(pA0, pA1, K_lds, qr, negm, r32, hi); partialSM<true>(pA0, pA1, m_reg, negm, alA);
  SLOAD(SO, KVBLK); if (2 < NT) SLOAD(SE, 2 * KVBLK);
  SWAIT(); SWRITE(1, SO); __syncthreads();
  for (int j = 1; j + 1 < NT; j += 2) {
    SBAR(); qkt<DQ>(pB0, pB1, K_lds + SHM_K, qr, negm, r32, hi);
    finishSM(pA0, pA1, alA, l_reg, pa0, pa1, pa2, pa3); SBAR();
    SLOAD(SO, (j + 2) * KVBLK); SBAR();
    pv_d0(o, vb0, pa0, pa1, pa2, pa3); partialSM<false>(pB0, pB1, m_reg, negm, alB);
    __syncthreads(); SWAIT(); SWRITE(0, SE);
    RESC(alB); __syncthreads();
    SBAR(); qkt<DQ>(pA0, pA1, K_lds, qr, negm, r32, hi);
    finishSM(pB0, pB1, alB, l_reg, pa0, pa1, pa2, pa3); SBAR();
    if (j + 3 < NT) SLOAD(SE, (j + 3) * KVBLK); SBAR();
    pv_d0(o, vb0 + SHM_V, pa0, pa1, pa2, pa3); partialSM<false>(pA0, pA1, m_reg, negm, alA);
    __syncthreads(); SWAIT(); SWRITE(1, SO);
    RESC(alA); __syncthreads();
  }
  SBAR(); qkt<DQ>(pB0, pB1, K_lds + SHM_K, qr, negm, r32, hi);
  finishSM(pA0, pA1, alA, l_reg, pa0, pa1, pa2, pa3); SBAR();
  pv_d0(o, vb0, pa0, pa1, pa2, pa3); partialSM<false>(pB0, pB1, m_reg, negm, alB);
  __syncthreads(); RESC(alB);
  finishSM(pB0, pB1, alB, l_reg, pa0, pa1, pa2, pa3); SBAR();
  pv_d0(o, vb0 + SHM_V, pa0, pa1, pa2, pa3);
  if (hi == 0) li_l[r32] = l_reg; asm volatile("s_waitcnt lgkmcnt(0)" ::: "memory");
  float rli[16];
#pragma unroll
  for (int r = 0; r < 16; ++r) rli[r] = __builtin_amdgcn_rcpf(li_l[crow(r, hi)]);
  bf16_t* Ow = Ob + (long)(wid * QBLK) * LDO;
#pragma unroll
  for (int r = 0; r < 16; ++r) { int orow = crow(r, hi);
#pragma unroll
    for (int d0 = 0; d0 < 2; ++d0) { const float v = o[d0][r] * rli[r]; Ow[(long)orow * LDO + d0 * 32 + r32] = (bf16_t)(cvtpk(v, v) & 0xffffu); } }
  __syncthreads();
#undef SLOAD
#undef SWRITE
#undef SWAIT
#undef RESC
}
#undef SBAR
}

typedef unsigned short bf16_t;
typedef float f32x4 __attribute__((ext_vector_type(4)));
typedef float f32x2 __attribute__((ext_vector_type(2)));
typedef unsigned u32x2 __attribute__((ext_vector_type(2)));
typedef unsigned u32x4 __attribute__((ext_vector_type(4)));
#define LAS __attribute__((address_space(3)))
constexpr size_t MiB = 1u << 20;
constexpr size_t WS_MOD = 1 * MiB, WS_ROPEM = 2 * MiB, WS_ROPEG = 3 * MiB, WS_Z = 5 * MiB;
constexpr size_t WS_WIN = 10 * MiB, WS_WUQ = 26 * MiB, WS_WUKV = 28 * MiB, WS_WO = 29 * MiB, WS_W1 = 37 * MiB, WS_W2 = 69 * MiB;
constexpr size_t WS_U = 101 * MiB, WS_Y = WS_U  , WS_PART = 167 * MiB  , WS_OV = 233 * MiB;
constexpr size_t WS_HM = WS_OV, WS_H = WS_OV, WS_MQ = WS_OV, WS_MK = 271 * MiB, WS_MV = 296 * MiB;
constexpr size_t WS_CKV = 365 * MiB, WS_CQ = 374 * MiB, WS_KPE = 391 * MiB, WS_GK = 394 * MiB, WS_GV = 403 * MiB, WS_GQ = 412 * MiB, WS_O = 437 * MiB, WS_END = 503 * MiB;
static_assert(WS_MQ + (size_t)MROWS * 576 * 2 <= WS_MK && WS_MK + (size_t)MROWS * 384 * 2 <= WS_MV && WS_MV + (size_t)MROWS * 384 * 2 <= WS_H + (size_t)MROWS * HP * 2, "overlay");
static_assert(WS_H + (size_t)MROWS * HP * 2 <= WS_CKV && WS_CKV + (size_t)MROWS * 256 <= WS_CQ && WS_CQ + (size_t)MROWS * 512 <= WS_KPE && WS_KPE + (size_t)MROWS * 64 <= WS_GK, "map1");
static_assert(WS_GK + (size_t)MROWS * 256 <= WS_GV && WS_GV + (size_t)MROWS * 256 <= WS_GQ && WS_GQ + (size_t)MROWS * 768 <= WS_O && WS_O + (size_t)MROWS * 2048 <= WS_END, "map2");
static_assert(WS_HM + (size_t)MROWS * DFF * 2 <= WS_END, "map3");
#ifndef ATT_REPS
#define ATT_REPS 1
#endif
#ifndef GEMM_REPS
#define GEMM_REPS 1
#endif
constexpr float QSC64 = 0.125f * 1.4426950408889634f, QSC96 = 0.10206207261596575f * 1.4426950408889634f;
constexpr int LDS_BYTES = 135168;

struct Params { const float* in[21]; float* out; unsigned char* ws; };
enum { I_X = 0, I_C, I_CTX, I_CCTX, I_WADA, I_BADA, I_WIN, I_GCQ, I_WUQ, I_GCKV, I_WUKV, I_GQN, I_GKN, I_WCONV, I_WO, I_LN1G, I_LN1B, I_W1, I_W2, I_LN2G, I_LN2B };

__device__ __forceinline__ float shx(float v, int lane, int o) { return __int_as_float(__builtin_amdgcn_ds_bpermute((lane ^ o) << 2, __float_as_int(v))); }
__device__ __forceinline__ float wave_sum(float v, int lane) {
#pragma unroll
    for (int o = 1; o < 64; o <<= 1) v += shx(v, lane, o);
    return v;
}
__device__ __forceinline__ float half_sum(float v, int lane) {
#pragma unroll
    for (int o = 1; o < 32; o <<= 1) v += shx(v, lane, o);
    return v;
}
__device__ __forceinline__ unsigned pk2(float lo, float hi) { unsigned r; asm volatile("v_cvt_pk_bf16_f32 %0, %1, %2" : "=v"(r) : "v"(lo), "v"(hi)); return r; }
__device__ __forceinline__ float bflo(unsigned w) { return __uint_as_float(w << 16); }
__device__ __forceinline__ float bfhi(unsigned w) { return __uint_as_float(w & 0xffff0000u); }

__device__ __forceinline__ void transpose_item(const float* W, int K, int N, bf16_t* WT, LAS float* scr, int item, int lane) {
    const int nblk = N / 32, kb = item / nblk, nb = item % nblk, k0 = 64 * kb, n0 = 32 * nb;
#pragma unroll 8
    for (int i = 0; i < 32; ++i) { const int kk = 2 * i + (lane >> 5); scr[kk * 33 + (lane & 31)] = W[(size_t)(k0 + kk) * N + n0 + (lane & 31)]; }
    asm volatile("s_waitcnt lgkmcnt(0)" ::: "memory");
    const int c = lane & 7;
#pragma unroll
    for (int j = 0; j < 4; ++j) { const int n = (lane >> 3) + 8 * j; const LAS float* s = scr + (8 * c) * 33 + n;
        u32x4 o; o.x = pk2(s[0 * 33], s[1 * 33]); o.y = pk2(s[2 * 33], s[3 * 33]); o.z = pk2(s[4 * 33], s[5 * 33]); o.w = pk2(s[6 * 33], s[7 * 33]);
        *(u32x4*)(WT + (size_t)(n0 + n) * K + k0 + 8 * c) = o; }
    asm volatile("s_waitcnt lgkmcnt(0)" ::: "memory");
}

struct RowInfo { int b, i, v; bool isctx; };
__device__ __forceinline__ RowInfo row_info(int m) { RowInfo r; r.b = m / LTOK; r.i = m - r.b * LTOK; r.isctx = r.i < CTX; r.v = r.isctx ? 4 : r.b; return r; }

__global__ void __launch_bounds__(512, 2) fwd_megakernel(Params p) {
    extern __shared__ __attribute__((aligned(16))) unsigned char lds[];
    cg::grid_group grid = cg::this_grid();
    const int wave = __builtin_amdgcn_readfirstlane(threadIdx.x >> 6);
    const int G = gridDim.x, bx = blockIdx.x;
    const int vcu = (G % 8 == 0) ? (bx % 8) * (G / 8) + bx / 8 : bx;
    const int gw = bx * 8 + wave, NGW = G * 8;
#define KP() ({ const __attribute__((address_space(4))) Params* k_ = (const __attribute__((address_space(4))) Params*)__builtin_amdgcn_kernarg_segment_ptr(); asm volatile("" : "+s"(k_)); k_; })
#define WSB() ((unsigned char*)KP()->ws)
#define DEFWS(w) \
    float* MOD = (float*)((w) + WS_MOD); float* ROPEM = (float*)((w) + WS_ROPEM); float* ROPEG = (float*)((w) + WS_ROPEG); float* Z = (float*)((w) + WS_Z); \
    bf16_t* WIN = (bf16_t*)((w) + WS_WIN); bf16_t* WUQ = (bf16_t*)((w) + WS_WUQ); bf16_t* WUKV = (bf16_t*)((w) + WS_WUKV); bf16_t* WO = (bf16_t*)((w) + WS_WO); \
    bf16_t* W1 = (bf16_t*)((w) + WS_W1); bf16_t* W2 = (bf16_t*)((w) + WS_W2); \
    bf16_t* U = (bf16_t*)((w) + WS_U); bf16_t* Y = (bf16_t*)((w) + WS_Y); bf16_t* HM = (bf16_t*)((w) + WS_HM); bf16_t* H = (bf16_t*)((w) + WS_H); \
    bf16_t* MQ = (bf16_t*)((w) + WS_MQ); bf16_t* MK = (bf16_t*)((w) + WS_MK); bf16_t* MV = (bf16_t*)((w) + WS_MV); \
    bf16_t* CKV = (bf16_t*)((w) + WS_CKV); bf16_t* CQ = (bf16_t*)((w) + WS_CQ); bf16_t* KPE = (bf16_t*)((w) + WS_KPE); \
    bf16_t* GK = (bf16_t*)((w) + WS_GK); bf16_t* GV = (bf16_t*)((w) + WS_GV); bf16_t* GQ = (bf16_t*)((w) + WS_GQ); bf16_t* OC = (bf16_t*)((w) + WS_O); float* PART = (float*)((w) + WS_PART); (void)PART; \
    (void)MOD; (void)ROPEM; (void)ROPEG; (void)Z; (void)WIN; (void)WUQ; (void)WUKV; (void)WO; (void)W1; (void)W2; (void)U; (void)Y; (void)HM; (void)H; (void)MQ; (void)MK; (void)MV; \
    (void)CKV; (void)CQ; (void)KPE; (void)GK; (void)GV; (void)GQ; (void)OC;

    {
        DEFWS(WSB())
        const int lane = pg8::lane_id_asm(), tid = wave * 64 + lane;
        LAS float* scr = (LAS float*)((LAS unsigned char*)lds + wave * 16384);
        constexpr int I_IN = 16 * 57, I_UQ = 4 * 18, I_UKV = 2 * 24, I_O = 16 * 32, I_1 = 16 * 128, I_2 = 64 * 32, PER = I_IN + I_UQ + I_UKV + I_O + I_1 + I_2;
        for (int it = gw; it < DEPTH * PER; it += NGW) {
            const int l = it / PER; int r = it - l * PER;
            if (r < I_IN) { transpose_item(KP()->in[I_WIN] + (size_t)l * DM * IN_COLS, DM, IN_COLS, WIN + (size_t)l * HP * DM, scr, r, lane); continue; } r -= I_IN;
            if (r < I_UQ) { transpose_item(KP()->in[I_WUQ] + (size_t)l * 256 * 576, 256, 576, WUQ + (size_t)l * 768 * 256, scr, r, lane); continue; } r -= I_UQ;
            if (r < I_UKV) { transpose_item(KP()->in[I_WUKV] + (size_t)l * 128 * 768, 128, 768, WUKV + (size_t)l * 768 * 128, scr, r, lane); continue; } r -= I_UKV;
            if (r < I_O) { transpose_item(KP()->in[I_WO] + (size_t)l * DM * DM, DM, DM, WO + (size_t)l * DM * DM, scr, r, lane); continue; } r -= I_O;
            if (r < I_1) { transpose_item(KP()->in[I_W1] + (size_t)l * DM * DFF, DM, DFF, W1 + (size_t)l * DFF * DM, scr, r, lane); continue; } r -= I_1;
            transpose_item(KP()->in[I_W2] + (size_t)l * DFF * DM, DFF, DM, W2 + (size_t)l * DM * DFF, scr, r, lane);
        }
        const int gt = bx * 512 + tid, NGT = G * 512;
        for (int idx = gt; idx < DEPTH * 224 * 128; idx += NGT) { const int l = idx / (224 * 128), r = idx % (224 * 128);
            *(u32x4*)(WIN + ((size_t)l * HP + IN_COLS) * DM + (size_t)r * 8) = (u32x4){0u, 0u, 0u, 0u}; }
        for (int idx = gt; idx < DEPTH * 192 * 32; idx += NGT) { const int l = idx / (192 * 32), r = idx % (192 * 32);
            *(u32x4*)(WUQ + ((size_t)l * 768 + 576) * 256 + (size_t)r * 8) = (u32x4){0u, 0u, 0u, 0u}; }
        for (int idx = gt; idx < SEQ * 16; idx += NGT) { const int pos = idx >> 4, i = idx & 15; const int rw = pos >> 6, cl = pos & 63;
            const float inv = powf(10000.f, -(float)(i & 7) / 8.f); const float ang = (float)(i < 8 ? rw : cl) * inv;
            ROPEM[2 * idx] = cosf(ang); ROPEM[2 * idx + 1] = sinf(ang); }
        for (int idx = gt; idx < SEQ * 32; idx += NGT) { const int pos = idx >> 5, i = idx & 31; const int rw = pos >> 6, cl = pos & 63;
            const float inv = powf(10000.f, -(float)(i & 15) / 16.f); const float ang = (float)(i < 16 ? rw : cl) * inv;
            ROPEG[2 * idx] = cosf(ang); ROPEG[2 * idx + 1] = sinf(ang); }
        __syncthreads();
        float* sil = (float*)lds;
        float* part = (float*)lds + 5 * 1024;
        { const float* c_in = KP()->in[I_C]; const float* cc_in = KP()->in[I_CCTX];
        for (int idx = tid; idx < 5 * 1024; idx += 512) { const int v = idx >> 10, k = idx & 1023; const float c = (v < 4) ? c_in[v * 1024 + k] : cc_in[k]; sil[idx] = c / (1.f + __expf(-c)); } }
        const float* wada_ = KP()->in[I_WADA]; const float* bada_ = KP()->in[I_BADA];
        __syncthreads();
        for (int it = bx; it < DEPTH * 96; it += G) { const int l = it / 96, jb = it % 96; const int j = jb * 64 + lane;
            const float* wp = wada_ + ((size_t)l * DM + wave * 128) * 6144 + j;
            float a0 = 0, a1 = 0, a2 = 0, a3 = 0, a4 = 0;
#pragma unroll 8
            for (int k = 0; k < 128; ++k) { const float w = wp[(size_t)k * 6144]; const int kk = wave * 128 + k;
                a0 += sil[kk] * w; a1 += sil[1024 + kk] * w; a2 += sil[2048 + kk] * w; a3 += sil[3072 + kk] * w; a4 += sil[4096 + kk] * w; }
            part[(wave * 5 + 0) * 64 + lane] = a0; part[(wave * 5 + 1) * 64 + lane] = a1; part[(wave * 5 + 2) * 64 + lane] = a2; part[(wave * 5 + 3) * 64 + lane] = a3; part[(wave * 5 + 4) * 64 + lane] = a4;
            __syncthreads();
            if (tid < 320) { const int v = tid >> 6, c = tid & 63; float s = bada_[l * 6144 + jb * 64 + c];
#pragma unroll
                for (int w = 0; w < 8; ++w) s += part[(w * 5 + v) * 64 + c];
                MOD[((size_t)l * 5 + v) * 6144 + jb * 64 + c] = s; }
            __syncthreads();
        }
    }
    grid.sync();
    { DEFWS(WSB())
    const int lane = pg8::lane_id_asm(); const float* xin_ = KP()->in[I_X]; const float* cin_ = KP()->in[I_CTX];
    for (int m = gw; m < MROWS; m += NGW) { const RowInfo ri = row_info(m);
        const float* xr = ri.isctx ? cin_ + ((size_t)ri.b * CTX + ri.i) * DM : xin_ + ((size_t)ri.b * SEQ + ri.i - CTX) * DM;
        const float* md = MOD + (size_t)ri.v * 6144;
#pragma unroll
        for (int j = 0; j < 4; ++j) { const int col = 4 * lane + 256 * j; const f32x4 x = *(const f32x4*)(xr + col), sh = *(const f32x4*)(md + col), sc = *(const f32x4*)(md + 1024 + col);
            const f32x4 u = x * (1.f + sc) + sh; u32x2 w; w.x = pk2(u[0], u[1]); w.y = pk2(u[2], u[3]); *(u32x2*)(U + (size_t)m * DM + col) = w; }
    } }
    grid.sync();

#pragma unroll 1
    for (int l = 0; l < DEPTH; ++l) {
        { DEFWS(WSB()) pg8::Gemm g{U, WIN + (size_t)l * HP * DM, MROWS, HP, DM, DM}; pg8::StaticOrder S; S.init(MROWS, HP, G, bx);
          pg8::EpiStore<0> E{H, HP};
          pg8::gemm_phase<pg8::EpiStore<0>, pg8::StaticOrder, true, true>((LAS unsigned char*)lds, g, S, E, wave); }
        grid.sync();
        {
            DEFWS(WSB())
            const int lane = pg8::lane_id_asm();
            const f32x2* gckv = (const f32x2*)(KP()->in[I_GCKV] + l * 128); const f32x2* gkn = (const f32x2*)(KP()->in[I_GKN] + l * 64);
            const f32x2* gcq = (const f32x2*)(KP()->in[I_GCQ] + l * 256); const f32x2* gqn = (const f32x2*)(KP()->in[I_GQN] + l * 64);
            const f32x2* wc0 = (const f32x2*)(KP()->in[I_WCONV] + (size_t)l * 768); const f32x2* wc1 = wc0 + 128; const f32x2* wc2 = wc0 + 256;
            const f32x2* rM = (const f32x2*)ROPEM; const f32x2* rG = (const f32x2*)ROPEG;
            for (int m = gw; m < MROWS; m += NGW) { const RowInfo ri = row_info(m); const bool lat = !ri.isctx; const int pos = ri.i - CTX;
                const unsigned* hr = (const unsigned*)(H + (size_t)m * HP);
                {
                    const unsigned w = hr[lane]; const float a = bflo(w), b = bfhi(w); const float r = rsqrtf(wave_sum(a * a + b * b, lane) * (1.f / 128.f) + LN_EPS); const f32x2 g = gckv[lane];
                    ((unsigned*)(CKV + (size_t)m * 128))[lane] = pk2(a * r * g.x, b * r * g.y); }
                if (lane < 16) {
                    const unsigned w = hr[64 + lane]; float a = bflo(w), b = bfhi(w);
                    if (lat) { const f32x2 cs = rM[pos * 16 + lane]; const float a2 = a * cs.x - b * cs.y, b2 = a * cs.y + b * cs.x; a = a2; b = b2; }
                    ((unsigned*)(KPE + (size_t)m * 32))[lane] = pk2(a, b); }
                {
                    const unsigned w = hr[80 + lane]; float a = bflo(w), b = bfhi(w); const float r = rsqrtf(half_sum(a * a + b * b, lane) * (1.f / 64.f) + LN_EPS); const f32x2 g = gkn[lane & 31];
                    a = a * r * g.x; b = b * r * g.y;
                    if (lat) { const f32x2 cs = rG[pos * 32 + (lane & 31)]; const float a2 = a * cs.x - b * cs.y, b2 = a * cs.y + b * cs.x; a = a2; b = b2; }
                    ((unsigned*)(GK + (size_t)m * 128))[lane] = pk2(a, b); }
                ((unsigned*)(GV + (size_t)m * 128))[lane] = hr[144 + lane];
                {
                    const unsigned w0 = hr[208 + lane], w1 = hr[272 + lane]; const float a0 = bflo(w0), b0 = bfhi(w0), a1 = bflo(w1), b1 = bfhi(w1);
                    const float r = rsqrtf(wave_sum(a0 * a0 + b0 * b0 + a1 * a1 + b1 * b1, lane) * (1.f / 256.f) + LN_EPS); const f32x2 g0 = gcq[lane], g1 = gcq[64 + lane];
                    unsigned* o = (unsigned*)(CQ + (size_t)m * 256); o[lane] = pk2(a0 * r * g0.x, b0 * r * g0.y); o[64 + lane] = pk2(a1 * r * g1.x, b1 * r * g1.y); }
#pragma unroll
                for (int j = 0; j < 3; ++j) {
                    const unsigned w = hr[336 + 64 * j + lane]; float a = bflo(w), b = bfhi(w); const float r = rsqrtf(half_sum(a * a + b * b, lane) * (1.f / 64.f) + LN_EPS); const f32x2 g = gqn[lane & 31];
                    a = a * r * g.x; b = b * r * g.y;
                    if (lat) { const f32x2 cs = rG[pos * 32 + (lane & 31)]; const float a2 = a * cs.x - b * cs.y, b2 = a * cs.y + b * cs.x; a = a2; b = b2; }
                    ((unsigned*)(GQ + (size_t)m * 384))[64 * j + lane] = pk2(a * QSC64, b * QSC64); }
                {
                    const int seqlen = lat ? SEQ : CTX, t = lat ? pos : ri.i; const bool hp = t > 0, hn = t + 1 < seqlen;
                    const unsigned* hm1 = hr - HP / 2; const unsigned* hp1 = hr + HP / 2;
#pragma unroll
                    for (int j = 0; j < 2; ++j) { const int ix = lane + 64 * j;
                        const unsigned c0 = hr[528 + ix], k0 = hr[784 + ix], bb = hr[656 + ix];
                        const unsigned cm = hp ? hm1[528 + ix] : 0u, km = hp ? hm1[784 + ix] : 0u, cn = hn ? hp1[528 + ix] : 0u, kn = hn ? hp1[784 + ix] : 0u;
                        const f32x2 w0 = wc0[ix], w1 = wc1[ix], w2 = wc2[ix];
                        const float oa = bflo(bb) * (w0.x * bflo(cm) * bflo(km) + w1.x * bflo(c0) * bflo(k0) + w2.x * bflo(cn) * bflo(kn));
                        const float ob = bfhi(bb) * (w0.y * bfhi(cm) * bfhi(km) + w1.y * bfhi(c0) * bfhi(k0) + w2.y * bfhi(cn) * bfhi(kn));
                        ((unsigned*)(OC + (size_t)m * DM))[384 + ix] = pk2(oa, ob); }
                }
            }
        }
        grid.sync();
        { DEFWS(WSB()) pg8::Gemm g{CQ, WUQ + (size_t)l * 768 * 256, MROWS, 768, 256, 256}; pg8::StaticOrder S; S.init(MROWS, 768, G, bx);
          pg8::EpiUQ E{MQ, ROPEM, QSC96};
          pg8::gemm_phase<pg8::EpiUQ, pg8::StaticOrder, true, false>((LAS unsigned char*)lds, g, S, E, wave); }
        { DEFWS(WSB()) pg8::Gemm g{CKV, WUKV + (size_t)l * 768 * 128, MROWS, 768, 128, 128}; pg8::StaticOrder S; S.init(MROWS, 768, G, bx);
          pg8::EpiUKV E{MK, MV};
          pg8::gemm_phase<pg8::EpiUKV, pg8::StaticOrder, true, false>((LAS unsigned char*)lds, g, S, E, wave); }
        grid.sync();
        {
            DEFWS(WSB())
            const int nrounds = (l < DEPTH - 1) ? 7 : 6;
            for (int i_ = 0; i_ < nrounds * ATT_REPS; ++i_) { const int i = (ATT_REPS == 1) ? i_ : (i_ % nrounds);
                int type, b, h, qrow0, seq;
                if (i < 6) { const int u = vcu + 256 * i; type = u / 768; const int rem = u % 768; b = rem / 192; h = (rem >> 5) % 6; const int qb = rem & 31; qrow0 = b * LTOK + CTX + qb * 256; seq = LTOK; }
                else { if (vcu >= 48) continue; type = vcu / 24; b = (vcu % 24) / 6; h = vcu % 6; qrow0 = b * LTOK; seq = CTX; }
                const size_t kr = (size_t)b * LTOK;
                if (type == 0) att::attn_unit<96>(MQ + (size_t)qrow0 * 576 + h * 96, MK + kr * 384 + h * 64, KPE + kr * 32, MV + kr * 384 + h * 64, OC + (size_t)qrow0 * DM + h * 64, seq, (char*)lds, wave);
                else att::attn_unit<64>(GQ + (size_t)qrow0 * 384 + h * 64, GK + kr * 128 + (h / 3) * 64, nullptr, GV + kr * 128 + (h / 3) * 64, OC + (size_t)qrow0 * DM + 384 + h * 64, seq, (char*)lds, wave);
            }
        }
        grid.sync();
        { DEFWS(WSB()) pg8::Gemm g{OC, WO + (size_t)l * DM * DM, MROWS, DM, DM, DM}; pg8::RowOrder S; S.init(DM, G, bx, true);
          pg8::EpiStore<0> E{Y, DM};
          pg8::gemm_phase<pg8::EpiStore<0>, pg8::RowOrder, true, true>((LAS unsigned char*)lds, g, S, E, wave); }
        if (l < DEPTH - 1) { DEFWS(WSB()) pg8::Gemm g{OC, WO + (size_t)l * DM * DM, MROWS, DM, 128, DM}; pg8::CtxSplitOrder S; S.init(DM, 8, G, bx);
          pg8::EpiPart E{PART, DM, (size_t)1024 * DM};
          pg8::gemm_phase<pg8::EpiPart, pg8::CtxSplitOrder, true, true>((LAS unsigned char*)lds, g, S, E, wave); }
        grid.sync();
#pragma unroll 1
        for (int which = 0; which < 2; ++which) {
            {
                DEFWS(WSB())
                const int lane = pg8::lane_id_asm();
                const float* lg = KP()->in[which ? I_LN2G : I_LN1G] + l * DM; const float* lb = KP()->in[which ? I_LN2B : I_LN1B] + l * DM;
                const float* xin_ = KP()->in[I_X]; const float* cin_ = KP()->in[I_CTX]; float* out_ = KP()->out;
                const bool first = (l == 0 && which == 0); const bool wantu = !(which == 1 && l == DEPTH - 1);
                const int KS = which ? 16 : 8;
                for (int m = gw; m < MROWS; m += NGW) { const RowInfo ri = row_info(m);
                    if (ri.isctx && l == DEPTH - 1) continue;
                    const size_t zoff = ((size_t)ri.b * CTX + ri.i) * DM, xoff = ((size_t)ri.b * SEQ + ri.i - CTX) * DM;
                    const float* xo = ri.isctx ? (first ? cin_ + zoff : Z + zoff) : (first ? xin_ + xoff : out_ + xoff);
                    float* xn = ri.isctx ? Z + zoff : out_ + xoff;
                    const float* md = MOD + ((size_t)l * 5 + ri.v) * 6144; const float* gate = md + (which ? 5 : 2) * 1024;
                    const float* md2 = which ? MOD + ((size_t)(wantu ? l + 1 : l) * 5 + ri.v) * 6144 : md + 3 * 1024;
                    f32x4 t[4]; float s = 0.f;
#pragma unroll
                    for (int j = 0; j < 4; ++j) { const int col = 4 * lane + 256 * j; const f32x4 x = *(const f32x4*)(xo + col), gt = *(const f32x4*)(gate + col);
                        f32x4 y;
                        if (ri.isctx) { const float* pp = PART + ((size_t)ri.b * CTX + ri.i) * DM + col; y = *(const f32x4*)pp;
                            for (int k = 1; k < KS; ++k) y += *(const f32x4*)(pp + (size_t)k * 1024 * DM); }
                        else { const u32x2 yw = *(const u32x2*)(Y + (size_t)m * DM + col); y = (f32x4){bflo(yw.x), bfhi(yw.x), bflo(yw.y), bfhi(yw.y)}; }
                        t[j] = ALPHA * x + gt * y; s += (t[j][0] + t[j][1]) + (t[j][2] + t[j][3]); }
                    const float mean = wave_sum(s, lane) * (1.f / DM); float s2 = 0.f;
#pragma unroll
                    for (int j = 0; j < 4; ++j) { t[j] = t[j] - mean; s2 += (t[j][0] * t[j][0] + t[j][1] * t[j][1]) + (t[j][2] * t[j][2] + t[j][3] * t[j][3]); }
                    const float rstd = rsqrtf(wave_sum(s2, lane) * (1.f / DM) + LN_EPS);
#pragma unroll
                    for (int j = 0; j < 4; ++j) { const int col = 4 * lane + 256 * j; const f32x4 g4 = *(const f32x4*)(lg + col), b4 = *(const f32x4*)(lb + col);
                        const f32x4 xv = t[j] * rstd * g4 + b4; *(f32x4*)(xn + col) = xv;
                        if (wantu) { const f32x4 sh = *(const f32x4*)(md2 + col), sc = *(const f32x4*)(md2 + 1024 + col); const f32x4 u = xv * (1.f + sc) + sh;
                            u32x2 w; w.x = pk2(u[0], u[1]); w.y = pk2(u[2], u[3]); *(u32x2*)(U + (size_t)m * DM + col) = w; } }
                }
            }
            if (which == 1) { if (l < DEPTH - 1) grid.sync(); break; }
            grid.sync();
            { DEFWS(WSB()) pg8::Gemm g{U, W1 + (size_t)l * DFF * DM, MROWS, DFF, DM, DM}; pg8::RowOrder S; S.init(DFF, G, bx, l == DEPTH - 1);
              pg8::EpiStore<1> E{HM, DFF};
              pg8::gemm_phase<pg8::EpiStore<1>, pg8::RowOrder, true, true>((LAS unsigned char*)lds, g, S, E, wave); }
            grid.sync();
            { DEFWS(WSB()) pg8::Gemm g{HM, W2 + (size_t)l * DM * DFF, MROWS, DM, DFF, DFF}; pg8::RowOrder S; S.init(DM, G, bx, true);
              pg8::EpiStore<0> E{Y, DM};
              pg8::gemm_phase<pg8::EpiStore<0>, pg8::RowOrder, true, true>((LAS unsigned char*)lds, g, S, E, wave); }
            if (l < DEPTH - 1) { DEFWS(WSB()) pg8::Gemm g{HM, W2 + (size_t)l * DM * DFF, MROWS, DM, 256, DFF}; pg8::CtxSplitOrder S; S.init(DM, 16, G, bx);
              pg8::EpiPart E{PART, DM, (size_t)1024 * DM};
              pg8::gemm_phase<pg8::EpiPart, pg8::CtxSplitOrder, true, true>((LAS unsigned char*)lds, g, S, E, wave); }
            grid.sync();
        }
    }
}

extern "C" void kernel_launch(void* const* d_in, const int* in_sizes, int n_in, void* d_out, int out_size, void* d_ws, size_t ws_size, hipStream_t stream) {
    static int grid = 0;
    if (grid == 0) {
        if (n_in != 21 || in_sizes[0] != NBATCH * SEQ * DM || out_size != NBATCH * SEQ * DM || ws_size < WS_END) {
            fprintf(stderr, "kernel_launch: shape mismatch n_in %d in0 %d out %d ws %zu (need %zu)\n", n_in, n_in > 0 ? in_sizes[0] : -1, out_size, ws_size, (size_t)WS_END); grid = -1; return; }
        int dev = 0, cus = 0, per_cu = 0;
        hipGetDevice(&dev); hipDeviceGetAttribute(&cus, hipDeviceAttributeMultiprocessorCount, dev);
        if (hipFuncSetAttribute((const void*)fwd_megakernel, hipFuncAttributeMaxDynamicSharedMemorySize, LDS_BYTES) != hipSuccess) { fprintf(stderr, "kernel_launch: hipFuncSetAttribute failed\n"); grid = -1; return; }
        if (hipOccupancyMaxActiveBlocksPerMultiprocessor(&per_cu, (const void*)fwd_megakernel, 512, LDS_BYTES) != hipSuccess || per_cu < 1) { fprintf(stderr, "kernel_launch: occupancy query says %d\n", per_cu); per_cu = 1; }
        (void)hipGetLastError();
        grid = cus;
        fprintf(stderr, "kernel_launch: grid %d (per_cu %d)\n", grid, per_cu);
    }
    if (grid < 0) return;
    Params p{};
    for (int i = 0; i < 21; ++i) p.in[i] = (const float*)d_in[i];
    p.out = (float*)d_out; p.ws = (unsigned char*)d_ws;
    void* args[] = {&p};
    hipError_t e = hipLaunchCooperativeKernel((const void*)fwd_megakernel, dim3(grid), dim3(512), args, LDS_BYTES, stream);
    if (e != hipSuccess) fprintf(stderr, "kernel_launch: cooperative launch failed: %s (grid %d)\n", hipGetErrorString(e), grid);
}
```

```cpp
#include <hip/hip_runtime.h>
#include <hip/hip_cooperative_groups.h>
#include <cstdio>
#include <cstdint>
namespace cg = cooperative_groups;

constexpr int DM = 1024, NBATCH = 4, SEQ = 8192, DEPTH = 4, CTX = 256, DFF = 4096;
constexpr int LTOK = CTX + SEQ;
constexpr int MROWS = NBATCH * LTOK;
constexpr int IN_COLS = 1824, HP = 2048;
constexpr float LN_EPS = 1e-6f;
constexpr float ALPHA = 1.6817928305074290f;
namespace pg8 {
#define PG8_LAS __attribute__((address_space(3)))
typedef unsigned short bf16_t;
typedef short bf16x8 __attribute__((ext_vector_type(8)));
typedef float f32x4 __attribute__((ext_vector_type(4)));
typedef unsigned u32x4 __attribute__((ext_vector_type(4)));
constexpr int BM = 256, BK = 64, HALF = 128, HTB = HALF * BK * 2  , STAGE_BYTES = 8 * HTB, NXCD = 8, WGM = 8;

__host__ __device__ __forceinline__ int lds_byte(int r, int c) { const int st = (r >> 4) * 2 + (c >> 5), rr = r & 15, cc = c & 31, ob = rr * 64 + cc * 2; return st * 1024 + (ob ^ (((ob >> 9) & 1) << 5)); }
__host__ __device__ __forceinline__ void stage_rc(int b, int& R, int& C) { const int st = b / 1024, sb = b % 1024, swz = sb ^ (((sb >> 9) & 1) << 5); R = (st >> 1) * 16 + swz / 64; C = (st & 1) * 32 + (swz % 64) / 2; }
__host__ __device__ __forceinline__ int perm32(int rho) { const int n = rho >> 4, i = rho & 15; return 8 * (i >> 2) + 4 * n + (i & 3); }

struct Unit { int pm, pn, pk; };
struct Gemm { const bf16_t* A; const bf16_t* Bt; int M, N, K, ld; };

struct StaticOrder {
    int nM, nN, nwg, G, c;
    __host__ __device__ void init(int M, int N, int G_, int c_) { nM = M / BM; nN = N / BM; nwg = nM * nN; G = G_; c = c_; }
    __host__ __device__ bool next(int i, Unit& u) const {
        const long L = (long)i * G + c; if (L >= nwg) return false;
        int wgid = (int)L; { const int q = nwg / NXCD, r = nwg % NXCD, xcd = wgid % NXCD, off = wgid / NXCD; wgid = (xcd < r ? xcd * (q + 1) : r * (q + 1) + (xcd - r) * q) + off; }
        const int nig = WGM * nN, gid = wgid / nig, fm = gid * WGM, gsz = (nM - fm) < WGM ? (nM - fm) : WGM;
        u.pm = fm + ((wgid % nig) % gsz); u.pn = (wgid % nig) / gsz; u.pk = 0; return true;
    }
    __device__ __forceinline__ void a_ready(const Unit&) const {}
    __device__ __forceinline__ void done(const Unit&) const {}
};

__device__ __forceinline__ unsigned cvt_pk_bf16(float lo, float hi) { unsigned r; asm volatile("v_cvt_pk_bf16_f32 %0, %1, %2" : "=v"(r) : "v"(lo), "v"(hi)); return r; }
__device__ __forceinline__ int lane_id_asm() { int l; asm volatile("v_mbcnt_lo_u32_b32 %0, -1, 0\n\tv_mbcnt_hi_u32_b32 %0, -1, %0" : "=v"(l)); return l; }
typedef float f32x2 __attribute__((ext_vector_type(2)));
template <int ACT  > struct EpiStore {
    static constexpr bool PERM = true, AFTER_DRAIN = false;
    bf16_t* O; int ldc;
    __device__ __forceinline__ void operator()(const f32x4 (&acc)[2][2][4][2], const Unit& u, int wr, int wc, int fr, int fq) const {
        const int row0 = u.pm * BM + wr * 64 + fr; const int col0 = u.pn * BM + wc * 32 + 8 * fq;
#pragma unroll
        for (int ai = 0; ai < 2; ++ai)
#pragma unroll
            for (int m = 0; m < 4; ++m) { bf16_t* rowp = O + (size_t)(row0 + ai * HALF + m * 16) * ldc + col0;
#pragma unroll
                for (int bj = 0; bj < 2; ++bj) { f32x4 v0 = acc[ai][bj][m][0], v1 = acc[ai][bj][m][1];
                    if (ACT == 1) {
#pragma unroll
                        for (int e = 0; e < 4; ++e) { float a = fmaxf(v0[e], 0.f), b = fmaxf(v1[e], 0.f); v0[e] = a * a; v1[e] = b * b; } }
                    u32x4 w; w.x = cvt_pk_bf16(v0[0], v0[1]); w.y = cvt_pk_bf16(v0[2], v0[3]); w.z = cvt_pk_bf16(v1[0], v1[1]); w.w = cvt_pk_bf16(v1[2], v1[3]);
                    *(u32x4*)(rowp + bj * HALF) = w; } }
    }
};
struct EpiUQ {
    static constexpr bool PERM = true, AFTER_DRAIN = false;
    bf16_t* MQ; const float* ropeM; float qscale;
    __device__ __forceinline__ void operator()(const f32x4 (&acc)[2][2][4][2], const Unit& u, int wr, int wc, int fr, int fq) const {
        const int row0 = u.pm * BM + wr * 64 + fr;
        const int pt = u.pm % 33; const bool lat = pt != 0; const int pos0 = (pt - 1) * 256 + wr * 64 + fr;
#pragma unroll
        for (int bj = 0; bj < 2; ++bj) {
            const int c = u.pn * BM + bj * HALF + wc * 32 + 8 * fq;
            if (c >= 576) continue;
            const int d = c % 96; const bool isrope = (d >= 64) && lat; const int i0 = (d - 64) >> 1;
#pragma unroll
            for (int ai = 0; ai < 2; ++ai)
#pragma unroll
                for (int m = 0; m < 4; ++m) { const int row = row0 + ai * HALF + m * 16;
                    f32x4 v0 = acc[ai][bj][m][0], v1 = acc[ai][bj][m][1];
                    if (isrope) { const f32x4* rp = (const f32x4*)(ropeM + ((size_t)(pos0 + ai * HALF + m * 16) * 16 + i0) * 2);
                        const f32x4 r0 = rp[0], r1 = rp[1];
                        f32x4 a, b;
                        a[0] = v0[0] * r0[0] - v0[1] * r0[1]; a[1] = v0[0] * r0[1] + v0[1] * r0[0];
                        a[2] = v0[2] * r0[2] - v0[3] * r0[3]; a[3] = v0[2] * r0[3] + v0[3] * r0[2];
                        b[0] = v1[0] * r1[0] - v1[1] * r1[1]; b[1] = v1[0] * r1[1] + v1[1] * r1[0];
                        b[2] = v1[2] * r1[2] - v1[3] * r1[3]; b[3] = v1[2] * r1[3] + v1[3] * r1[2];
                        v0 = a; v1 = b; }
                    v0 = v0 * qscale; v1 = v1 * qscale;
                    u32x4 w; w.x = cvt_pk_bf16(v0[0], v0[1]); w.y = cvt_pk_bf16(v0[2], v0[3]); w.z = cvt_pk_bf16(v1[0], v1[1]); w.w = cvt_pk_bf16(v1[2], v1[3]);
                    *(u32x4*)(MQ + (size_t)row * 576 + c) = w; }
        }
    }
};
struct EpiUKV {
    static constexpr bool PERM = true, AFTER_DRAIN = false;
    bf16_t* MK; bf16_t* MV;
    __device__ __forceinline__ void operator()(const f32x4 (&acc)[2][2][4][2], const Unit& u, int wr, int wc, int fr, int fq) const {
        const int row0 = u.pm * BM + wr * 64 + fr;
#pragma unroll
        for (int bj = 0; bj < 2; ++bj) {
            const int head = u.pn * 2 + bj; const int d = wc * 32 + 8 * fq;
            bf16_t* base = (d < 64) ? (MK + head * 64 + d) : (MV + head * 64 + d - 64);
#pragma unroll
            for (int ai = 0; ai < 2; ++ai)
#pragma unroll
                for (int m = 0; m < 4; ++m) { const int row = row0 + ai * HALF + m * 16;
                    const f32x4 v0 = acc[ai][bj][m][0], v1 = acc[ai][bj][m][1];
                    u32x4 w; w.x = cvt_pk_bf16(v0[0], v0[1]); w.y = cvt_pk_bf16(v0[2], v0[3]); w.z = cvt_pk_bf16(v1[0], v1[1]); w.w = cvt_pk_bf16(v1[2], v1[3]);
                    *(u32x4*)(base + (size_t)row * 384) = w; }
        }
    }
};
struct RowOrder {
    StaticOrder S0; bool latonly;
    __host__ __device__ void init(int N, int G_, int c_, bool latonly_) { latonly = latonly_; S0.init(latonly_ ? 128 * BM : 132 * BM, N, G_, c_); }
    __host__ __device__ bool next(int i, Unit& u) const { if (!S0.next(i, u)) return false; if (latonly) u.pm = u.pm + u.pm / 32 + 1; return true; }
    __device__ __forceinline__ void a_ready(const Unit&) const {}
    __device__ __forceinline__ void done(const Unit&) const {}
};
struct CtxSplitOrder {
    int nN, KS, total, G, c;
    __host__ __device__ void init(int N, int KS_, int G_, int c_) { nN = N / BM; KS = KS_; total = 4 * nN * KS_; G = G_; c = c_; }
    __host__ __device__ bool next(int i, Unit& u) const { const int L = i * G + c; if (L >= total) return false; u.pk = L % KS; const int t = L / KS; u.pn = t % nN; u.pm = 33 * (t / nN); return true; }
    __device__ __forceinline__ void a_ready(const Unit&) const {}
    __device__ __forceinline__ void done(const Unit&) const {}
};
struct EpiPart {
    static constexpr bool PERM = false, AFTER_DRAIN = false;
    float* P; int ldc; size_t kstride;
    __device__ __forceinline__ void operator()(const f32x4 (&acc)[2][2][4][2], const Unit& u, int wr, int wc, int fr, int fq) const {
        float* base = P + (size_t)u.pk * kstride + (size_t)((u.pm / 33) * BM + wr * 64 + fr) * ldc + u.pn * BM + wc * 32 + 4 * fq;
#pragma unroll
        for (int ai = 0; ai < 2; ++ai)
#pragma unroll
            for (int m = 0; m < 4; ++m)
#pragma unroll
                for (int bj = 0; bj < 2; ++bj)
#pragma unroll
                    for (int n = 0; n < 2; ++n) *(f32x4*)(base + (size_t)(ai * HALF + m * 16) * ldc + bj * HALF + n * 16) = acc[ai][bj][m][n];
    }
};
template <class Epi, class Sched, bool ALIGN_EPI = false, bool SP2 = false>
__device__ __forceinline__ void gemm_phase(PG8_LAS unsigned char* lds, const Gemm g, const Sched& S, const Epi& E, const int wave_in) {
    const int tid_l_ = wave_in * 64 + lane_id_asm();
    const int tid = tid_l_, wid = __builtin_amdgcn_readfirstlane(tid >> 6), lane = tid & 63, wr = wid >> 2, wc = wid & 3, fr = lane & 15, fq = lane >> 4;
    const int K = g.K, nt = K / BK;
    unsigned voffA[2], voffB[2];
#pragma unroll
    for (int i = 0; i < 2; ++i) { int R, C; stage_rc(tid * 16 + i * 8192, R, C); const int Rb = Epi::PERM ? ((R & ~31) + perm32(R & 31)) : R;
        voffA[i] = (unsigned)(R * g.ld + C) * 2u; voffB[i] = (unsigned)(Rb * g.ld + C) * 2u; }
    const size_t kstep = (size_t)(BK * 2);
    const size_t hstep = (size_t)HALF * g.ld * 2;
    const size_t tstep = 2 * hstep;
    const unsigned ldsw = (unsigned)wid * 1024u;
    const int aoff = lds_byte(wr * 64 + fr, fq * 8), boff = lds_byte(wc * 32 + fr, fq * 8);
#define PG8_SA(b, h) (((b) * 2 + (h)) * HTB)
#define PG8_SB(b, h) ((4 + (b) * 2 + (h)) * HTB)
#define PG8_STAGE(bufoff, gbase, voff) do { _Pragma("unroll") for (int _i = 0; _i < 2; ++_i) \
        __builtin_amdgcn_global_load_lds((const unsigned*)((const char*)(gbase) + (voff)[_i]), (PG8_LAS unsigned*)(lds + (bufoff) + ldsw + _i * 8192), 16, 0, 0); } while (0)
#define PG8_LDA(dst, b, h) do { _Pragma("unroll") for (int m = 0; m < 4; ++m) _Pragma("unroll") for (int k = 0; k < 2; ++k) dst[m][k] = *(const PG8_LAS bf16x8*)(lds + PG8_SA(b, h) + aoff + m * 2048 + k * 1024); } while (0)
#define PG8_LDB(dst, b, h) do { _Pragma("unroll") for (int n = 0; n < 2; ++n) _Pragma("unroll") for (int k = 0; k < 2; ++k) dst[n][k] = *(const PG8_LAS bf16x8*)(lds + PG8_SB(b, h) + boff + n * 2048 + k * 1024); } while (0)
#define PG8_MMA(ai, bj, At, Bt) do { __builtin_amdgcn_s_setprio(1); _Pragma("unroll") for (int m = 0; m < 4; ++m) _Pragma("unroll") for (int n = 0; n < 2; ++n) _Pragma("unroll") for (int k = 0; k < 2; ++k) \
        acc[ai][bj][m][n] = __builtin_amdgcn_mfma_f32_16x16x32_bf16(Bt[n][k], At[m][k], acc[ai][bj][m][n], 0, 0, 0); __builtin_amdgcn_s_setprio(0); } while (0)
#define PG8_WAIT_V(n) asm volatile("s_waitcnt vmcnt(" #n ")" ::: "memory")
#define PG8_WAIT_L(n) asm volatile("s_waitcnt lgkmcnt(" #n ")" ::: "memory")
#define PG8_BAR __builtin_amdgcn_s_barrier()
#define PG8_SCHED __builtin_amdgcn_sched_barrier(0)
    Unit cur, nxt; int ui = 0;
    if (!S.next(0, cur)) return;
    f32x4 acc[2][2][4][2];
#pragma unroll
    for (int a = 0; a < 2; ++a)
#pragma unroll
        for (int b = 0; b < 2; ++b)
#pragma unroll
            for (int m = 0; m < 4; ++m)
#pragma unroll
                for (int n = 0; n < 2; ++n) acc[a][b][m][n] = (f32x4){0.f, 0.f, 0.f, 0.f};
    bf16x8 At[4][2], B0[2][2], B1[2][2];
    const char* cA = (const char*)g.A + (size_t)cur.pm * tstep + (size_t)cur.pk * K * 2; const char* cB = (const char*)g.Bt + (size_t)cur.pn * tstep + (size_t)cur.pk * K * 2;
    S.a_ready(cur);
    if constexpr (SP2) {
        PG8_STAGE(PG8_SB(0, 0), cB, voffB); PG8_STAGE(PG8_SB(0, 1), cB + hstep, voffB); PG8_STAGE(PG8_SA(0, 0), cA, voffA); PG8_STAGE(PG8_SA(0, 1), cA + hstep, voffA);
        if (wr == 1) PG8_BAR;
        PG8_WAIT_V(2); PG8_BAR;
        PG8_STAGE(PG8_SB(1, 0), cB + kstep, voffB); PG8_STAGE(PG8_SA(1, 0), cA + kstep, voffA); PG8_STAGE(PG8_SB(1, 1), cB + hstep + kstep, voffB);
        PG8_WAIT_V(6); PG8_BAR;
    } else {
        PG8_STAGE(PG8_SB(0, 0), cB, voffB); PG8_STAGE(PG8_SA(0, 0), cA, voffA); PG8_STAGE(PG8_SB(0, 1), cB + hstep, voffB); PG8_STAGE(PG8_SA(0, 1), cA + hstep, voffA);
        if (wr == 1) PG8_BAR;
        PG8_WAIT_V(4); PG8_BAR;
        PG8_STAGE(PG8_SB(1, 0), cB + kstep, voffB); PG8_STAGE(PG8_SA(1, 0), cA + kstep, voffA); PG8_STAGE(PG8_SB(1, 1), cB + hstep + kstep, voffB);
        PG8_WAIT_V(6); PG8_BAR;
    }
    for (;;) {
        const bool has_next = S.next(ui + 1, nxt);
        const char* nA = has_next ? (const char*)g.A + (size_t)nxt.pm * tstep + (size_t)nxt.pk * K * 2 : cA; const char* nB = has_next ? (const char*)g.Bt + (size_t)nxt.pn * tstep + (size_t)nxt.pk * K * 2 : cB;
        for (int t = 0; t < nt; t += 2) {
            const bool last = (t == nt - 2);
            const char* a1 = cA + (size_t)(t + 1) * kstep;
            const char* a2 = last ? nA : cA + (size_t)(t + 2) * kstep; const char* b2 = last ? nB : cB + (size_t)(t + 2) * kstep;
            const char* a3 = a2 + kstep; const char* b3 = b2 + kstep;
            if (last && has_next) S.a_ready(nxt);
            if constexpr (SP2) {
            PG8_LDB(B0, 0, 0); PG8_LDB(B1, 0, 1); PG8_SCHED; PG8_LDA(At, 0, 0); PG8_STAGE(PG8_SA(1, 1), a1 + hstep, voffA);
            PG8_WAIT_V(8); PG8_WAIT_L(0); PG8_BAR; PG8_MMA(0, 0, At, B0); PG8_MMA(0, 1, At, B1); PG8_BAR; PG8_SCHED;
            PG8_LDA(At, 0, 1); PG8_STAGE(PG8_SB(0, 0), b2, voffB); PG8_STAGE(PG8_SB(0, 1), b2 + hstep, voffB); PG8_STAGE(PG8_SA(0, 0), a2, voffA);
            PG8_WAIT_V(8); PG8_WAIT_L(0); PG8_BAR; PG8_MMA(1, 0, At, B0); PG8_MMA(1, 1, At, B1); PG8_BAR; PG8_SCHED;
            PG8_LDB(B0, 1, 0); PG8_LDB(B1, 1, 1); PG8_SCHED; PG8_LDA(At, 1, 0); PG8_STAGE(PG8_SA(0, 1), a2 + hstep, voffA);
            PG8_WAIT_V(8); PG8_WAIT_L(0); PG8_BAR; PG8_MMA(0, 0, At, B0); PG8_MMA(0, 1, At, B1); PG8_BAR; PG8_SCHED;
            PG8_LDA(At, 1, 1); PG8_STAGE(PG8_SB(1, 0), b3, voffB); PG8_STAGE(PG8_SB(1, 1), b3 + hstep, voffB); PG8_STAGE(PG8_SA(1, 0), a3, voffA);
            PG8_WAIT_V(8); PG8_WAIT_L(0); PG8_BAR; PG8_MMA(1, 0, At, B0); PG8_MMA(1, 1, At, B1); PG8_BAR; PG8_SCHED;
            } else {
            PG8_LDB(B0, 0, 0); PG8_SCHED; PG8_LDA(At, 0, 0); PG8_STAGE(PG8_SA(1, 1), a1 + hstep, voffA);
            PG8_WAIT_L(8); PG8_BAR; PG8_WAIT_L(0); PG8_MMA(0, 0, At, B0); PG8_BAR; PG8_SCHED;
            PG8_LDB(B1, 0, 1); PG8_STAGE(PG8_SB(0, 0), b2, voffB);
            PG8_BAR; PG8_WAIT_L(0); PG8_MMA(0, 1, At, B1); PG8_BAR;
            PG8_LDA(At, 0, 1); PG8_STAGE(PG8_SA(0, 0), a2, voffA);
            PG8_BAR; PG8_WAIT_L(0); PG8_MMA(1, 0, At, B0); PG8_BAR; PG8_SCHED;
            PG8_STAGE(PG8_SB(0, 1), b2 + hstep, voffB);
            PG8_WAIT_V(6); PG8_BAR; PG8_MMA(1, 1, At, B1); PG8_BAR;
            PG8_LDB(B0, 1, 0); PG8_SCHED; PG8_LDA(At, 1, 0); PG8_STAGE(PG8_SA(0, 1), a2 + hstep, voffA);
            PG8_WAIT_L(8); PG8_BAR; PG8_WAIT_L(0); PG8_MMA(0, 0, At, B0); PG8_BAR; PG8_SCHED;
            PG8_LDB(B1, 1, 1); PG8_STAGE(PG8_SB(1, 0), b3, voffB);
            PG8_BAR; PG8_WAIT_L(0); PG8_MMA(0, 1, At, B1); PG8_BAR;
            PG8_LDA(At, 1, 1); PG8_STAGE(PG8_SA(1, 0), a3, voffA);
            PG8_BAR; PG8_WAIT_L(0); PG8_MMA(1, 0, At, B0); PG8_BAR; PG8_SCHED;
            PG8_STAGE(PG8_SB(1, 1), b3 + hstep, voffB);
            PG8_WAIT_V(6); PG8_BAR; PG8_MMA(1, 1, At, B1); PG8_BAR;
            }
        }
        if constexpr (ALIGN_EPI) { if (wr == 0) PG8_BAR; }
        if constexpr (!Epi::AFTER_DRAIN) { const int le_ = lane_id_asm(); E(acc, cur, wr, wc, le_ & 15, le_ >> 4); S.done(cur); }
        if (!has_next) break;
#pragma unroll
        for (int a = 0; a < 2; ++a)
#pragma unroll
            for (int b = 0; b < 2; ++b)
#pragma unroll
                for (int m = 0; m < 4; ++m)
#pragma unroll
                    for (int n = 0; n < 2; ++n) acc[a][b][m][n] = (f32x4){0.f, 0.f, 0.f, 0.f};
        cur = nxt; cA = nA; cB = nB; ++ui;
        if constexpr (ALIGN_EPI) { if (wr == 1) PG8_BAR; }
    }
    PG8_WAIT_V(0);
    if constexpr (!ALIGN_EPI) { if (wr == 0) PG8_BAR; }
    PG8_BAR;
    if constexpr (Epi::AFTER_DRAIN) { E.fused(acc, cur, wr, wc, fr, fq, lds, wid, lane); S.done(cur); }
#undef PG8_SA
#undef PG8_SB
#undef PG8_STAGE
#undef PG8_LDA
#undef PG8_LDB
#undef PG8_MMA
#undef PG8_WAIT_V
#undef PG8_WAIT_L
#undef PG8_BAR
#undef PG8_SCHED
}
}

namespace att {
typedef unsigned short bf16_t;
using bf16x8 = __attribute__((ext_vector_type(8))) short;
using s16x4  = __attribute__((ext_vector_type(4))) short;
using f32x16 = __attribute__((ext_vector_type(16))) float;
using u32x4  = __attribute__((ext_vector_type(4))) unsigned;
constexpr int NW = 8, QBLK = 32, KVBLK = 64;
constexpr float THR = 8.f;
constexpr int SHM_V = 16384, SHM_K = 16384;
#define KSWZ(row, colB) ((row) * 256 + ((colB) ^ (((row) & 7) << 4)))
#define SBAR() __builtin_amdgcn_sched_barrier(0)
__device__ __forceinline__ int crow(int r, int hi) { return (r & 3) + 8 * (r >> 2) + 4 * hi; }
__device__ __forceinline__ unsigned cvtpk(float lo, float hi) { unsigned r; asm volatile("v_cvt_pk_bf16_f32 %0, %1, %2" : "=v"(r) : "v"(lo), "v"(hi)); return r; }

constexpr float THRL = 11.0f;
template <bool FIRST> __device__ __forceinline__ void partialSM(f32x16& p0, f32x16& p1, float& m_reg, f32x16& negm, float& alpha) {
  float pmax = fmaxf(fmaxf(p0[0], p0[1]), p1[0]);
#pragma unroll
  for (int r = 2; r < 16; r += 2) pmax = fmaxf(fmaxf(pmax, p0[r]), p0[r + 1]);
#pragma unroll
  for (int r = 1; r < 15; r += 2) pmax = fmaxf(fmaxf(pmax, p1[r]), p1[r + 1]);
  pmax = fmaxf(pmax, p1[15]);
  { auto rr = __builtin_amdgcn_permlane32_swap(__float_as_uint(pmax), __float_as_uint(pmax), false, false);
    pmax = fmaxf(__uint_as_float(rr[0]), __uint_as_float(rr[1])); }
  alpha = 1.f;
  if (FIRST || !__builtin_expect(__all(pmax <= THRL), 1)) {
    const float dl = FIRST ? pmax : fmaxf(pmax, 0.f);
    m_reg += dl;
#pragma unroll
    for (int r = 0; r < 16; ++r) { p0[r] -= dl; p1[r] -= dl; }
#pragma unroll
    for (int r = 0; r < 16; ++r) negm[r] = -m_reg;
    if (!FIRST) alpha = __builtin_amdgcn_exp2f(-dl);
  }
#pragma unroll
  for (int r = 0; r < 16; ++r) p0[r] = __builtin_amdgcn_exp2f(p0[r]);
}
__device__ __forceinline__ void finishSM(f32x16& p0, f32x16& p1, float alpha, float& l_reg, bf16x8& pa0, bf16x8& pa1, bf16x8& pa2, bf16x8& pa3) {
#pragma unroll
  for (int r = 0; r < 16; ++r) p1[r] = __builtin_amdgcn_exp2f(p1[r]);
  float ps = 0;
#pragma unroll
  for (int r = 0; r < 16; ++r) ps += p0[r];
#pragma unroll
  for (int r = 0; r < 16; ++r) ps += p1[r];
  { auto rr = __builtin_amdgcn_permlane32_swap(__float_as_uint(ps), __float_as_uint(ps), false, false);
    ps = __uint_as_float(rr[0]) + __uint_as_float(rr[1]); }
  l_reg = l_reg * alpha + ps;
#define PK4(P, BASE, OUT) do { unsigned a0 = cvtpk(P[BASE + 0], P[BASE + 1]), a1 = cvtpk(P[BASE + 2], P[BASE + 3]);   \
    unsigned b0 = cvtpk(P[BASE + 4], P[BASE + 5]), b1 = cvtpk(P[BASE + 6], P[BASE + 7]);                              \
    auto r0 = __builtin_amdgcn_permlane32_swap(a0, b0, false, false); auto r1 = __builtin_amdgcn_permlane32_swap(a1, b1, false, false); \
    u32x4 w = {r0[0], r1[0], r0[1], r1[1]}; OUT = *reinterpret_cast<bf16x8*>(&w); } while (0)
  PK4(p0, 0, pa0); PK4(p0, 8, pa1); PK4(p1, 0, pa2); PK4(p1, 8, pa3);
#undef PK4
}
template <int DQ> __device__ __forceinline__ void qkt(f32x16& p0, f32x16& p1, const char* Ks, const bf16x8* qr, const f32x16& negm, int r32, int hi) {
#pragma unroll
  for (int d0 = 0; d0 < DQ / 16; ++d0) { int cb = (d0 * 16 + hi * 8) * 2;
    bf16x8 b0 = *reinterpret_cast<const bf16x8*>(Ks + KSWZ(r32, cb));
    bf16x8 b1 = *reinterpret_cast<const bf16x8*>(Ks + KSWZ(32 + r32, cb));
    if (d0 == 0) { p0 = __builtin_amdgcn_mfma_f32_32x32x16_bf16(b0, qr[0], negm, 0, 0, 0); p1 = __builtin_amdgcn_mfma_f32_32x32x16_bf16(b1, qr[0], negm, 0, 0, 0); }
    else { p0 = __builtin_amdgcn_mfma_f32_32x32x16_bf16(b0, qr[d0], p0, 0, 0, 0); p1 = __builtin_amdgcn_mfma_f32_32x32x16_bf16(b1, qr[d0], p1, 0, 0, 0); } }
}
__device__ __forceinline__ int v_st(int k, int c) { const int kk = (k & ~0xC) | ((k & 4) << 1) | ((k & 8) >> 1); return ((kk >> 3) * 4 + (c >> 5)) * 512 + ((kk & 7) * 32 + (c & 31)) * 2; }
__device__ __forceinline__ int v_rd_base(int lane) { return ((lane & 3) << 3) | (((lane >> 2) & 3) << 6) | (((lane >> 4) & 1) << 5) | (((lane >> 5) & 1) << 8); }
constexpr int v_rd_off(int d0, int ks, int half) { return d0 * 512 + ks * 4096 + half * 2048; }
template <int OFF> __device__ __forceinline__ s16x4 tr_read(int vb) {
  s16x4 r; asm volatile("ds_read_b64_tr_b16 %0, %1 offset:%2" : "=&v"(r) : "v"(vb), "i"(OFF) : "memory"); return r;
}
template <int D0> __device__ __forceinline__ void pv_one(f32x16& od, int vb, bf16x8 pa0, bf16x8 pa1, bf16x8 pa2, bf16x8 pa3) {
  const s16x4 l0 = tr_read<v_rd_off(D0, 0, 0)>(vb), h0 = tr_read<v_rd_off(D0, 0, 1)>(vb), l1 = tr_read<v_rd_off(D0, 1, 0)>(vb), h1 = tr_read<v_rd_off(D0, 1, 1)>(vb);
  const s16x4 l2 = tr_read<v_rd_off(D0, 2, 0)>(vb), h2 = tr_read<v_rd_off(D0, 2, 1)>(vb), l3 = tr_read<v_rd_off(D0, 3, 0)>(vb), h3 = tr_read<v_rd_off(D0, 3, 1)>(vb);
  asm volatile("s_waitcnt lgkmcnt(0)" ::: "memory"); SBAR();
#define PK(L, H) (bf16x8){L[0], L[1], L[2], L[3], H[0], H[1], H[2], H[3]}
  od = __builtin_amdgcn_mfma_f32_32x32x16_bf16(pa0, PK(l0, h0), od, 0, 0, 0);
  od = __builtin_amdgcn_mfma_f32_32x32x16_bf16(pa1, PK(l1, h1), od, 0, 0, 0);
  od = __builtin_amdgcn_mfma_f32_32x32x16_bf16(pa2, PK(l2, h2), od, 0, 0, 0);
  od = __builtin_amdgcn_mfma_f32_32x32x16_bf16(pa3, PK(l3, h3), od, 0, 0, 0);
#undef PK
}
__device__ __forceinline__ void pv_d0(f32x16* o, int vb, bf16x8 pa0, bf16x8 pa1, bf16x8 pa2, bf16x8 pa3) {
  pv_one<0>(o[0], vb, pa0, pa1, pa2, pa3); pv_one<1>(o[1], vb, pa0, pa1, pa2, pa3);
}

template <int DQ>
__device__ __forceinline__ void attn_unit(const bf16_t* __restrict__ Qb, const bf16_t* __restrict__ Kh, const bf16_t* __restrict__ Kpe, const bf16_t* __restrict__ Vh,
                                          bf16_t* __restrict__ Ob, int seq, char* lds, const int wave_in) {
  constexpr int LDQ = (DQ == 96) ? 576 : 384, LDK = (DQ == 96) ? 384 : 128, LDO = 1024, ND = DQ / 16;
  const int tid = wave_in * 64 + pg8::lane_id_asm(), wid = wave_in, lane = tid & 63, r32 = lane & 31, hi = lane >> 5;
  char* V_lds = lds; char* K_lds = lds + 2 * SHM_V;
  float* ws = (float*)(lds + 2 * SHM_V + 2 * SHM_K) + wid * 64; float* li_l = ws; float* al_l = ws + 32;
  float m_reg = 0.f, l_reg = 0; f32x16 o[2] = {}; f32x16 negm = {}; bf16x8 qr[ND];
  const bf16_t* Qw = Qb + (unsigned)((wid * QBLK + r32) * LDQ + hi * 8);
#pragma unroll
  for (int d0 = 0; d0 < ND; ++d0) qr[d0] = *reinterpret_cast<const bf16x8*>(Qw + d0 * 16);
  const int sr = tid >> 3, sc = (tid & 7) * 8;
  const int pr = (tid >> 2) & 63, pc = (tid & 3) * 8;
  const int vst = v_st(sr, sc), kst = KSWZ(sr, sc * 2), pst = KSWZ(pr, (64 + pc) * 2);
  const int vb0 = (int)(uintptr_t)V_lds + v_rd_base(lane);
  struct { bf16x8 vs, ks, ps; } sr_[2];
  const unsigned voff = (unsigned)(sr * LDK + sc), poff = (unsigned)(pr * 32 + pc);
#define SLOAD(i, k0) do { const bf16_t* Vt_ = Vh + (size_t)(k0) * LDK; const bf16_t* Kt_ = Kh + (size_t)(k0) * LDK; \
    sr_[i].vs = *reinterpret_cast<const bf16x8*>(Vt_ + voff); sr_[i].ks = *reinterpret_cast<const bf16x8*>(Kt_ + voff); \
    if constexpr (DQ == 96) { const bf16_t* Pt_ = Kpe + (size_t)(k0) * 32; sr_[i].ps = *reinterpret_cast<const bf16x8*>(Pt_ + poff); } } while (0)
#define SWRITE(b, i) do { *(bf16x8*)(V_lds + (b) * SHM_V + vst) = sr_[i].vs; *(bf16x8*)(K_lds + (b) * SHM_K + kst) = sr_[i].ks; \
    if constexpr (DQ == 96) { if (tid < 256) *(bf16x8*)(K_lds + (b) * SHM_K + pst) = sr_[i].ps; } } while (0)
#define SWAIT() do { if constexpr (DQ == 96) asm volatile("s_waitcnt vmcnt(3)" ::: "memory"); else asm volatile("s_waitcnt vmcnt(2)" ::: "memory"); } while (0)
#define RESC(a) do { if (__any((a) < 1.f)) { if (hi == 0) al_l[r32] = (a); asm volatile("s_waitcnt lgkmcnt(0)" ::: "memory"); \
    _Pragma("unroll") for (int d = 0; d < 2; ++d) _Pragma("unroll") for (int r = 0; r < 16; ++r) o[d][r] *= al_l[crow(r, hi)]; } } while (0)
  f32x16 pA0, pA1, pB0, pB1; float alA, alB; bf16x8 pa0, pa1, pa2, pa3; const int NT = seq / KVBLK;
  constexpr int SE = 0, SO = 1;
  SLOAD(SE, 0); asm volatile("s_waitcnt vmcnt(0)" ::: "memory"); SWRITE(0, SE); __syncthreads();
  qkt<DQ>(pA0, pA1, K_lds, qr, negm, r32, hi); partialSM<true>(pA0, pA1, m_reg, negm, alA);
  SLOAD(SO, KVBLK); if (2 < NT) SLOAD(SE, 2 * KVBLK);
  SWAIT(); SWRITE(1, SO); __syncthreads();
  for (int j = 1; j + 1 < NT; j += 2) {
    SBAR(); qkt<DQ>(pB0, pB1, K_lds + SHM_K, qr, negm, r32, hi);
    finishSM(pA0, pA1, alA, l_reg, pa0, pa1, pa2, pa3); SBAR();
    SLOAD(SO, (j + 2) * KVBLK); SBAR();
    pv_d0(o, vb0, pa0, pa1, pa2, pa3); partialSM<false>(pB0, pB1, m_reg, negm, alB);
    __syncthreads(); SWAIT(); SWRITE(0, SE);
    RESC(alB); __syncthreads();
    SBAR(); qkt<DQ>(pA0, pA1, K_lds, qr, negm, r32, hi);
    finishSM(pB0, pB1, alB, l_reg, pa0, pa1, pa2, pa3); SBAR();
    if (j + 3 < NT) SLOAD(SE, (j + 3) * KVBLK); SBAR();
    pv_d0(o, vb0 + SHM_V, pa0, pa1, pa2, pa3); partialSM<false>(pA0, pA1, m_reg, negm, alA);
    __syncthreads(); SWAIT(); SWRITE(1, SO);
    RESC(alA); __syncthreads();
  }
  SBAR(); qkt<DQ>(pB0, pB1, K_lds + SHM_K, qr, negm, r32, hi);
  finishSM(pA0, pA1, alA, l_reg, pa0, pa1, pa2, pa3); SBAR();
  pv_d0(o, vb0, pa0, pa1, pa2, pa3); partialSM<false>(pB0, pB1, m_reg, negm, alB);
  __syncthreads(); RESC(alB);
  finishSM(pB0, pB1, alB, l_reg, pa0, pa1, pa2, pa3); SBAR();
  pv_d0(o, vb0 + SHM_V, pa0, pa1, pa2, pa3);
  if (hi == 0) li_l[r32] = l_reg; asm volatile("s_waitcnt lgkmcnt(0)" ::: "memory");
  float rli[16];
#pragma unroll
  for (int r = 0; r < 16; ++r) rli[r] = __builtin_amdgcn_rcpf(li_l[crow(r, hi)]);
  bf16_t* Ow = Ob + (long)(wid * QBLK) * LDO;
#pragma unroll
  for (int r = 0; r < 16; ++r) { int orow = crow(r, hi);
#pragma unroll
    for (int d0 = 0; d0 < 2; ++d0) { const float v = o[d0][r] * rli[r]; Ow[(long)orow * LDO + d0 * 32 + r32] = (bf16_t)(cvtpk(v, v) & 0xffffu); } }
  __syncthreads();
#undef SLOAD
#undef SWRITE
#undef SWAIT
#undef RESC
}
#undef SBAR
}

typedef unsigned short bf16_t;
typedef float f32x4 __attribute__((ext_vector_type(4)));
typedef float f32x2 __attribute__((ext_vector_type(2)));
typedef unsigned u32x2 __attribute__((ext_vector_type(2)));
typedef unsigned u32x4 __attribute__((ext_vector_type(4)));
#define LAS __attribute__((address_space(3)))
constexpr size_t MiB = 1u << 20;
constexpr size_t WS_MOD = 1 * MiB, WS_ROPEM = 2 * MiB, WS_ROPEG = 3 * MiB, WS_Z = 5 * MiB;
constexpr size_t WS_WIN = 10 * MiB, WS_WUQ = 26 * MiB, WS_WUKV = 28 * MiB, WS_WO = 29 * MiB, WS_W1 = 37 * MiB, WS_W2 = 69 * MiB;
constexpr size_t WS_U = 101 * MiB, WS_Y = WS_U  , WS_PART = 167 * MiB  , WS_OV = 233 * MiB;
constexpr size_t WS_HM = WS_OV, WS_H = WS_OV, WS_MQ = WS_OV, WS_MK = 271 * MiB, WS_MV = 296 * MiB;
constexpr size_t WS_CKV = 365 * MiB, WS_CQ = 374 * MiB, WS_KPE = 391 * MiB, WS_GK = 394 * MiB, WS_GV = 403 * MiB, WS_GQ = 412 * MiB, WS_O = 437 * MiB, WS_END = 503 * MiB;
static_assert(WS_MQ + (size_t)MROWS * 576 * 2 <= WS_MK && WS_MK + (size_t)MROWS * 384 * 2 <= WS_MV && WS_MV + (size_t)MROWS * 384 * 2 <= WS_H + (size_t)MROWS * HP * 2, "overlay");
static_assert(WS_H + (size_t)MROWS * HP * 2 <= WS_CKV && WS_CKV + (size_t)MROWS * 256 <= WS_CQ && WS_CQ + (size_t)MROWS * 512 <= WS_KPE && WS_KPE + (size_t)MROWS * 64 <= WS_GK, "map1");
static_assert(WS_GK + (size_t)MROWS * 256 <= WS_GV && WS_GV + (size_t)MROWS * 256 <= WS_GQ && WS_GQ + (size_t)MROWS * 768 <= WS_O && WS_O + (size_t)MROWS * 2048 <= WS_END, "map2");
static_assert(WS_HM + (size_t)MROWS * DFF * 2 <= WS_END, "map3");
#ifndef ATT_REPS
#define ATT_REPS 1
#endif
#ifndef GEMM_REPS
#define GEMM_REPS 1
#endif
constexpr float QSC64 = 0.125f * 1.4426950408889634f, QSC96 = 0.10206207261596575f * 1.4426950408889634f;
constexpr int LDS_BYTES = 135168;

struct Params { const float* in[21]; float* out; unsigned char* ws; };
enum { I_X = 0, I_C, I_CTX, I_CCTX, I_WADA, I_BADA, I_WIN, I_GCQ, I_WUQ, I_GCKV, I_WUKV, I_GQN, I_GKN, I_WCONV, I_WO, I_LN1G, I_LN1B, I_W1, I_W2, I_LN2G, I_LN2B };

__device__ __forceinline__ float shx(float v, int lane, int o) { return __int_as_float(__builtin_amdgcn_ds_bpermute((lane ^ o) << 2, __float_as_int(v))); }
__device__ __forceinline__ float wave_sum(float v, int lane) {
#pragma unroll
    for (int o = 1; o < 64; o <<= 1) v += shx(v, lane, o);
    return v;
}
__device__ __forceinline__ float half_sum(float v, int lane) {
#pragma unroll
    for (int o = 1; o < 32; o <<= 1) v += shx(v, lane, o);
    return v;
}
__device__ __forceinline__ unsigned pk2(float lo, float hi) { unsigned r; asm volatile("v_cvt_pk_bf16_f32 %0, %1, %2" : "=v"(r) : "v"(lo), "v"(hi)); return r; }
__device__ __forceinline__ float bflo(unsigned w) { return __uint_as_float(w << 16); }
__device__ __forceinline__ float bfhi(unsigned w) { return __uint_as_float(w & 0xffff0000u); }

__device__ __forceinline__ void transpose_item(const float* W, int K, int N, bf16_t* WT, LAS float* scr, int item, int lane) {
    const int nblk = N / 32, kb = item / nblk, nb = item % nblk, k0 = 64 * kb, n0 = 32 * nb;
#pragma unroll 8
    for (int i = 0; i < 32; ++i) { const int kk = 2 * i + (lane >> 5); scr[kk * 33 + (lane & 31)] = W[(size_t)(k0 + kk) * N + n0 + (lane & 31)]; }
    asm volatile("s_waitcnt lgkmcnt(0)" ::: "memory");
    const int c = lane & 7;
#pragma unroll
    for (int j = 0; j < 4; ++j) { const int n = (lane >> 3) + 8 * j; const LAS float* s = scr + (8 * c) * 33 + n;
        u32x4 o; o.x = pk2(s[0 * 33], s[1 * 33]); o.y = pk2(s[2 * 33], s[3 * 33]); o.z = pk2(s[4 * 33], s[5 * 33]); o.w = pk2(s[6 * 33], s[7 * 33]);
        *(u32x4*)(WT + (size_t)(n0 + n) * K + k0 + 8 * c) = o; }
    asm volatile("s_waitcnt lgkmcnt(0)" ::: "memory");
}

struct RowInfo { int b, i, v; bool isctx; };
__device__ __forceinline__ RowInfo row_info(int m) { RowInfo r; r.b = m / LTOK; r.i = m - r.b * LTOK; r.isctx = r.i < CTX; r.v = r.isctx ? 4 : r.b; return r; }

__global__ void __launch_bounds__(512, 2) fwd_megakernel(Params p) {
    extern __shared__ __attribute__((aligned(16))) unsigned char lds[];
    cg::grid_group grid = cg::this_grid();
    const int wave = __builtin_amdgcn_readfirstlane(threadIdx.x >> 6);
    const int G = gridDim.x, bx = blockIdx.x;
    const int vcu = (G % 8 == 0) ? (bx % 8) * (G / 8) + bx / 8 : bx;
    const int gw = bx * 8 + wave, NGW = G * 8;
#define KP() ({ const __attribute__((address_space(4))) Params* k_ = (const __attribute__((address_space(4))) Params*)__builtin_amdgcn_kernarg_segment_ptr(); asm volatile("" : "+s"(k_)); k_; })
#define WSB() ((unsigned char*)KP()->ws)
#define DEFWS(w) \
    float* MOD = (float*)((w) + WS_MOD); float* ROPEM = (float*)((w) + WS_ROPEM); float* ROPEG = (float*)((w) + WS_ROPEG); float* Z = (float*)((w) + WS_Z); \
    bf16_t* WIN = (bf16_t*)((w) + WS_WIN); bf16_t* WUQ = (bf16_t*)((w) + WS_WUQ); bf16_t* WUKV = (bf16_t*)((w) + WS_WUKV); bf16_t* WO = (bf16_t*)((w) + WS_WO); \
    bf16_t* W1 = (bf16_t*)((w) + WS_W1); bf16_t* W2 = (bf16_t*)((w) + WS_W2); \
    bf16_t* U = (bf16_t*)((w) + WS_U); bf16_t* Y = (bf16_t*)((w) + WS_Y); bf16_t* HM = (bf16_t*)((w) + WS_HM); bf16_t* H = (bf16_t*)((w) + WS_H); \
    bf16_t* MQ = (bf16_t*)((w) + WS_MQ); bf16_t* MK = (bf16_t*)((w) + WS_MK); bf16_t* MV = (bf16_t*)((w) + WS_MV); \
    bf16_t* CKV = (bf16_t*)((w) + WS_CKV); bf16_t* CQ = (bf16_t*)((w) + WS_CQ); bf16_t* KPE = (bf16_t*)((w) + WS_KPE); \
    bf16_t* GK = (bf16_t*)((w) + WS_GK); bf16_t* GV = (bf16_t*)((w) + WS_GV); bf16_t* GQ = (bf16_t*)((w) + WS_GQ); bf16_t* OC = (bf16_t*)((w) + WS_O); float* PART = (float*)((w) + WS_PART); (void)PART; \
    (void)MOD; (void)ROPEM; (void)ROPEG; (void)Z; (void)WIN; (void)WUQ; (void)WUKV; (void)WO; (void)W1; (void)W2; (void)U; (void)Y; (void)HM; (void)H; (void)MQ; (void)MK; (void)MV; \
    (void)CKV; (void)CQ; (void)KPE; (void)GK; (void)GV; (void)GQ; (void)OC;

    {
        DEFWS(WSB())
        const int lane = pg8::lane_id_asm(), tid = wave * 64 + lane;
        LAS float* scr = (LAS float*)((LAS unsigned char*)lds + wave * 16384);
        constexpr int I_IN = 16 * 57, I_UQ = 4 * 18, I_UKV = 2 * 24, I_O = 16 * 32, I_1 = 16 * 128, I_2 = 64 * 32, PER = I_IN + I_UQ + I_UKV + I_O + I_1 + I_2;
        for (int it = gw; it < DEPTH * PER; it += NGW) {
            const int l = it / PER; int r = it - l * PER;
            if (r < I_IN) { transpose_item(KP()->in[I_WIN] + (size_t)l * DM * IN_COLS, DM, IN_COLS, WIN + (size_t)l * HP * DM, scr, r, lane); continue; } r -= I_IN;
            if (r < I_UQ) { transpose_item(KP()->in[I_WUQ] + (size_t)l * 256 * 576, 256, 576, WUQ + (size_t)l * 768 * 256, scr, r, lane); continue; } r -= I_UQ;
            if (r < I_UKV) { transpose_item(KP()->in[I_WUKV] + (size_t)l * 128 * 768, 128, 768, WUKV + (size_t)l * 768 * 128, scr, r, lane); continue; } r -= I_UKV;
            if (r < I_O) { transpose_item(KP()->in[I_WO] + (size_t)l * DM * DM, DM, DM, WO + (size_t)l * DM * DM, scr, r, lane); continue; } r -= I_O;
            if (r < I_1) { transpose_item(KP()->in[I_W1] + (size_t)l * DM * DFF, DM, DFF, W1 + (size_t)l * DFF * DM, scr, r, lane); continue; } r -= I_1;
            transpose_item(KP()->in[I_W2] + (size_t)l * DFF * DM, DFF, DM, W2 + (size_t)l * DM * DFF, scr, r, lane);
        }
        const int gt = bx * 512 + tid, NGT = G * 512;
        for (int idx = gt; idx < DEPTH * 224 * 128; idx += NGT) { const int l = idx / (224 * 128), r = idx % (224 * 128);
            *(u32x4*)(WIN + ((size_t)l * HP + IN_COLS) * DM + (size_t)r * 8) = (u32x4){0u, 0u, 0u, 0u}; }
        for (int idx = gt; idx < DEPTH * 192 * 32; idx += NGT) { const int l = idx / (192 * 32), r = idx % (192 * 32);
            *(u32x4*)(WUQ + ((size_t)l * 768 + 576) * 256 + (size_t)r * 8) = (u32x4){0u, 0u, 0u, 0u}; }
        for (int idx = gt; idx < SEQ * 16; idx += NGT) { const int pos = idx >> 4, i = idx & 15; const int rw = pos >> 6, cl = pos & 63;
            const float inv = powf(10000.f, -(float)(i & 7) / 8.f); const float ang = (float)(i < 8 ? rw : cl) * inv;
            ROPEM[2 * idx] = cosf(ang); ROPEM[2 * idx + 1] = sinf(ang); }
        for (int idx = gt; idx < SEQ * 32; idx += NGT) { const int pos = idx >> 5, i = idx & 31; const int rw = pos >> 6, cl = pos & 63;
            const float inv = powf(10000.f, -(float)(i & 15) / 16.f); const float ang = (float)(i < 16 ? rw : cl) * inv;
            ROPEG[2 * idx] = cosf(ang); ROPEG[2 * idx + 1] = sinf(ang); }
        __syncthreads();
        float* sil = (float*)lds;
        float* part = (float*)lds + 5 * 1024;
        { const float* c_in = KP()->in[I_C]; const float* cc_in = KP()->in[I_CCTX];
        for (int idx = tid; idx < 5 * 1024; idx += 512) { const int v = idx >> 10, k = idx & 1023; const float c = (v < 4) ? c_in[v * 1024 + k] : cc_in[k]; sil[idx] = c / (1.f + __expf(-c)); } }
        const float* wada_ = KP()->in[I_WADA]; const float* bada_ = KP()->in[I_BADA];
        __syncthreads();
        for (int it = bx; it < DEPTH * 96; it += G) { const int l = it / 96, jb = it % 96; const int j = jb * 64 + lane;
            const float* wp = wada_ + ((size_t)l * DM + wave * 128) * 6144 + j;
            float a0 = 0, a1 = 0, a2 = 0, a3 = 0, a4 = 0;
#pragma unroll 8
            for (int k = 0; k < 128; ++k) { const float w = wp[(size_t)k * 6144]; const int kk = wave * 128 + k;
                a0 += sil[kk] * w; a1 += sil[1024 + kk] * w; a2 += sil[2048 + kk] * w; a3 += sil[3072 + kk] * w; a4 += sil[4096 + kk] * w; }
            part[(wave * 5 + 0) * 64 + lane] = a0; part[(wave * 5 + 1) * 64 + lane] = a1; part[(wave * 5 + 2) * 64 + lane] = a2; part[(wave * 5 + 3) * 64 + lane] = a3; part[(wave * 5 + 4) * 64 + lane] = a4;
            __syncthreads();
            if (tid < 320) { const int v = tid >> 6, c = tid & 63; float s = bada_[l * 6144 + jb * 64 + c];
#pragma unroll
                for (int w = 0; w < 8; ++w) s += part[(w * 5 + v) * 64 + c];
                MOD[((size_t)l * 5 + v) * 6144 + jb * 64 + c] = s; }
            __syncthreads();
        }
    }
    grid.sync();
    { DEFWS(WSB())
    const int lane = pg8::lane_id_asm(); const float* xin_ = KP()->in[I_X]; const float* cin_ = KP()->in[I_CTX];
    for (int m = gw; m < MROWS; m += NGW) { const RowInfo ri = row_info(m);
        const float* xr = ri.isctx ? cin_ + ((size_t)ri.b * CTX + ri.i) * DM : xin_ + ((size_t)ri.b * SEQ + ri.i - CTX) * DM;
        const float* md = MOD + (size_t)ri.v * 6144;
#pragma unroll
        for (int j = 0; j < 4; ++j) { const int col = 4 * lane + 256 * j; const f32x4 x = *(const f32x4*)(xr + col), sh = *(const f32x4*)(md + col), sc = *(const f32x4*)(md + 1024 + col);
            const f32x4 u = x * (1.f + sc) + sh; u32x2 w; w.x = pk2(u[0], u[1]); w.y = pk2(u[2], u[3]); *(u32x2*)(U + (size_t)m * DM + col) = w; }
    } }
    grid.sync();

#pragma unroll 1
    for (int l = 0; l < DEPTH; ++l) {
        { DEFWS(WSB()) pg8::Gemm g{U, WIN + (size_t)l * HP * DM, MROWS, HP, DM, DM}; pg8::StaticOrder S; S.init(MROWS, HP, G, bx);
          pg8::EpiStore<0> E{H, HP};
          pg8::gemm_phase<pg8::EpiStore<0>, pg8::StaticOrder, true, true>((LAS unsigned char*)lds, g, S, E, wave); }
        grid.sync();
        {
            DEFWS(WSB())
            const int lane = pg8::lane_id_asm();
            const f32x2* gckv = (const f32x2*)(KP()->in[I_GCKV] + l * 128); const f32x2* gkn = (const f32x2*)(KP()->in[I_GKN] + l * 64);
            const f32x2* gcq = (const f32x2*)(KP()->in[I_GCQ] + l * 256); const f32x2* gqn = (const f32x2*)(KP()->in[I_GQN] + l * 64);
            const f32x2* wc0 = (const f32x2*)(KP()->in[I_WCONV] + (size_t)l * 768); const f32x2* wc1 = wc0 + 128; const f32x2* wc2 = wc0 + 256;
            const f32x2* rM = (const f32x2*)ROPEM; const f32x2* rG = (const f32x2*)ROPEG;
            for (int m = gw; m < MROWS; m += NGW) { const RowInfo ri = row_info(m); const bool lat = !ri.isctx; const int pos = ri.i - CTX;
                const unsigned* hr = (const unsigned*)(H + (size_t)m * HP);
                {
                    const unsigned w = hr[lane]; const float a = bflo(w), b = bfhi(w); const float r = rsqrtf(wave_sum(a * a + b * b, lane) * (1.f / 128.f) + LN_EPS); const f32x2 g = gckv[lane];
                    ((unsigned*)(CKV + (size_t)m * 128))[lane] = pk2(a * r * g.x, b * r * g.y); }
                if (lane < 16) {
                    const unsigned w = hr[64 + lane]; float a = bflo(w), b = bfhi(w);
                    if (lat) { const f32x2 cs = rM[pos * 16 + lane]; const float a2 = a * cs.x - b * cs.y, b2 = a * cs.y + b * cs.x; a = a2; b = b2; }
                    ((unsigned*)(KPE + (size_t)m * 32))[lane] = pk2(a, b); }
                {
                    const unsigned w = hr[80 + lane]; float a = bflo(w), b = bfhi(w); const float r = rsqrtf(half_sum(a * a + b * b, lane) * (1.f / 64.f) + LN_EPS); const f32x2 g = gkn[lane & 31];
                    a = a * r * g.x; b = b * r * g.y;
                    if (lat) { const f32x2 cs = rG[pos * 32 + (lane & 31)]; const float a2 = a * cs.x - b * cs.y, b2 = a * cs.y + b * cs.x; a = a2; b = b2; }
                    ((unsigned*)(GK + (size_t)m * 128))[lane] = pk2(a, b); }
                ((unsigned*)(GV + (size_t)m * 128))[lane] = hr[144 + lane];
                {
                    const unsigned w0 = hr[208 + lane], w1 = hr[272 + lane]; const float a0 = bflo(w0), b0 = bfhi(w0), a1 = bflo(w1), b1 = bfhi(w1);
                    const float r = rsqrtf(wave_sum(a0 * a0 + b0 * b0 + a1 * a1 + b1 * b1, lane) * (1.f / 256.f) + LN_EPS); const f32x2 g0 = gcq[lane], g1 = gcq[64 + lane];
                    unsigned* o = (unsigned*)(CQ + (size_t)m * 256); o[lane] = pk2(a0 * r * g0.x, b0 * r * g0.y); o[64 + lane] = pk2(a1 * r * g1.x, b1 * r * g1.y); }
#pragma unroll
                for (int j = 0; j < 3; ++j) {
                    const unsigned w = hr[336 + 64 * j + lane]; float a = bflo(w), b = bfhi(w); const float r = rsqrtf(half_sum(a * a + b * b, lane) * (1.f / 64.f) + LN_EPS); const f32x2 g = gqn[lane & 31];
                    a = a * r * g.x; b = b * r * g.y;
                    if (lat) { const f32x2 cs = rG[pos * 32 + (lane & 31)]; const float a2 = a * cs.x - b * cs.y, b2 = a * cs.y + b * cs.x; a = a2; b = b2; }
                    ((unsigned*)(GQ + (size_t)m * 384))[64 * j + lane] = pk2(a * QSC64, b * QSC64); }
                {
                    const int seqlen = lat ? SEQ : CTX, t = lat ? pos : ri.i; const bool hp = t > 0, hn = t + 1 < seqlen;
                    const unsigned* hm1 = hr - HP / 2; const unsigned* hp1 = hr + HP / 2;
#pragma unroll
                    for (int j = 0; j < 2; ++j) { const int ix = lane + 64 * j;
                        const unsigned c0 = hr[528 + ix], k0 = hr[784 + ix], bb = hr[656 + ix];
                        const unsigned cm = hp ? hm1[528 + ix] : 0u, km = hp ? hm1[784 + ix] : 0u, cn = hn ? hp1[528 + ix] : 0u, kn = hn ? hp1[784 + ix] : 0u;
                        const f32x2 w0 = wc0[ix], w1 = wc1[ix], w2 = wc2[ix];
                        const float oa = bflo(bb) * (w0.x * bflo(cm) * bflo(km) + w1.x * bflo(c0) * bflo(k0) + w2.x * bflo(cn) * bflo(kn));
                        const float ob = bfhi(bb) * (w0.y * bfhi(cm) * bfhi(km) + w1.y * bfhi(c0) * bfhi(k0) + w2.y * bfhi(cn) * bfhi(kn));
                        ((unsigned*)(OC + (size_t)m * DM))[384 + ix] = pk2(oa, ob); }
                }
            }
        }
        grid.sync();
        { DEFWS(WSB()) pg8::Gemm g{CQ, WUQ + (size_t)l * 768 * 256, MROWS, 768, 256, 256}; pg8::StaticOrder S; S.init(MROWS, 768, G, bx);
          pg8::EpiUQ E{MQ, ROPEM, QSC96};
          pg8::gemm_phase<pg8::EpiUQ, pg8::StaticOrder, true, false>((LAS unsigned char*)lds, g, S, E, wave); }
        { DEFWS(WSB()) pg8::Gemm g{CKV, WUKV + (size_t)l * 768 * 128, MROWS, 768, 128, 128}; pg8::StaticOrder S; S.init(MROWS, 768, G, bx);
          pg8::EpiUKV E{MK, MV};
          pg8::gemm_phase<pg8::EpiUKV, pg8::StaticOrder, true, false>((LAS unsigned char*)lds, g, S, E, wave); }
        grid.sync();
        {
            DEFWS(WSB())
            const int nrounds = (l < DEPTH - 1) ? 7 : 6;
            for (int i_ = 0; i_ < nrounds * ATT_REPS; ++i_) { const int i = (ATT_REPS == 1) ? i_ : (i_ % nrounds);
                int type, b, h, qrow0, seq;
                if (i < 6) { const int u = vcu + 256 * i; type = u / 768; const int rem = u % 768; b = rem / 192; h = (rem >> 5) % 6; const int qb = rem & 31; qrow0 = b * LTOK + CTX + qb * 256; seq = LTOK; }
                else { if (vcu >= 48) continue; type = vcu / 24; b = (vcu % 24) / 6; h = vcu % 6; qrow0 = b * LTOK; seq = CTX; }
                const size_t kr = (size_t)b * LTOK;
                if (type == 0) att::attn_unit<96>(MQ + (size_t)qrow0 * 576 + h * 96, MK + kr * 384 + h * 64, KPE + kr * 32, MV + kr * 384 + h * 64, OC + (size_t)qrow0 * DM + h * 64, seq, (char*)lds, wave);
                else att::attn_unit<64>(GQ + (size_t)qrow0 * 384 + h * 64, GK + kr * 128 + (h / 3) * 64, nullptr, GV + kr * 128 + (h / 3) * 64, OC + (size_t)qrow0 * DM + 384 + h * 64, seq, (char*)lds, wave);
            }
        }
        grid.sync();
        { DEFWS(WSB()) pg8::Gemm g{OC, WO + (size_t)l * DM * DM, MROWS, DM, DM, DM}; pg8::RowOrder S; S.init(DM, G, bx, true);
          pg8::EpiStore<0> E{Y, DM};
          pg8::gemm_phase<pg8::EpiStore<0>, pg8::RowOrder, true, true>((LAS unsigned char*)lds, g, S, E, wave); }
        if (l < DEPTH - 1) { DEFWS(WSB()) pg8::Gemm g{OC, WO + (size_t)l * DM * DM, MROWS, DM, 256, DM}; pg8::CtxSplitOrder S; S.init(DM, 4, G, bx);
          pg8::EpiPart E{PART, DM, (size_t)1024 * DM};
          pg8::gemm_phase<pg8::EpiPart, pg8::CtxSplitOrder, true, true>((LAS unsigned char*)lds, g, S, E, wave); }
        grid.sync();
#pragma unroll 1
        for (int which = 0; which < 2; ++which) {
            {
                DEFWS(WSB())
                const int lane = pg8::lane_id_asm();
                const float* lg = KP()->in[which ? I_LN2G : I_LN1G] + l * DM; const float* lb = KP()->in[which ? I_LN2B : I_LN1B] + l * DM;
                const float* xin_ = KP()->in[I_X]; const float* cin_ = KP()->in[I_CTX]; float* out_ = KP()->out;
                const bool first = (l == 0 && which == 0); const bool wantu = !(which == 1 && l == DEPTH - 1);
                const int KS = which ? 8 : 4;
                for (int m = gw; m < MROWS; m += NGW) { const RowInfo ri = row_info(m);
                    if (ri.isctx && l == DEPTH - 1) continue;
                    const size_t zoff = ((size_t)ri.b * CTX + ri.i) * DM, xoff = ((size_t)ri.b * SEQ + ri.i - CTX) * DM;
                    const float* xo = ri.isctx ? (first ? cin_ + zoff : Z + zoff) : (first ? xin_ + xoff : out_ + xoff);
                    float* xn = ri.isctx ? Z + zoff : out_ + xoff;
                    const float* md = MOD + ((size_t)l * 5 + ri.v) * 6144; const float* gate = md + (which ? 5 : 2) * 1024;
                    const float* md2 = which ? MOD + ((size_t)(wantu ? l + 1 : l) * 5 + ri.v) * 6144 : md + 3 * 1024;
                    f32x4 t[4]; float s = 0.f;
#pragma unroll
                    for (int j = 0; j < 4; ++j) { const int col = 4 * lane + 256 * j; const f32x4 x = *(const f32x4*)(xo + col), gt = *(const f32x4*)(gate + col);
                        f32x4 y;
                        if (ri.isctx) { const float* pp = PART + ((size_t)ri.b * CTX + ri.i) * DM + col; f32x4 yy[8];
#pragma unroll
                            for (int k = 0; k < 4; ++k) yy[k] = *(const f32x4*)(pp + (size_t)k * 1024 * DM);
                            if (KS == 8) {
#pragma unroll
                                for (int k = 4; k < 8; ++k) yy[k] = *(const f32x4*)(pp + (size_t)k * 1024 * DM);
                                y = ((yy[0] + yy[1]) + (yy[2] + yy[3])) + ((yy[4] + yy[5]) + (yy[6] + yy[7])); }
                            else y = (yy[0] + yy[1]) + (yy[2] + yy[3]); }
                        else { const u32x2 yw = *(const u32x2*)(Y + (size_t)m * DM + col); y = (f32x4){bflo(yw.x), bfhi(yw.x), bflo(yw.y), bfhi(yw.y)}; }
                        t[j] = ALPHA * x + gt * y; s += (t[j][0] + t[j][1]) + (t[j][2] + t[j][3]); }
                    const float mean = wave_sum(s, lane) * (1.f / DM); float s2 = 0.f;
#pragma unroll
                    for (int j = 0; j < 4; ++j) { t[j] = t[j] - mean; s2 += (t[j][0] * t[j][0] + t[j][1] * t[j][1]) + (t[j][2] * t[j][2] + t[j][3] * t[j][3]); }
                    const float rstd = rsqrtf(wave_sum(s2, lane) * (1.f / DM) + LN_EPS);
#pragma unroll
                    for (int j = 0; j < 4; ++j) { const int col = 4 * lane + 256 * j; const f32x4 g4 = *(const f32x4*)(lg + col), b4 = *(const f32x4*)(lb + col);
                        const f32x4 xv = t[j] * rstd * g4 + b4; *(f32x4*)(xn + col) = xv;
                        if (wantu) { const f32x4 sh = *(const f32x4*)(md2 + col), sc = *(const f32x4*)(md2 + 1024 + col); const f32x4 u = xv * (1.f + sc) + sh;
                            u32x2 w; w.x = pk2(u[0], u[1]); w.y = pk2(u[2], u[3]); *(u32x2*)(U + (size_t)m * DM + col) = w; } }
                }
            }
            if (which == 1) { if (l < DEPTH - 1) grid.sync(); break; }
            grid.sync();
            { DEFWS(WSB()) pg8::Gemm g{U, W1 + (size_t)l * DFF * DM, MROWS, DFF, DM, DM}; pg8::RowOrder S; S.init(DFF, G, bx, l == DEPTH - 1);
              pg8::EpiStore<1> E{HM, DFF};
              pg8::gemm_phase<pg8::EpiStore<1>, pg8::RowOrder, true, true>((LAS unsigned char*)lds, g, S, E, wave); }
            grid.sync();
            { DEFWS(WSB()) pg8::Gemm g{HM, W2 + (size_t)l * DM * DFF, MROWS, DM, DFF, DFF}; pg8::RowOrder S; S.init(DM, G, bx, true);
              pg8::EpiStore<0> E{Y, DM};
              pg8::gemm_phase<pg8::EpiStore<0>, pg8::RowOrder, true, true>((LAS unsigned char*)lds, g, S, E, wave); }
            if (l < DEPTH - 1) { DEFWS(WSB()) pg8::Gemm g{HM, W2 + (size_t)l * DM * DFF, MROWS, DM, 512, DFF}; pg8::CtxSplitOrder S; S.init(DM, 8, G, bx);
              pg8::EpiPart E{PART, DM, (size_t)1024 * DM};
              pg8::gemm_phase<pg8::EpiPart, pg8::CtxSplitOrder, true, true>((LAS unsigned char*)lds, g, S, E, wave); }
            grid.sync();
        }
    }
}

extern "C" void kernel_launch(void* const* d_in, const int* in_sizes, int n_in, void* d_out, int out_size, void* d_ws, size_t ws_size, hipStream_t stream) {
    static int grid = 0;
    if (grid == 0) {
        if (n_in != 21 || in_sizes[0] != NBATCH * SEQ * DM || out_size != NBATCH * SEQ * DM || ws_size < WS_END) {
            fprintf(stderr, "kernel_launch: shape mismatch n_in %d in0 %d out %d ws %zu (need %zu)\n", n_in, n_in > 0 ? in_sizes[0] : -1, out_size, ws_size, (size_t)WS_END); grid = -1; return; }
        int dev = 0, cus = 0, per_cu = 0;
        hipGetDevice(&dev); hipDeviceGetAttribute(&cus, hipDeviceAttributeMultiprocessorCount, dev);
        if (hipFuncSetAttribute((const void*)fwd_megakernel, hipFuncAttributeMaxDynamicSharedMemorySize, LDS_BYTES) != hipSuccess) { fprintf(stderr, "kernel_launch: hipFuncSetAttribute failed\n"); grid = -1; return; }
        if (hipOccupancyMaxActiveBlocksPerMultiprocessor(&per_cu, (const void*)fwd_megakernel, 512, LDS_BYTES) != hipSuccess || per_cu < 1) { fprintf(stderr, "kernel_launch: occupancy query says %d\n", per_cu); per_cu = 1; }
        (void)hipGetLastError();
        grid = cus;
        fprintf(stderr, "kernel_launch: grid %d (per_cu %d)\n", grid, per_cu);
    }
    if (grid < 0) return;
    Params p{};
    for (int i = 0; i < 21; ++i) p.in[i] = (const float*)d_in[i];
    p.out = (float*)d_out; p.ws = (unsigned char*)d_ws;
    void* args[] = {&p};
    hipError_t e = hipLaunchCooperativeKernel((const void*)fwd_megakernel, dim3(grid), dim3(512), args, LDS_BYTES, stream);
    if (e != hipSuccess) fprintf(stderr, "kernel_launch: cooperative launch failed: %s (grid %d)\n", hipGetErrorString(e), grid);
}
```

```cpp
#include <hip/hip_runtime.h>
#include <hip/hip_cooperative_groups.h>
#include <hip/hip_bf16.h>
#include <cstdio>
#include <cstdint>
namespace cg = cooperative_groups;

constexpr int DM = 1024, NBATCH = 4, SEQ = 8192, DEPTH = 4, CTX = 256, DFF = 4096;
constexpr int LTOK = CTX + SEQ;
constexpr int MROWS = NBATCH * LTOK;
constexpr int IN_COLS = 1824, HP = 2048, HPI = 1856;
constexpr float LN_EPS = 1e-6f;
constexpr float ALPHA = 1.6817928305074290f;
namespace pg8 {
#define PG8_LAS __attribute__((address_space(3)))
typedef unsigned short bf16_t;
typedef short bf16x8 __attribute__((ext_vector_type(8)));
typedef float f32x4 __attribute__((ext_vector_type(4)));
typedef unsigned u32x4 __attribute__((ext_vector_type(4)));
constexpr int BM = 256, BK = 64, HALF = 128, HTB = HALF * BK * 2  , STAGE_BYTES = 8 * HTB, NXCD = 8, WGM = 8;

__host__ __device__ __forceinline__ int lds_byte(int r, int c) { const int st = (r >> 4) * 2 + (c >> 5), rr = r & 15, cc = c & 31, ob = rr * 64 + cc * 2; return st * 1024 + (ob ^ (((ob >> 9) & 1) << 5)); }
__host__ __device__ __forceinline__ void stage_rc(int b, int& R, int& C) { const int st = b / 1024, sb = b % 1024, swz = sb ^ (((sb >> 9) & 1) << 5); R = (st >> 1) * 16 + swz / 64; C = (st & 1) * 32 + (swz % 64) / 2; }
__host__ __device__ __forceinline__ int perm32(int rho) { const int n = rho >> 4, i = rho & 15; return 8 * (i >> 2) + 4 * n + (i & 3); }

struct Unit { int pm, pn, pk; };
struct Gemm { const bf16_t* A; const bf16_t* Bt; int M, N, K, ld; };

struct StaticOrder {
    int nM, nN, nwg, G, c;
    __host__ __device__ void init(int M, int N, int G_, int c_) { nM = M / BM; nN = N / BM; nwg = nM * nN; G = G_; c = c_; }
    __host__ __device__ bool next(int i, Unit& u) const {
        const long L = (long)i * G + c; if (L >= nwg) return false;
        int wgid = (int)L; { const int q = nwg / NXCD, r = nwg % NXCD, xcd = wgid % NXCD, off = wgid / NXCD; wgid = (xcd < r ? xcd * (q + 1) : r * (q + 1) + (xcd - r) * q) + off; }
        const int nig = WGM * nN, gid = wgid / nig, fm = gid * WGM, gsz = (nM - fm) < WGM ? (nM - fm) : WGM;
        u.pm = fm + ((wgid % nig) % gsz); u.pn = (wgid % nig) / gsz; u.pk = 0; return true;
    }
    __device__ __forceinline__ void a_ready(const Unit&) const {}
    __device__ __forceinline__ void done(const Unit&) const {}
};

__device__ __forceinline__ unsigned cvt_pk_bf16(float lo, float hi) { unsigned r; asm volatile("v_cvt_pk_bf16_f32 %0, %1, %2" : "=v"(r) : "v"(lo), "v"(hi)); return r; }
__device__ __forceinline__ int lane_id_asm() { int l; asm volatile("v_mbcnt_lo_u32_b32 %0, -1, 0\n\tv_mbcnt_hi_u32_b32 %0, -1, %0" : "=v"(l)); return l; }
typedef float f32x2 __attribute__((ext_vector_type(2)));
template <int ACT  > struct EpiStore {
    static constexpr bool PERM = true, AFTER_DRAIN = false;
    bf16_t* O; int ldc; int ncol;
    __device__ __forceinline__ void operator()(const f32x4 (&acc)[2][2][4][2], const Unit& u, int wr, int wc, int fr, int fq) const {
        const int row0 = u.pm * BM + wr * 64 + fr; const int col0 = u.pn * BM + wc * 32 + 8 * fq;
#pragma unroll
        for (int ai = 0; ai < 2; ++ai)
#pragma unroll
            for (int m = 0; m < 4; ++m) { bf16_t* rowp = O + (unsigned)((row0 + ai * HALF + m * 16) * ldc + col0);
#pragma unroll
                for (int bj = 0; bj < 2; ++bj) { f32x4 v0 = acc[ai][bj][m][0], v1 = acc[ai][bj][m][1];
                    if (ACT == 1) {
#pragma unroll
                        for (int e = 0; e < 4; ++e) { float a = fmaxf(v0[e], 0.f), b = fmaxf(v1[e], 0.f); v0[e] = a * a; v1[e] = b * b; } }
                    u32x4 w; w.x = cvt_pk_bf16(v0[0], v0[1]); w.y = cvt_pk_bf16(v0[2], v0[3]); w.z = cvt_pk_bf16(v1[0], v1[1]); w.w = cvt_pk_bf16(v1[2], v1[3]);
                    if (col0 + bj * HALF < ncol) *(u32x4*)(rowp + bj * HALF) = w; } }
    }
};
struct EpiUQ {
    static constexpr bool PERM = true, AFTER_DRAIN = false;
    bf16_t* MQ; const float* ropeM; float qscale;
    __device__ __forceinline__ void operator()(const f32x4 (&acc)[2][2][4][2], const Unit& u, int wr, int wc, int fr, int fq) const {
        const int row0 = u.pm * BM + wr * 64 + fr;
        const int pt = u.pm % 33; const bool lat = pt != 0; const int pos0 = (pt - 1) * 256 + wr * 64 + fr;
#pragma unroll
        for (int bj = 0; bj < 2; ++bj) {
            const int c = u.pn * BM + bj * HALF + wc * 32 + 8 * fq;
            if (c >= 576) continue;
            const int d = c % 96; const bool isrope = (d >= 64) && lat; const int i0 = (d - 64) >> 1;
#pragma unroll
            for (int ai = 0; ai < 2; ++ai)
#pragma unroll
                for (int m = 0; m < 4; ++m) { const int row = row0 + ai * HALF + m * 16;
                    f32x4 v0 = acc[ai][bj][m][0], v1 = acc[ai][bj][m][1];
                    if (isrope) { const f32x4* rp = (const f32x4*)(ropeM + (unsigned)(((pos0 + ai * HALF + m * 16) * 16 + i0) * 2));
                        const f32x4 r0 = rp[0], r1 = rp[1];
                        f32x4 a, b;
                        a[0] = v0[0] * r0[0] - v0[1] * r0[1]; a[1] = v0[0] * r0[1] + v0[1] * r0[0];
                        a[2] = v0[2] * r0[2] - v0[3] * r0[3]; a[3] = v0[2] * r0[3] + v0[3] * r0[2];
                        b[0] = v1[0] * r1[0] - v1[1] * r1[1]; b[1] = v1[0] * r1[1] + v1[1] * r1[0];
                        b[2] = v1[2] * r1[2] - v1[3] * r1[3]; b[3] = v1[2] * r1[3] + v1[3] * r1[2];
                        v0 = a; v1 = b; }
                    v0 = v0 * qscale; v1 = v1 * qscale;
                    u32x4 w; w.x = cvt_pk_bf16(v0[0], v0[1]); w.y = cvt_pk_bf16(v0[2], v0[3]); w.z = cvt_pk_bf16(v1[0], v1[1]); w.w = cvt_pk_bf16(v1[2], v1[3]);
                    *(u32x4*)(MQ + (unsigned)(row * 576 + c)) = w; }
        }
    }
};
struct EpiUKV {
    static constexpr bool PERM = true, AFTER_DRAIN = false;
    bf16_t* MK; bf16_t* MV;
    __device__ __forceinline__ void operator()(const f32x4 (&acc)[2][2][4][2], const Unit& u, int wr, int wc, int fr, int fq) const {
        const int row0 = u.pm * BM + wr * 64 + fr;
#pragma unroll
        for (int bj = 0; bj < 2; ++bj) {
            const int head = u.pn * 2 + bj; const int d = wc * 32 + 8 * fq;
            bf16_t* base = (d < 64) ? MK : MV; const unsigned boff = (unsigned)(head * 64 + (d & 63));
#pragma unroll
            for (int ai = 0; ai < 2; ++ai)
#pragma unroll
                for (int m = 0; m < 4; ++m) { const int row = row0 + ai * HALF + m * 16;
                    const f32x4 v0 = acc[ai][bj][m][0], v1 = acc[ai][bj][m][1];
                    u32x4 w; w.x = cvt_pk_bf16(v0[0], v0[1]); w.y = cvt_pk_bf16(v0[2], v0[3]); w.z = cvt_pk_bf16(v1[0], v1[1]); w.w = cvt_pk_bf16(v1[2], v1[3]);
                    *(u32x4*)(base + (boff + (unsigned)(row * 384))) = w; }
        }
    }
};
struct RowOrder {
    StaticOrder S0; bool latonly;
    __host__ __device__ void init(int N, int G_, int c_, bool latonly_) { latonly = latonly_; S0.init(latonly_ ? 128 * BM : 132 * BM, N, G_, c_); }
    __host__ __device__ bool next(int i, Unit& u) const { if (!S0.next(i, u)) return false; if (latonly) u.pm = u.pm + u.pm / 32 + 1; return true; }
    __device__ __forceinline__ void a_ready(const Unit&) const {}
    __device__ __forceinline__ void done(const Unit&) const {}
};
struct CtxSplitOrder {
    int nN, KS, total, G, c;
    __host__ __device__ void init(int N, int KS_, int G_, int c_) { nN = N / BM; KS = KS_; total = 4 * nN * KS_; G = G_; c = c_; }
    __host__ __device__ bool next(int i, Unit& u) const { const int L = i * G + c; if (L >= total) return false; u.pk = L % KS; const int t = L / KS; u.pn = t % nN; u.pm = 33 * (t / nN); return true; }
    __device__ __forceinline__ void a_ready(const Unit&) const {}
    __device__ __forceinline__ void done(const Unit&) const {}
};
struct LightOrder {
    int c;
    __host__ __device__ void init(int c_) { c = c_; }
    __host__ __device__ bool next(int i, Unit& u) const { const int k = c - 156; if (k < 0) return false; int j; if (i == 0) j = k; else if (i == 1 && k < 32) j = 100 + k; else return false; u.pm = j; u.pn = 7; u.pk = 0; return true; }
    __device__ __forceinline__ void a_ready(const Unit&) const {}
    __device__ __forceinline__ void done(const Unit&) const {}
};
struct EpiPart {
    static constexpr bool PERM = false, AFTER_DRAIN = false;
    float* P; int ldc; size_t kstride;
    __device__ __forceinline__ void operator()(const f32x4 (&acc)[2][2][4][2], const Unit& u, int wr, int wc, int fr, int fq) const {
        float* base = P + (size_t)u.pk * kstride + (size_t)((u.pm / 33) * BM + wr * 64 + fr) * ldc + u.pn * BM + wc * 32 + 4 * fq;
#pragma unroll
        for (int ai = 0; ai < 2; ++ai)
#pragma unroll
            for (int m = 0; m < 4; ++m)
#pragma unroll
                for (int bj = 0; bj < 2; ++bj)
#pragma unroll
                    for (int n = 0; n < 2; ++n) *(f32x4*)(base + (size_t)(ai * HALF + m * 16) * ldc + bj * HALF + n * 16) = acc[ai][bj][m][n];
    }
};
template <class Epi, class Sched, bool ALIGN_EPI = false, bool SP2 = false, bool LIGHT = false>
__device__ __forceinline__ void gemm_phase(PG8_LAS unsigned char* lds, const Gemm g, const Sched& S, const Epi& E, const int wave_in) {
    const int tid_l_ = wave_in * 64 + lane_id_asm();
    const int tid = tid_l_, wid = __builtin_amdgcn_readfirstlane(tid >> 6), lane = tid & 63, wr = wid >> 2, wc = wid & 3, fr = lane & 15, fq = lane >> 4;
    const int K = g.K, nt = K / BK;
    unsigned voffA[2], voffB[2];
#pragma unroll
    for (int i = 0; i < 2; ++i) { int R, C; stage_rc(tid * 16 + i * 8192, R, C); const int Rb = Epi::PERM ? ((R & ~31) + perm32(R & 31)) : R;
        voffA[i] = (unsigned)(R * g.ld + C) * 2u; voffB[i] = (unsigned)(Rb * g.ld + C) * 2u; }
    const size_t kstep = (size_t)(BK * 2);
    const size_t hstep = (size_t)HALF * g.ld * 2;
    const size_t tstep = 2 * hstep;
    const unsigned ldsw = (unsigned)wid * 1024u;
    const int aoff = lds_byte(wr * 64 + fr, fq * 8), boff = lds_byte(wc * 32 + fr, fq * 8);
#define PG8_SA(b, h) (((b) * 2 + (h)) * HTB)
#define PG8_SB(b, h) ((4 + (b) * 2 + (h)) * HTB)
#define PG8_STAGE(bufoff, gbase, voff) do { _Pragma("unroll") for (int _i = 0; _i < 2; ++_i) \
        __builtin_amdgcn_global_load_lds((const unsigned*)((const char*)(gbase) + (voff)[_i]), (PG8_LAS unsigned*)(lds + (bufoff) + ldsw + _i * 8192), 16, 0, 0); } while (0)
#define PG8_LDA(dst, b, h) do { _Pragma("unroll") for (int m = 0; m < 4; ++m) _Pragma("unroll") for (int k = 0; k < 2; ++k) dst[m][k] = *(const PG8_LAS bf16x8*)(lds + PG8_SA(b, h) + aoff + m * 2048 + k * 1024); } while (0)
#define PG8_LDB(dst, b, h) do { _Pragma("unroll") for (int n = 0; n < 2; ++n) _Pragma("unroll") for (int k = 0; k < 2; ++k) dst[n][k] = *(const PG8_LAS bf16x8*)(lds + PG8_SB(b, h) + boff + n * 2048 + k * 1024); } while (0)
#define PG8_MMA(ai, bj, At, Bt) do { if (!LIGHT || ((bj) == 0 && wc == 0)) { __builtin_amdgcn_s_setprio(1); _Pragma("unroll") for (int m = 0; m < 4; ++m) _Pragma("unroll") for (int n = 0; n < 2; ++n) _Pragma("unroll") for (int k = 0; k < 2; ++k) \
        acc[ai][bj][m][n] = __builtin_amdgcn_mfma_f32_16x16x32_bf16(Bt[n][k], At[m][k], acc[ai][bj][m][n], 0, 0, 0); __builtin_amdgcn_s_setprio(0); } } while (0)
#define PG8_WAIT_V(n) asm volatile("s_waitcnt vmcnt(" #n ")" ::: "memory")
#define PG8_WAIT_L(n) asm volatile("s_waitcnt lgkmcnt(" #n ")" ::: "memory")
#define PG8_BAR __builtin_amdgcn_s_barrier()
#define PG8_SCHED __builtin_amdgcn_sched_barrier(0)
    Unit cur, nxt; int ui = 0;
    if (!S.next(0, cur)) return;
    f32x4 acc[2][2][4][2];
#pragma unroll
    for (int a = 0; a < 2; ++a)
#pragma unroll
        for (int b = 0; b < 2; ++b)
#pragma unroll
            for (int m = 0; m < 4; ++m)
#pragma unroll
                for (int n = 0; n < 2; ++n) acc[a][b][m][n] = (f32x4){0.f, 0.f, 0.f, 0.f};
    bf16x8 At[4][2], B0[2][2], B1[2][2];
    const char* cA = (const char*)g.A + (size_t)cur.pm * tstep + (size_t)cur.pk * K * 2; const char* cB = (const char*)g.Bt + (size_t)cur.pn * tstep + (size_t)cur.pk * K * 2;
    S.a_ready(cur);
    if constexpr (SP2) {
        PG8_STAGE(PG8_SB(0, 0), cB, voffB); PG8_STAGE(PG8_SB(0, 1), cB + hstep, voffB); PG8_STAGE(PG8_SA(0, 0), cA, voffA); PG8_STAGE(PG8_SA(0, 1), cA + hstep, voffA);
        if (wr == 1) PG8_BAR;
        PG8_WAIT_V(2); PG8_BAR;
        PG8_STAGE(PG8_SB(1, 0), cB + kstep, voffB); PG8_STAGE(PG8_SA(1, 0), cA + kstep, voffA); PG8_STAGE(PG8_SB(1, 1), cB + hstep + kstep, voffB);
        PG8_WAIT_V(6); PG8_BAR;
    } else {
        PG8_STAGE(PG8_SB(0, 0), cB, voffB); PG8_STAGE(PG8_SA(0, 0), cA, voffA); PG8_STAGE(PG8_SB(0, 1), cB + hstep, voffB); PG8_STAGE(PG8_SA(0, 1), cA + hstep, voffA);
        if (wr == 1) PG8_BAR;
        PG8_WAIT_V(4); PG8_BAR;
        PG8_STAGE(PG8_SB(1, 0), cB + kstep, voffB); PG8_STAGE(PG8_SA(1, 0), cA + kstep, voffA); PG8_STAGE(PG8_SB(1, 1), cB + hstep + kstep, voffB);
        PG8_WAIT_V(6); PG8_BAR;
    }
    for (;;) {
        const bool has_next = S.next(ui + 1, nxt);
        const char* nA = has_next ? (const char*)g.A + (size_t)nxt.pm * tstep + (size_t)nxt.pk * K * 2 : cA; const char* nB = has_next ? (const char*)g.Bt + (size_t)nxt.pn * tstep + (size_t)nxt.pk * K * 2 : cB;
        for (int t = 0; t < nt; t += 2) {
            const bool last = (t == nt - 2);
            const char* a1 = cA + (size_t)(t + 1) * kstep;
            const char* a2 = last ? nA : cA + (size_t)(t + 2) * kstep; const char* b2 = last ? nB : cB + (size_t)(t + 2) * kstep;
            const char* a3 = a2 + kstep; const char* b3 = b2 + kstep;
            if (last && has_next) S.a_ready(nxt);
            if constexpr (SP2) {
            PG8_LDB(B0, 0, 0); PG8_LDB(B1, 0, 1); PG8_SCHED; PG8_LDA(At, 0, 0); PG8_STAGE(PG8_SA(1, 1), a1 + hstep, voffA);
            PG8_WAIT_V(8); PG8_WAIT_L(0); PG8_BAR; PG8_MMA(0, 0, At, B0); PG8_MMA(0, 1, At, B1); PG8_BAR; PG8_SCHED;
            PG8_LDA(At, 0, 1); PG8_STAGE(PG8_SB(0, 0), b2, voffB); PG8_STAGE(PG8_SB(0, 1), b2 + hstep, voffB); PG8_STAGE(PG8_SA(0, 0), a2, voffA);
            PG8_WAIT_V(8); PG8_WAIT_L(0); PG8_BAR; PG8_MMA(1, 0, At, B0); PG8_MMA(1, 1, At, B1); PG8_BAR; PG8_SCHED;
            PG8_LDB(B0, 1, 0); PG8_LDB(B1, 1, 1); PG8_SCHED; PG8_LDA(At, 1, 0); PG8_STAGE(PG8_SA(0, 1), a2 + hstep, voffA);
            PG8_WAIT_V(8); PG8_WAIT_L(0); PG8_BAR; PG8_MMA(0, 0, At, B0); PG8_MMA(0, 1, At, B1); PG8_BAR; PG8_SCHED;
            PG8_LDA(At, 1, 1); PG8_STAGE(PG8_SB(1, 0), b3, voffB); PG8_STAGE(PG8_SB(1, 1), b3 + hstep, voffB); PG8_STAGE(PG8_SA(1, 0), a3, voffA);
            PG8_WAIT_V(8); PG8_WAIT_L(0); PG8_BAR; PG8_MMA(1, 0, At, B0); PG8_MMA(1, 1, At, B1); PG8_BAR; PG8_SCHED;
            } else {
            PG8_LDB(B0, 0, 0); PG8_SCHED; PG8_LDA(At, 0, 0); PG8_STAGE(PG8_SA(1, 1), a1 + hstep, voffA);
            PG8_WAIT_L(8); PG8_BAR; PG8_WAIT_L(0); PG8_MMA(0, 0, At, B0); PG8_BAR; PG8_SCHED;
            PG8_LDB(B1, 0, 1); PG8_STAGE(PG8_SB(0, 0), b2, voffB);
            PG8_BAR; PG8_WAIT_L(0); PG8_MMA(0, 1, At, B1); PG8_BAR;
            PG8_LDA(At, 0, 1); PG8_STAGE(PG8_SA(0, 0), a2, voffA);
            PG8_BAR; PG8_WAIT_L(0); PG8_MMA(1, 0, At, B0); PG8_BAR; PG8_SCHED;
            PG8_STAGE(PG8_SB(0, 1), b2 + hstep, voffB);
            PG8_WAIT_V(6); PG8_BAR; PG8_MMA(1, 1, At, B1); PG8_BAR;
            PG8_LDB(B0, 1, 0); PG8_SCHED; PG8_LDA(At, 1, 0); PG8_STAGE(PG8_SA(0, 1), a2 + hstep, voffA);
            PG8_WAIT_L(8); PG8_BAR; PG8_WAIT_L(0); PG8_MMA(0, 0, At, B0); PG8_BAR; PG8_SCHED;
            PG8_LDB(B1, 1, 1); PG8_STAGE(PG8_SB(1, 0), b3, voffB);
            PG8_BAR; PG8_WAIT_L(0); PG8_MMA(0, 1, At, B1); PG8_BAR;
            PG8_LDA(At, 1, 1); PG8_STAGE(PG8_SA(1, 0), a3, voffA);
            PG8_BAR; PG8_WAIT_L(0); PG8_MMA(1, 0, At, B0); PG8_BAR; PG8_SCHED;
            PG8_STAGE(PG8_SB(1, 1), b3 + hstep, voffB);
            PG8_WAIT_V(6); PG8_BAR; PG8_MMA(1, 1, At, B1); PG8_BAR;
            }
        }
        if constexpr (ALIGN_EPI) { if (wr == 0) PG8_BAR; }
        if constexpr (!Epi::AFTER_DRAIN) { const int le_ = lane_id_asm(); E(acc, cur, wr, wc, le_ & 15, le_ >> 4); S.done(cur); }
        if (!has_next) break;
#pragma unroll
        for (int a = 0; a < 2; ++a)
#pragma unroll
            for (int b = 0; b < 2; ++b)
#pragma unroll
                for (int m = 0; m < 4; ++m)
#pragma unroll
                    for (int n = 0; n < 2; ++n) acc[a][b][m][n] = (f32x4){0.f, 0.f, 0.f, 0.f};
        cur = nxt; cA = nA; cB = nB; ++ui;
        if constexpr (ALIGN_EPI) { if (wr == 1) PG8_BAR; }
    }
    PG8_WAIT_V(0);
    if constexpr (!ALIGN_EPI) { if (wr == 0) PG8_BAR; }
    PG8_BAR;
    if constexpr (Epi::AFTER_DRAIN) { E.fused(acc, cur, wr, wc, fr, fq, lds, wid, lane); S.done(cur); }
#undef PG8_SA
#undef PG8_SB
#undef PG8_STAGE
#undef PG8_LDA
#undef PG8_LDB
#undef PG8_MMA
#undef PG8_WAIT_V
#undef PG8_WAIT_L
#undef PG8_BAR
#undef PG8_SCHED
}
}

namespace att {
typedef unsigned short bf16_t;
using bf16x8 = __attribute__((ext_vector_type(8))) short;
using s16x4  = __attribute__((ext_vector_type(4))) short;
using f32x16 = __attribute__((ext_vector_type(16))) float;
using u32x4  = __attribute__((ext_vector_type(4))) unsigned;
constexpr int NW = 8, QBLK = 32, KVBLK = 64;
constexpr float THR = 8.f;
constexpr int SHM_V = 16384, SHM_K = 16384;
#define KSWZ(row, colB) ((row) * 256 + ((colB) ^ (((row) & 15) << 4)))
#define SBAR() __builtin_amdgcn_sched_barrier(0)
__device__ __forceinline__ int crow(int r, int hi) { return (r & 3) + 8 * (r >> 2) + 4 * hi; }
__device__ __forceinline__ unsigned cvtpk(float lo, float hi) { unsigned r; asm volatile("v_cvt_pk_bf16_f32 %0, %1, %2" : "=v"(r) : "v"(lo), "v"(hi)); return r; }

constexpr float THRL = 11.0f;
template <bool FIRST> __device__ __forceinline__ void partialSM(f32x16& p0, f32x16& p1, float& m_reg, f32x16& negm, float& alpha) {
  float pmax = fmaxf(fmaxf(p0[0], p0[1]), p1[0]);
#pragma unroll
  for (int r = 2; r < 16; r += 2) pmax = fmaxf(fmaxf(pmax, p0[r]), p0[r + 1]);
#pragma unroll
  for (int r = 1; r < 15; r += 2) pmax = fmaxf(fmaxf(pmax, p1[r]), p1[r + 1]);
  pmax = fmaxf(pmax, p1[15]);
  { auto rr = __builtin_amdgcn_permlane32_swap(__float_as_uint(pmax), __float_as_uint(pmax), false, false);
    pmax = fmaxf(__uint_as_float(rr[0]), __uint_as_float(rr[1])); }
  alpha = 1.f;
  if (FIRST || !__builtin_expect(__all(pmax <= THRL), 1)) {
    const float dl = FIRST ? pmax : fmaxf(pmax, 0.f);
    m_reg += dl;
#pragma unroll
    for (int r = 0; r < 16; ++r) { p0[r] -= dl; p1[r] -= dl; }
#pragma unroll
    for (int r = 0; r < 16; ++r) negm[r] = -m_reg;
    if (!FIRST) alpha = __builtin_amdgcn_exp2f(-dl);
  }
#pragma unroll
  for (int r = 0; r < 16; ++r) p0[r] = __builtin_amdgcn_exp2f(p0[r]);
}
__device__ __forceinline__ void finishSM(f32x16& p0, f32x16& p1, float alpha, float& l_reg, bf16x8& pa0, bf16x8& pa1, bf16x8& pa2, bf16x8& pa3) {
#pragma unroll
  for (int r = 0; r < 16; ++r) p1[r] = __builtin_amdgcn_exp2f(p1[r]);
  float ps = 0;
#pragma unroll
  for (int r = 0; r < 16; ++r) ps += p0[r];
#pragma unroll
  for (int r = 0; r < 16; ++r) ps += p1[r];
  { auto rr = __builtin_amdgcn_permlane32_swap(__float_as_uint(ps), __float_as_uint(ps), false, false);
    ps = __uint_as_float(rr[0]) + __uint_as_float(rr[1]); }
  l_reg = l_reg * alpha + ps;
#define PK4(P, BASE, OUT) do { unsigned a0 = cvtpk(P[BASE + 0], P[BASE + 1]), a1 = cvtpk(P[BASE + 2], P[BASE + 3]);   \
    unsigned b0 = cvtpk(P[BASE + 4], P[BASE + 5]), b1 = cvtpk(P[BASE + 6], P[BASE + 7]);                              \
    auto r0 = __builtin_amdgcn_permlane32_swap(a0, b0, false, false); auto r1 = __builtin_amdgcn_permlane32_swap(a1, b1, false, false); \
    u32x4 w = {r0[0], r1[0], r0[1], r1[1]}; OUT = *reinterpret_cast<bf16x8*>(&w); } while (0)
  PK4(p0, 0, pa0); PK4(p0, 8, pa1); PK4(p1, 0, pa2); PK4(p1, 8, pa3);
#undef PK4
}
#define SBVS() __builtin_amdgcn_sched_barrier(0x6)
template <int DQ> __device__ __forceinline__ void qkt(f32x16& p0, f32x16& p1, const char* Ks, const bf16x8* qr, const f32x16& negm, int r32, int hi) {
  constexpr int ND = DQ / 16;
  const char* k0p = Ks + r32 * 256; const char* k1p = Ks + (32 + r32) * 256; const int sw = (r32 & 15) << 4;
  bf16x8 a0, a1, b0, b1;
#define KLD(x0, x1, d0) do { const int cb_ = (((d0) * 16 + hi * 8) * 2) ^ sw; x0 = *reinterpret_cast<const bf16x8*>(k0p + cb_); x1 = *reinterpret_cast<const bf16x8*>(k1p + cb_); } while (0)
  KLD(a0, a1, 0); KLD(b0, b1, 1); SBVS();
  p0 = __builtin_amdgcn_mfma_f32_32x32x16_bf16(a0, qr[0], negm, 0, 0, 0); p1 = __builtin_amdgcn_mfma_f32_32x32x16_bf16(a1, qr[0], negm, 0, 0, 0); SBVS();
#pragma unroll
  for (int d0 = 1; d0 < ND; ++d0) {
    if (d0 & 1) { if (d0 + 1 < ND) { KLD(a0, a1, d0 + 1); SBVS(); }
      p0 = __builtin_amdgcn_mfma_f32_32x32x16_bf16(b0, qr[d0], p0, 0, 0, 0); p1 = __builtin_amdgcn_mfma_f32_32x32x16_bf16(b1, qr[d0], p1, 0, 0, 0); SBVS(); }
    else { if (d0 + 1 < ND) { KLD(b0, b1, d0 + 1); SBVS(); }
      p0 = __builtin_amdgcn_mfma_f32_32x32x16_bf16(a0, qr[d0], p0, 0, 0, 0); p1 = __builtin_amdgcn_mfma_f32_32x32x16_bf16(a1, qr[d0], p1, 0, 0, 0); SBVS(); }
  }
#undef KLD
}
__device__ __forceinline__ int v_st(int k, int c) { const int kk = (k & ~0xC) | ((k & 4) << 1) | ((k & 8) >> 1); return ((kk >> 3) * 4 + (c >> 5)) * 512 + ((kk & 7) * 32 + (c & 31)) * 2; }
__device__ __forceinline__ int v_rd_base(int lane) { return ((lane & 3) << 3) | (((lane >> 2) & 3) << 6) | (((lane >> 4) & 1) << 5) | (((lane >> 5) & 1) << 8); }
constexpr int v_rd_off(int d0, int ks, int half) { return d0 * 512 + ks * 4096 + half * 2048; }
template <int OFF> __device__ __forceinline__ s16x4 tr_read(int vb) {
  s16x4 r; asm volatile("ds_read_b64_tr_b16 %0, %1 offset:%2" : "=&v"(r) : "v"(vb), "i"(OFF) : "memory"); return r;
}
template <int D0> __device__ __forceinline__ void pv_one(f32x16& od, int vb, bf16x8 pa0, bf16x8 pa1, bf16x8 pa2, bf16x8 pa3) {
  const s16x4 l0 = tr_read<v_rd_off(D0, 0, 0)>(vb), h0 = tr_read<v_rd_off(D0, 0, 1)>(vb), l1 = tr_read<v_rd_off(D0, 1, 0)>(vb), h1 = tr_read<v_rd_off(D0, 1, 1)>(vb);
  const s16x4 l2 = tr_read<v_rd_off(D0, 2, 0)>(vb), h2 = tr_read<v_rd_off(D0, 2, 1)>(vb), l3 = tr_read<v_rd_off(D0, 3, 0)>(vb), h3 = tr_read<v_rd_off(D0, 3, 1)>(vb);
  asm volatile("s_waitcnt lgkmcnt(0)" ::: "memory"); SBAR();
#define PK(L, H) (bf16x8){L[0], L[1], L[2], L[3], H[0], H[1], H[2], H[3]}
  od = __builtin_amdgcn_mfma_f32_32x32x16_bf16(pa0, PK(l0, h0), od, 0, 0, 0);
  od = __builtin_amdgcn_mfma_f32_32x32x16_bf16(pa1, PK(l1, h1), od, 0, 0, 0);
  od = __builtin_amdgcn_mfma_f32_32x32x16_bf16(pa2, PK(l2, h2), od, 0, 0, 0);
  od = __builtin_amdgcn_mfma_f32_32x32x16_bf16(pa3, PK(l3, h3), od, 0, 0, 0);
#undef PK
}
__device__ __forceinline__ void pv_d0(f32x16* o, int vb, bf16x8 pa0, bf16x8 pa1, bf16x8 pa2, bf16x8 pa3) {
  pv_one<0>(o[0], vb, pa0, pa1, pa2, pa3); pv_one<1>(o[1], vb, pa0, pa1, pa2, pa3);
}
struct VFrag { s16x4 l[2][4], h[2][4]; };
__device__ __forceinline__ void v_load(VFrag& f, int vb) {
  f.l[0][0] = tr_read<v_rd_off(0, 0, 0)>(vb); f.h[0][0] = tr_read<v_rd_off(0, 0, 1)>(vb); f.l[0][1] = tr_read<v_rd_off(0, 1, 0)>(vb); f.h[0][1] = tr_read<v_rd_off(0, 1, 1)>(vb);
  f.l[0][2] = tr_read<v_rd_off(0, 2, 0)>(vb); f.h[0][2] = tr_read<v_rd_off(0, 2, 1)>(vb); f.l[0][3] = tr_read<v_rd_off(0, 3, 0)>(vb); f.h[0][3] = tr_read<v_rd_off(0, 3, 1)>(vb);
  f.l[1][0] = tr_read<v_rd_off(1, 0, 0)>(vb); f.h[1][0] = tr_read<v_rd_off(1, 0, 1)>(vb); f.l[1][1] = tr_read<v_rd_off(1, 1, 0)>(vb); f.h[1][1] = tr_read<v_rd_off(1, 1, 1)>(vb);
  f.l[1][2] = tr_read<v_rd_off(1, 2, 0)>(vb); f.h[1][2] = tr_read<v_rd_off(1, 2, 1)>(vb); f.l[1][3] = tr_read<v_rd_off(1, 3, 0)>(vb); f.h[1][3] = tr_read<v_rd_off(1, 3, 1)>(vb);
}
__device__ __forceinline__ void pv_mma(f32x16* o, const VFrag& f, bf16x8 pa0, bf16x8 pa1, bf16x8 pa2, bf16x8 pa3) {
#define PK(L, H) (bf16x8){L[0], L[1], L[2], L[3], H[0], H[1], H[2], H[3]}
  asm volatile("s_waitcnt lgkmcnt(0)" ::: "memory"); SBAR();
  o[0] = __builtin_amdgcn_mfma_f32_32x32x16_bf16(pa0, PK(f.l[0][0], f.h[0][0]), o[0], 0, 0, 0);
  o[0] = __builtin_amdgcn_mfma_f32_32x32x16_bf16(pa1, PK(f.l[0][1], f.h[0][1]), o[0], 0, 0, 0);
  o[0] = __builtin_amdgcn_mfma_f32_32x32x16_bf16(pa2, PK(f.l[0][2], f.h[0][2]), o[0], 0, 0, 0);
  o[0] = __builtin_amdgcn_mfma_f32_32x32x16_bf16(pa3, PK(f.l[0][3], f.h[0][3]), o[0], 0, 0, 0);
  o[1] = __builtin_amdgcn_mfma_f32_32x32x16_bf16(pa0, PK(f.l[1][0], f.h[1][0]), o[1], 0, 0, 0);
  o[1] = __builtin_amdgcn_mfma_f32_32x32x16_bf16(pa1, PK(f.l[1][1], f.h[1][1]), o[1], 0, 0, 0);
  o[1] = __builtin_amdgcn_mfma_f32_32x32x16_bf16(pa2, PK(f.l[1][2], f.h[1][2]), o[1], 0, 0, 0);
  o[1] = __builtin_amdgcn_mfma_f32_32x32x16_bf16(pa3, PK(f.l[1][3], f.h[1][3]), o[1], 0, 0, 0);
#undef PK
}

template <int DQ>
__device__ __forceinline__ void attn_unit(const bf16_t* __restrict__ Qb, const bf16_t* __restrict__ Kh, const bf16_t* __restrict__ Kpe, const bf16_t* __restrict__ Vh,
                                          bf16_t* __restrict__ Ob, int seq, char* lds, const int wave_in) {
  constexpr int LDQ = (DQ == 96) ? 576 : 384, LDK = (DQ == 96) ? 384 : 128, LDO = 1024, ND = DQ / 16;
  const int tid = wave_in * 64 + pg8::lane_id_asm(), wid = wave_in, lane = tid & 63, r32 = lane & 31, hi = lane >> 5;
  char* V_lds = lds; char* K_lds = lds + 2 * SHM_V;
  float* ws = (float*)(lds + 2 * SHM_V + 2 * SHM_K) + wid * 64; float* li_l = ws; float* al_l = ws + 32;
  float m_reg = 0.f, l_reg = 0; f32x16 o[2] = {}; f32x16 negm = {}; bf16x8 qr[ND];
  const bf16_t* Qw = Qb + (unsigned)((wid * QBLK + r32) * LDQ + hi * 8);
#pragma unroll
  for (int d0 = 0; d0 < ND; ++d0) qr[d0] = *reinterpret_cast<const bf16x8*>(Qw + d0 * 16);
  const int sr = tid >> 3, sc = (tid & 7) * 8;
  const int pr = (tid >> 2) & 63, pc = (tid & 3) * 8;
  const int vst = v_st(sr, sc), kst = KSWZ(sr, sc * 2), pst = KSWZ(pr, (64 + pc) * 2);
  const int vb0 = (int)(uintptr_t)V_lds + v_rd_base(lane);
  struct { bf16x8 vs, ks, ps; } sr_[2];
  const unsigned voff = (unsigned)(sr * LDK + sc), poff = (unsigned)(pr * 32 + pc);
#define SLOAD(i, k0) do { const bf16_t* Vt_ = Vh + (size_t)(k0) * LDK; const bf16_t* Kt_ = Kh + (size_t)(k0) * LDK; \
    sr_[i].vs = *reinterpret_cast<const bf16x8*>(Vt_ + voff); sr_[i].ks = *reinterpret_cast<const bf16x8*>(Kt_ + voff); \
    if constexpr (DQ == 96) { const bf16_t* Pt_ = Kpe + (size_t)(k0) * 32; sr_[i].ps = *reinterpret_cast<const bf16x8*>(Pt_ + poff); } } while (0)
#define SWRITE(b, i) do { *(bf16x8*)(V_lds + (b) * SHM_V + vst) = sr_[i].vs; *(bf16x8*)(K_lds + (b) * SHM_K + kst) = sr_[i].ks; \
    if constexpr (DQ == 96) { if (tid < 256) *(bf16x8*)(K_lds + (b) * SHM_K + pst) = sr_[i].ps; } } while (0)
#define SWAIT() do { if constexpr (DQ == 96) asm volatile("s_waitcnt vmcnt(3)" ::: "memory"); else asm volatile("s_waitcnt vmcnt(2)" ::: "memory"); } while (0)
#define RESC(a) do { if (__any((a) < 1.f)) { if (hi == 0) al_l[r32] = (a); asm volatile("s_waitcnt lgkmcnt(0)" ::: "memory"); \
    _Pragma("unroll") for (int d = 0; d < 2; ++d) _Pragma("unroll") for (int r = 0; r < 16; ++r) o[d][r] *= al_l[crow(r, hi)]; } } while (0)
  f32x16 pA0, pA1, pB0, pB1; float alA, alB; bf16x8 pa0, pa1, pa2, pa3; const int NT = seq / KVBLK;
  constexpr int SE = 0, SO = 1;
  SLOAD(SE, 0); asm volatile("s_waitcnt vmcnt(0)" ::: "memory"); SWRITE(0, SE); __syncthreads();
  qkt<DQ>(pA0, pA1, K_lds, qr, negm, r32, hi); partialSM<true>(pA0, pA1, m_reg, negm, alA);
  SLOAD(SO, KVBLK); if (2 < NT) SLOAD(SE, 2 * KVBLK);
  SWAIT(); SWRITE(1, SO); __syncthreads();
  for (int j = 1; j + 1 < NT; j += 2) {
    SBAR(); qkt<DQ>(pB0, pB1, K_lds + SHM_K, qr, negm, r32, hi);
    finishSM(pA0, pA1, alA, l_reg, pa0, pa1, pa2, pa3); SBAR();
    SLOAD(SO, (j + 2) * KVBLK); SBAR();
    pv_d0(o, vb0, pa0, pa1, pa2, pa3); partialSM<false>(pB0, pB1, m_reg, negm, alB);
    __syncthreads(); SWAIT(); SWRITE(0, SE);
    RESC(alB); __syncthreads();
    SBAR(); qkt<DQ>(pA0, pA1, K_lds, qr, negm, r32, hi);
    finishSM(pB0, pB1, alB, l_reg, pa0, pa1, pa2, pa3); SBAR();
    if (j + 3 < NT) SLOAD(SE, (j + 3) * KVBLK); SBAR();
    pv_d0(o, vb0 + SHM_V, pa0, pa1, pa2, pa3); partialSM<false>(pA0, pA1, m_reg, negm, alA);
    __syncthreads(); SWAIT(); SWRITE(1, SO);
    RESC(alA); __syncthreads();
  }
  SBAR(); qkt<DQ>(pB0, pB1, K_lds + SHM_K, qr, negm, r32, hi);
  finishSM(pA0, pA1, alA, l_reg, pa0, pa1, pa2, pa3); SBAR();
  pv_d0(o, vb0, pa0, pa1, pa2, pa3); partialSM<false>(pB0, pB1, m_reg, negm, alB);
  __syncthreads(); RESC(alB);
  finishSM(pB0, pB1, alB, l_reg, pa0, pa1, pa2, pa3); SBAR();
  pv_d0(o, vb0 + SHM_V, pa0, pa1, pa2, pa3);
  if (hi == 0) li_l[r32] = l_reg; asm volatile("s_waitcnt lgkmcnt(0)" ::: "memory");
  float rli[16];
#pragma unroll
  for (int r = 0; r < 16; ++r) rli[r] = __builtin_amdgcn_rcpf(li_l[crow(r, hi)]);
  bf16_t* Ow = Ob + (long)(wid * QBLK) * LDO;
#pragma unroll
  for (int r = 0; r < 16; ++r) { int orow = crow(r, hi);
#pragma unroll
    for (int d0 = 0; d0 < 2; ++d0) { const float v = o[d0][r] * rli[r]; Ow[(long)orow * LDO + d0 * 32 + r32] = (bf16_t)(cvtpk(v, v) & 0xffffu); } }
  __syncthreads();
#undef SLOAD
#undef SWRITE
#undef SWAIT
#undef RESC
}
#undef SBAR
}

namespace d64 {
using bf16=__hip_bfloat16;
using bf16x8=__attribute__((ext_vector_type(8)))short;
using s16x4=__attribute__((ext_vector_type(4)))short;
using f32x16=__attribute__((ext_vector_type(16)))float;
using u32x4=__attribute__((ext_vector_type(4)))unsigned;
constexpr int D=64,LDQ=384,LDK=128,LDO=1024;
constexpr int NW=8,QBLK=32,QB=QBLK*NW,KVBLK=64;
__device__ __forceinline__ int crow(int r,int hi){return (r&3)+8*(r>>2)+4*hi;}
#define SBAR() __builtin_amdgcn_sched_barrier(0)
constexpr int NSLOT=3, SLOTB=8192;
constexpr int LDS_K=0, LDS_V=NSLOT*SLOTB, LDS_WS=2*NSLOT*SLOTB, LDS_OST=LDS_WS+NW*64*4, LDS_BYTES=LDS_OST+NW*4096;
constexpr float C2=0.125f*1.4426950408889634f;
__device__ __forceinline__ void glds16(const void*gsrc,unsigned lds_dst){unsigned keep;
  asm volatile("s_mov_b32 %0, m0\n\ts_mov_b32 m0, %2\n\ts_nop 0\n\tglobal_load_lds_dwordx4 %1, off\n\ts_mov_b32 m0, %0":"=&s"(keep):"v"(gsrc),"s"(lds_dst):"memory");}
__device__ __forceinline__ float max3f(float a,float b,float c){float r;asm("v_max3_f32 %0, %1, %2, %3":"=v"(r):"v"(a),"v"(b),"v"(c));return r;}
__device__ __forceinline__ float max2f(float a,float b){float r;asm("v_max_f32_e32 %0, %1, %2":"=v"(r):"v"(a),"v"(b));return r;}
__device__ __forceinline__ float fadd_s(float a,float b){float r;asm("v_add_f32_e32 %0, %1, %2":"=v"(r):"v"(a),"v"(b));return r;}
__device__ __forceinline__ float fsub_s(float a,float b){float r;asm("v_sub_f32_e32 %0, %1, %2":"=v"(r):"v"(a),"v"(b));return r;}
typedef float f32x2_t __attribute__((ext_vector_type(2))); typedef __bf16 bf16x2_t __attribute__((ext_vector_type(2)));
__device__ __forceinline__ unsigned cvtpk_s(float lo,float hi){f32x2_t v={lo,hi};bf16x2_t b=__builtin_convertvector(v,bf16x2_t);return __builtin_bit_cast(unsigned,b);}
#define WAIT_BAR(N) asm volatile("s_waitcnt vmcnt(" #N ") lgkmcnt(0)\n\ts_barrier":::"memory")

__device__ __forceinline__ void qkt(f32x16&p0,f32x16&p1,const char*Kslot,const bf16x8*qr,const f32x16&negm,int r32,int hi){
  const char*kb=Kslot+hi*1024+r32*16;
  #pragma unroll
  for(int d0=0;d0<4;++d0){
    const bf16x8 b0=*reinterpret_cast<const bf16x8*>(kb+d0*2048);
    const bf16x8 b1=*reinterpret_cast<const bf16x8*>(kb+d0*2048+512);
    if(d0==0){p0=__builtin_amdgcn_mfma_f32_32x32x16_bf16(b0,qr[0],negm,0,0,0);p1=__builtin_amdgcn_mfma_f32_32x32x16_bf16(b1,qr[0],negm,0,0,0);}
    else{p0=__builtin_amdgcn_mfma_f32_32x32x16_bf16(b0,qr[d0],p0,0,0,0);p1=__builtin_amdgcn_mfma_f32_32x32x16_bf16(b1,qr[d0],p1,0,0,0);}}
}
typedef __attribute__((address_space(3))) const char* lds_cptr;
typedef short v4i16_t __attribute__((ext_vector_type(4)));
__device__ __forceinline__ void kload8(bf16x8*kf,lds_cptr kp){
  kf[0]=*(const __attribute__((address_space(3))) bf16x8*)(kp);      kf[1]=*(const __attribute__((address_space(3))) bf16x8*)(kp+512);
  kf[2]=*(const __attribute__((address_space(3))) bf16x8*)(kp+2048); kf[3]=*(const __attribute__((address_space(3))) bf16x8*)(kp+2560);
  kf[4]=*(const __attribute__((address_space(3))) bf16x8*)(kp+4096); kf[5]=*(const __attribute__((address_space(3))) bf16x8*)(kp+4608);
  kf[6]=*(const __attribute__((address_space(3))) bf16x8*)(kp+6144); kf[7]=*(const __attribute__((address_space(3))) bf16x8*)(kp+6656);
}
__device__ __forceinline__ void kload2(bf16x8*kf,lds_cptr kp,int j){ kf[2*j]=*(const __attribute__((address_space(3))) bf16x8*)(kp+j*2048); kf[2*j+1]=*(const __attribute__((address_space(3))) bf16x8*)(kp+j*2048+512); }
__device__ __forceinline__ s16x4 vtr(lds_cptr p){ return __builtin_bit_cast(s16x4,__builtin_amdgcn_ds_read_tr16_b64_v4i16((__attribute__((address_space(3))) v4i16_t*)p)); }
__device__ __forceinline__ float rowmax(const f32x16&p0,const f32x16&p1){
  float a=max3f(p0[0],p0[1],p1[0]),b=max3f(p0[2],p0[3],p1[1]);a=max3f(a,p1[2],p1[3]);
  #pragma unroll
  for(int r=4;r<16;r+=4){a=max3f(a,p0[r],p0[r+1]);b=max3f(b,p0[r+2],p0[r+3]);a=max3f(a,p1[r],p1[r+1]);b=max3f(b,p1[r+2],p1[r+3]);}
  const float m=max2f(a,b);
  auto rr=__builtin_amdgcn_permlane32_swap(__float_as_uint(m),__float_as_uint(m),false,false);
  return max2f(__uint_as_float(rr[0]),__uint_as_float(rr[1]));
}
__device__ __forceinline__ void pv(f32x16*o,int vb,bf16x8 pa0,bf16x8 pa1,bf16x8 pa2,bf16x8 pa3){
  #pragma unroll
  for(int d0=0;d0<2;++d0){s16x4 lo[4],hi[4];
    #pragma unroll
    for(int ks=0;ks<4;++ks){
      asm volatile("ds_read_b64_tr_b16 %0,%1 offset:%c2":"=&v"(lo[ks]):"v"(vb),"i"(d0*4096+ks*1024):"memory");
      asm volatile("ds_read_b64_tr_b16 %0,%1 offset:%c2":"=&v"(hi[ks]):"v"(vb),"i"(d0*4096+ks*1024+512):"memory");}
    asm volatile("s_waitcnt lgkmcnt(0)":::"memory");SBAR();
    #define PK(k) (bf16x8){lo[k][0],lo[k][1],lo[k][2],lo[k][3],hi[k][0],hi[k][1],hi[k][2],hi[k][3]}
    o[d0]=__builtin_amdgcn_mfma_f32_32x32x16_bf16(pa0,PK(0),o[d0],0,0,0);
    o[d0]=__builtin_amdgcn_mfma_f32_32x32x16_bf16(pa1,PK(1),o[d0],0,0,0);
    o[d0]=__builtin_amdgcn_mfma_f32_32x32x16_bf16(pa2,PK(2),o[d0],0,0,0);
    o[d0]=__builtin_amdgcn_mfma_f32_32x32x16_bf16(pa3,PK(3),o[d0],0,0,0);
    #undef PK
  }
}

#ifndef ATTN_STORE16
#define ATTN_STORE16(p,v) (*(u32x4*)(p)=(v))
#endif
template<int THRL,bool PE> __device__ __forceinline__ void attn_unit(const bf16*Qu,const bf16*__restrict__ Kh,const bf16*__restrict__ Kpe,const bf16*__restrict__ Vh,bf16*Ou,const int NT,char*shm,const int wave_in){
  constexpr int LDQ_=PE?576:384, LDK_=PE?384:128, NDQ=PE?6:4, LDS_KPE=LDS_BYTES;
  const int lane=pg8::lane_id_asm(),tid=wave_in*64+lane,r32=lane&31,hi=lane>>5; const int wid=wave_in; (void)tid;
  const bf16*Qw=Qu+(long)(wid*QBLK)*LDQ_;
  const unsigned lds0=(unsigned)(uintptr_t)shm;
  float*wsf=(float*)(shm+LDS_WS)+wid*64;
  const bf16*ksrc=Kh+(long)lane*LDK_+wid*8; const bf16*psrc=PE?Kpe+(long)lane*32+(wid&3)*8:nullptr;
  const bf16*vsrc=Vh+(long)(16*(wid&3)+(lane>>2))*LDK_+(wid>>2)*32+(lane&3)*8;
  const unsigned kdst=lds0+LDS_K+wid*1024, vdst=lds0+LDS_V+wid*1024, pdst=lds0+LDS_KPE+(wid&3)*1024;
  #define DMA_K(t,slot) do{ glds16(ksrc+(long)(t)*KVBLK*LDK_,(unsigned)__builtin_amdgcn_readfirstlane(kdst+(slot))); \
    if constexpr(PE) glds16(psrc+(long)(t)*KVBLK*32,(unsigned)__builtin_amdgcn_readfirstlane(pdst+((slot)>>1))); }while(0)
  #define DMA_V(t,slot) glds16(vsrc+(long)(t)*KVBLK*LDK_,(unsigned)__builtin_amdgcn_readfirstlane(vdst+(slot)))
  const int vb0=(int)(lds0+LDS_V)+((lane>>4)&1)*32+(lane&3)*8+(4*hi+((lane&15)>>2))*64;
  const char*Kbase=shm+LDS_K; bf16x8 kf[8]; bf16x8 kpf[4];
  const lds_cptr shm3=(lds_cptr)shm; const lds_cptr kp0=shm3+LDS_K+hi*1024+r32*16; const lds_cptr pp0=shm3+LDS_KPE+hi*1024+r32*16; const lds_cptr vp0=shm3+LDS_V+((lane>>4)&1)*32+(lane&3)*8+(4*hi+((lane&15)>>2))*64;
  DMA_K(0,0);DMA_V(0,0);DMA_K(1,SLOTB);
  bf16x8 qr[NDQ];
  #pragma unroll
  for(int d0=0;d0<NDQ;++d0)qr[d0]=*reinterpret_cast<const bf16x8*>(&Qw[(long)r32*LDQ_+d0*16+hi*8]);
  float mhat=0.f,l_reg=0.f;f32x16 o[2];o[0]=f32x16{};o[1]=f32x16{};f32x16 negm=f32x16{};asm volatile("":"+v"(negm));
  #define CMASK(P0,P1,t) do{}while(0)
  bool resc=false;
  #define START(P0,P1) do{ const float rm=rowmax(P0,P1); resc=false; \
    { const float dl=rm; mhat=fadd_s(mhat,dl); \
      _Pragma("unroll") for(int r=0;r<16;++r){P0[r]=fsub_s(P0[r],dl);P1[r]=fsub_s(P1[r],dl);} \
      _Pragma("unroll") for(int r=0;r<16;++r)negm[r]=-mhat; asm volatile("":"+v"(negm)); } \
    _Pragma("unroll") for(int r=0;r<16;++r)P0[r]=__builtin_amdgcn_exp2f(P0[r]); }while(0)
  #define RESC() do{ if(resc){ asm volatile("s_waitcnt lgkmcnt(0)":::"memory"); \
      _Pragma("unroll") for(int d_=0;d_<2;++d_) _Pragma("unroll") for(int r=0;r<16;++r)o[d_][r]*=wsf[crow(r,hi)]; } }while(0)
  f32x16 pA0,pA1,pB0,pB1;
  int sl_prev=0,sl_cur=0,sl_next=SLOTB;
  #define ROT() do{sl_prev=sl_cur;sl_cur=sl_next;sl_next=(sl_next==(NSLOT-1)*SLOTB)?0:sl_next+SLOTB;}while(0)
  DMA_K(2,2*SLOTB);
  if constexpr(PE){WAIT_BAR(5);}else{WAIT_BAR(3);}
  qkt(pA0,pA1,Kbase,qr,negm,r32,hi);
  if constexpr(PE){ const char*pb=shm+LDS_KPE+hi*1024+r32*16;
    _Pragma("unroll") for(int j=0;j<2;++j){ const bf16x8 b0=*reinterpret_cast<const bf16x8*>(pb+j*2048), b1=*reinterpret_cast<const bf16x8*>(pb+j*2048+512);
      pA0=__builtin_amdgcn_mfma_f32_32x32x16_bf16(b0,qr[4+j],pA0,0,0,0); pA1=__builtin_amdgcn_mfma_f32_32x32x16_bf16(b1,qr[4+j],pA1,0,0,0);} }
  asm volatile("s_nop 15\n\ts_nop 7":"+v"(pA0),"+v"(pA1));CMASK(pA0,pA1,0);
  START(pA0,pA1);
  _Pragma("unroll") for(int r=0;r<16;++r)pA1[r]=__builtin_amdgcn_exp2f(pA1[r]);
  WAIT_BAR(0);
  DMA_K(3,0);DMA_V(1,SLOTB);
  ROT();
  kload8(kf,kp0+sl_cur); if constexpr(PE){ kload2(kpf,pp0+(sl_cur>>1),0); kload2(kpf,pp0+(sl_cur>>1),1); }
  if constexpr(PE){WAIT_BAR(3);}else{WAIT_BAR(2);}
  s16x4 vlo[8],vhi[8]; u32x4 pw0,pw1,pw2,pw3;
  #define PKW(P,B) cvtpk_s(P[B],P[B+1])
  #define PAF(k) __builtin_bit_cast(bf16x8,pw##k)
  #define VFR(i) (bf16x8){vlo[i][0],vlo[i][1],vlo[i][2],vlo[i][3],vhi[i][0],vhi[i][1],vhi[i][2],vhi[i][3]}
  #define PIN(x) asm volatile("":"+v"(x))
  #define MX3(a,b,c) __builtin_fmaxf(__builtin_fmaxf((a),(b)),(c))
  #define GAPA(MF,A0,A1,A2,A3,W0,W1,PW) do{ MF; sacc+=A0; sacc+=A1; sacc+=A2; sacc+=A3; PIN(sacc); W0; W1; PIN(PW); SBAR(); }while(0)
  #define EX(v) __builtin_amdgcn_exp2f(v)
  #define GAPB(MF,X,B) do{ MF; X[B]=EX(X[B]); X[B+1]=EX(X[B+1]); X[B+2]=EX(X[B+2]); X[B+3]=EX(X[B+3]); PIN(X); SBAR(); }while(0)
  #define VRD(i) do{ vlo[i]=vtr(vp_+(((i)>>2)*4096+((i)&3)*1024)); vhi[i]=vtr(vp_+(((i)>>2)*4096+((i)&3)*1024+512)); }while(0)
  #define KRD(G,j) do{ if(G){ kload2(kf,kp0+sl_next,j); if constexpr(PE){ if((j)<2) kload2(kpf,pp0+(sl_next>>1),j); } SBAR(); } }while(0)
  #define STEP(C0,C1,P0,P1,t,GK,GV,GL) do{ SBAR(); \
    const lds_cptr vp_=vp0+sl_prev; \
    VRD(0); SBAR(); float sacc=(P0[0]+P0[1]); \
    GAPA(C0=__builtin_amdgcn_mfma_f32_32x32x16_bf16(kf[0],qr[0],negm,0,0,0), P0[2],P0[3],P0[4],P0[5],     pw0[0]=PKW(P0,0), pw0[1]=PKW(P0,2), pw0); \
    VRD(4); SBAR(); GAPA(C1=__builtin_amdgcn_mfma_f32_32x32x16_bf16(kf[1],qr[0],negm,0,0,0), P0[6],P0[7],P0[8],P0[9],     pw0[2]=PKW(P0,4), pw0[3]=PKW(P0,6), pw0); \
    VRD(1); SBAR(); GAPA(C0=__builtin_amdgcn_mfma_f32_32x32x16_bf16(kf[2],qr[1],C0,0,0,0),   P0[10],P0[11],P0[12],P0[13], pw1[0]=PKW(P0,8), pw1[1]=PKW(P0,10), pw1); \
    VRD(5); SBAR(); GAPA(C1=__builtin_amdgcn_mfma_f32_32x32x16_bf16(kf[3],qr[1],C1,0,0,0),   P0[14],P0[15],P1[0],P1[1],   pw1[2]=PKW(P0,12),pw1[3]=PKW(P0,14), pw1); \
    VRD(2); SBAR(); GAPA(C0=__builtin_amdgcn_mfma_f32_32x32x16_bf16(kf[4],qr[2],C0,0,0,0),   P1[2],P1[3],P1[4],P1[5],     pw2[0]=PKW(P1,0), pw2[1]=PKW(P1,2), pw2); \
    VRD(6); SBAR(); GAPA(C1=__builtin_amdgcn_mfma_f32_32x32x16_bf16(kf[5],qr[2],C1,0,0,0),   P1[6],P1[7],P1[8],P1[9],     pw2[2]=PKW(P1,4), pw2[3]=PKW(P1,6), pw2); \
    VRD(3); SBAR(); GAPA(C0=__builtin_amdgcn_mfma_f32_32x32x16_bf16(kf[6],qr[3],C0,0,0,0),   P1[10],P1[11],P1[12],P1[13], pw3[0]=PKW(P1,8), pw3[1]=PKW(P1,10), pw3); \
    VRD(7); SBAR(); GAPA(C1=__builtin_amdgcn_mfma_f32_32x32x16_bf16(kf[7],qr[3],C1,0,0,0),   P1[14],P1[15],0.f,0.f,       pw3[2]=PKW(P1,12),pw3[3]=PKW(P1,14), pw3); \
    if constexpr(PE){ C0=__builtin_amdgcn_mfma_f32_32x32x16_bf16(kpf[0],qr[4],C0,0,0,0); C1=__builtin_amdgcn_mfma_f32_32x32x16_bf16(kpf[1],qr[4],C1,0,0,0); \
      C0=__builtin_amdgcn_mfma_f32_32x32x16_bf16(kpf[2],qr[5],C0,0,0,0); C1=__builtin_amdgcn_mfma_f32_32x32x16_bf16(kpf[3],qr[5],C1,0,0,0); } \
    l_reg+=sacc; \
    if(GK){DMA_K((t)+3,sl_cur);} if(GV){DMA_V((t)+1,sl_next);} \
    CMASK(C0,C1,t); \
    { float a=MX3(C0[0],C0[1],C1[0]),b=MX3(C0[2],C0[3],C1[1]); a=MX3(a,C1[2],C1[3]); \
      _Pragma("unroll") for(int r=4;r<16;r+=4){a=MX3(a,C0[r],C0[r+1]);b=MX3(b,C0[r+2],C0[r+3]);a=MX3(a,C1[r],C1[r+1]);b=MX3(b,C1[r+2],C1[r+3]);} \
      float rm=__builtin_fmaxf(a,b); { auto rr=__builtin_amdgcn_permlane32_swap(__float_as_uint(rm),__float_as_uint(rm),false,false); rm=__builtin_fmaxf(__uint_as_float(rr[0]),__uint_as_float(rr[1])); } \
      resc=false; \
      if(__builtin_expect(__any(rm>(float)THRL),0)){ const float dl=__builtin_fmaxf(rm,0.f); mhat+=dl; \
        _Pragma("unroll") for(int r=0;r<16;++r){C0[r]-=dl;C1[r]-=dl;} \
        _Pragma("unroll") for(int r=0;r<16;++r)negm[r]=-mhat; asm volatile("":"+v"(negm)); \
        const float f=__builtin_amdgcn_exp2f(-dl); l_reg*=f; if(hi==0)wsf[r32]=f; resc=true; } } \
    SBAR(); \
    GAPB(o[0]=__builtin_amdgcn_mfma_f32_32x32x16_bf16(PAF(0),VFR(0),o[0],0,0,0), C0,0); \
    GAPB(o[1]=__builtin_amdgcn_mfma_f32_32x32x16_bf16(PAF(0),VFR(4),o[1],0,0,0), C0,4); \
    KRD(GL,0); GAPB(o[0]=__builtin_amdgcn_mfma_f32_32x32x16_bf16(PAF(1),VFR(1),o[0],0,0,0), C0,8); \
    KRD(GL,1); GAPB(o[1]=__builtin_amdgcn_mfma_f32_32x32x16_bf16(PAF(1),VFR(5),o[1],0,0,0), C0,12); \
    KRD(GL,2); GAPB(o[0]=__builtin_amdgcn_mfma_f32_32x32x16_bf16(PAF(2),VFR(2),o[0],0,0,0), C1,0); \
    KRD(GL,3); GAPB(o[1]=__builtin_amdgcn_mfma_f32_32x32x16_bf16(PAF(2),VFR(6),o[1],0,0,0), C1,4); \
    GAPB(o[0]=__builtin_amdgcn_mfma_f32_32x32x16_bf16(PAF(3),VFR(3),o[0],0,0,0), C1,8); \
    GAPB(o[1]=__builtin_amdgcn_mfma_f32_32x32x16_bf16(PAF(3),VFR(7),o[1],0,0,0), C1,12); \
    }while(0)
  int t=1;
  #undef CMASK
  #define CMASK(P0,P1,t) do{}while(0)
  for(;t+5<NT;t+=2){
    STEP(pB0,pB1,pA0,pA1,t,true,true,true);     if constexpr(PE){WAIT_BAR(3);}else{WAIT_BAR(2);} RESC(); ROT();
    STEP(pA0,pA1,pB0,pB1,t+1,true,true,true);   if constexpr(PE){WAIT_BAR(3);}else{WAIT_BAR(2);} RESC(); ROT();
  }
  #undef CMASK
  #define CMASK(P0,P1,t) do{}while(0)
  #define ENDW(tt) do{ if((tt)+3<NT){ if constexpr(PE){WAIT_BAR(3);}else{WAIT_BAR(2);} } else if((tt)+2<NT){WAIT_BAR(1);} else {WAIT_BAR(0);} }while(0)
  for(;t+1<NT;t+=2){
    STEP(pB0,pB1,pA0,pA1,t,(t+3<NT),(t+1<NT),(t+1<NT));       ENDW(t);   RESC(); ROT();
    STEP(pA0,pA1,pB0,pB1,t+1,(t+4<NT),(t+2<NT),(t+2<NT));     ENDW(t+1); RESC(); ROT();
  }
  STEP(pB0,pB1,pA0,pA1,NT-1,false,false,false); RESC();
  { float sacc=pB0[0]+pB0[1]; _Pragma("unroll") for(int r=2;r<16;++r)sacc+=pB0[r]; _Pragma("unroll") for(int r=0;r<16;++r)sacc+=pB1[r]; l_reg+=sacc;
    pw0=(u32x4){PKW(pB0,0),PKW(pB0,2),PKW(pB0,4),PKW(pB0,6)};pw1=(u32x4){PKW(pB0,8),PKW(pB0,10),PKW(pB0,12),PKW(pB0,14)};pw2=(u32x4){PKW(pB1,0),PKW(pB1,2),PKW(pB1,4),PKW(pB1,6)};pw3=(u32x4){PKW(pB1,8),PKW(pB1,10),PKW(pB1,12),PKW(pB1,14)};
    SBAR(); pv(o,vb0+sl_cur,PAF(0),PAF(1),PAF(2),PAF(3)); }
  #undef PKW
  #undef PAF
  #undef VFR
  #undef PIN
  #undef MX3
  #undef GAPA
  #undef GAPB
  #undef EX
  #undef VRD
  #undef KRD
  #undef STEP
  #undef ENDW
  {auto rr=__builtin_amdgcn_permlane32_swap(__float_as_uint(l_reg),__float_as_uint(l_reg),false,false);l_reg=__uint_as_float(rr[0])+__uint_as_float(rr[1]);}
  if(hi==0)wsf[32+r32]=l_reg;asm volatile("s_waitcnt lgkmcnt(0)":::"memory");
  float rli[16];
  #pragma unroll
  for(int r=0;r<16;++r)rli[r]=__builtin_amdgcn_rcpf(wsf[32+crow(r,hi)]);
  bf16*Ow=Ou+(long)(wid*QBLK)*LDO;
  { bf16*stg=(bf16*)(shm+LDS_OST)+wid*2048;
    #pragma unroll
    for(int r=0;r<16;++r){const int orow=crow(r,hi);
      #pragma unroll
      for(int d0=0;d0<2;++d0)stg[orow*64+d0*32+r32]=__float2bfloat16(o[d0][r]*rli[r]);}
    asm volatile("s_waitcnt lgkmcnt(0)":::"memory");
    #pragma unroll
    for(int i=0;i<4;++i){const int row=i*8+(lane>>3),ch=lane&7; const u32x4 v=*(const u32x4*)(stg+row*64+ch*8); ATTN_STORE16(Ow+(long)row*LDO+ch*8,v);} }
  asm volatile("s_waitcnt lgkmcnt(0)\n\ts_barrier":::"memory");
  #undef DMA_K
  #undef DMA_V
  #undef CMASK
  #undef START
  #undef RESC
  #undef ROT
}
#undef SBAR
#undef WAIT_BAR
}

typedef unsigned short bf16_t;
typedef float f32x4 __attribute__((ext_vector_type(4)));
typedef float f32x2 __attribute__((ext_vector_type(2)));
typedef unsigned u32x2 __attribute__((ext_vector_type(2)));
typedef unsigned u32x4 __attribute__((ext_vector_type(4)));
#define LAS __attribute__((address_space(3)))
#define XB_TMO      128
#define XB_XCNT(j)  (256  + 64 * (j))
#define XB_XSUB(j)  (1280 + 64 * (j))
#define XB_XGEN(j)  (2304 + 64 * (j))
#define XB_TOP      3328
#define XB_TOPGEN   3392
#define XCD_BAR_WORDS 3456
#define XB_SPIN_CAP (1u << 18)

__device__ __forceinline__ unsigned xb_ld(unsigned* p)              { return __hip_atomic_load(p, __ATOMIC_RELAXED, __HIP_MEMORY_SCOPE_AGENT); }
__device__ __forceinline__ unsigned xb_add(unsigned* p, unsigned v) { return __hip_atomic_fetch_add(p, v, __ATOMIC_RELAXED, __HIP_MEMORY_SCOPE_AGENT); }
__device__ __forceinline__ unsigned xb_xcc_id() { return (unsigned)__builtin_amdgcn_s_getreg((3 << 11) | 20) & 0xFu; }
#define XB_SPIN(cond, bar) do { unsigned _sp = 0; while (cond) { __builtin_amdgcn_s_sleep(1); \
    if ((++_sp & 255u) == 0u) { if (xb_ld(&(bar)[XB_TMO])) break; if (_sp > XB_SPIN_CAP) { atomicAdd(&(bar)[XB_TMO], 1u); break; } } } } while (0)

struct XcdBarrier {
    unsigned* bar; unsigned x;
    volatile LAS unsigned* st;
};

__device__ __forceinline__ XcdBarrier xcd_barrier_post(unsigned* bar, volatile LAS unsigned* st, const bool t0) {
    XcdBarrier b; b.bar = bar; b.x = xb_xcc_id(); b.st = st;
    if (t0) (void)xb_add(&bar[XB_XCNT(b.x)], 1u);
    return b;
}
__device__ __forceinline__ void xcd_barrier_complete(unsigned* bar, unsigned x, unsigned& nloc, unsigned& nx) {
    const unsigned G = gridDim.x * gridDim.y * gridDim.z;
    unsigned sum, cnt, mine, sp = 0u;
    for (;;) {
        sum = 0u; cnt = 0u; mine = 0u;
#pragma unroll
        for (unsigned j = 0; j < 16; ++j) { const unsigned c = xb_ld(&bar[XB_XCNT(j)]); sum += c; cnt += (c > 0u) ? 1u : 0u; mine = (j == x) ? c : mine; }
        if (sum == G) break;
        __builtin_amdgcn_s_sleep(1);
        if ((++sp & 255u) == 0u) { if (xb_ld(&bar[XB_TMO])) break; if (sp > XB_SPIN_CAP) { atomicAdd(&bar[XB_TMO], 1u); break; } }
    }
    nloc = mine > 0u ? mine : 1u; nx = cnt > 0u ? cnt : 1u;
}

__device__ __forceinline__ void xcd_barrier(const XcdBarrier& b, const bool t0) {
    asm volatile("s_waitcnt vmcnt(0)" ::: "memory");
    __syncthreads();
    if (t0) {
        unsigned* bar = b.bar;
        __builtin_amdgcn_s_waitcnt(0);
        unsigned nloc = b.st[0], nx = b.st[1];
        if (nloc == 0u) { xcd_barrier_complete(bar, b.x, nloc, nx); b.st[0] = nloc; b.st[1] = nx; }
        const unsigned old = xb_add(&bar[XB_XSUB(b.x)], 1u);
        const unsigned gen = old / nloc;
        if (old + 1u == (gen + 1u) * nloc) {
            __builtin_amdgcn_fence(__ATOMIC_RELEASE, "agent");
            asm volatile("s_waitcnt vmcnt(0)" ::: "memory");
            const unsigned og = xb_add(&bar[XB_TOP], 1u);
            const unsigned tg = og / nx;
            if (og + 1u == (tg + 1u) * nx) xb_add(&bar[XB_TOPGEN], 1u);
            else XB_SPIN(xb_ld(&bar[XB_TOPGEN]) == tg, bar);
            __builtin_amdgcn_fence(__ATOMIC_ACQUIRE, "agent");
            xb_add(&bar[XB_XGEN(b.x)], 1u);
            asm volatile("s_waitcnt vmcnt(0)" ::: "memory");
        } else {
            XB_SPIN(xb_ld(&bar[XB_XGEN(b.x)]) == gen, bar);
            __builtin_amdgcn_fence(__ATOMIC_ACQUIRE, "agent");
            asm volatile("s_waitcnt vmcnt(0)" ::: "memory");
        }
    }
    __syncthreads();
}

constexpr size_t MiB = 1u << 20;
constexpr size_t WS_MOD = 1 * MiB, WS_ROPEM = 2 * MiB, WS_ROPEG = 3 * MiB, WS_Z = 5 * MiB;
constexpr size_t WS_WIN = 10 * MiB, WS_WUQ = 26 * MiB, WS_WUKV = 28 * MiB, WS_WO = 29 * MiB, WS_W1 = 37 * MiB, WS_W2 = 69 * MiB;
constexpr size_t WS_U = 101 * MiB, WS_Y = WS_U  , WS_PART = 167 * MiB  , WS_OV = 233 * MiB;
constexpr size_t WS_HM = WS_OV, WS_H = WS_OV, WS_MQ = WS_OV, WS_MK = 271 * MiB, WS_MV = 296 * MiB;
constexpr size_t WS_CKV = 365 * MiB, WS_CQ = 374 * MiB, WS_KPE = 391 * MiB, WS_GK = 394 * MiB, WS_GV = 403 * MiB, WS_GQ = 412 * MiB, WS_O = 437 * MiB, WS_END = 503 * MiB;
static_assert(WS_MQ + (size_t)MROWS * 576 * 2 <= WS_MK && WS_MK + (size_t)MROWS * 384 * 2 <= WS_MV && WS_MV + (size_t)MROWS * 384 * 2 <= WS_H + (size_t)MROWS * HP * 2, "overlay");
static_assert(WS_H + (size_t)MROWS * HP * 2 <= WS_CKV && WS_CKV + (size_t)MROWS * 256 <= WS_CQ && WS_CQ + (size_t)MROWS * 512 <= WS_KPE && WS_KPE + (size_t)MROWS * 64 <= WS_GK, "map1");
static_assert(WS_GK + (size_t)MROWS * 256 <= WS_GV && WS_GV + (size_t)MROWS * 256 <= WS_GQ && WS_GQ + (size_t)MROWS * 768 <= WS_O && WS_O + (size_t)MROWS * 2048 <= WS_END, "map2");
static_assert(WS_HM + (size_t)MROWS * DFF * 2 <= WS_END, "map3");
#ifndef ATT_REPS
#define ATT_REPS 1
#endif
#ifndef TDIV
#define TDIV 1
#endif
#ifndef TSEL
#define TSEL -1
#endif
constexpr float QSC64 = 0.125f * 1.4426950408889634f, QSC96 = 0.10206207261596575f * 1.4426950408889634f;
constexpr int LDS_BYTES = 135168;

struct Params { const float* in[21]; float* out; unsigned char* ws; };
enum { I_X = 0, I_C, I_CTX, I_CCTX, I_WADA, I_BADA, I_WIN, I_GCQ, I_WUQ, I_GCKV, I_WUKV, I_GQN, I_GKN, I_WCONV, I_WO, I_LN1G, I_LN1B, I_W1, I_W2, I_LN2G, I_LN2B };

template <int CTRL> __device__ __forceinline__ float dppf(float v) { return __int_as_float(__builtin_amdgcn_update_dpp(0, __float_as_int(v), CTRL, 0xf, 0xf, true)); }
__device__ __forceinline__ float half_sum(float v) {
    v += dppf<0xB1>(v); v += dppf<0x4E>(v); v += dppf<0x141>(v); v += dppf<0x140>(v);
    auto r = __builtin_amdgcn_permlane16_swap(__float_as_uint(v), __float_as_uint(v), false, false);
    return __uint_as_float(r[0]) + __uint_as_float(r[1]);
}
__device__ __forceinline__ float wave_sum(float v) {
    v = half_sum(v);
    auto r = __builtin_amdgcn_permlane32_swap(__float_as_uint(v), __float_as_uint(v), false, false);
    return __uint_as_float(r[0]) + __uint_as_float(r[1]);
}
__device__ __forceinline__ unsigned pk2(float lo, float hi) { unsigned r; asm volatile("v_cvt_pk_bf16_f32 %0, %1, %2" : "=v"(r) : "v"(lo), "v"(hi)); return r; }
__device__ __forceinline__ float bflo(unsigned w) { return __uint_as_float(w << 16); }
__device__ __forceinline__ float bfhi(unsigned w) { return __uint_as_float(w & 0xffff0000u); }

__device__ __forceinline__ void transpose_item(const float* W, int K, int N, bf16_t* WT, LAS float* scr, int item, int lane) {
    const int nblk = N / 32, kb = item / nblk, nb = item % nblk, k0 = 64 * kb, n0 = 32 * nb;
#pragma unroll 8
    for (int i = 0; i < 32; ++i) { const int kk = 2 * i + (lane >> 5); scr[kk * 33 + (lane & 31)] = W[(size_t)(k0 + kk) * N + n0 + (lane & 31)]; }
    asm volatile("s_waitcnt lgkmcnt(0)" ::: "memory");
    const int c = lane & 7;
#pragma unroll
    for (int j = 0; j < 4; ++j) { const int n = (lane >> 3) + 8 * j; const LAS float* s = scr + (8 * c) * 33 + n;
        u32x4 o; o.x = pk2(s[0 * 33], s[1 * 33]); o.y = pk2(s[2 * 33], s[3 * 33]); o.z = pk2(s[4 * 33], s[5 * 33]); o.w = pk2(s[6 * 33], s[7 * 33]);
        *(u32x4*)(WT + (size_t)(n0 + n) * K + k0 + 8 * c) = o; }
    asm volatile("s_waitcnt lgkmcnt(0)" ::: "memory");
}

struct RowInfo { int b, i, v; bool isctx; };
__device__ __forceinline__ RowInfo row_info(int m) { RowInfo r; r.b = m / LTOK; r.i = m - r.b * LTOK; r.isctx = r.i < CTX; r.v = r.isctx ? 4 : r.b; return r; }

__global__ void __launch_bounds__(512, 2) fwd_megakernel(Params p) {
    extern __shared__ __attribute__((aligned(16))) unsigned char lds[];
    cg::grid_group grid = cg::this_grid();
#if TSEL >= 0
#define TSL ((unsigned*)(lds + 133120))
#define TST (blockIdx.x == 0 && wave == 0 && pg8::lane_id_asm() == 0)
#define TINIT() do { if (TST) { for (int k = 0; k < 16; ++k) TSL[k] = 0; TSL[12] = (unsigned)__builtin_amdgcn_s_memrealtime(); } } while (0)
#define TBODY(k) do { if (TST) { const unsigned t_ = (unsigned)__builtin_amdgcn_s_memrealtime(); const unsigned d_ = t_ - TSL[12]; TSL[k] += d_; TSL[11] += d_; TSL[12] = t_; } } while (0)
#define TSYNC() do { if (TST) { const unsigned t_ = (unsigned)__builtin_amdgcn_s_memrealtime(); const unsigned d_ = t_ - TSL[12]; TSL[10] += d_; TSL[11] += d_; TSL[12] = t_; } } while (0)
#else
#define TINIT() do {} while (0)
#define TBODY(k) do {} while (0)
#define TSYNC() do {} while (0)
#endif
#define XB_T0 (wave == 0 && pg8::lane_id_asm() == 0)
#define XB_ST ((volatile LAS unsigned*)((LAS unsigned char*)lds + 133376))
#define XB_BAR ((unsigned*)WSB())
#define GSYNC_CG(k) do { TBODY(k); grid.sync(); TSYNC(); } while (0)
#define GSYNC(k) do { TBODY(k); { XcdBarrier xb_; xb_.bar = XB_BAR; xb_.x = xb_xcc_id(); xb_.st = XB_ST; xcd_barrier(xb_, XB_T0); } TSYNC(); } while (0)
    const int wave = __builtin_amdgcn_readfirstlane(threadIdx.x >> 6);
    TINIT();
    if (XB_T0) { XB_ST[0] = 0u; XB_ST[1] = 0u; }
    __syncthreads();
#define G ((int)gridDim.x)
#define bx ((int)blockIdx.x)
#define vcu ((G % 8 == 0) ? (bx % 8) * (G / 8) + bx / 8 : bx)
#define gw (bx * 8 + wave)
#define NGW (G * 8)
#define LAUN3() int G_ = G, bx_ = bx, wave_ = wave; asm volatile("" : "+s"(G_), "+s"(bx_), "+s"(wave_))
#define KP() ({ const __attribute__((address_space(4))) Params* k_ = (const __attribute__((address_space(4))) Params*)__builtin_amdgcn_kernarg_segment_ptr(); asm volatile("" : "+s"(k_)); k_; })
#define WSB() ((unsigned char*)KP()->ws)
#define DEFWS(w) \
    float* MOD = (float*)((w) + WS_MOD); float* ROPEM = (float*)((w) + WS_ROPEM); float* ROPEG = (float*)((w) + WS_ROPEG); float* Z = (float*)((w) + WS_Z); \
    bf16_t* WIN = (bf16_t*)((w) + WS_WIN); bf16_t* WUQ = (bf16_t*)((w) + WS_WUQ); bf16_t* WUKV = (bf16_t*)((w) + WS_WUKV); bf16_t* WO = (bf16_t*)((w) + WS_WO); \
    bf16_t* W1 = (bf16_t*)((w) + WS_W1); bf16_t* W2 = (bf16_t*)((w) + WS_W2); \
    bf16_t* U = (bf16_t*)((w) + WS_U); bf16_t* Y = (bf16_t*)((w) + WS_Y); bf16_t* HM = (bf16_t*)((w) + WS_HM); bf16_t* H = (bf16_t*)((w) + WS_H); \
    bf16_t* MQ = (bf16_t*)((w) + WS_MQ); bf16_t* MK = (bf16_t*)((w) + WS_MK); bf16_t* MV = (bf16_t*)((w) + WS_MV); \
    bf16_t* CKV = (bf16_t*)((w) + WS_CKV); bf16_t* CQ = (bf16_t*)((w) + WS_CQ); bf16_t* KPE = (bf16_t*)((w) + WS_KPE); \
    bf16_t* GK = (bf16_t*)((w) + WS_GK); bf16_t* GV = (bf16_t*)((w) + WS_GV); bf16_t* GQ = (bf16_t*)((w) + WS_GQ); bf16_t* OC = (bf16_t*)((w) + WS_O); float* PART = (float*)((w) + WS_PART); (void)PART; \
    (void)MOD; (void)ROPEM; (void)ROPEG; (void)Z; (void)WIN; (void)WUQ; (void)WUKV; (void)WO; (void)W1; (void)W2; (void)U; (void)Y; (void)HM; (void)H; (void)MQ; (void)MK; (void)MV; \
    (void)CKV; (void)CQ; (void)KPE; (void)GK; (void)GV; (void)GQ; (void)OC;

    {
        unsigned char* ws_b_ = WSB(); DEFWS(ws_b_)
        const int lane = pg8::lane_id_asm(), tid = wave * 64 + lane;
        if (bx == 0) { unsigned* bar_ = (unsigned*)ws_b_; for (int i = tid; i < XCD_BAR_WORDS; i += 512) bar_[i] = 0u; }
        LAS float* scr = (LAS float*)((LAS unsigned char*)lds + wave * 16384);
        constexpr int I_IN = 16 * 57, I_UQ = 4 * 18, I_UKV = 2 * 24, I_O = 16 * 32, I_1 = 16 * 128, I_2 = 64 * 32, PER = I_IN + I_UQ + I_UKV + I_O + I_1 + I_2;
        for (int it = gw; it < DEPTH * PER; it += NGW) {
            const int l = it / PER; int r = it - l * PER;
            if (r < I_IN) { transpose_item(KP()->in[I_WIN] + (size_t)l * DM * IN_COLS, DM, IN_COLS, WIN + (size_t)l * HP * DM, scr, r, lane); continue; } r -= I_IN;
            if (r < I_UQ) { transpose_item(KP()->in[I_WUQ] + (size_t)l * 256 * 576, 256, 576, WUQ + (size_t)l * 768 * 256, scr, r, lane); continue; } r -= I_UQ;
            if (r < I_UKV) { transpose_item(KP()->in[I_WUKV] + (size_t)l * 128 * 768, 128, 768, WUKV + (size_t)l * 768 * 128, scr, r, lane); continue; } r -= I_UKV;
            if (r < I_O) { transpose_item(KP()->in[I_WO] + (size_t)l * DM * DM, DM, DM, WO + (size_t)l * DM * DM, scr, r, lane); continue; } r -= I_O;
            if (r < I_1) { transpose_item(KP()->in[I_W1] + (size_t)l * DM * DFF, DM, DFF, W1 + (size_t)l * DFF * DM, scr, r, lane); continue; } r -= I_1;
            transpose_item(KP()->in[I_W2] + (size_t)l * DFF * DM, DFF, DM, W2 + (size_t)l * DM * DFF, scr, r, lane);
        }
        const int gt = bx * 512 + tid, NGT = G * 512;
        for (int idx = gt; idx < DEPTH * 224 * 128; idx += NGT) { const int l = idx / (224 * 128), r = idx % (224 * 128);
            *(u32x4*)(WIN + ((size_t)l * HP + IN_COLS) * DM + (size_t)r * 8) = (u32x4){0u, 0u, 0u, 0u}; }
        for (int idx = gt; idx < DEPTH * 192 * 32; idx += NGT) { const int l = idx / (192 * 32), r = idx % (192 * 32);
            *(u32x4*)(WUQ + ((size_t)l * 768 + 576) * 256 + (size_t)r * 8) = (u32x4){0u, 0u, 0u, 0u}; }
        for (int idx = gt; idx < SEQ * 16; idx += NGT) { const int pos = idx >> 4, i = idx & 15; const int rw = pos >> 6, cl = pos & 63;
            const float inv = powf(10000.f, -(float)(i & 7) / 8.f); const float ang = (float)(i < 8 ? rw : cl) * inv;
            ROPEM[2 * idx] = cosf(ang); ROPEM[2 * idx + 1] = sinf(ang); }
        for (int idx = gt; idx < SEQ * 32; idx += NGT) { const int pos = idx >> 5, i = idx & 31; const int rw = pos >> 6, cl = pos & 63;
            const float inv = powf(10000.f, -(float)(i & 15) / 16.f); const float ang = (float)(i < 16 ? rw : cl) * inv;
            ROPEG[2 * idx] = cosf(ang); ROPEG[2 * idx + 1] = sinf(ang); }
        __syncthreads();
        float* sil = (float*)lds;
        float* part = (float*)lds + 5 * 1024;
        { const float* c_in = KP()->in[I_C]; const float* cc_in = KP()->in[I_CCTX];
        for (int idx = tid; idx < 5 * 1024; idx += 512) { const int v = idx >> 10, k = idx & 1023; const float c = (v < 4) ? c_in[v * 1024 + k] : cc_in[k]; sil[idx] = c / (1.f + __expf(-c)); } }
        const float* wada_ = KP()->in[I_WADA]; const float* bada_ = KP()->in[I_BADA];
        __syncthreads();
        for (int it = bx; it < DEPTH * 96; it += G) { const int l = it / 96, jb = it % 96; const int j = jb * 64 + lane;
            const float* wp = wada_ + ((size_t)l * DM + wave * 128) * 6144 + j;
            float a0 = 0, a1 = 0, a2 = 0, a3 = 0, a4 = 0;
#pragma unroll 8
            for (int k = 0; k < 128; ++k) { const float w = wp[(size_t)k * 6144]; const int kk = wave * 128 + k;
                a0 += sil[kk] * w; a1 += sil[1024 + kk] * w; a2 += sil[2048 + kk] * w; a3 += sil[3072 + kk] * w; a4 += sil[4096 + kk] * w; }
            part[(wave * 5 + 0) * 64 + lane] = a0; part[(wave * 5 + 1) * 64 + lane] = a1; part[(wave * 5 + 2) * 64 + lane] = a2; part[(wave * 5 + 3) * 64 + lane] = a3; part[(wave * 5 + 4) * 64 + lane] = a4;
            __syncthreads();
            if (tid < 320) { const int v = tid >> 6, c = tid & 63; float s = bada_[l * 6144 + jb * 64 + c];
#pragma unroll
                for (int w = 0; w < 8; ++w) s += part[(w * 5 + v) * 64 + c];
                MOD[((size_t)l * 5 + v) * 6144 + jb * 64 + c] = s; }
            __syncthreads();
        }
    }
    GSYNC_CG(0);
    (void)xcd_barrier_post(XB_BAR, XB_ST, XB_T0);
    { DEFWS(WSB())
    const int lane = pg8::lane_id_asm(); const float* xin_ = KP()->in[I_X]; const float* cin_ = KP()->in[I_CTX];
    for (int m = gw; m < MROWS; m += NGW) { const RowInfo ri = row_info(m);
        const float* xr = ri.isctx ? cin_ + ((size_t)ri.b * CTX + ri.i) * DM : xin_ + ((size_t)ri.b * SEQ + ri.i - CTX) * DM;
        const float* md = MOD + (size_t)ri.v * 6144;
#pragma unroll
        for (int j = 0; j < 4; ++j) { const int col = 4 * lane + 256 * j; const f32x4 x = *(const f32x4*)(xr + col), sh = *(const f32x4*)(md + col), sc = *(const f32x4*)(md + 1024 + col);
            const f32x4 u = x * (1.f + sc) + sh; u32x2 w; w.x = pk2(u[0], u[1]); w.y = pk2(u[2], u[3]); *(u32x2*)(U + (size_t)m * DM + col) = w; }
    } }
    GSYNC(0);

#pragma unroll 1
    for (int l = 0; l < DEPTH; ++l) {
        { DEFWS(WSB()) LAUN3(); pg8::Gemm g{U, WIN + (size_t)l * HP * DM, MROWS, 1792, DM, DM}; pg8::StaticOrder S; S.init(MROWS, 1792, G_, bx_);
          pg8::EpiStore<0> E{H, HPI, IN_COLS};
          pg8::gemm_phase<pg8::EpiStore<0>, pg8::StaticOrder, true, true>((LAS unsigned char*)lds, g, S, E, wave_); }
        { DEFWS(WSB()) LAUN3(); pg8::Gemm g{U, WIN + (size_t)l * HP * DM, MROWS, HP, DM, DM}; pg8::LightOrder S; S.init(bx_);
          pg8::EpiStore<0> E{H, HPI, IN_COLS};
          pg8::gemm_phase<pg8::EpiStore<0>, pg8::LightOrder, true, true, true>((LAS unsigned char*)lds, g, S, E, wave_); }
        GSYNC(1);
        {
            DEFWS(WSB())
            const int lane = pg8::lane_id_asm();
            const f32x2* gckv = (const f32x2*)(KP()->in[I_GCKV] + l * 128); const f32x2* gkn = (const f32x2*)(KP()->in[I_GKN] + l * 64);
            const f32x2* gcq = (const f32x2*)(KP()->in[I_GCQ] + l * 256); const f32x2* gqn = (const f32x2*)(KP()->in[I_GQN] + l * 64);
            const f32x2* wc0 = (const f32x2*)(KP()->in[I_WCONV] + (size_t)l * 768); const f32x2* wc1 = wc0 + 128; const f32x2* wc2 = wc0 + 256;
            const f32x2* rM = (const f32x2*)ROPEM; const f32x2* rG = (const f32x2*)ROPEG;
            const f32x2 gckv_l = gckv[lane], gkn_l = gkn[lane & 31], gcq0_l = gcq[lane], gcq1_l = gcq[64 + lane], gqn_l = gqn[lane & 31];
            f32x2 wcv[2][3];
#pragma unroll
            for (int j = 0; j < 2; ++j) { wcv[j][0] = wc0[lane + 64 * j]; wcv[j][1] = wc1[lane + 64 * j]; wcv[j][2] = wc2[lane + 64 * j]; }
#define RED4(v, NSTEP) _Pragma("unroll") for (int q_ = 0; q_ < 4; ++q_) v[q_] = ((NSTEP) == 64) ? wave_sum(v[q_]) : half_sum(v[q_]);
            for (int ch = wave * G + bx; ch < MROWS / 4; ch += NGW) { const int m0 = ch * 4; const RowInfo ri = row_info(m0); const bool lat = !ri.isctx; const int pos0 = ri.i - CTX;
                const unsigned* hr0 = (const unsigned*)(H + (size_t)m0 * HPI);
#if TSEL >= 0
                unsigned tp0_ = 0; if (TST) tp0_ = (unsigned)__builtin_amdgcn_s_memrealtime();
#endif
                unsigned wkv[4], wpe[4], wgk[4], wgv[4], wq0[4], wq1[4], wgq[4][3];
#pragma unroll
                for (int q = 0; q < 4; ++q) { const unsigned* hr = hr0 + (size_t)q * (HPI / 2);
                    wkv[q] = hr[lane]; wpe[q] = hr[64 + (lane & 15)]; wgk[q] = hr[80 + lane]; wgv[q] = hr[144 + lane]; wq0[q] = hr[208 + lane]; wq1[q] = hr[272 + lane];
#pragma unroll
                    for (int j = 0; j < 3; ++j) wgq[q][j] = hr[336 + 64 * j + lane]; }
                f32x2 csM[4], csG[4];
#pragma unroll
                for (int q = 0; q < 4; ++q) { csM[q] = lat ? rM[(pos0 + q) * 16 + (lane & 15)] : (f32x2){1.f, 0.f}; csG[q] = lat ? rG[(pos0 + q) * 32 + (lane & 31)] : (f32x2){1.f, 0.f}; }
                const int seqlen = lat ? SEQ : CTX, t0 = lat ? pos0 : ri.i; const bool hp = t0 > 0, hn = t0 + 4 < seqlen; const float zp = hp ? 1.f : 0.f, zn = hn ? 1.f : 0.f;
                unsigned cvh[2][6], cvc[2][6], cvb[2][4];
#pragma unroll
                for (int q = 0; q < 6; ++q) { const int qq = (q == 0 && !hp) ? 1 : (q == 5 && !hn) ? 4 : q; const unsigned* hq = hr0 + (ptrdiff_t)(qq - 1) * (HPI / 2);
#pragma unroll
                    for (int j = 0; j < 2; ++j) { cvh[j][q] = hq[528 + lane + 64 * j]; cvc[j][q] = hq[784 + lane + 64 * j]; } }
#pragma unroll
                for (int q = 0; q < 4; ++q)
#pragma unroll
                    for (int j = 0; j < 2; ++j) cvb[j][q] = (hr0 + (size_t)q * (HPI / 2))[656 + lane + 64 * j];
                {
                    float ss[4];
#pragma unroll
                    for (int q = 0; q < 4; ++q) { const float a = bflo(wkv[q]), b2 = bfhi(wkv[q]); ss[q] = a * a + b2 * b2; }
                    RED4(ss, 64)
#if TSEL >= 0
                    if (TST) { const unsigned t_ = (unsigned)__builtin_amdgcn_s_memrealtime(); TSL[13] += t_ - tp0_; tp0_ = t_; }
#endif
#pragma unroll
                    for (int q = 0; q < 4; ++q) { const float r = rsqrtf(ss[q] * (1.f / 128.f) + LN_EPS); ((unsigned*)(CKV + (size_t)(m0 + q) * 128))[lane] = pk2(bflo(wkv[q]) * r * gckv_l.x, bfhi(wkv[q]) * r * gckv_l.y); } }
                if (lane < 16) {
#pragma unroll
                    for (int q = 0; q < 4; ++q) { const float a = bflo(wpe[q]), b2 = bfhi(wpe[q]); ((unsigned*)(KPE + (size_t)(m0 + q) * 32))[lane] = pk2(a * csM[q].x - b2 * csM[q].y, a * csM[q].y + b2 * csM[q].x); } }
                {
                    float ss[4];
#pragma unroll
                    for (int q = 0; q < 4; ++q) { const float a = bflo(wgk[q]), b2 = bfhi(wgk[q]); ss[q] = a * a + b2 * b2; }
                    RED4(ss, 32)
#pragma unroll
                    for (int q = 0; q < 4; ++q) { const float r = rsqrtf(ss[q] * (1.f / 64.f) + LN_EPS); const float a = bflo(wgk[q]) * r * gkn_l.x, b2 = bfhi(wgk[q]) * r * gkn_l.y;
                        ((unsigned*)(GK + (size_t)(m0 + q) * 128))[lane] = pk2(a * csG[q].x - b2 * csG[q].y, a * csG[q].y + b2 * csG[q].x); } }
#pragma unroll
                for (int q = 0; q < 4; ++q) ((unsigned*)(GV + (size_t)(m0 + q) * 128))[lane] = wgv[q];
                {
                    float ss[4];
#pragma unroll
                    for (int q = 0; q < 4; ++q) { const float a0 = bflo(wq0[q]), b0 = bfhi(wq0[q]), a1 = bflo(wq1[q]), b1 = bfhi(wq1[q]); ss[q] = (a0 * a0 + b0 * b0) + (a1 * a1 + b1 * b1); }
                    RED4(ss, 64)
#pragma unroll
                    for (int q = 0; q < 4; ++q) { const float r = rsqrtf(ss[q] * (1.f / 256.f) + LN_EPS); unsigned* o = (unsigned*)(CQ + (size_t)(m0 + q) * 256);
                        o[lane] = pk2(bflo(wq0[q]) * r * gcq0_l.x, bfhi(wq0[q]) * r * gcq0_l.y); o[64 + lane] = pk2(bflo(wq1[q]) * r * gcq1_l.x, bfhi(wq1[q]) * r * gcq1_l.y); } }
#pragma unroll
                for (int j = 0; j < 3; ++j) {
                    float ss[4];
#pragma unroll
                    for (int q = 0; q < 4; ++q) { const float a = bflo(wgq[q][j]), b2 = bfhi(wgq[q][j]); ss[q] = a * a + b2 * b2; }
                    RED4(ss, 32)
#pragma unroll
                    for (int q = 0; q < 4; ++q) { const float r = rsqrtf(ss[q] * (1.f / 64.f) + LN_EPS); const float a = bflo(wgq[q][j]) * r * gqn_l.x, b2 = bfhi(wgq[q][j]) * r * gqn_l.y;
                        ((unsigned*)(GQ + (size_t)(m0 + q) * 384))[64 * j + lane] = pk2((a * csG[q].x - b2 * csG[q].y) * QSC64, (a * csG[q].y + b2 * csG[q].x) * QSC64); } }
                {
#pragma unroll
                    for (int j = 0; j < 2; ++j) { const int ix = lane + 64 * j; float pa[6], pb[6];
#pragma unroll
                        for (int q = 0; q < 6; ++q) { const float z = (q == 0) ? zp : (q == 5) ? zn : 1.f; pa[q] = bflo(cvh[j][q]) * bflo(cvc[j][q]) * z; pb[q] = bfhi(cvh[j][q]) * bfhi(cvc[j][q]) * z; }
#pragma unroll
                        for (int q = 0; q < 4; ++q) { const unsigned bb = cvb[j][q];
                            const float oa = bflo(bb) * (wcv[j][0].x * pa[q] + wcv[j][1].x * pa[q + 1] + wcv[j][2].x * pa[q + 2]);
                            const float ob = bfhi(bb) * (wcv[j][0].y * pb[q] + wcv[j][1].y * pb[q + 1] + wcv[j][2].y * pb[q + 2]);
                            ((unsigned*)(OC + (size_t)(m0 + q) * DM))[384 + ix] = pk2(oa, ob); } }
                }
#if TSEL >= 0
                if (TST) { const unsigned t_ = (unsigned)__builtin_amdgcn_s_memrealtime(); TSL[14] += t_ - tp0_; }
#endif
            }
#undef RED4
        }
        GSYNC(2);
        { DEFWS(WSB()) LAUN3(); pg8::Gemm g{CQ, WUQ + (size_t)l * 768 * 256, MROWS, 768, 256, 256}; pg8::StaticOrder S; S.init(MROWS, 768, G_, bx_);
          pg8::EpiUQ E{MQ, ROPEM, QSC96};
          pg8::gemm_phase<pg8::EpiUQ, pg8::StaticOrder, true, false>((LAS unsigned char*)lds, g, S, E, wave_); }
        { DEFWS(WSB()) LAUN3(); pg8::Gemm g{CKV, WUKV + (size_t)l * 768 * 128, MROWS, 768, 128, 128}; pg8::StaticOrder S; S.init(MROWS, 768, G_, bx_);
          pg8::EpiUKV E{MK, MV};
          pg8::gemm_phase<pg8::EpiUKV, pg8::StaticOrder, true, true>((LAS unsigned char*)lds, g, S, E, wave_); }
        GSYNC(3);
        {
            DEFWS(WSB())
            const int nrounds = (l < DEPTH - 1) ? 7 : 6;
            for (int i_ = 0; i_ < nrounds * ATT_REPS; ++i_) { const int i = (ATT_REPS == 1) ? i_ : (i_ % nrounds);
                int type, b, h, qrow0, seq;
                if (i < 6) { const int u = vcu + 256 * i; type = u / 768; const int rem = u % 768; b = rem / 192; h = (rem >> 5) % 6; const int qb = rem & 31; qrow0 = b * LTOK + CTX + qb * 256; seq = LTOK; }
                else { if (vcu >= 48) continue; type = vcu / 24; b = (vcu % 24) / 6; h = vcu % 6; qrow0 = b * LTOK; seq = CTX; }
                const size_t kr = (size_t)b * LTOK;
                if (type == 0) d64::attn_unit<8, true>((const d64::bf16*)(MQ + (size_t)qrow0 * 576 + h * 96), (const d64::bf16*)(MK + kr * 384 + h * 64), (const d64::bf16*)(KPE + kr * 32), (const d64::bf16*)(MV + kr * 384 + h * 64), (d64::bf16*)(OC + (size_t)qrow0 * DM + h * 64), seq / 64, (char*)lds, wave);
                else d64::attn_unit<8, false>((const d64::bf16*)(GQ + (size_t)qrow0 * 384 + h * 64), (const d64::bf16*)(GK + kr * 128 + (h / 3) * 64), nullptr, (const d64::bf16*)(GV + kr * 128 + (h / 3) * 64), (d64::bf16*)(OC + (size_t)qrow0 * DM + 384 + h * 64), seq / 64, (char*)lds, wave);
            }
        }
        GSYNC(4);
        { DEFWS(WSB()) LAUN3(); pg8::Gemm g{OC, WO + (size_t)l * DM * DM, MROWS, DM, DM, DM}; pg8::RowOrder S; S.init(DM, G_, bx_, true);
          pg8::EpiStore<0> E{Y, DM, DM};
          pg8::gemm_phase<pg8::EpiStore<0>, pg8::RowOrder, true, true>((LAS unsigned char*)lds, g, S, E, wave_); }
        if (l < DEPTH - 1) { DEFWS(WSB()) LAUN3(); pg8::Gemm g{OC, WO + (size_t)l * DM * DM, MROWS, DM, 256, DM}; pg8::CtxSplitOrder S; S.init(DM, 4, G_, bx_);
          pg8::EpiPart E{PART, DM, (size_t)1024 * DM};
          pg8::gemm_phase<pg8::EpiPart, pg8::CtxSplitOrder, true, true>((LAS unsigned char*)lds, g, S, E, wave_); }
        GSYNC(5);
#pragma unroll 1
        for (int which = 0; which < 2; ++which) {
            {
                DEFWS(WSB())
                const int lane = pg8::lane_id_asm();
                const float* lg = KP()->in[which ? I_LN2G : I_LN1G] + l * DM; const float* lb = KP()->in[which ? I_LN2B : I_LN1B] + l * DM;
                const float* xin_ = KP()->in[I_X]; const float* cin_ = KP()->in[I_CTX]; float* out_ = KP()->out;
                const bool first = (l == 0 && which == 0); const bool wantu = !(which == 1 && l == DEPTH - 1);
                const int KS = which ? 8 : 4;
                f32x4 g4[4], b4[4];
#pragma unroll
                for (int j = 0; j < 4; ++j) { g4[j] = *(const f32x4*)(lg + 4 * lane + 256 * j); b4[j] = *(const f32x4*)(lb + 4 * lane + 256 * j); }
                for (int ch = wave * G + bx; ch < MROWS / 2; ch += NGW) { const int m0 = ch * 2; const RowInfo ri = row_info(m0);
                    if (ri.isctx && l == DEPTH - 1) continue;
                    const size_t zoff = ((size_t)ri.b * CTX + ri.i) * DM, xoff = ((size_t)ri.b * SEQ + ri.i - CTX) * DM;
                    const float* xo = ri.isctx ? (first ? cin_ + zoff : Z + zoff) : (first ? xin_ + xoff : out_ + xoff);
                    float* xn = ri.isctx ? Z + zoff : out_ + xoff;
                    const float* md = MOD + ((size_t)l * 5 + ri.v) * 6144; const float* gate = md + (which ? 5 : 2) * 1024;
                    const float* md2 = which ? MOD + ((size_t)(wantu ? l + 1 : l) * 5 + ri.v) * 6144 : md + 3 * 1024;
                    f32x4 gt[4], sh[4], sc1[4];
#pragma unroll
                    for (int j = 0; j < 4; ++j) { const int col = 4 * lane + 256 * j; gt[j] = *(const f32x4*)(gate + col); sh[j] = *(const f32x4*)(md2 + col); sc1[j] = 1.f + *(const f32x4*)(md2 + 1024 + col); }
                    const float* pp0 = PART + zoff;
                    { const int r = 0;
                        f32x4 t[2][4]; float s[2] = {0.f, 0.f};
#pragma unroll
                        for (int q = 0; q < 2; ++q)
#pragma unroll
                            for (int j = 0; j < 4; ++j) { const int col = 4 * lane + 256 * j; const size_t ro = (size_t)(r + q) * DM + col; const f32x4 x = *(const f32x4*)(xo + ro);
                                f32x4 y;
                                if (ri.isctx) { const float* pp = pp0 + ro; f32x4 yy[8];
#pragma unroll
                                    for (int k = 0; k < 4; ++k) yy[k] = *(const f32x4*)(pp + (size_t)k * 1024 * DM);
                                    if (KS == 8) {
#pragma unroll
                                        for (int k = 4; k < 8; ++k) yy[k] = *(const f32x4*)(pp + (size_t)k * 1024 * DM);
                                        y = ((yy[0] + yy[1]) + (yy[2] + yy[3])) + ((yy[4] + yy[5]) + (yy[6] + yy[7])); }
                                    else y = (yy[0] + yy[1]) + (yy[2] + yy[3]); }
                                else { const u32x2 yw = *(const u32x2*)(Y + (size_t)m0 * DM + ro); y = (f32x4){bflo(yw.x), bfhi(yw.x), bflo(yw.y), bfhi(yw.y)}; }
                                t[q][j] = ALPHA * x + gt[j] * y; s[q] += (t[q][j][0] + t[q][j][1]) + (t[q][j][2] + t[q][j][3]); }
                        s[0] = wave_sum(s[0]); s[1] = wave_sum(s[1]);
                        float s2[2] = {0.f, 0.f};
#pragma unroll
                        for (int q = 0; q < 2; ++q) { const float mean = s[q] * (1.f / DM);
#pragma unroll
                            for (int j = 0; j < 4; ++j) { t[q][j] = t[q][j] - mean; s2[q] += (t[q][j][0] * t[q][j][0] + t[q][j][1] * t[q][j][1]) + (t[q][j][2] * t[q][j][2] + t[q][j][3] * t[q][j][3]); } }
                        s2[0] = wave_sum(s2[0]); s2[1] = wave_sum(s2[1]);
#pragma unroll
                        for (int q = 0; q < 2; ++q) { const float rstd = rsqrtf(s2[q] * (1.f / DM) + LN_EPS);
#pragma unroll
                            for (int j = 0; j < 4; ++j) { const int col = 4 * lane + 256 * j; const size_t ro = (size_t)(r + q) * DM + col;
                                const f32x4 xv = t[q][j] * rstd * g4[j] + b4[j]; *(f32x4*)(xn + ro) = xv;
                                if (wantu) { const f32x4 u = xv * sc1[j] + sh[j]; u32x2 w; w.x = pk2(u[0], u[1]); w.y = pk2(u[2], u[3]); *(u32x2*)(U + (size_t)m0 * DM + ro) = w; } } }
                    }
                }
            }
            if (which == 1) { if (l < DEPTH - 1) GSYNC(9); else TBODY(9); break; }
            GSYNC(6);
            { DEFWS(WSB()) LAUN3(); pg8::Gemm g{U, W1 + (size_t)l * DFF * DM, MROWS, DFF, DM, DM}; pg8::RowOrder S; S.init(DFF, G_, bx_, l == DEPTH - 1);
              pg8::EpiStore<1> E{HM, DFF, DFF};
              pg8::gemm_phase<pg8::EpiStore<1>, pg8::RowOrder, true, true>((LAS unsigned char*)lds, g, S, E, wave_); }
            GSYNC(7);
            { DEFWS(WSB()) LAUN3(); pg8::Gemm g{HM, W2 + (size_t)l * DM * DFF, MROWS, DM, DFF, DFF}; pg8::RowOrder S; S.init(DM, G_, bx_, true);
              pg8::EpiStore<0> E{Y, DM, DM};
              pg8::gemm_phase<pg8::EpiStore<0>, pg8::RowOrder, true, true>((LAS unsigned char*)lds, g, S, E, wave_); }
            if (l < DEPTH - 1) { DEFWS(WSB()) LAUN3(); pg8::Gemm g{HM, W2 + (size_t)l * DM * DFF, MROWS, DM, 512, DFF}; pg8::CtxSplitOrder S; S.init(DM, 8, G_, bx_);
              pg8::EpiPart E{PART, DM, (size_t)1024 * DM};
              pg8::gemm_phase<pg8::EpiPart, pg8::CtxSplitOrder, true, true>((LAS unsigned char*)lds, g, S, E, wave_); }
            GSYNC(8);
        }
    }
#if TSEL >= 0
    grid.sync();
    if (blockIdx.x == 0) { __syncthreads(); unsigned ticks = 0; for (int k = 0; k < 16; ++k) if ((TSEL >> k) & 1) ticks += TSL[k]; const int n = (int)((ticks / 100u) / TDIV); float* o_ = KP()->out;
        for (int i = wave * 64 + pg8::lane_id_asm(); i < n; i += 512) o_[(size_t)i * 1031] += 0.2f; }
#endif
}

extern "C" void kernel_launch(void* const* d_in, const int* in_sizes, int n_in, void* d_out, int out_size, void* d_ws, size_t ws_size, hipStream_t stream) {
    static int grid = 0;
    if (grid == 0) {
        if (n_in != 21 || in_sizes[0] != NBATCH * SEQ * DM || out_size != NBATCH * SEQ * DM || ws_size < WS_END) {
            fprintf(stderr, "kernel_launch: shape mismatch n_in %d in0 %d out %d ws %zu (need %zu)\n", n_in, n_in > 0 ? in_sizes[0] : -1, out_size, ws_size, (size_t)WS_END); grid = -1; return; }
        int dev = 0, cus = 0, per_cu = 0;
        hipGetDevice(&dev); hipDeviceGetAttribute(&cus, hipDeviceAttributeMultiprocessorCount, dev);
        if (hipFuncSetAttribute((const void*)fwd_megakernel, hipFuncAttributeMaxDynamicSharedMemorySize, LDS_BYTES) != hipSuccess) { fprintf(stderr, "kernel_launch: hipFuncSetAttribute failed\n"); grid = -1; return; }
        if (hipOccupancyMaxActiveBlocksPerMultiprocessor(&per_cu, (const void*)fwd_megakernel, 512, LDS_BYTES) != hipSuccess || per_cu < 1) { fprintf(stderr, "kernel_launch: occupancy query says %d\n", per_cu); per_cu = 1; }
        (void)hipGetLastError();
        if (cus < 256) { fprintf(stderr, "kernel_launch: built for a 256-CU device, found %d CUs\n", cus); grid = -1; return; }
        grid = 256;
        fprintf(stderr, "kernel_launch: grid %d (per_cu %d)\n", grid, per_cu);
    }
    if (grid < 0) return;
    Params p{};
    for (int i = 0; i < 21; ++i) p.in[i] = (const float*)d_in[i];
    p.out = (float*)d_out; p.ws = (unsigned char*)d_ws;
    void* args[] = {&p};
    hipError_t e = hipLaunchCooperativeKernel((const void*)fwd_megakernel, dim3(grid), dim3(512), args, LDS_BYTES, stream);
    if (e != hipSuccess) fprintf(stderr, "kernel_launch: cooperative launch failed: %s (grid %d)\n", hipGetErrorString(e), grid);
}
```

```cpp
#include <hip/hip_runtime.h>
#include <hip/hip_cooperative_groups.h>
#include <hip/hip_bf16.h>
#include <cstdio>
#include <cstdint>
namespace cg = cooperative_groups;

constexpr int DM = 1024, NBATCH = 4, SEQ = 8192, DEPTH = 4, CTX = 256, DFF = 4096;
constexpr int LTOK = CTX + SEQ;
constexpr int MROWS = NBATCH * LTOK;
constexpr int IN_COLS = 1824, HP = 2048, HPI = 1856;
constexpr float LN_EPS = 1e-6f;
constexpr float ALPHA = 1.6817928305074290f;
namespace pg8 {
#define PG8_LAS __attribute__((address_space(3)))
typedef unsigned short bf16_t;
typedef short bf16x8 __attribute__((ext_vector_type(8)));
typedef float f32x4 __attribute__((ext_vector_type(4)));
typedef unsigned u32x4 __attribute__((ext_vector_type(4)));
constexpr int BM = 256, BK = 64, HALF = 128, HTB = HALF * BK * 2  , STAGE_BYTES = 8 * HTB, NXCD = 8, WGM = 8;

__host__ __device__ __forceinline__ int lds_byte(int r, int c) { const int st = (r >> 4) * 2 + (c >> 5), rr = r & 15, cc = c & 31, ob = rr * 64 + cc * 2; return st * 1024 + (ob ^ (((ob >> 9) & 1) << 5)); }
__host__ __device__ __forceinline__ void stage_rc(int b, int& R, int& C) { const int st = b / 1024, sb = b % 1024, swz = sb ^ (((sb >> 9) & 1) << 5); R = (st >> 1) * 16 + swz / 64; C = (st & 1) * 32 + (swz % 64) / 2; }
__host__ __device__ __forceinline__ int perm32(int rho) { const int n = rho >> 4, i = rho & 15; return 8 * (i >> 2) + 4 * n + (i & 3); }

struct Unit { int pm, pn, pk; };
struct Gemm { const bf16_t* A; const bf16_t* Bt; int M, N, K, ld; };

struct StaticOrder {
    int nM, nN, nwg, G, c;
    __host__ __device__ void init(int M, int N, int G_, int c_) { nM = M / BM; nN = N / BM; nwg = nM * nN; G = G_; c = c_; }
    __host__ __device__ bool next(int i, Unit& u) const {
        const long L = (long)i * G + c; if (L >= nwg) return false;
        int wgid = (int)L; { const int q = nwg / NXCD, r = nwg % NXCD, xcd = wgid % NXCD, off = wgid / NXCD; wgid = (xcd < r ? xcd * (q + 1) : r * (q + 1) + (xcd - r) * q) + off; }
        const int nig = WGM * nN, gid = wgid / nig, fm = gid * WGM, gsz = (nM - fm) < WGM ? (nM - fm) : WGM;
        u.pm = fm + ((wgid % nig) % gsz); u.pn = (wgid % nig) / gsz; u.pk = 0; return true;
    }
    __device__ __forceinline__ void a_ready(const Unit&) const {}
    __device__ __forceinline__ void done(const Unit&) const {}
};

__device__ __forceinline__ unsigned cvt_pk_bf16(float lo, float hi) { unsigned r; asm volatile("v_cvt_pk_bf16_f32 %0, %1, %2" : "=v"(r) : "v"(lo), "v"(hi)); return r; }
__device__ __forceinline__ int lane_id_asm() { int l; asm volatile("v_mbcnt_lo_u32_b32 %0, -1, 0\n\tv_mbcnt_hi_u32_b32 %0, -1, %0" : "=v"(l)); return l; }
typedef float f32x2 __attribute__((ext_vector_type(2)));
template <int ACT  > struct EpiStore {
    static constexpr bool PERM = true, AFTER_DRAIN = false;
    bf16_t* O; int ldc; int ncol;
    __device__ __forceinline__ void operator()(const f32x4 (&acc)[2][2][4][2], const Unit& u, int wr, int wc, int fr, int fq) const {
        const int row0 = u.pm * BM + wr * 64 + fr; const int col0 = u.pn * BM + wc * 32 + 8 * fq;
#pragma unroll
        for (int ai = 0; ai < 2; ++ai)
#pragma unroll
            for (int m = 0; m < 4; ++m) { bf16_t* rowp = O + (unsigned)((row0 + ai * HALF + m * 16) * ldc + col0);
#pragma unroll
                for (int bj = 0; bj < 2; ++bj) { f32x4 v0 = acc[ai][bj][m][0], v1 = acc[ai][bj][m][1];
                    if (ACT == 1) {
#pragma unroll
                        for (int e = 0; e < 4; ++e) { float a = fmaxf(v0[e], 0.f), b = fmaxf(v1[e], 0.f); v0[e] = a * a; v1[e] = b * b; } }
                    u32x4 w; w.x = cvt_pk_bf16(v0[0], v0[1]); w.y = cvt_pk_bf16(v0[2], v0[3]); w.z = cvt_pk_bf16(v1[0], v1[1]); w.w = cvt_pk_bf16(v1[2], v1[3]);
                    if (col0 + bj * HALF < ncol) *(u32x4*)(rowp + bj * HALF) = w; } }
    }
};
struct EpiUQ {
    static constexpr bool PERM = true, AFTER_DRAIN = false;
    bf16_t* MQ; const float* ropeM; float qscale;
    __device__ __forceinline__ void operator()(const f32x4 (&acc)[2][2][4][2], const Unit& u, int wr, int wc, int fr, int fq) const {
        const int row0 = u.pm * BM + wr * 64 + fr;
        const int pt = u.pm % 33; const bool lat = pt != 0; const int pos0 = (pt - 1) * 256 + wr * 64 + fr;
#pragma unroll
        for (int bj = 0; bj < 2; ++bj) {
            const int c = u.pn * BM + bj * HALF + wc * 32 + 8 * fq;
            if (c >= 576) continue;
            const int d = c % 96; const bool isrope = (d >= 64) && lat; const int i0 = (d - 64) >> 1;
#pragma unroll
            for (int ai = 0; ai < 2; ++ai)
#pragma unroll
                for (int m = 0; m < 4; ++m) { const int row = row0 + ai * HALF + m * 16;
                    f32x4 v0 = acc[ai][bj][m][0], v1 = acc[ai][bj][m][1];
                    if (isrope) { const f32x4* rp = (const f32x4*)(ropeM + (unsigned)(((pos0 + ai * HALF + m * 16) * 16 + i0) * 2));
                        const f32x4 r0 = rp[0], r1 = rp[1];
                        f32x4 a, b;
                        a[0] = v0[0] * r0[0] - v0[1] * r0[1]; a[1] = v0[0] * r0[1] + v0[1] * r0[0];
                        a[2] = v0[2] * r0[2] - v0[3] * r0[3]; a[3] = v0[2] * r0[3] + v0[3] * r0[2];
                        b[0] = v1[0] * r1[0] - v1[1] * r1[1]; b[1] = v1[0] * r1[1] + v1[1] * r1[0];
                        b[2] = v1[2] * r1[2] - v1[3] * r1[3]; b[3] = v1[2] * r1[3] + v1[3] * r1[2];
                        v0 = a; v1 = b; }
                    v0 = v0 * qscale; v1 = v1 * qscale;
                    u32x4 w; w.x = cvt_pk_bf16(v0[0], v0[1]); w.y = cvt_pk_bf16(v0[2], v0[3]); w.z = cvt_pk_bf16(v1[0], v1[1]); w.w = cvt_pk_bf16(v1[2], v1[3]);
                    *(u32x4*)(MQ + (unsigned)(row * 576 + c)) = w; }
        }
    }
};
struct EpiUKV {
    static constexpr bool PERM = true, AFTER_DRAIN = false;
    bf16_t* MK; bf16_t* MV;
    __device__ __forceinline__ void operator()(const f32x4 (&acc)[2][2][4][2], const Unit& u, int wr, int wc, int fr, int fq) const {
        const int row0 = u.pm * BM + wr * 64 + fr;
#pragma unroll
        for (int bj = 0; bj < 2; ++bj) {
            const int head = u.pn * 2 + bj; const int d = wc * 32 + 8 * fq;
            bf16_t* base = (d < 64) ? MK : MV; const unsigned boff = (unsigned)(head * 64 + (d & 63));
#pragma unroll
            for (int ai = 0; ai < 2; ++ai)
#pragma unroll
                for (int m = 0; m < 4; ++m) { const int row = row0 + ai * HALF + m * 16;
                    const f32x4 v0 = acc[ai][bj][m][0], v1 = acc[ai][bj][m][1];
                    u32x4 w; w.x = cvt_pk_bf16(v0[0], v0[1]); w.y = cvt_pk_bf16(v0[2], v0[3]); w.z = cvt_pk_bf16(v1[0], v1[1]); w.w = cvt_pk_bf16(v1[2], v1[3]);
                    *(u32x4*)(base + (boff + (unsigned)(row * 384))) = w; }
        }
    }
};
struct RowOrder {
    StaticOrder S0; bool latonly;
    __host__ __device__ void init(int N, int G_, int c_, bool latonly_) { latonly = latonly_; S0.init(latonly_ ? 128 * BM : 132 * BM, N, G_, c_); }
    __host__ __device__ bool next(int i, Unit& u) const { if (!S0.next(i, u)) return false; if (latonly) u.pm = u.pm + u.pm / 32 + 1; return true; }
    __device__ __forceinline__ void a_ready(const Unit&) const {}
    __device__ __forceinline__ void done(const Unit&) const {}
};
struct CtxSplitOrder {
    int nN, KS, total, G, c;
    __host__ __device__ void init(int N, int KS_, int G_, int c_) { nN = N / BM; KS = KS_; total = 4 * nN * KS_; G = G_; c = c_; }
    __host__ __device__ bool next(int i, Unit& u) const { const int L = i * G + c; if (L >= total) return false; u.pk = L % KS; const int t = L / KS; u.pn = t % nN; u.pm = 33 * (t / nN); return true; }
    __device__ __forceinline__ void a_ready(const Unit&) const {}
    __device__ __forceinline__ void done(const Unit&) const {}
};
struct EpiPart {
    static constexpr bool PERM = false, AFTER_DRAIN = false;
    float* P; int ldc; size_t kstride;
    __device__ __forceinline__ void operator()(const f32x4 (&acc)[2][2][4][2], const Unit& u, int wr, int wc, int fr, int fq) const {
        float* base = P + (size_t)u.pk * kstride + (size_t)((u.pm / 33) * BM + wr * 64 + fr) * ldc + u.pn * BM + wc * 32 + 4 * fq;
#pragma unroll
        for (int ai = 0; ai < 2; ++ai)
#pragma unroll
            for (int m = 0; m < 4; ++m)
#pragma unroll
                for (int bj = 0; bj < 2; ++bj)
#pragma unroll
                    for (int n = 0; n < 2; ++n) *(f32x4*)(base + (size_t)(ai * HALF + m * 16) * ldc + bj * HALF + n * 16) = acc[ai][bj][m][n];
    }
};
template <class Epi, class Sched, bool ALIGN_EPI = false, bool SP2 = false>
__device__ __forceinline__ void gemm_phase(PG8_LAS unsigned char* lds, const Gemm g, const Sched& S, const Epi& E, const int wave_in) {
    const int tid_l_ = wave_in * 64 + lane_id_asm();
    const int tid = tid_l_, wid = __builtin_amdgcn_readfirstlane(tid >> 6), lane = tid & 63, wr = wid >> 2, wc = wid & 3, fr = lane & 15, fq = lane >> 4;
    const int K = g.K, nt = K / BK;
    unsigned voffA[2], voffB[2];
#pragma unroll
    for (int i = 0; i < 2; ++i) { int R, C; stage_rc(tid * 16 + i * 8192, R, C); const int Rb = Epi::PERM ? ((R & ~31) + perm32(R & 31)) : R;
        voffA[i] = (unsigned)(R * g.ld + C) * 2u; voffB[i] = (unsigned)(Rb * g.ld + C) * 2u; }
    const size_t kstep = (size_t)(BK * 2);
    const size_t hstep = (size_t)HALF * g.ld * 2;
    const size_t tstep = 2 * hstep;
    const unsigned ldsw = (unsigned)wid * 1024u;
    const int aoff = lds_byte(wr * 64 + fr, fq * 8), boff = lds_byte(wc * 32 + fr, fq * 8);
#define PG8_SA(b, h) (((b) * 2 + (h)) * HTB)
#define PG8_SB(b, h) ((4 + (b) * 2 + (h)) * HTB)
#define PG8_STAGE(bufoff, gbase, voff) do { _Pragma("unroll") for (int _i = 0; _i < 2; ++_i) \
        __builtin_amdgcn_global_load_lds((const unsigned*)((const char*)(gbase) + (voff)[_i]), (PG8_LAS unsigned*)(lds + (bufoff) + ldsw + _i * 8192), 16, 0, 0); } while (0)
#define PG8_LDA(dst, b, h) do { _Pragma("unroll") for (int m = 0; m < 4; ++m) _Pragma("unroll") for (int k = 0; k < 2; ++k) dst[m][k] = *(const PG8_LAS bf16x8*)(lds + PG8_SA(b, h) + aoff + m * 2048 + k * 1024); } while (0)
#define PG8_LDB(dst, b, h) do { _Pragma("unroll") for (int n = 0; n < 2; ++n) _Pragma("unroll") for (int k = 0; k < 2; ++k) dst[n][k] = *(const PG8_LAS bf16x8*)(lds + PG8_SB(b, h) + boff + n * 2048 + k * 1024); } while (0)
#define PG8_MMA(ai, bj, At, Bt) do { __builtin_amdgcn_s_setprio(1); _Pragma("unroll") for (int m = 0; m < 4; ++m) _Pragma("unroll") for (int n = 0; n < 2; ++n) _Pragma("unroll") for (int k = 0; k < 2; ++k) \
        acc[ai][bj][m][n] = __builtin_amdgcn_mfma_f32_16x16x32_bf16(Bt[n][k], At[m][k], acc[ai][bj][m][n], 0, 0, 0); __builtin_amdgcn_s_setprio(0); } while (0)
#define PG8_WAIT_V(n) asm volatile("s_waitcnt vmcnt(" #n ")" ::: "memory")
#define PG8_WAIT_L(n) asm volatile("s_waitcnt lgkmcnt(" #n ")" ::: "memory")
#define PG8_BAR __builtin_amdgcn_s_barrier()
#define PG8_SCHED __builtin_amdgcn_sched_barrier(0)
    Unit cur, nxt; int ui = 0;
    if (!S.next(0, cur)) return;
    f32x4 acc[2][2][4][2];
#pragma unroll
    for (int a = 0; a < 2; ++a)
#pragma unroll
        for (int b = 0; b < 2; ++b)
#pragma unroll
            for (int m = 0; m < 4; ++m)
#pragma unroll
                for (int n = 0; n < 2; ++n) acc[a][b][m][n] = (f32x4){0.f, 0.f, 0.f, 0.f};
    bf16x8 At[4][2], B0[2][2], B1[2][2];
    const char* cA = (const char*)g.A + (size_t)cur.pm * tstep + (size_t)cur.pk * K * 2; const char* cB = (const char*)g.Bt + (size_t)cur.pn * tstep + (size_t)cur.pk * K * 2;
    S.a_ready(cur);
    if constexpr (SP2) {
        PG8_STAGE(PG8_SB(0, 0), cB, voffB); PG8_STAGE(PG8_SB(0, 1), cB + hstep, voffB); PG8_STAGE(PG8_SA(0, 0), cA, voffA); PG8_STAGE(PG8_SA(0, 1), cA + hstep, voffA);
        if (wr == 1) PG8_BAR;
        PG8_WAIT_V(2); PG8_BAR;
        PG8_STAGE(PG8_SB(1, 0), cB + kstep, voffB); PG8_STAGE(PG8_SA(1, 0), cA + kstep, voffA); PG8_STAGE(PG8_SB(1, 1), cB + hstep + kstep, voffB);
        PG8_WAIT_V(6); PG8_BAR;
    } else {
        PG8_STAGE(PG8_SB(0, 0), cB, voffB); PG8_STAGE(PG8_SA(0, 0), cA, voffA); PG8_STAGE(PG8_SB(0, 1), cB + hstep, voffB); PG8_STAGE(PG8_SA(0, 1), cA + hstep, voffA);
        if (wr == 1) PG8_BAR;
        PG8_WAIT_V(4); PG8_BAR;
        PG8_STAGE(PG8_SB(1, 0), cB + kstep, voffB); PG8_STAGE(PG8_SA(1, 0), cA + kstep, voffA); PG8_STAGE(PG8_SB(1, 1), cB + hstep + kstep, voffB);
        PG8_WAIT_V(6); PG8_BAR;
    }
    for (;;) {
        const bool has_next = S.next(ui + 1, nxt);
        const char* nA = has_next ? (const char*)g.A + (size_t)nxt.pm * tstep + (size_t)nxt.pk * K * 2 : cA; const char* nB = has_next ? (const char*)g.Bt + (size_t)nxt.pn * tstep + (size_t)nxt.pk * K * 2 : cB;
        for (int t = 0; t < nt; t += 2) {
            const bool last = (t == nt - 2);
            const char* a1 = cA + (size_t)(t + 1) * kstep;
            const char* a2 = last ? nA : cA + (size_t)(t + 2) * kstep; const char* b2 = last ? nB : cB + (size_t)(t + 2) * kstep;
            const char* a3 = a2 + kstep; const char* b3 = b2 + kstep;
            if (last && has_next) S.a_ready(nxt);
            if constexpr (SP2) {
            PG8_LDB(B0, 0, 0); PG8_LDB(B1, 0, 1); PG8_SCHED; PG8_LDA(At, 0, 0); PG8_STAGE(PG8_SA(1, 1), a1 + hstep, voffA);
            PG8_WAIT_V(8); PG8_WAIT_L(0); PG8_BAR; PG8_MMA(0, 0, At, B0); PG8_MMA(0, 1, At, B1); PG8_BAR; PG8_SCHED;
            PG8_LDA(At, 0, 1); PG8_STAGE(PG8_SB(0, 0), b2, voffB); PG8_STAGE(PG8_SB(0, 1), b2 + hstep, voffB); PG8_STAGE(PG8_SA(0, 0), a2, voffA);
            PG8_WAIT_V(8); PG8_WAIT_L(0); PG8_BAR; PG8_MMA(1, 0, At, B0); PG8_MMA(1, 1, At, B1); PG8_BAR; PG8_SCHED;
            PG8_LDB(B0, 1, 0); PG8_LDB(B1, 1, 1); PG8_SCHED; PG8_LDA(At, 1, 0); PG8_STAGE(PG8_SA(0, 1), a2 + hstep, voffA);
            PG8_WAIT_V(8); PG8_WAIT_L(0); PG8_BAR; PG8_MMA(0, 0, At, B0); PG8_MMA(0, 1, At, B1); PG8_BAR; PG8_SCHED;
            PG8_LDA(At, 1, 1); PG8_STAGE(PG8_SB(1, 0), b3, voffB); PG8_STAGE(PG8_SB(1, 1), b3 + hstep, voffB); PG8_STAGE(PG8_SA(1, 0), a3, voffA);
            PG8_WAIT_V(8); PG8_WAIT_L(0); PG8_BAR; PG8_MMA(1, 0, At, B0); PG8_MMA(1, 1, At, B1); PG8_BAR; PG8_SCHED;
            } else {
            PG8_LDB(B0, 0, 0); PG8_SCHED; PG8_LDA(At, 0, 0); PG8_STAGE(PG8_SA(1, 1), a1 + hstep, voffA);
            PG8_WAIT_L(8); PG8_BAR; PG8_WAIT_L(0); PG8_MMA(0, 0, At, B0); PG8_BAR; PG8_SCHED;
            PG8_LDB(B1, 0, 1); PG8_STAGE(PG8_SB(0, 0), b2, voffB);
            PG8_BAR; PG8_WAIT_L(0); PG8_MMA(0, 1, At, B1); PG8_BAR;
            PG8_LDA(At, 0, 1); PG8_STAGE(PG8_SA(0, 0), a2, voffA);
            PG8_BAR; PG8_WAIT_L(0); PG8_MMA(1, 0, At, B0); PG8_BAR; PG8_SCHED;
            PG8_STAGE(PG8_SB(0, 1), b2 + hstep, voffB);
            PG8_WAIT_V(6); PG8_BAR; PG8_MMA(1, 1, At, B1); PG8_BAR;
            PG8_LDB(B0, 1, 0); PG8_SCHED; PG8_LDA(At, 1, 0); PG8_STAGE(PG8_SA(0, 1), a2 + hstep, voffA);
            PG8_WAIT_L(8); PG8_BAR; PG8_WAIT_L(0); PG8_MMA(0, 0, At, B0); PG8_BAR; PG8_SCHED;
            PG8_LDB(B1, 1, 1); PG8_STAGE(PG8_SB(1, 0), b3, voffB);
            PG8_BAR; PG8_WAIT_L(0); PG8_MMA(0, 1, At, B1); PG8_BAR;
            PG8_LDA(At, 1, 1); PG8_STAGE(PG8_SA(1, 0), a3, voffA);
            PG8_BAR; PG8_WAIT_L(0); PG8_MMA(1, 0, At, B0); PG8_BAR; PG8_SCHED;
            PG8_STAGE(PG8_SB(1, 1), b3 + hstep, voffB);
            PG8_WAIT_V(6); PG8_BAR; PG8_MMA(1, 1, At, B1); PG8_BAR;
            }
        }
        if constexpr (ALIGN_EPI) { if (wr == 0) PG8_BAR; }
        if constexpr (!Epi::AFTER_DRAIN) { const int le_ = lane_id_asm(); E(acc, cur, wr, wc, le_ & 15, le_ >> 4); S.done(cur); }
        if (!has_next) break;
#pragma unroll
        for (int a = 0; a < 2; ++a)
#pragma unroll
            for (int b = 0; b < 2; ++b)
#pragma unroll
                for (int m = 0; m < 4; ++m)
#pragma unroll
                    for (int n = 0; n < 2; ++n) acc[a][b][m][n] = (f32x4){0.f, 0.f, 0.f, 0.f};
        cur = nxt; cA = nA; cB = nB; ++ui;
        if constexpr (ALIGN_EPI) { if (wr == 1) PG8_BAR; }
    }
    PG8_WAIT_V(0);
    if constexpr (!ALIGN_EPI) { if (wr == 0) PG8_BAR; }
    PG8_BAR;
    if constexpr (Epi::AFTER_DRAIN) { E.fused(acc, cur, wr, wc, fr, fq, lds, wid, lane); S.done(cur); }
#undef PG8_SA
#undef PG8_SB
#undef PG8_STAGE
#undef PG8_LDA
#undef PG8_LDB
#undef PG8_MMA
#undef PG8_WAIT_V
#undef PG8_WAIT_L
#undef PG8_BAR
#undef PG8_SCHED
}
}

namespace att {
typedef unsigned short bf16_t;
using bf16x8 = __attribute__((ext_vector_type(8))) short;
using s16x4  = __attribute__((ext_vector_type(4))) short;
using f32x16 = __attribute__((ext_vector_type(16))) float;
using u32x4  = __attribute__((ext_vector_type(4))) unsigned;
constexpr int NW = 8, QBLK = 32, KVBLK = 64;
constexpr float THR = 8.f;
constexpr int SHM_V = 16384, SHM_K = 16384;
#define KSWZ(row, colB) ((row) * 256 + ((colB) ^ (((row) & 15) << 4)))
#define SBAR() __builtin_amdgcn_sched_barrier(0)
__device__ __forceinline__ int crow(int r, int hi) { return (r & 3) + 8 * (r >> 2) + 4 * hi; }
__device__ __forceinline__ unsigned cvtpk(float lo, float hi) { unsigned r; asm volatile("v_cvt_pk_bf16_f32 %0, %1, %2" : "=v"(r) : "v"(lo), "v"(hi)); return r; }

constexpr float THRL = 11.0f;
template <bool FIRST> __device__ __forceinline__ void partialSM(f32x16& p0, f32x16& p1, float& m_reg, f32x16& negm, float& alpha) {
  float pmax = fmaxf(fmaxf(p0[0], p0[1]), p1[0]);
#pragma unroll
  for (int r = 2; r < 16; r += 2) pmax = fmaxf(fmaxf(pmax, p0[r]), p0[r + 1]);
#pragma unroll
  for (int r = 1; r < 15; r += 2) pmax = fmaxf(fmaxf(pmax, p1[r]), p1[r + 1]);
  pmax = fmaxf(pmax, p1[15]);
  { auto rr = __builtin_amdgcn_permlane32_swap(__float_as_uint(pmax), __float_as_uint(pmax), false, false);
    pmax = fmaxf(__uint_as_float(rr[0]), __uint_as_float(rr[1])); }
  alpha = 1.f;
  if (FIRST || !__builtin_expect(__all(pmax <= THRL), 1)) {
    const float dl = FIRST ? pmax : fmaxf(pmax, 0.f);
    m_reg += dl;
#pragma unroll
    for (int r = 0; r < 16; ++r) { p0[r] -= dl; p1[r] -= dl; }
#pragma unroll
    for (int r = 0; r < 16; ++r) negm[r] = -m_reg;
    if (!FIRST) alpha = __builtin_amdgcn_exp2f(-dl);
  }
#pragma unroll
  for (int r = 0; r < 16; ++r) p0[r] = __builtin_amdgcn_exp2f(p0[r]);
}
__device__ __forceinline__ void finishSM(f32x16& p0, f32x16& p1, float alpha, float& l_reg, bf16x8& pa0, bf16x8& pa1, bf16x8& pa2, bf16x8& pa3) {
#pragma unroll
  for (int r = 0; r < 16; ++r) p1[r] = __builtin_amdgcn_exp2f(p1[r]);
  float ps = 0;
#pragma unroll
  for (int r = 0; r < 16; ++r) ps += p0[r];
#pragma unroll
  for (int r = 0; r < 16; ++r) ps += p1[r];
  { auto rr = __builtin_amdgcn_permlane32_swap(__float_as_uint(ps), __float_as_uint(ps), false, false);
    ps = __uint_as_float(rr[0]) + __uint_as_float(rr[1]); }
  l_reg = l_reg * alpha + ps;
#define PK4(P, BASE, OUT) do { unsigned a0 = cvtpk(P[BASE + 0], P[BASE + 1]), a1 = cvtpk(P[BASE + 2], P[BASE + 3]);   \
    unsigned b0 = cvtpk(P[BASE + 4], P[BASE + 5]), b1 = cvtpk(P[BASE + 6], P[BASE + 7]);                              \
    auto r0 = __builtin_amdgcn_permlane32_swap(a0, b0, false, false); auto r1 = __builtin_amdgcn_permlane32_swap(a1, b1, false, false); \
    u32x4 w = {r0[0], r1[0], r0[1], r1[1]}; OUT = *reinterpret_cast<bf16x8*>(&w); } while (0)
  PK4(p0, 0, pa0); PK4(p0, 8, pa1); PK4(p1, 0, pa2); PK4(p1, 8, pa3);
#undef PK4
}
#define SBVS() __builtin_amdgcn_sched_barrier(0x6)
template <int DQ> __device__ __forceinline__ void qkt(f32x16& p0, f32x16& p1, const char* Ks, const bf16x8* qr, const f32x16& negm, int r32, int hi) {
  constexpr int ND = DQ / 16;
  const char* k0p = Ks + r32 * 256; const char* k1p = Ks + (32 + r32) * 256; const int sw = (r32 & 15) << 4;
  bf16x8 a0, a1, b0, b1;
#define KLD(x0, x1, d0) do { const int cb_ = (((d0) * 16 + hi * 8) * 2) ^ sw; x0 = *reinterpret_cast<const bf16x8*>(k0p + cb_); x1 = *reinterpret_cast<const bf16x8*>(k1p + cb_); } while (0)
  KLD(a0, a1, 0); KLD(b0, b1, 1); SBVS();
  p0 = __builtin_amdgcn_mfma_f32_32x32x16_bf16(a0, qr[0], negm, 0, 0, 0); p1 = __builtin_amdgcn_mfma_f32_32x32x16_bf16(a1, qr[0], negm, 0, 0, 0); SBVS();
#pragma unroll
  for (int d0 = 1; d0 < ND; ++d0) {
    if (d0 & 1) { if (d0 + 1 < ND) { KLD(a0, a1, d0 + 1); SBVS(); }
      p0 = __builtin_amdgcn_mfma_f32_32x32x16_bf16(b0, qr[d0], p0, 0, 0, 0); p1 = __builtin_amdgcn_mfma_f32_32x32x16_bf16(b1, qr[d0], p1, 0, 0, 0); SBVS(); }
    else { if (d0 + 1 < ND) { KLD(b0, b1, d0 + 1); SBVS(); }
      p0 = __builtin_amdgcn_mfma_f32_32x32x16_bf16(a0, qr[d0], p0, 0, 0, 0); p1 = __builtin_amdgcn_mfma_f32_32x32x16_bf16(a1, qr[d0], p1, 0, 0, 0); SBVS(); }
  }
#undef KLD
}
__device__ __forceinline__ int v_st(int k, int c) { const int kk = (k & ~0xC) | ((k & 4) << 1) | ((k & 8) >> 1); return ((kk >> 3) * 4 + (c >> 5)) * 512 + ((kk & 7) * 32 + (c & 31)) * 2; }
__device__ __forceinline__ int v_rd_base(int lane) { return ((lane & 3) << 3) | (((lane >> 2) & 3) << 6) | (((lane >> 4) & 1) << 5) | (((lane >> 5) & 1) << 8); }
constexpr int v_rd_off(int d0, int ks, int half) { return d0 * 512 + ks * 4096 + half * 2048; }
template <int OFF> __device__ __forceinline__ s16x4 tr_read(int vb) {
  s16x4 r; asm volatile("ds_read_b64_tr_b16 %0, %1 offset:%2" : "=&v"(r) : "v"(vb), "i"(OFF) : "memory"); return r;
}
template <int D0> __device__ __forceinline__ void pv_one(f32x16& od, int vb, bf16x8 pa0, bf16x8 pa1, bf16x8 pa2, bf16x8 pa3) {
  const s16x4 l0 = tr_read<v_rd_off(D0, 0, 0)>(vb), h0 = tr_read<v_rd_off(D0, 0, 1)>(vb), l1 = tr_read<v_rd_off(D0, 1, 0)>(vb), h1 = tr_read<v_rd_off(D0, 1, 1)>(vb);
  const s16x4 l2 = tr_read<v_rd_off(D0, 2, 0)>(vb), h2 = tr_read<v_rd_off(D0, 2, 1)>(vb), l3 = tr_read<v_rd_off(D0, 3, 0)>(vb), h3 = tr_read<v_rd_off(D0, 3, 1)>(vb);
  asm volatile("s_waitcnt lgkmcnt(0)" ::: "memory"); SBAR();
#define PK(L, H) (bf16x8){L[0], L[1], L[2], L[3], H[0], H[1], H[2], H[3]}
  od = __builtin_amdgcn_mfma_f32_32x32x16_bf16(pa0, PK(l0, h0), od, 0, 0, 0);
  od = __builtin_amdgcn_mfma_f32_32x32x16_bf16(pa1, PK(l1, h1), od, 0, 0, 0);
  od = __builtin_amdgcn_mfma_f32_32x32x16_bf16(pa2, PK(l2, h2), od, 0, 0, 0);
  od = __builtin_amdgcn_mfma_f32_32x32x16_bf16(pa3, PK(l3, h3), od, 0, 0, 0);
#undef PK
}
__device__ __forceinline__ void pv_d0(f32x16* o, int vb, bf16x8 pa0, bf16x8 pa1, bf16x8 pa2, bf16x8 pa3) {
  pv_one<0>(o[0], vb, pa0, pa1, pa2, pa3); pv_one<1>(o[1], vb, pa0, pa1, pa2, pa3);
}
struct VFrag { s16x4 l[2][4], h[2][4]; };
__device__ __forceinline__ void v_load(VFrag& f, int vb) {
  f.l[0][0] = tr_read<v_rd_off(0, 0, 0)>(vb); f.h[0][0] = tr_read<v_rd_off(0, 0, 1)>(vb); f.l[0][1] = tr_read<v_rd_off(0, 1, 0)>(vb); f.h[0][1] = tr_read<v_rd_off(0, 1, 1)>(vb);
  f.l[0][2] = tr_read<v_rd_off(0, 2, 0)>(vb); f.h[0][2] = tr_read<v_rd_off(0, 2, 1)>(vb); f.l[0][3] = tr_read<v_rd_off(0, 3, 0)>(vb); f.h[0][3] = tr_read<v_rd_off(0, 3, 1)>(vb);
  f.l[1][0] = tr_read<v_rd_off(1, 0, 0)>(vb); f.h[1][0] = tr_read<v_rd_off(1, 0, 1)>(vb); f.l[1][1] = tr_read<v_rd_off(1, 1, 0)>(vb); f.h[1][1] = tr_read<v_rd_off(1, 1, 1)>(vb);
  f.l[1][2] = tr_read<v_rd_off(1, 2, 0)>(vb); f.h[1][2] = tr_read<v_rd_off(1, 2, 1)>(vb); f.l[1][3] = tr_read<v_rd_off(1, 3, 0)>(vb); f.h[1][3] = tr_read<v_rd_off(1, 3, 1)>(vb);
}
__device__ __forceinline__ void pv_mma(f32x16* o, const VFrag& f, bf16x8 pa0, bf16x8 pa1, bf16x8 pa2, bf16x8 pa3) {
#define PK(L, H) (bf16x8){L[0], L[1], L[2], L[3], H[0], H[1], H[2], H[3]}
  asm volatile("s_waitcnt lgkmcnt(0)" ::: "memory"); SBAR();
  o[0] = __builtin_amdgcn_mfma_f32_32x32x16_bf16(pa0, PK(f.l[0][0], f.h[0][0]), o[0], 0, 0, 0);
  o[0] = __builtin_amdgcn_mfma_f32_32x32x16_bf16(pa1, PK(f.l[0][1], f.h[0][1]), o[0], 0, 0, 0);
  o[0] = __builtin_amdgcn_mfma_f32_32x32x16_bf16(pa2, PK(f.l[0][2], f.h[0][2]), o[0], 0, 0, 0);
  o[0] = __builtin_amdgcn_mfma_f32_32x32x16_bf16(pa3, PK(f.l[0][3], f.h[0][3]), o[0], 0, 0, 0);
  o[1] = __builtin_amdgcn_mfma_f32_32x32x16_bf16(pa0, PK(f.l[1][0], f.h[1][0]), o[1], 0, 0, 0);
  o[1] = __builtin_amdgcn_mfma_f32_32x32x16_bf16(pa1, PK(f.l[1][1], f.h[1][1]), o[1], 0, 0, 0);
  o[1] = __builtin_amdgcn_mfma_f32_32x32x16_bf16(pa2, PK(f.l[1][2], f.h[1][2]), o[1], 0, 0, 0);
  o[1] = __builtin_amdgcn_mfma_f32_32x32x16_bf16(pa3, PK(f.l[1][3], f.h[1][3]), o[1], 0, 0, 0);
#undef PK
}

template <int DQ>
__device__ __forceinline__ void attn_unit(const bf16_t* __restrict__ Qb, const bf16_t* __restrict__ Kh, const bf16_t* __restrict__ Kpe, const bf16_t* __restrict__ Vh,
                                          bf16_t* __restrict__ Ob, int seq, char* lds, const int wave_in) {
  constexpr int LDQ = (DQ == 96) ? 576 : 384, LDK = (DQ == 96) ? 384 : 128, LDO = 1024, ND = DQ / 16;
  const int tid = wave_in * 64 + pg8::lane_id_asm(), wid = wave_in, lane = tid & 63, r32 = lane & 31, hi = lane >> 5;
  char* V_lds = lds; char* K_lds = lds + 2 * SHM_V;
  float* ws = (float*)(lds + 2 * SHM_V + 2 * SHM_K) + wid * 64; float* li_l = ws; float* al_l = ws + 32;
  float m_reg = 0.f, l_reg = 0; f32x16 o[2] = {}; f32x16 negm = {}; bf16x8 qr[ND];
  const bf16_t* Qw = Qb + (unsigned)((wid * QBLK + r32) * LDQ + hi * 8);
#pragma unroll
  for (int d0 = 0; d0 < ND; ++d0) qr[d0] = *reinterpret_cast<const bf16x8*>(Qw + d0 * 16);
  const int sr = tid >> 3, sc = (tid & 7) * 8;
  const int pr = (tid >> 2) & 63, pc = (tid & 3) * 8;
  const int vst = v_st(sr, sc), kst = KSWZ(sr, sc * 2), pst = KSWZ(pr, (64 + pc) * 2);
  const int vb0 = (int)(uintptr_t)V_lds + v_rd_base(lane);
  struct { bf16x8 vs, ks, ps; } sr_[2];
  const unsigned voff = (unsigned)(sr * LDK + sc), poff = (unsigned)(pr * 32 + pc);
#define SLOAD(i, k0) do { const bf16_t* Vt_ = Vh + (size_t)(k0) * LDK; const bf16_t* Kt_ = Kh + (size_t)(k0) * LDK; \
    sr_[i].vs = *reinterpret_cast<const bf16x8*>(Vt_ + voff); sr_[i].ks = *reinterpret_cast<const bf16x8*>(Kt_ + voff); \
    if constexpr (DQ == 96) { const bf16_t* Pt_ = Kpe + (size_t)(k0) * 32; sr_[i].ps = *reinterpret_cast<const bf16x8*>(Pt_ + poff); } } while (0)
#define SWRITE(b, i) do { *(bf16x8*)(V_lds + (b) * SHM_V + vst) = sr_[i].vs; *(bf16x8*)(K_lds + (b) * SHM_K + kst) = sr_[i].ks; \
    if constexpr (DQ == 96) { if (tid < 256) *(bf16x8*)(K_lds + (b) * SHM_K + pst) = sr_[i].ps; } } while (0)
#define SWAIT() do { if constexpr (DQ == 96) asm volatile("s_waitcnt vmcnt(3)" ::: "memory"); else asm volatile("s_waitcnt vmcnt(2)" ::: "memory"); } while (0)
#define RESC(a) do { if (__any((a) < 1.f)) { if (hi == 0) al_l[r32] = (a); asm volatile("s_waitcnt lgkmcnt(0)" ::: "memory"); \
    _Pragma("unroll") for (int d = 0; d < 2; ++d) _Pragma("unroll") for (int r = 0; r < 16; ++r) o[d][r] *= al_l[crow(r, hi)]; } } while (0)
  f32x16 pA0, pA1, pB0, pB1; float alA, alB; bf16x8 pa0, pa1, pa2, pa3; const int NT = seq / KVBLK;
  constexpr int SE = 0, SO = 1;
  SLOAD(SE, 0); asm volatile("s_waitcnt vmcnt(0)" ::: "memory"); SWRITE(0, SE); __syncthreads();
  qkt<DQ>(pA0, pA1, K_lds, qr, negm, r32, hi); partialSM<true>(pA0, pA1, m_reg, negm, alA);
  SLOAD(SO, KVBLK); if (2 < NT) SLOAD(SE, 2 * KVBLK);
  SWAIT(); SWRITE(1, SO); __syncthreads();
  for (int j = 1; j + 1 < NT; j += 2) {
    SBAR(); qkt<DQ>(pB0, pB1, K_lds + SHM_K, qr, negm, r32, hi);
    finishSM(pA0, pA1, alA, l_reg, pa0, pa1, pa2, pa3); SBAR();
    SLOAD(SO, (j + 2) * KVBLK); SBAR();
    pv_d0(o, vb0, pa0, pa1, pa2, pa3); partialSM<false>(pB0, pB1, m_reg, negm, alB);
    __syncthreads(); SWAIT(); SWRITE(0, SE);
    RESC(alB); __syncthreads();
    SBAR(); qkt<DQ>(pA0, pA1, K_lds, qr, negm, r32, hi);
    finishSM(pB0, pB1, alB, l_reg, pa0, pa1, pa2, pa3); SBAR();
    if (j + 3 < NT) SLOAD(SE, (j + 3) * KVBLK); SBAR();
    pv_d0(o, vb0 + SHM_V, pa0, pa1, pa2, pa3); partialSM<false>(pA0, pA1, m_reg, negm, alA);
    __syncthreads(); SWAIT(); SWRITE(1, SO);
    RESC(alA); __syncthreads();
  }
  SBAR(); qkt<DQ>(pB0, pB1, K_lds + SHM_K, qr, negm, r32, hi);
  finishSM(pA0, pA1, alA, l_reg, pa0, pa1, pa2, pa3); SBAR();
  pv_d0(o, vb0, pa0, pa1, pa2, pa3); partialSM<false>(pB0, pB1, m_reg, negm, alB);
  __syncthreads(); RESC(alB);
  finishSM(pB0, pB1, alB, l_reg, pa0, pa1, pa2, pa3); SBAR();
  pv_d0(o, vb0 + SHM_V, pa0, pa1, pa2, pa3);
  if (hi == 0) li_l[r32] = l_reg; asm volatile("s_waitcnt lgkmcnt(0)" ::: "memory");
  float rli[16];
#pragma unroll
  for (int r = 0; r < 16; ++r) rli[r] = __builtin_amdgcn_rcpf(li_l[crow(r, hi)]);
  bf16_t* Ow = Ob + (long)(wid * QBLK) * LDO;
#pragma unroll
  for (int r = 0; r < 16; ++r) { int orow = crow(r, hi);
#pragma unroll
    for (int d0 = 0; d0 < 2; ++d0) { const float v = o[d0][r] * rli[r]; Ow[(long)orow * LDO + d0 * 32 + r32] = (bf16_t)(cvtpk(v, v) & 0xffffu); } }
  __syncthreads();
#undef SLOAD
#undef SWRITE
#undef SWAIT
#undef RESC
}
#undef SBAR
}

namespace d64 {
using bf16=__hip_bfloat16;
using bf16x8=__attribute__((ext_vector_type(8)))short;
using s16x4=__attribute__((ext_vector_type(4)))short;
using f32x16=__attribute__((ext_vector_type(16)))float;
using u32x4=__attribute__((ext_vector_type(4)))unsigned;
constexpr int D=64,LDQ=384,LDK=128,LDO=1024;
constexpr int NW=8,QBLK=32,QB=QBLK*NW,KVBLK=64;
__device__ __forceinline__ int crow(int r,int hi){return (r&3)+8*(r>>2)+4*hi;}
#define SBAR() __builtin_amdgcn_sched_barrier(0)
constexpr int NSLOT=3, SLOTB=8192;
constexpr int LDS_K=0, LDS_V=NSLOT*SLOTB, LDS_WS=2*NSLOT*SLOTB, LDS_OST=LDS_WS+NW*64*4, LDS_BYTES=LDS_OST+NW*4096;
constexpr float C2=0.125f*1.4426950408889634f;
__device__ __forceinline__ void glds16(const void*gsrc,unsigned lds_dst){unsigned keep;
  asm volatile("s_mov_b32 %0, m0\n\ts_mov_b32 m0, %2\n\ts_nop 0\n\tglobal_load_lds_dwordx4 %1, off\n\ts_mov_b32 m0, %0":"=&s"(keep):"v"(gsrc),"s"(lds_dst):"memory");}
__device__ __forceinline__ float max3f(float a,float b,float c){float r;asm("v_max3_f32 %0, %1, %2, %3":"=v"(r):"v"(a),"v"(b),"v"(c));return r;}
__device__ __forceinline__ float max2f(float a,float b){float r;asm("v_max_f32_e32 %0, %1, %2":"=v"(r):"v"(a),"v"(b));return r;}
__device__ __forceinline__ float fadd_s(float a,float b){float r;asm("v_add_f32_e32 %0, %1, %2":"=v"(r):"v"(a),"v"(b));return r;}
__device__ __forceinline__ float fsub_s(float a,float b){float r;asm("v_sub_f32_e32 %0, %1, %2":"=v"(r):"v"(a),"v"(b));return r;}
typedef float f32x2_t __attribute__((ext_vector_type(2))); typedef __bf16 bf16x2_t __attribute__((ext_vector_type(2)));
__device__ __forceinline__ unsigned cvtpk_s(float lo,float hi){f32x2_t v={lo,hi};bf16x2_t b=__builtin_convertvector(v,bf16x2_t);return __builtin_bit_cast(unsigned,b);}
#define WAIT_BAR(N) asm volatile("s_waitcnt vmcnt(" #N ") lgkmcnt(0)\n\ts_barrier":::"memory")

__device__ __forceinline__ void qkt(f32x16&p0,f32x16&p1,const char*Kslot,const bf16x8*qr,const f32x16&negm,int r32,int hi){
  const char*kb=Kslot+hi*1024+r32*16;
  #pragma unroll
  for(int d0=0;d0<4;++d0){
    const bf16x8 b0=*reinterpret_cast<const bf16x8*>(kb+d0*2048);
    const bf16x8 b1=*reinterpret_cast<const bf16x8*>(kb+d0*2048+512);
    if(d0==0){p0=__builtin_amdgcn_mfma_f32_32x32x16_bf16(b0,qr[0],negm,0,0,0);p1=__builtin_amdgcn_mfma_f32_32x32x16_bf16(b1,qr[0],negm,0,0,0);}
    else{p0=__builtin_amdgcn_mfma_f32_32x32x16_bf16(b0,qr[d0],p0,0,0,0);p1=__builtin_amdgcn_mfma_f32_32x32x16_bf16(b1,qr[d0],p1,0,0,0);}}
}
typedef __attribute__((address_space(3))) const char* lds_cptr;
typedef short v4i16_t __attribute__((ext_vector_type(4)));
__device__ __forceinline__ void kload8(bf16x8*kf,lds_cptr kp){
  kf[0]=*(const __attribute__((address_space(3))) bf16x8*)(kp);      kf[1]=*(const __attribute__((address_space(3))) bf16x8*)(kp+512);
  kf[2]=*(const __attribute__((address_space(3))) bf16x8*)(kp+2048); kf[3]=*(const __attribute__((address_space(3))) bf16x8*)(kp+2560);
  kf[4]=*(const __attribute__((address_space(3))) bf16x8*)(kp+4096); kf[5]=*(const __attribute__((address_space(3))) bf16x8*)(kp+4608);
  kf[6]=*(const __attribute__((address_space(3))) bf16x8*)(kp+6144); kf[7]=*(const __attribute__((address_space(3))) bf16x8*)(kp+6656);
}
__device__ __forceinline__ void kload2(bf16x8*kf,lds_cptr kp,int j){ kf[2*j]=*(const __attribute__((address_space(3))) bf16x8*)(kp+j*2048); kf[2*j+1]=*(const __attribute__((address_space(3))) bf16x8*)(kp+j*2048+512); }
__device__ __forceinline__ s16x4 vtr(lds_cptr p){ return __builtin_bit_cast(s16x4,__builtin_amdgcn_ds_read_tr16_b64_v4i16((__attribute__((address_space(3))) v4i16_t*)p)); }
__device__ __forceinline__ float rowmax(const f32x16&p0,const f32x16&p1){
  float a=max3f(p0[0],p0[1],p1[0]),b=max3f(p0[2],p0[3],p1[1]);a=max3f(a,p1[2],p1[3]);
  #pragma unroll
  for(int r=4;r<16;r+=4){a=max3f(a,p0[r],p0[r+1]);b=max3f(b,p0[r+2],p0[r+3]);a=max3f(a,p1[r],p1[r+1]);b=max3f(b,p1[r+2],p1[r+3]);}
  const float m=max2f(a,b);
  auto rr=__builtin_amdgcn_permlane32_swap(__float_as_uint(m),__float_as_uint(m),false,false);
  return max2f(__uint_as_float(rr[0]),__uint_as_float(rr[1]));
}
__device__ __forceinline__ void pv(f32x16*o,int vb,bf16x8 pa0,bf16x8 pa1,bf16x8 pa2,bf16x8 pa3){
  #pragma unroll
  for(int d0=0;d0<2;++d0){s16x4 lo[4],hi[4];
    #pragma unroll
    for(int ks=0;ks<4;++ks){
      asm volatile("ds_read_b64_tr_b16 %0,%1 offset:%c2":"=&v"(lo[ks]):"v"(vb),"i"(d0*4096+ks*1024):"memory");
      asm volatile("ds_read_b64_tr_b16 %0,%1 offset:%c2":"=&v"(hi[ks]):"v"(vb),"i"(d0*4096+ks*1024+512):"memory");}
    asm volatile("s_waitcnt lgkmcnt(0)":::"memory");SBAR();
    #define PK(k) (bf16x8){lo[k][0],lo[k][1],lo[k][2],lo[k][3],hi[k][0],hi[k][1],hi[k][2],hi[k][3]}
    o[d0]=__builtin_amdgcn_mfma_f32_32x32x16_bf16(pa0,PK(0),o[d0],0,0,0);
    o[d0]=__builtin_amdgcn_mfma_f32_32x32x16_bf16(pa1,PK(1),o[d0],0,0,0);
    o[d0]=__builtin_amdgcn_mfma_f32_32x32x16_bf16(pa2,PK(2),o[d0],0,0,0);
    o[d0]=__builtin_amdgcn_mfma_f32_32x32x16_bf16(pa3,PK(3),o[d0],0,0,0);
    #undef PK
  }
}

#ifndef ATTN_STORE16
#define ATTN_STORE16(p,v) (*(u32x4*)(p)=(v))
#endif
template<int THRL,bool PE> __device__ __forceinline__ void attn_unit(const bf16*Qu,const bf16*__restrict__ Kh,const bf16*__restrict__ Kpe,const bf16*__restrict__ Vh,bf16*Ou,const int NT,char*shm,const int wave_in){
  constexpr int LDQ_=PE?576:384, LDK_=PE?384:128, NDQ=PE?6:4, LDS_KPE=LDS_BYTES;
  const int lane=pg8::lane_id_asm(),tid=wave_in*64+lane,r32=lane&31,hi=lane>>5; const int wid=wave_in; (void)tid;
  const bf16*Qw=Qu+(long)(wid*QBLK)*LDQ_;
  const unsigned lds0=(unsigned)(uintptr_t)shm;
  float*wsf=(float*)(shm+LDS_WS)+wid*64;
  const bf16*ksrc=Kh+(long)lane*LDK_+wid*8; const bf16*psrc=PE?Kpe+(long)lane*32+(wid&3)*8:nullptr;
  const bf16*vsrc=Vh+(long)(16*(wid&3)+(lane>>2))*LDK_+(wid>>2)*32+(lane&3)*8;
  const unsigned kdst=lds0+LDS_K+wid*1024, vdst=lds0+LDS_V+wid*1024, pdst=lds0+LDS_KPE+(wid&3)*1024;
  #define DMA_K(t,slot) do{ glds16(ksrc+(long)(t)*KVBLK*LDK_,(unsigned)__builtin_amdgcn_readfirstlane(kdst+(slot))); \
    if constexpr(PE) glds16(psrc+(long)(t)*KVBLK*32,(unsigned)__builtin_amdgcn_readfirstlane(pdst+((slot)>>1))); }while(0)
  #define DMA_V(t,slot) glds16(vsrc+(long)(t)*KVBLK*LDK_,(unsigned)__builtin_amdgcn_readfirstlane(vdst+(slot)))
  const int vb0=(int)(lds0+LDS_V)+((lane>>4)&1)*32+(lane&3)*8+(4*hi+((lane&15)>>2))*64;
  const char*Kbase=shm+LDS_K; bf16x8 kf[8]; bf16x8 kpf[4];
  const lds_cptr shm3=(lds_cptr)shm; const lds_cptr kp0=shm3+LDS_K+hi*1024+r32*16; const lds_cptr pp0=shm3+LDS_KPE+hi*1024+r32*16; const lds_cptr vp0=shm3+LDS_V+((lane>>4)&1)*32+(lane&3)*8+(4*hi+((lane&15)>>2))*64;
  DMA_K(0,0);DMA_V(0,0);DMA_K(1,SLOTB);
  bf16x8 qr[NDQ];
  #pragma unroll
  for(int d0=0;d0<NDQ;++d0)qr[d0]=*reinterpret_cast<const bf16x8*>(&Qw[(long)r32*LDQ_+d0*16+hi*8]);
  float mhat=0.f,l_reg=0.f;f32x16 o[2];o[0]=f32x16{};o[1]=f32x16{};f32x16 negm=f32x16{};asm volatile("":"+v"(negm));
  #define CMASK(P0,P1,t) do{}while(0)
  bool resc=false;
  #define START(P0,P1) do{ const float rm=rowmax(P0,P1); resc=false; \
    { const float dl=rm; mhat=fadd_s(mhat,dl); \
      _Pragma("unroll") for(int r=0;r<16;++r){P0[r]=fsub_s(P0[r],dl);P1[r]=fsub_s(P1[r],dl);} \
      _Pragma("unroll") for(int r=0;r<16;++r)negm[r]=-mhat; asm volatile("":"+v"(negm)); } \
    _Pragma("unroll") for(int r=0;r<16;++r)P0[r]=__builtin_amdgcn_exp2f(P0[r]); }while(0)
  #define RESC() do{ if(resc){ asm volatile("s_waitcnt lgkmcnt(0)":::"memory"); \
      _Pragma("unroll") for(int d_=0;d_<2;++d_) _Pragma("unroll") for(int r=0;r<16;++r)o[d_][r]*=wsf[crow(r,hi)]; } }while(0)
  f32x16 pA0,pA1,pB0,pB1;
  int sl_prev=0,sl_cur=0,sl_next=SLOTB;
  #define ROT() do{sl_prev=sl_cur;sl_cur=sl_next;sl_next=(sl_next==(NSLOT-1)*SLOTB)?0:sl_next+SLOTB;}while(0)
  DMA_K(2,2*SLOTB);
  if constexpr(PE){WAIT_BAR(5);}else{WAIT_BAR(3);}
  qkt(pA0,pA1,Kbase,qr,negm,r32,hi);
  if constexpr(PE){ const char*pb=shm+LDS_KPE+hi*1024+r32*16;
    _Pragma("unroll") for(int j=0;j<2;++j){ const bf16x8 b0=*reinterpret_cast<const bf16x8*>(pb+j*2048), b1=*reinterpret_cast<const bf16x8*>(pb+j*2048+512);
      pA0=__builtin_amdgcn_mfma_f32_32x32x16_bf16(b0,qr[4+j],pA0,0,0,0); pA1=__builtin_amdgcn_mfma_f32_32x32x16_bf16(b1,qr[4+j],pA1,0,0,0);} }
  asm volatile("s_nop 15\n\ts_nop 7":"+v"(pA0),"+v"(pA1));CMASK(pA0,pA1,0);
  START(pA0,pA1);
  _Pragma("unroll") for(int r=0;r<16;++r)pA1[r]=__builtin_amdgcn_exp2f(pA1[r]);
  WAIT_BAR(0);
  DMA_K(3,0);DMA_V(1,SLOTB);
  ROT();
  kload8(kf,kp0+sl_cur); if constexpr(PE){ kload2(kpf,pp0+(sl_cur>>1),0); kload2(kpf,pp0+(sl_cur>>1),1); }
  if constexpr(PE){WAIT_BAR(3);}else{WAIT_BAR(2);}
  s16x4 vlo[8],vhi[8]; u32x4 pw0,pw1,pw2,pw3;
  #define PKW(P,B) cvtpk_s(P[B],P[B+1])
  #define PAF(k) __builtin_bit_cast(bf16x8,pw##k)
  #define VFR(i) (bf16x8){vlo[i][0],vlo[i][1],vlo[i][2],vlo[i][3],vhi[i][0],vhi[i][1],vhi[i][2],vhi[i][3]}
  #define PIN(x) asm volatile("":"+v"(x))
  #define MX3(a,b,c) __builtin_fmaxf(__builtin_fmaxf((a),(b)),(c))
  #define GAPA(MF,A0,A1,A2,A3,W0,W1,PW) do{ MF; sacc+=A0; sacc+=A1; sacc+=A2; sacc+=A3; PIN(sacc); W0; W1; PIN(PW); SBAR(); }while(0)
  #define EX(v) __builtin_amdgcn_exp2f(v)
  #define GAPB(MF,X,B) do{ MF; X[B]=EX(X[B]); X[B+1]=EX(X[B+1]); X[B+2]=EX(X[B+2]); X[B+3]=EX(X[B+3]); PIN(X); SBAR(); }while(0)
  #define VRD(i) do{ vlo[i]=vtr(vp_+(((i)>>2)*4096+((i)&3)*1024)); vhi[i]=vtr(vp_+(((i)>>2)*4096+((i)&3)*1024+512)); }while(0)
  #define KRD(G,j) do{ if(G){ kload2(kf,kp0+sl_next,j); if constexpr(PE){ if((j)<2) kload2(kpf,pp0+(sl_next>>1),j); } SBAR(); } }while(0)
  #define STEP(C0,C1,P0,P1,t,GK,GV,GL) do{ SBAR(); \
    const lds_cptr vp_=vp0+sl_prev; \
    VRD(0); SBAR(); float sacc=(P0[0]+P0[1]); \
    GAPA(C0=__builtin_amdgcn_mfma_f32_32x32x16_bf16(kf[0],qr[0],negm,0,0,0), P0[2],P0[3],P0[4],P0[5],     pw0[0]=PKW(P0,0), pw0[1]=PKW(P0,2), pw0); \
    VRD(4); SBAR(); GAPA(C1=__builtin_amdgcn_mfma_f32_32x32x16_bf16(kf[1],qr[0],negm,0,0,0), P0[6],P0[7],P0[8],P0[9],     pw0[2]=PKW(P0,4), pw0[3]=PKW(P0,6), pw0); \
    VRD(1); SBAR(); GAPA(C0=__builtin_amdgcn_mfma_f32_32x32x16_bf16(kf[2],qr[1],C0,0,0,0),   P0[10],P0[11],P0[12],P0[13], pw1[0]=PKW(P0,8), pw1[1]=PKW(P0,10), pw1); \
    VRD(5); SBAR(); GAPA(C1=__builtin_amdgcn_mfma_f32_32x32x16_bf16(kf[3],qr[1],C1,0,0,0),   P0[14],P0[15],P1[0],P1[1],   pw1[2]=PKW(P0,12),pw1[3]=PKW(P0,14), pw1); \
    VRD(2); SBAR(); GAPA(C0=__builtin_amdgcn_mfma_f32_32x32x16_bf16(kf[4],qr[2],C0,0,0,0),   P1[2],P1[3],P1[4],P1[5],     pw2[0]=PKW(P1,0), pw2[1]=PKW(P1,2), pw2); \
    VRD(6); SBAR(); GAPA(C1=__builtin_amdgcn_mfma_f32_32x32x16_bf16(kf[5],qr[2],C1,0,0,0),   P1[6],P1[7],P1[8],P1[9],     pw2[2]=PKW(P1,4), pw2[3]=PKW(P1,6), pw2); \
    VRD(3); SBAR(); GAPA(C0=__builtin_amdgcn_mfma_f32_32x32x16_bf16(kf[6],qr[3],C0,0,0,0),   P1[10],P1[11],P1[12],P1[13], pw3[0]=PKW(P1,8), pw3[1]=PKW(P1,10), pw3); \
    VRD(7); SBAR(); GAPA(C1=__builtin_amdgcn_mfma_f32_32x32x16_bf16(kf[7],qr[3],C1,0,0,0),   P1[14],P1[15],0.f,0.f,       pw3[2]=PKW(P1,12),pw3[3]=PKW(P1,14), pw3); \
    if constexpr(PE){ C0=__builtin_amdgcn_mfma_f32_32x32x16_bf16(kpf[0],qr[4],C0,0,0,0); C1=__builtin_amdgcn_mfma_f32_32x32x16_bf16(kpf[1],qr[4],C1,0,0,0); \
      C0=__builtin_amdgcn_mfma_f32_32x32x16_bf16(kpf[2],qr[5],C0,0,0,0); C1=__builtin_amdgcn_mfma_f32_32x32x16_bf16(kpf[3],qr[5],C1,0,0,0); } \
    l_reg+=sacc; \
    if(GK){DMA_K((t)+3,sl_cur);} if(GV){DMA_V((t)+1,sl_next);} \
    CMASK(C0,C1,t); \
    { float a=MX3(C0[0],C0[1],C1[0]),b=MX3(C0[2],C0[3],C1[1]); a=MX3(a,C1[2],C1[3]); \
      _Pragma("unroll") for(int r=4;r<16;r+=4){a=MX3(a,C0[r],C0[r+1]);b=MX3(b,C0[r+2],C0[r+3]);a=MX3(a,C1[r],C1[r+1]);b=MX3(b,C1[r+2],C1[r+3]);} \
      float rm=__builtin_fmaxf(a,b); { auto rr=__builtin_amdgcn_permlane32_swap(__float_as_uint(rm),__float_as_uint(rm),false,false); rm=__builtin_fmaxf(__uint_as_float(rr[0]),__uint_as_float(rr[1])); } \
      resc=false; \
      if(__builtin_expect(__any(rm>(float)THRL),0)){ const float dl=__builtin_fmaxf(rm,0.f); mhat+=dl; \
        _Pragma("unroll") for(int r=0;r<16;++r){C0[r]-=dl;C1[r]-=dl;} \
        _Pragma("unroll") for(int r=0;r<16;++r)negm[r]=-mhat; asm volatile("":"+v"(negm)); \
        const float f=__builtin_amdgcn_exp2f(-dl); l_reg*=f; if(hi==0)wsf[r32]=f; resc=true; } } \
    SBAR(); \
    GAPB(o[0]=__builtin_amdgcn_mfma_f32_32x32x16_bf16(PAF(0),VFR(0),o[0],0,0,0), C0,0); \
    GAPB(o[1]=__builtin_amdgcn_mfma_f32_32x32x16_bf16(PAF(0),VFR(4),o[1],0,0,0), C0,4); \
    KRD(GL,0); GAPB(o[0]=__builtin_amdgcn_mfma_f32_32x32x16_bf16(PAF(1),VFR(1),o[0],0,0,0), C0,8); \
    KRD(GL,1); GAPB(o[1]=__builtin_amdgcn_mfma_f32_32x32x16_bf16(PAF(1),VFR(5),o[1],0,0,0), C0,12); \
    KRD(GL,2); GAPB(o[0]=__builtin_amdgcn_mfma_f32_32x32x16_bf16(PAF(2),VFR(2),o[0],0,0,0), C1,0); \
    KRD(GL,3); GAPB(o[1]=__builtin_amdgcn_mfma_f32_32x32x16_bf16(PAF(2),VFR(6),o[1],0,0,0), C1,4); \
    GAPB(o[0]=__builtin_amdgcn_mfma_f32_32x32x16_bf16(PAF(3),VFR(3),o[0],0,0,0), C1,8); \
    GAPB(o[1]=__builtin_amdgcn_mfma_f32_32x32x16_bf16(PAF(3),VFR(7),o[1],0,0,0), C1,12); \
    }while(0)
  int t=1;
  #undef CMASK
  #define CMASK(P0,P1,t) do{}while(0)
  for(;t+5<NT;t+=2){
    STEP(pB0,pB1,pA0,pA1,t,true,true,true);     if constexpr(PE){WAIT_BAR(3);}else{WAIT_BAR(2);} RESC(); ROT();
    STEP(pA0,pA1,pB0,pB1,t+1,true,true,true);   if constexpr(PE){WAIT_BAR(3);}else{WAIT_BAR(2);} RESC(); ROT();
  }
  #undef CMASK
  #define CMASK(P0,P1,t) do{}while(0)
  #define ENDW(tt) do{ if((tt)+3<NT){ if constexpr(PE){WAIT_BAR(3);}else{WAIT_BAR(2);} } else if((tt)+2<NT){WAIT_BAR(1);} else {WAIT_BAR(0);} }while(0)
  for(;t+1<NT;t+=2){
    STEP(pB0,pB1,pA0,pA1,t,(t+3<NT),(t+1<NT),(t+1<NT));       ENDW(t);   RESC(); ROT();
    STEP(pA0,pA1,pB0,pB1,t+1,(t+4<NT),(t+2<NT),(t+2<NT));     ENDW(t+1); RESC(); ROT();
  }
  STEP(pB0,pB1,pA0,pA1,NT-1,false,false,false); RESC();
  { float sacc=pB0[0]+pB0[1]; _Pragma("unroll") for(int r=2;r<16;++r)sacc+=pB0[r]; _Pragma("unroll") for(int r=0;r<16;++r)sacc+=pB1[r]; l_reg+=sacc;
    pw0=(u32x4){PKW(pB0,0),PKW(pB0,2),PKW(pB0,4),PKW(pB0,6)};pw1=(u32x4){PKW(pB0,8),PKW(pB0,10),PKW(pB0,12),PKW(pB0,14)};pw2=(u32x4){PKW(pB1,0),PKW(pB1,2),PKW(pB1,4),PKW(pB1,6)};pw3=(u32x4){PKW(pB1,8),PKW(pB1,10),PKW(pB1,12),PKW(pB1,14)};
    SBAR(); pv(o,vb0+sl_cur,PAF(0),PAF(1),PAF(2),PAF(3)); }
  #undef PKW
  #undef PAF
  #undef VFR
  #undef PIN
  #undef MX3
  #undef GAPA
  #undef GAPB
  #undef EX
  #undef VRD
  #undef KRD
  #undef STEP
  #undef ENDW
  {auto rr=__builtin_amdgcn_permlane32_swap(__float_as_uint(l_reg),__float_as_uint(l_reg),false,false);l_reg=__uint_as_float(rr[0])+__uint_as_float(rr[1]);}
  if(hi==0)wsf[32+r32]=l_reg;asm volatile("s_waitcnt lgkmcnt(0)":::"memory");
  float rli[16];
  #pragma unroll
  for(int r=0;r<16;++r)rli[r]=__builtin_amdgcn_rcpf(wsf[32+crow(r,hi)]);
  bf16*Ow=Ou+(long)(wid*QBLK)*LDO;
  { bf16*stg=(bf16*)(shm+LDS_OST)+wid*2048;
    #pragma unroll
    for(int r=0;r<16;++r){const int orow=crow(r,hi);
      #pragma unroll
      for(int d0=0;d0<2;++d0)stg[orow*64+d0*32+r32]=__float2bfloat16(o[d0][r]*rli[r]);}
    asm volatile("s_waitcnt lgkmcnt(0)":::"memory");
    #pragma unroll
    for(int i=0;i<4;++i){const int row=i*8+(lane>>3),ch=lane&7; const u32x4 v=*(const u32x4*)(stg+row*64+ch*8); ATTN_STORE16(Ow+(long)row*LDO+ch*8,v);} }
  asm volatile("s_waitcnt lgkmcnt(0)\n\ts_barrier":::"memory");
  #undef DMA_K
  #undef DMA_V
  #undef CMASK
  #undef START
  #undef RESC
  #undef ROT
}
#undef SBAR
#undef WAIT_BAR
}

typedef unsigned short bf16_t;
typedef float f32x4 __attribute__((ext_vector_type(4)));
typedef float f32x2 __attribute__((ext_vector_type(2)));
typedef unsigned u32x2 __attribute__((ext_vector_type(2)));
typedef unsigned u32x4 __attribute__((ext_vector_type(4)));
#define LAS __attribute__((address_space(3)))
#define XB_TMO      128
#define XB_XCNT(j)  (256  + 64 * (j))
#define XB_XSUB(j)  (1280 + 64 * (j))
#define XB_XGEN(j)  (2304 + 64 * (j))
#define XB_TOP      3328
#define XB_TOPGEN   3392
#define XCD_BAR_WORDS 3456
#define XB_SPIN_CAP (1u << 18)

__device__ __forceinline__ unsigned xb_ld(unsigned* p)              { return __hip_atomic_load(p, __ATOMIC_RELAXED, __HIP_MEMORY_SCOPE_AGENT); }
__device__ __forceinline__ unsigned xb_add(unsigned* p, unsigned v) { return __hip_atomic_fetch_add(p, v, __ATOMIC_RELAXED, __HIP_MEMORY_SCOPE_AGENT); }
__device__ __forceinline__ unsigned xb_xcc_id() { return (unsigned)__builtin_amdgcn_s_getreg((3 << 11) | 20) & 0xFu; }
#define XB_SPIN(cond, bar) do { unsigned _sp = 0; while (cond) { __builtin_amdgcn_s_sleep(1); \
    if ((++_sp & 255u) == 0u) { if (xb_ld(&(bar)[XB_TMO])) break; if (_sp > XB_SPIN_CAP) { atomicAdd(&(bar)[XB_TMO], 1u); break; } } } } while (0)

struct XcdBarrier {
    unsigned* bar; unsigned x;
    volatile LAS unsigned* st;
};

__device__ __forceinline__ XcdBarrier xcd_barrier_post(unsigned* bar, volatile LAS unsigned* st, const bool t0) {
    XcdBarrier b; b.bar = bar; b.x = xb_xcc_id(); b.st = st;
    if (t0) (void)xb_add(&bar[XB_XCNT(b.x)], 1u);
    return b;
}
__device__ __forceinline__ void xcd_barrier_complete(unsigned* bar, unsigned x, unsigned& nloc, unsigned& nx) {
    const unsigned G = gridDim.x * gridDim.y * gridDim.z;
    unsigned sum, cnt, mine, sp = 0u;
    for (;;) {
        sum = 0u; cnt = 0u; mine = 0u;
#pragma unroll
        for (unsigned j = 0; j < 16; ++j) { const unsigned c = xb_ld(&bar[XB_XCNT(j)]); sum += c; cnt += (c > 0u) ? 1u : 0u; mine = (j == x) ? c : mine; }
        if (sum == G) break;
        __builtin_amdgcn_s_sleep(1);
        if ((++sp & 255u) == 0u) { if (xb_ld(&bar[XB_TMO])) break; if (sp > XB_SPIN_CAP) { atomicAdd(&bar[XB_TMO], 1u); break; } }
    }
    nloc = mine > 0u ? mine : 1u; nx = cnt > 0u ? cnt : 1u;
}

__device__ __forceinline__ void xcd_barrier(const XcdBarrier& b, const bool t0) {
    asm volatile("s_waitcnt vmcnt(0)" ::: "memory");
    __syncthreads();
    if (t0) {
        unsigned* bar = b.bar;
        __builtin_amdgcn_s_waitcnt(0);
        unsigned nloc = b.st[0], nx = b.st[1];
        if (nloc == 0u) { xcd_barrier_complete(bar, b.x, nloc, nx); b.st[0] = nloc; b.st[1] = nx; }
        const unsigned old = xb_add(&bar[XB_XSUB(b.x)], 1u);
        const unsigned gen = old / nloc;
        if (old + 1u == (gen + 1u) * nloc) {
            __builtin_amdgcn_fence(__ATOMIC_RELEASE, "agent");
            asm volatile("s_waitcnt vmcnt(0)" ::: "memory");
            const unsigned og = xb_add(&bar[XB_TOP], 1u);
            const unsigned tg = og / nx;
            if (og + 1u == (tg + 1u) * nx) xb_add(&bar[XB_TOPGEN], 1u);
            else XB_SPIN(xb_ld(&bar[XB_TOPGEN]) == tg, bar);
            __builtin_amdgcn_fence(__ATOMIC_ACQUIRE, "agent");
            xb_add(&bar[XB_XGEN(b.x)], 1u);
            asm volatile("s_waitcnt vmcnt(0)" ::: "memory");
        } else {
            XB_SPIN(xb_ld(&bar[XB_XGEN(b.x)]) == gen, bar);
            __builtin_amdgcn_fence(__ATOMIC_ACQUIRE, "agent");
            asm volatile("s_waitcnt vmcnt(0)" ::: "memory");
        }
    }
    __syncthreads();
}

constexpr size_t MiB = 1u << 20;
constexpr size_t WS_MOD = 1 * MiB, WS_ROPEM = 2 * MiB, WS_ROPEG = 3 * MiB, WS_Z = 5 * MiB;
constexpr size_t WS_WIN = 10 * MiB, WS_WUQ = 26 * MiB, WS_WUKV = 28 * MiB, WS_WO = 29 * MiB, WS_W1 = 37 * MiB, WS_W2 = 69 * MiB;
constexpr size_t WS_U = 101 * MiB, WS_Y = WS_U  , WS_PART = 167 * MiB  , WS_OV = 233 * MiB;
constexpr size_t WS_HM = WS_OV, WS_H = WS_OV, WS_MQ = WS_OV, WS_MK = 271 * MiB, WS_MV = 296 * MiB;
constexpr size_t WS_CKV = 365 * MiB, WS_CQ = 374 * MiB, WS_KPE = 391 * MiB, WS_GK = 394 * MiB, WS_GV = 403 * MiB, WS_GQ = 412 * MiB, WS_O = 437 * MiB, WS_END = 503 * MiB;
static_assert(WS_MQ + (size_t)MROWS * 576 * 2 <= WS_MK && WS_MK + (size_t)MROWS * 384 * 2 <= WS_MV && WS_MV + (size_t)MROWS * 384 * 2 <= WS_H + (size_t)MROWS * HP * 2, "overlay");
static_assert(WS_H + (size_t)MROWS * HP * 2 <= WS_CKV && WS_CKV + (size_t)MROWS * 256 <= WS_CQ && WS_CQ + (size_t)MROWS * 512 <= WS_KPE && WS_KPE + (size_t)MROWS * 64 <= WS_GK, "map1");
static_assert(WS_GK + (size_t)MROWS * 256 <= WS_GV && WS_GV + (size_t)MROWS * 256 <= WS_GQ && WS_GQ + (size_t)MROWS * 768 <= WS_O && WS_O + (size_t)MROWS * 2048 <= WS_END, "map2");
static_assert(WS_HM + (size_t)MROWS * DFF * 2 <= WS_END, "map3");
#ifndef ATT_REPS
#define ATT_REPS 1
#endif
#ifndef TDIV
#define TDIV 1
#endif
#ifndef TSEL
#define TSEL -1
#endif
constexpr float QSC64 = 0.125f * 1.4426950408889634f, QSC96 = 0.10206207261596575f * 1.4426950408889634f;
constexpr int LDS_BYTES = 135168;

struct Params { const float* in[21]; float* out; unsigned char* ws; };
enum { I_X = 0, I_C, I_CTX, I_CCTX, I_WADA, I_BADA, I_WIN, I_GCQ, I_WUQ, I_GCKV, I_WUKV, I_GQN, I_GKN, I_WCONV, I_WO, I_LN1G, I_LN1B, I_W1, I_W2, I_LN2G, I_LN2B };

template <int CTRL> __device__ __forceinline__ float dppf(float v) { return __int_as_float(__builtin_amdgcn_update_dpp(0, __float_as_int(v), CTRL, 0xf, 0xf, true)); }
__device__ __forceinline__ float half_sum(float v) {
    v += dppf<0xB1>(v); v += dppf<0x4E>(v); v += dppf<0x141>(v); v += dppf<0x140>(v);
    auto r = __builtin_amdgcn_permlane16_swap(__float_as_uint(v), __float_as_uint(v), false, false);
    return __uint_as_float(r[0]) + __uint_as_float(r[1]);
}
__device__ __forceinline__ float wave_sum(float v) {
    v = half_sum(v);
    auto r = __builtin_amdgcn_permlane32_swap(__float_as_uint(v), __float_as_uint(v), false, false);
    return __uint_as_float(r[0]) + __uint_as_float(r[1]);
}
__device__ __forceinline__ unsigned pk2(float lo, float hi) { unsigned r; asm volatile("v_cvt_pk_bf16_f32 %0, %1, %2" : "=v"(r) : "v"(lo), "v"(hi)); return r; }
__device__ __forceinline__ float bflo(unsigned w) { return __uint_as_float(w << 16); }
__device__ __forceinline__ float bfhi(unsigned w) { return __uint_as_float(w & 0xffff0000u); }

__device__ __forceinline__ void transpose_item(const float* W, int K, int N, bf16_t* WT, LAS float* scr, int item, int lane) {
    const int nblk = N / 32, kb = item / nblk, nb = item % nblk, k0 = 64 * kb, n0 = 32 * nb;
#pragma unroll 8
    for (int i = 0; i < 32; ++i) { const int kk = 2 * i + (lane >> 5); scr[kk * 33 + (lane & 31)] = W[(size_t)(k0 + kk) * N + n0 + (lane & 31)]; }
    asm volatile("s_waitcnt lgkmcnt(0)" ::: "memory");
    const int c = lane & 7;
#pragma unroll
    for (int j = 0; j < 4; ++j) { const int n = (lane >> 3) + 8 * j; const LAS float* s = scr + (8 * c) * 33 + n;
        u32x4 o; o.x = pk2(s[0 * 33], s[1 * 33]); o.y = pk2(s[2 * 33], s[3 * 33]); o.z = pk2(s[4 * 33], s[5 * 33]); o.w = pk2(s[6 * 33], s[7 * 33]);
        *(u32x4*)(WT + (size_t)(n0 + n) * K + k0 + 8 * c) = o; }
    asm volatile("s_waitcnt lgkmcnt(0)" ::: "memory");
}

struct RowInfo { int b, i, v; bool isctx; };
__device__ __forceinline__ RowInfo row_info(int m) { RowInfo r; r.b = m / LTOK; r.i = m - r.b * LTOK; r.isctx = r.i < CTX; r.v = r.isctx ? 4 : r.b; return r; }

__global__ void __launch_bounds__(512, 2) fwd_megakernel(Params p) {
    extern __shared__ __attribute__((aligned(16))) unsigned char lds[];
    cg::grid_group grid = cg::this_grid();
#if TSEL >= 0
#define TSL ((unsigned*)(lds + 133120))
#define TST (blockIdx.x == 0 && wave == 0 && pg8::lane_id_asm() == 0)
#define TINIT() do { if (TST) { for (int k = 0; k < 16; ++k) TSL[k] = 0; TSL[12] = (unsigned)__builtin_amdgcn_s_memrealtime(); } } while (0)
#define TBODY(k) do { if (TST) { const unsigned t_ = (unsigned)__builtin_amdgcn_s_memrealtime(); const unsigned d_ = t_ - TSL[12]; TSL[k] += d_; TSL[11] += d_; TSL[12] = t_; } } while (0)
#define TSYNC() do { if (TST) { const unsigned t_ = (unsigned)__builtin_amdgcn_s_memrealtime(); const unsigned d_ = t_ - TSL[12]; TSL[10] += d_; TSL[11] += d_; TSL[12] = t_; } } while (0)
#else
#define TINIT() do {} while (0)
#define TBODY(k) do {} while (0)
#define TSYNC() do {} while (0)
#endif
#define XB_T0 (wave == 0 && pg8::lane_id_asm() == 0)
#define XB_ST ((volatile LAS unsigned*)((LAS unsigned char*)lds + 133376))
#define XB_BAR ((unsigned*)WSB())
#define GSYNC_CG(k) do { TBODY(k); grid.sync(); TSYNC(); } while (0)
#define GSYNC(k) do { TBODY(k); { XcdBarrier xb_; xb_.bar = XB_BAR; xb_.x = xb_xcc_id(); xb_.st = XB_ST; xcd_barrier(xb_, XB_T0); } TSYNC(); } while (0)
    const int wave = __builtin_amdgcn_readfirstlane(threadIdx.x >> 6);
    TINIT();
    if (XB_T0) { XB_ST[0] = 0u; XB_ST[1] = 0u; }
    __syncthreads();
#define G ((int)gridDim.x)
#define bx ((int)blockIdx.x)
#define vcu ((G % 8 == 0) ? (bx % 8) * (G / 8) + bx / 8 : bx)
#define gw (bx * 8 + wave)
#define NGW (G * 8)
#define LAUN3() int G_ = G, bx_ = bx, wave_ = wave; asm volatile("" : "+s"(G_), "+s"(bx_), "+s"(wave_))
#define KP() ({ const __attribute__((address_space(4))) Params* k_ = (const __attribute__((address_space(4))) Params*)__builtin_amdgcn_kernarg_segment_ptr(); asm volatile("" : "+s"(k_)); k_; })
#define WSB() ((unsigned char*)KP()->ws)
#define DEFWS(w) \
    float* MOD = (float*)((w) + WS_MOD); float* ROPEM = (float*)((w) + WS_ROPEM); float* ROPEG = (float*)((w) + WS_ROPEG); float* Z = (float*)((w) + WS_Z); \
    bf16_t* WIN = (bf16_t*)((w) + WS_WIN); bf16_t* WUQ = (bf16_t*)((w) + WS_WUQ); bf16_t* WUKV = (bf16_t*)((w) + WS_WUKV); bf16_t* WO = (bf16_t*)((w) + WS_WO); \
    bf16_t* W1 = (bf16_t*)((w) + WS_W1); bf16_t* W2 = (bf16_t*)((w) + WS_W2); \
    bf16_t* U = (bf16_t*)((w) + WS_U); bf16_t* Y = (bf16_t*)((w) + WS_Y); bf16_t* HM = (bf16_t*)((w) + WS_HM); bf16_t* H = (bf16_t*)((w) + WS_H); \
    bf16_t* MQ = (bf16_t*)((w) + WS_MQ); bf16_t* MK = (bf16_t*)((w) + WS_MK); bf16_t* MV = (bf16_t*)((w) + WS_MV); \
    bf16_t* CKV = (bf16_t*)((w) + WS_CKV); bf16_t* CQ = (bf16_t*)((w) + WS_CQ); bf16_t* KPE = (bf16_t*)((w) + WS_KPE); \
    bf16_t* GK = (bf16_t*)((w) + WS_GK); bf16_t* GV = (bf16_t*)((w) + WS_GV); bf16_t* GQ = (bf16_t*)((w) + WS_GQ); bf16_t* OC = (bf16_t*)((w) + WS_O); float* PART = (float*)((w) + WS_PART); (void)PART; \
    (void)MOD; (void)ROPEM; (void)ROPEG; (void)Z; (void)WIN; (void)WUQ; (void)WUKV; (void)WO; (void)W1; (void)W2; (void)U; (void)Y; (void)HM; (void)H; (void)MQ; (void)MK; (void)MV; \
    (void)CKV; (void)CQ; (void)KPE; (void)GK; (void)GV; (void)GQ; (void)OC;

    {
        unsigned char* ws_b_ = WSB(); DEFWS(ws_b_)
        const int lane = pg8::lane_id_asm(), tid = wave * 64 + lane;
        if (bx == 0) { unsigned* bar_ = (unsigned*)ws_b_; for (int i = tid; i < XCD_BAR_WORDS; i += 512) bar_[i] = 0u; }
        LAS float* scr = (LAS float*)((LAS unsigned char*)lds + wave * 16384);
        constexpr int I_IN = 16 * 57, I_UQ = 4 * 18, I_UKV = 2 * 24, I_O = 16 * 32, I_1 = 16 * 128, I_2 = 64 * 32, PER = I_IN + I_UQ + I_UKV + I_O + I_1 + I_2;
        for (int it = gw; it < DEPTH * PER; it += NGW) {
            const int l = it / PER; int r = it - l * PER;
            if (r < I_IN) { transpose_item(KP()->in[I_WIN] + (size_t)l * DM * IN_COLS, DM, IN_COLS, WIN + (size_t)l * HP * DM, scr, r, lane); continue; } r -= I_IN;
            if (r < I_UQ) { transpose_item(KP()->in[I_WUQ] + (size_t)l * 256 * 576, 256, 576, WUQ + (size_t)l * 768 * 256, scr, r, lane); continue; } r -= I_UQ;
            if (r < I_UKV) { transpose_item(KP()->in[I_WUKV] + (size_t)l * 128 * 768, 128, 768, WUKV + (size_t)l * 768 * 128, scr, r, lane); continue; } r -= I_UKV;
            if (r < I_O) { transpose_item(KP()->in[I_WO] + (size_t)l * DM * DM, DM, DM, WO + (size_t)l * DM * DM, scr, r, lane); continue; } r -= I_O;
            if (r < I_1) { transpose_item(KP()->in[I_W1] + (size_t)l * DM * DFF, DM, DFF, W1 + (size_t)l * DFF * DM, scr, r, lane); continue; } r -= I_1;
            transpose_item(KP()->in[I_W2] + (size_t)l * DFF * DM, DFF, DM, W2 + (size_t)l * DM * DFF, scr, r, lane);
        }
        const int gt = bx * 512 + tid, NGT = G * 512;
        for (int idx = gt; idx < DEPTH * 224 * 128; idx += NGT) { const int l = idx / (224 * 128), r = idx % (224 * 128);
            *(u32x4*)(WIN + ((size_t)l * HP + IN_COLS) * DM + (size_t)r * 8) = (u32x4){0u, 0u, 0u, 0u}; }
        for (int idx = gt; idx < DEPTH * 192 * 32; idx += NGT) { const int l = idx / (192 * 32), r = idx % (192 * 32);
            *(u32x4*)(WUQ + ((size_t)l * 768 + 576) * 256 + (size_t)r * 8) = (u32x4){0u, 0u, 0u, 0u}; }
        for (int idx = gt; idx < SEQ * 16; idx += NGT) { const int pos = idx >> 4, i = idx & 15; const int rw = pos >> 6, cl = pos & 63;
            const float inv = powf(10000.f, -(float)(i & 7) / 8.f); const float ang = (float)(i < 8 ? rw : cl) * inv;
            ROPEM[2 * idx] = cosf(ang); ROPEM[2 * idx + 1] = sinf(ang); }
        for (int idx = gt; idx < SEQ * 32; idx += NGT) { const int pos = idx >> 5, i = idx & 31; const int rw = pos >> 6, cl = pos & 63;
            const float inv = powf(10000.f, -(float)(i & 15) / 16.f); const float ang = (float)(i < 16 ? rw : cl) * inv;
            ROPEG[2 * idx] = cosf(ang); ROPEG[2 * idx + 1] = sinf(ang); }
        __syncthreads();
        float* sil = (float*)lds;
        float* part = (float*)lds + 5 * 1024;
        { const float* c_in = KP()->in[I_C]; const float* cc_in = KP()->in[I_CCTX];
        for (int idx = tid; idx < 5 * 1024; idx += 512) { const int v = idx >> 10, k = idx & 1023; const float c = (v < 4) ? c_in[v * 1024 + k] : cc_in[k]; sil[idx] = c / (1.f + __expf(-c)); } }
        const float* wada_ = KP()->in[I_WADA]; const float* bada_ = KP()->in[I_BADA];
        __syncthreads();
        for (int it = bx; it < DEPTH * 96; it += G) { const int l = it / 96, jb = it % 96; const int j = jb * 64 + lane;
            const float* wp = wada_ + ((size_t)l * DM + wave * 128) * 6144 + j;
            float a0 = 0, a1 = 0, a2 = 0, a3 = 0, a4 = 0;
#pragma unroll 8
            for (int k = 0; k < 128; ++k) { const float w = wp[(size_t)k * 6144]; const int kk = wave * 128 + k;
                a0 += sil[kk] * w; a1 += sil[1024 + kk] * w; a2 += sil[2048 + kk] * w; a3 += sil[3072 + kk] * w; a4 += sil[4096 + kk] * w; }
            part[(wave * 5 + 0) * 64 + lane] = a0; part[(wave * 5 + 1) * 64 + lane] = a1; part[(wave * 5 + 2) * 64 + lane] = a2; part[(wave * 5 + 3) * 64 + lane] = a3; part[(wave * 5 + 4) * 64 + lane] = a4;
            __syncthreads();
            if (tid < 320) { const int v = tid >> 6, c = tid & 63; float s = bada_[l * 6144 + jb * 64 + c];
#pragma unroll
                for (int w = 0; w < 8; ++w) s += part[(w * 5 + v) * 64 + c];
                MOD[((size_t)l * 5 + v) * 6144 + jb * 64 + c] = s; }
            __syncthreads();
        }
    }
    GSYNC_CG(0);
    (void)xcd_barrier_post(XB_BAR, XB_ST, XB_T0);
    { DEFWS(WSB())
    const int lane = pg8::lane_id_asm(); const float* xin_ = KP()->in[I_X]; const float* cin_ = KP()->in[I_CTX];
    for (int m = gw; m < MROWS; m += NGW) { const RowInfo ri = row_info(m);
        const float* xr = ri.isctx ? cin_ + ((size_t)ri.b * CTX + ri.i) * DM : xin_ + ((size_t)ri.b * SEQ + ri.i - CTX) * DM;
        const float* md = MOD + (size_t)ri.v * 6144;
#pragma unroll
        for (int j = 0; j < 4; ++j) { const int col = 4 * lane + 256 * j; const f32x4 x = *(const f32x4*)(xr + col), sh = *(const f32x4*)(md + col), sc = *(const f32x4*)(md + 1024 + col);
            const f32x4 u = x * (1.f + sc) + sh; u32x2 w; w.x = pk2(u[0], u[1]); w.y = pk2(u[2], u[3]); *(u32x2*)(U + (size_t)m * DM + col) = w; }
    } }
    GSYNC(0);

#pragma unroll 1
    for (int l = 0; l < DEPTH; ++l) {
        { DEFWS(WSB()) LAUN3(); pg8::Gemm g{U, WIN + (size_t)l * HP * DM, MROWS, HP, DM, DM}; pg8::StaticOrder S; S.init(MROWS, HP, G_, bx_);
          pg8::EpiStore<0> E{H, HPI, IN_COLS};
          pg8::gemm_phase<pg8::EpiStore<0>, pg8::StaticOrder, true, true>((LAS unsigned char*)lds, g, S, E, wave_); }
        GSYNC(1);
        {
            DEFWS(WSB())
            const int lane = pg8::lane_id_asm();
            const f32x2* gckv = (const f32x2*)(KP()->in[I_GCKV] + l * 128); const f32x2* gkn = (const f32x2*)(KP()->in[I_GKN] + l * 64);
            const f32x2* gcq = (const f32x2*)(KP()->in[I_GCQ] + l * 256); const f32x2* gqn = (const f32x2*)(KP()->in[I_GQN] + l * 64);
            const f32x2* wc0 = (const f32x2*)(KP()->in[I_WCONV] + (size_t)l * 768); const f32x2* wc1 = wc0 + 128; const f32x2* wc2 = wc0 + 256;
            const f32x2* rM = (const f32x2*)ROPEM; const f32x2* rG = (const f32x2*)ROPEG;
            const f32x2 gckv_l = gckv[lane], gkn_l = gkn[lane & 31], gcq0_l = gcq[lane], gcq1_l = gcq[64 + lane], gqn_l = gqn[lane & 31];
            f32x2 wcv[2][3];
#pragma unroll
            for (int j = 0; j < 2; ++j) { wcv[j][0] = wc0[lane + 64 * j]; wcv[j][1] = wc1[lane + 64 * j]; wcv[j][2] = wc2[lane + 64 * j]; }
#define RED4(v, NSTEP) _Pragma("unroll") for (int q_ = 0; q_ < 4; ++q_) v[q_] = ((NSTEP) == 64) ? wave_sum(v[q_]) : half_sum(v[q_]);
            for (int ch = wave * G + bx; ch < MROWS / 4; ch += NGW) { const int m0 = ch * 4; const RowInfo ri = row_info(m0); const bool lat = !ri.isctx; const int pos0 = ri.i - CTX;
                const unsigned* hr0 = (const unsigned*)(H + (size_t)m0 * HPI);
#if TSEL >= 0
                unsigned tp0_ = 0; if (TST) tp0_ = (unsigned)__builtin_amdgcn_s_memrealtime();
#endif
                unsigned wkv[4], wpe[4], wgk[4], wgv[4], wq0[4], wq1[4], wgq[4][3];
#pragma unroll
                for (int q = 0; q < 4; ++q) { const unsigned* hr = hr0 + (size_t)q * (HPI / 2);
                    wkv[q] = hr[lane]; wpe[q] = hr[64 + (lane & 15)]; wgk[q] = hr[80 + lane]; wgv[q] = hr[144 + lane]; wq0[q] = hr[208 + lane]; wq1[q] = hr[272 + lane];
#pragma unroll
                    for (int j = 0; j < 3; ++j) wgq[q][j] = hr[336 + 64 * j + lane]; }
                f32x2 csM[4], csG[4];
#pragma unroll
                for (int q = 0; q < 4; ++q) { csM[q] = lat ? rM[(pos0 + q) * 16 + (lane & 15)] : (f32x2){1.f, 0.f}; csG[q] = lat ? rG[(pos0 + q) * 32 + (lane & 31)] : (f32x2){1.f, 0.f}; }
                const int seqlen = lat ? SEQ : CTX, t0 = lat ? pos0 : ri.i; const bool hp = t0 > 0, hn = t0 + 4 < seqlen; const float zp = hp ? 1.f : 0.f, zn = hn ? 1.f : 0.f;
                unsigned cvh[2][6], cvc[2][6], cvb[2][4];
#pragma unroll
                for (int q = 0; q < 6; ++q) { const int qq = (q == 0 && !hp) ? 1 : (q == 5 && !hn) ? 4 : q; const unsigned* hq = hr0 + (ptrdiff_t)(qq - 1) * (HPI / 2);
#pragma unroll
                    for (int j = 0; j < 2; ++j) { cvh[j][q] = hq[528 + lane + 64 * j]; cvc[j][q] = hq[784 + lane + 64 * j]; } }
#pragma unroll
                for (int q = 0; q < 4; ++q)
#pragma unroll
                    for (int j = 0; j < 2; ++j) cvb[j][q] = (hr0 + (size_t)q * (HPI / 2))[656 + lane + 64 * j];
                {
                    float ss[4];
#pragma unroll
                    for (int q = 0; q < 4; ++q) { const float a = bflo(wkv[q]), b2 = bfhi(wkv[q]); ss[q] = a * a + b2 * b2; }
                    RED4(ss, 64)
#if TSEL >= 0
                    if (TST) { const unsigned t_ = (unsigned)__builtin_amdgcn_s_memrealtime(); TSL[13] += t_ - tp0_; tp0_ = t_; }
#endif
#pragma unroll
                    for (int q = 0; q < 4; ++q) { const float r = rsqrtf(ss[q] * (1.f / 128.f) + LN_EPS); ((unsigned*)(CKV + (size_t)(m0 + q) * 128))[lane] = pk2(bflo(wkv[q]) * r * gckv_l.x, bfhi(wkv[q]) * r * gckv_l.y); } }
                if (lane < 16) {
#pragma unroll
                    for (int q = 0; q < 4; ++q) { const float a = bflo(wpe[q]), b2 = bfhi(wpe[q]); ((unsigned*)(KPE + (size_t)(m0 + q) * 32))[lane] = pk2(a * csM[q].x - b2 * csM[q].y, a * csM[q].y + b2 * csM[q].x); } }
                {
                    float ss[4];
#pragma unroll
                    for (int q = 0; q < 4; ++q) { const float a = bflo(wgk[q]), b2 = bfhi(wgk[q]); ss[q] = a * a + b2 * b2; }
                    RED4(ss, 32)
#pragma unroll
                    for (int q = 0; q < 4; ++q) { const float r = rsqrtf(ss[q] * (1.f / 64.f) + LN_EPS); const float a = bflo(wgk[q]) * r * gkn_l.x, b2 = bfhi(wgk[q]) * r * gkn_l.y;
                        ((unsigned*)(GK + (size_t)(m0 + q) * 128))[lane] = pk2(a * csG[q].x - b2 * csG[q].y, a * csG[q].y + b2 * csG[q].x); } }
#pragma unroll
                for (int q = 0; q < 4; ++q) ((unsigned*)(GV + (size_t)(m0 + q) * 128))[lane] = wgv[q];
                {
                    float ss[4];
#pragma unroll
                    for (int q = 0; q < 4; ++q) { const float a0 = bflo(wq0[q]), b0 = bfhi(wq0[q]), a1 = bflo(wq1[q]), b1 = bfhi(wq1[q]); ss[q] = (a0 * a0 + b0 * b0) + (a1 * a1 + b1 * b1); }
                    RED4(ss, 64)
#pragma unroll
                    for (int q = 0; q < 4; ++q) { const float r = rsqrtf(ss[q] * (1.f / 256.f) + LN_EPS); unsigned* o = (unsigned*)(CQ + (size_t)(m0 + q) * 256);
                        o[lane] = pk2(bflo(wq0[q]) * r * gcq0_l.x, bfhi(wq0[q]) * r * gcq0_l.y); o[64 + lane] = pk2(bflo(wq1[q]) * r * gcq1_l.x, bfhi(wq1[q]) * r * gcq1_l.y); } }
#pragma unroll
                for (int j = 0; j < 3; ++j) {
                    float ss[4];
#pragma unroll
                    for (int q = 0; q < 4; ++q) { const float a = bflo(wgq[q][j]), b2 = bfhi(wgq[q][j]); ss[q] = a * a + b2 * b2; }
                    RED4(ss, 32)
#pragma unroll
                    for (int q = 0; q < 4; ++q) { const float r = rsqrtf(ss[q] * (1.f / 64.f) + LN_EPS); const float a = bflo(wgq[q][j]) * r * gqn_l.x, b2 = bfhi(wgq[q][j]) * r * gqn_l.y;
                        ((unsigned*)(GQ + (size_t)(m0 + q) * 384))[64 * j + lane] = pk2((a * csG[q].x - b2 * csG[q].y) * QSC64, (a * csG[q].y + b2 * csG[q].x) * QSC64); } }
                {
#pragma unroll
                    for (int j = 0; j < 2; ++j) { const int ix = lane + 64 * j; float pa[6], pb[6];
#pragma unroll
                        for (int q = 0; q < 6; ++q) { const float z = (q == 0) ? zp : (q == 5) ? zn : 1.f; pa[q] = bflo(cvh[j][q]) * bflo(cvc[j][q]) * z; pb[q] = bfhi(cvh[j][q]) * bfhi(cvc[j][q]) * z; }
#pragma unroll
                        for (int q = 0; q < 4; ++q) { const unsigned bb = cvb[j][q];
                            const float oa = bflo(bb) * (wcv[j][0].x * pa[q] + wcv[j][1].x * pa[q + 1] + wcv[j][2].x * pa[q + 2]);
                            const float ob = bfhi(bb) * (wcv[j][0].y * pb[q] + wcv[j][1].y * pb[q + 1] + wcv[j][2].y * pb[q + 2]);
                            ((unsigned*)(OC + (size_t)(m0 + q) * DM))[384 + ix] = pk2(oa, ob); } }
                }
#if TSEL >= 0
                if (TST) { const unsigned t_ = (unsigned)__builtin_amdgcn_s_memrealtime(); TSL[14] += t_ - tp0_; }
#endif
            }
#undef RED4
        }
        GSYNC(2);
        { DEFWS(WSB()) LAUN3(); pg8::Gemm g{CQ, WUQ + (size_t)l * 768 * 256, MROWS, 768, 256, 256}; pg8::StaticOrder S; S.init(MROWS, 768, G_, bx_);
          pg8::EpiUQ E{MQ, ROPEM, QSC96};
          pg8::gemm_phase<pg8::EpiUQ, pg8::StaticOrder, true, false>((LAS unsigned char*)lds, g, S, E, wave_); }
        { DEFWS(WSB()) LAUN3(); pg8::Gemm g{CKV, WUKV + (size_t)l * 768 * 128, MROWS, 768, 128, 128}; pg8::StaticOrder S; S.init(MROWS, 768, G_, bx_);
          pg8::EpiUKV E{MK, MV};
          pg8::gemm_phase<pg8::EpiUKV, pg8::StaticOrder, true, true>((LAS unsigned char*)lds, g, S, E, wave_); }
        GSYNC(3);
        {
            DEFWS(WSB())
            const int nrounds = (l < DEPTH - 1) ? 7 : 6;
            for (int i_ = 0; i_ < nrounds * ATT_REPS; ++i_) { const int i = (ATT_REPS == 1) ? i_ : (i_ % nrounds);
                int type, b, h, qrow0, seq;
                if (i < 6) { const int u = vcu + 256 * i; type = u / 768; const int rem = u % 768; b = rem / 192; h = (rem >> 5) % 6; const int qb = rem & 31; qrow0 = b * LTOK + CTX + qb * 256; seq = LTOK; }
                else { if (vcu >= 48) continue; type = vcu / 24; b = (vcu % 24) / 6; h = vcu % 6; qrow0 = b * LTOK; seq = CTX; }
                const size_t kr = (size_t)b * LTOK;
                if (type == 0) d64::attn_unit<8, true>((const d64::bf16*)(MQ + (size_t)qrow0 * 576 + h * 96), (const d64::bf16*)(MK + kr * 384 + h * 64), (const d64::bf16*)(KPE + kr * 32), (const d64::bf16*)(MV + kr * 384 + h * 64), (d64::bf16*)(OC + (size_t)qrow0 * DM + h * 64), seq / 64, (char*)lds, wave);
                else d64::attn_unit<8, false>((const d64::bf16*)(GQ + (size_t)qrow0 * 384 + h * 64), (const d64::bf16*)(GK + kr * 128 + (h / 3) * 64), nullptr, (const d64::bf16*)(GV + kr * 128 + (h / 3) * 64), (d64::bf16*)(OC + (size_t)qrow0 * DM + 384 + h * 64), seq / 64, (char*)lds, wave);
            }
        }
        GSYNC(4);
        { DEFWS(WSB()) LAUN3(); pg8::Gemm g{OC, WO + (size_t)l * DM * DM, MROWS, DM, DM, DM}; pg8::RowOrder S; S.init(DM, G_, bx_, true);
          pg8::EpiStore<0> E{Y, DM, DM};
          pg8::gemm_phase<pg8::EpiStore<0>, pg8::RowOrder, true, true>((LAS unsigned char*)lds, g, S, E, wave_); }
        if (l < DEPTH - 1) { DEFWS(WSB()) LAUN3(); pg8::Gemm g{OC, WO + (size_t)l * DM * DM, MROWS, DM, 256, DM}; pg8::CtxSplitOrder S; S.init(DM, 4, G_, bx_);
          pg8::EpiPart E{PART, DM, (size_t)1024 * DM};
          pg8::gemm_phase<pg8::EpiPart, pg8::CtxSplitOrder, true, true>((LAS unsigned char*)lds, g, S, E, wave_); }
        GSYNC(5);
#pragma unroll 1
        for (int which = 0; which < 2; ++which) {
            {
                DEFWS(WSB())
                const int lane = pg8::lane_id_asm();
                const float* lg = KP()->in[which ? I_LN2G : I_LN1G] + l * DM; const float* lb = KP()->in[which ? I_LN2B : I_LN1B] + l * DM;
                const float* xin_ = KP()->in[I_X]; const float* cin_ = KP()->in[I_CTX]; float* out_ = KP()->out;
                const bool first = (l == 0 && which == 0); const bool wantu = !(which == 1 && l == DEPTH - 1);
                const int KS = which ? 8 : 4;
                f32x4 g4[4], b4[4];
#pragma unroll
                for (int j = 0; j < 4; ++j) { g4[j] = *(const f32x4*)(lg + 4 * lane + 256 * j); b4[j] = *(const f32x4*)(lb + 4 * lane + 256 * j); }
                for (int ch = wave * G + bx; ch < MROWS / 2; ch += NGW) { const int m0 = ch * 2; const RowInfo ri = row_info(m0);
                    if (ri.isctx && l == DEPTH - 1) continue;
                    const size_t zoff = ((size_t)ri.b * CTX + ri.i) * DM, xoff = ((size_t)ri.b * SEQ + ri.i - CTX) * DM;
                    const float* xo = ri.isctx ? (first ? cin_ + zoff : Z + zoff) : (first ? xin_ + xoff : out_ + xoff);
                    float* xn = ri.isctx ? Z + zoff : out_ + xoff;
                    const float* md = MOD + ((size_t)l * 5 + ri.v) * 6144; const float* gate = md + (which ? 5 : 2) * 1024;
                    const float* md2 = which ? MOD + ((size_t)(wantu ? l + 1 : l) * 5 + ri.v) * 6144 : md + 3 * 1024;
                    f32x4 gt[4], sh[4], sc1[4];
#pragma unroll
                    for (int j = 0; j < 4; ++j) { const int col = 4 * lane + 256 * j; gt[j] = *(const f32x4*)(gate + col); sh[j] = *(const f32x4*)(md2 + col); sc1[j] = 1.f + *(const f32x4*)(md2 + 1024 + col); }
                    const float* pp0 = PART + zoff;
                    { const int r = 0;
                        f32x4 t[2][4]; float s[2] = {0.f, 0.f};
#pragma unroll
                        for (int q = 0; q < 2; ++q)
#pragma unroll
                            for (int j = 0; j < 4; ++j) { const int col = 4 * lane + 256 * j; const size_t ro = (size_t)(r + q) * DM + col; const f32x4 x = __builtin_nontemporal_load((const f32x4*)(xo + ro));
                                f32x4 y;
                                if (ri.isctx) { const float* pp = pp0 + ro; f32x4 yy[8];
#pragma unroll
                                    for (int k = 0; k < 4; ++k) yy[k] = *(const f32x4*)(pp + (size_t)k * 1024 * DM);
                                    if (KS == 8) {
#pragma unroll
                                        for (int k = 4; k < 8; ++k) yy[k] = *(const f32x4*)(pp + (size_t)k * 1024 * DM);
                                        y = ((yy[0] + yy[1]) + (yy[2] + yy[3])) + ((yy[4] + yy[5]) + (yy[6] + yy[7])); }
                                    else y = (yy[0] + yy[1]) + (yy[2] + yy[3]); }
                                else { const u32x2 yw = *(const u32x2*)(Y + (size_t)m0 * DM + ro); y = (f32x4){bflo(yw.x), bfhi(yw.x), bflo(yw.y), bfhi(yw.y)}; }
                                t[q][j] = ALPHA * x + gt[j] * y; s[q] += (t[q][j][0] + t[q][j][1]) + (t[q][j][2] + t[q][j][3]); }
                        s[0] = wave_sum(s[0]); s[1] = wave_sum(s[1]);
                        float s2[2] = {0.f, 0.f};
#pragma unroll
                        for (int q = 0; q < 2; ++q) { const float mean = s[q] * (1.f / DM);
#pragma unroll
                            for (int j = 0; j < 4; ++j) { t[q][j] = t[q][j] - mean; s2[q] += (t[q][j][0] * t[q][j][0] + t[q][j][1] * t[q][j][1]) + (t[q][j][2] * t[q][j][2] + t[q][j][3] * t[q][j][3]); } }
                        s2[0] = wave_sum(s2[0]); s2[1] = wave_sum(s2[1]);
#pragma unroll
                        for (int q = 0; q < 2; ++q) { const float rstd = rsqrtf(s2[q] * (1.f / DM) + LN_EPS);
#pragma unroll
                            for (int j = 0; j < 4; ++j) { const int col = 4 * lane + 256 * j; const size_t ro = (size_t)(r + q) * DM + col;
                                const f32x4 xv = t[q][j] * rstd * g4[j] + b4[j]; __builtin_nontemporal_store(xv, (f32x4*)(xn + ro));
                                if (wantu) { const f32x4 u = xv * sc1[j] + sh[j]; u32x2 w; w.x = pk2(u[0], u[1]); w.y = pk2(u[2], u[3]); *(u32x2*)(U + (size_t)m0 * DM + ro) = w; } } }
                    }
                }
            }
            if (which == 1) { if (l < DEPTH - 1) GSYNC(9); else TBODY(9); break; }
            GSYNC(6);
            { DEFWS(WSB()) LAUN3(); pg8::Gemm g{U, W1 + (size_t)l * DFF * DM, MROWS, DFF, DM, DM}; pg8::RowOrder S; S.init(DFF, G_, bx_, l == DEPTH - 1);
              pg8::EpiStore<1> E{HM, DFF, DFF};
              pg8::gemm_phase<pg8::EpiStore<1>, pg8::RowOrder, true, true>((LAS unsigned char*)lds, g, S, E, wave_); }
            GSYNC(7);
            { DEFWS(WSB()) LAUN3(); pg8::Gemm g{HM, W2 + (size_t)l * DM * DFF, MROWS, DM, DFF, DFF}; pg8::RowOrder S; S.init(DM, G_, bx_, true);
              pg8::EpiStore<0> E{Y, DM, DM};
              pg8::gemm_phase<pg8::EpiStore<0>, pg8::RowOrder, true, true>((LAS unsigned char*)lds, g, S, E, wave_); }
            if (l < DEPTH - 1) { DEFWS(WSB()) LAUN3(); pg8::Gemm g{HM, W2 + (size_t)l * DM * DFF, MROWS, DM, 512, DFF}; pg8::CtxSplitOrder S; S.init(DM, 8, G_, bx_);
              pg8::EpiPart E{PART, DM, (size_t)1024 * DM};
              pg8::gemm_phase<pg8::EpiPart, pg8::CtxSplitOrder, true, true>((LAS unsigned char*)lds, g, S, E, wave_); }
            GSYNC(8);
        }
    }
#if TSEL >= 0
    grid.sync();
    if (blockIdx.x == 0) { __syncthreads(); unsigned ticks = 0; for (int k = 0; k < 16; ++k) if ((TSEL >> k) & 1) ticks += TSL[k]; const int n = (int)((ticks / 100u) / TDIV); float* o_ = KP()->out;
        for (int i = wave * 64 + pg8::lane_id_asm(); i < n; i += 512) o_[(size_t)i * 1031] += 0.2f; }
#endif
}

extern "C" void kernel_launch(void* const* d_in, const int* in_sizes, int n_in, void* d_out, int out_size, void* d_ws, size_t ws_size, hipStream_t stream) {
    static int grid = 0;
    if (grid == 0) {
        if (n_in != 21 || in_sizes[0] != NBATCH * SEQ * DM || out_size != NBATCH * SEQ * DM || ws_size < WS_END) {
            fprintf(stderr, "kernel_launch: shape mismatch n_in %d in0 %d out %d ws %zu (need %zu)\n", n_in, n_in > 0 ? in_sizes[0] : -1, out_size, ws_size, (size_t)WS_END); grid = -1; return; }
        int dev = 0, cus = 0, per_cu = 0;
        hipGetDevice(&dev); hipDeviceGetAttribute(&cus, hipDeviceAttributeMultiprocessorCount, dev);
        if (hipFuncSetAttribute((const void*)fwd_megakernel, hipFuncAttributeMaxDynamicSharedMemorySize, LDS_BYTES) != hipSuccess) { fprintf(stderr, "kernel_launch: hipFuncSetAttribute failed\n"); grid = -1; return; }
        if (hipOccupancyMaxActiveBlocksPerMultiprocessor(&per_cu, (const void*)fwd_megakernel, 512, LDS_BYTES) != hipSuccess || per_cu < 1) { fprintf(stderr, "kernel_launch: occupancy query says %d\n", per_cu); per_cu = 1; }
        (void)hipGetLastError();
        if (cus < 256) { fprintf(stderr, "kernel_launch: built for a 256-CU device, found %d CUs\n", cus); grid = -1; return; }
        grid = 256;
        fprintf(stderr, "kernel_launch: grid %d (per_cu %d)\n", grid, per_cu);
    }
    if (grid < 0) return;
    Params p{};
    for (int i = 0; i < 21; ++i) p.in[i] = (const float*)d_in[i];
    p.out = (float*)d_out; p.ws = (unsigned char*)d_ws;
    void* args[] = {&p};
    hipError_t e = hipLaunchCooperativeKernel((const void*)fwd_megakernel, dim3(grid), dim3(512), args, LDS_BYTES, stream);
    if (e != hipSuccess) fprintf(stderr, "kernel_launch: cooperative launch failed: %s (grid %d)\n", hipGetErrorString(e), grid);
}
```

```cpp
#include <hip/hip_runtime.h>
#include <hip/hip_cooperative_groups.h>
#include <hip/hip_bf16.h>
#include <cstdio>
#include <cstdint>
namespace cg = cooperative_groups;

constexpr int DM = 1024, NBATCH = 4, SEQ = 8192, DEPTH = 4, CTX = 256, DFF = 4096;
constexpr int LTOK = CTX + SEQ;
constexpr int MROWS = NBATCH * LTOK;
constexpr int IN_COLS = 1824, HP = 2048, HPI = 1856;
constexpr float LN_EPS = 1e-6f;
constexpr float ALPHA = 1.6817928305074290f;
namespace pg8 {
#define PG8_LAS __attribute__((address_space(3)))
typedef unsigned short bf16_t;
typedef short bf16x8 __attribute__((ext_vector_type(8)));
typedef float f32x4 __attribute__((ext_vector_type(4)));
typedef unsigned u32x4 __attribute__((ext_vector_type(4)));
constexpr int BM = 256, BK = 64, HALF = 128, HTB = HALF * BK * 2  , STAGE_BYTES = 8 * HTB, NXCD = 8, WGM = 8;

__host__ __device__ __forceinline__ int lds_byte(int r, int c) { const int st = (r >> 4) * 2 + (c >> 5), rr = r & 15, cc = c & 31, ob = rr * 64 + cc * 2; return st * 1024 + (ob ^ (((ob >> 9) & 1) << 5)); }
__host__ __device__ __forceinline__ void stage_rc(int b, int& R, int& C) { const int st = b / 1024, sb = b % 1024, swz = sb ^ (((sb >> 9) & 1) << 5); R = (st >> 1) * 16 + swz / 64; C = (st & 1) * 32 + (swz % 64) / 2; }
__host__ __device__ __forceinline__ int perm32(int rho) { const int n = rho >> 4, i = rho & 15; return 8 * (i >> 2) + 4 * n + (i & 3); }

struct Unit { int pm, pn, pk; };
struct Gemm { const bf16_t* A; const bf16_t* Bt; int M, N, K, ld; };

struct StaticOrder {
    int nM, nN, nwg, G, c;
    __host__ __device__ void init(int M, int N, int G_, int c_) { nM = M / BM; nN = N / BM; nwg = nM * nN; G = G_; c = c_; }
    __host__ __device__ bool next(int i, Unit& u) const {
        const long L = (long)i * G + c; if (L >= nwg) return false;
        int wgid = (int)L; { const int q = nwg / NXCD, r = nwg % NXCD, xcd = wgid % NXCD, off = wgid / NXCD; wgid = (xcd < r ? xcd * (q + 1) : r * (q + 1) + (xcd - r) * q) + off; }
        const int nig = WGM * nN, gid = wgid / nig, fm = gid * WGM, gsz = (nM - fm) < WGM ? (nM - fm) : WGM;
        u.pm = fm + ((wgid % nig) % gsz); u.pn = (wgid % nig) / gsz; u.pk = 0; return true;
    }
    __device__ __forceinline__ void a_ready(const Unit&) const {}
    __device__ __forceinline__ void done(const Unit&) const {}
};

__device__ __forceinline__ unsigned cvt_pk_bf16(float lo, float hi) { unsigned r; asm volatile("v_cvt_pk_bf16_f32 %0, %1, %2" : "=v"(r) : "v"(lo), "v"(hi)); return r; }
__device__ __forceinline__ int lane_id_asm() { int l; asm volatile("v_mbcnt_lo_u32_b32 %0, -1, 0\n\tv_mbcnt_hi_u32_b32 %0, -1, %0" : "=v"(l)); return l; }
typedef float f32x2 __attribute__((ext_vector_type(2)));
template <int ACT  > struct EpiStore {
    static constexpr bool PERM = true, AFTER_DRAIN = false;
    bf16_t* O; int ldc; int ncol;
    __device__ __forceinline__ void operator()(const f32x4 (&acc)[2][2][4][2], const Unit& u, int wr, int wc, int fr, int fq) const {
        const int row0 = u.pm * BM + wr * 64 + fr; const int col0 = u.pn * BM + wc * 32 + 8 * fq;
#pragma unroll
        for (int ai = 0; ai < 2; ++ai)
#pragma unroll
            for (int m = 0; m < 4; ++m) { bf16_t* rowp = O + (unsigned)((row0 + ai * HALF + m * 16) * ldc + col0);
#pragma unroll
                for (int bj = 0; bj < 2; ++bj) { f32x4 v0 = acc[ai][bj][m][0], v1 = acc[ai][bj][m][1];
                    if (ACT == 1) {
#pragma unroll
                        for (int e = 0; e < 4; ++e) { float a = fmaxf(v0[e], 0.f), b = fmaxf(v1[e], 0.f); v0[e] = a * a; v1[e] = b * b; } }
                    u32x4 w; w.x = cvt_pk_bf16(v0[0], v0[1]); w.y = cvt_pk_bf16(v0[2], v0[3]); w.z = cvt_pk_bf16(v1[0], v1[1]); w.w = cvt_pk_bf16(v1[2], v1[3]);
                    if (col0 + bj * HALF < ncol) *(u32x4*)(rowp + bj * HALF) = w; } }
    }
};
struct EpiUQ {
    static constexpr bool PERM = true, AFTER_DRAIN = false;
    bf16_t* MQ; const float* ropeM; float qscale;
    __device__ __forceinline__ void operator()(const f32x4 (&acc)[2][2][4][2], const Unit& u, int wr, int wc, int fr, int fq) const {
        const int row0 = u.pm * BM + wr * 64 + fr;
        const int pt = u.pm % 33; const bool lat = pt != 0; const int pos0 = (pt - 1) * 256 + wr * 64 + fr;
#pragma unroll
        for (int bj = 0; bj < 2; ++bj) {
            const int c = u.pn * BM + bj * HALF + wc * 32 + 8 * fq;
            if (c >= 576) continue;
            const int d = c % 96; const bool isrope = (d >= 64) && lat; const int i0 = (d - 64) >> 1;
#pragma unroll
            for (int ai = 0; ai < 2; ++ai)
#pragma unroll
                for (int m = 0; m < 4; ++m) { const int row = row0 + ai * HALF + m * 16;
                    f32x4 v0 = acc[ai][bj][m][0], v1 = acc[ai][bj][m][1];
                    if (isrope) { const f32x4* rp = (const f32x4*)(ropeM + (unsigned)(((pos0 + ai * HALF + m * 16) * 16 + i0) * 2));
                        const f32x4 r0 = rp[0], r1 = rp[1];
                        f32x4 a, b;
                        a[0] = v0[0] * r0[0] - v0[1] * r0[1]; a[1] = v0[0] * r0[1] + v0[1] * r0[0];
                        a[2] = v0[2] * r0[2] - v0[3] * r0[3]; a[3] = v0[2] * r0[3] + v0[3] * r0[2];
                        b[0] = v1[0] * r1[0] - v1[1] * r1[1]; b[1] = v1[0] * r1[1] + v1[1] * r1[0];
                        b[2] = v1[2] * r1[2] - v1[3] * r1[3]; b[3] = v1[2] * r1[3] + v1[3] * r1[2];
                        v0 = a; v1 = b; }
                    v0 = v0 * qscale; v1 = v1 * qscale;
                    u32x4 w; w.x = cvt_pk_bf16(v0[0], v0[1]); w.y = cvt_pk_bf16(v0[2], v0[3]); w.z = cvt_pk_bf16(v1[0], v1[1]); w.w = cvt_pk_bf16(v1[2], v1[3]);
                    *(u32x4*)(MQ + (unsigned)(row * 576 + c)) = w; }
        }
    }
};
struct EpiUKV {
    static constexpr bool PERM = true, AFTER_DRAIN = false;
    bf16_t* MK; bf16_t* MV;
    __device__ __forceinline__ void operator()(const f32x4 (&acc)[2][2][4][2], const Unit& u, int wr, int wc, int fr, int fq) const {
        const int row0 = u.pm * BM + wr * 64 + fr;
#pragma unroll
        for (int bj = 0; bj < 2; ++bj) {
            const int head = u.pn * 2 + bj; const int d = wc * 32 + 8 * fq;
            bf16_t* base = (d < 64) ? MK : MV; const unsigned boff = (unsigned)(head * 64 + (d & 63));
#pragma unroll
            for (int ai = 0; ai < 2; ++ai)
#pragma unroll
                for (int m = 0; m < 4; ++m) { const int row = row0 + ai * HALF + m * 16;
                    const f32x4 v0 = acc[ai][bj][m][0], v1 = acc[ai][bj][m][1];
                    u32x4 w; w.x = cvt_pk_bf16(v0[0], v0[1]); w.y = cvt_pk_bf16(v0[2], v0[3]); w.z = cvt_pk_bf16(v1[0], v1[1]); w.w = cvt_pk_bf16(v1[2], v1[3]);
                    *(u32x4*)(base + (boff + (unsigned)(row * 384))) = w; }
        }
    }
};
struct RowOrder {
    StaticOrder S0; bool latonly;
    __host__ __device__ void init(int N, int G_, int c_, bool latonly_) { latonly = latonly_; S0.init(latonly_ ? 128 * BM : 132 * BM, N, G_, c_); }
    __host__ __device__ bool next(int i, Unit& u) const { if (!S0.next(i, u)) return false; if (latonly) u.pm = u.pm + u.pm / 32 + 1; return true; }
    __device__ __forceinline__ void a_ready(const Unit&) const {}
    __device__ __forceinline__ void done(const Unit&) const {}
};
struct CtxSplitOrder {
    int nN, KS, total, G, c;
    __host__ __device__ void init(int N, int KS_, int G_, int c_) { nN = N / BM; KS = KS_; total = 4 * nN * KS_; G = G_; c = c_; }
    __host__ __device__ bool next(int i, Unit& u) const { const int L = i * G + c; if (L >= total) return false; u.pk = L % KS; const int t = L / KS; u.pn = t % nN; u.pm = 33 * (t / nN); return true; }
    __device__ __forceinline__ void a_ready(const Unit&) const {}
    __device__ __forceinline__ void done(const Unit&) const {}
};
struct EpiPart {
    static constexpr bool PERM = false, AFTER_DRAIN = false;
    float* P; int ldc; size_t kstride;
    __device__ __forceinline__ void operator()(const f32x4 (&acc)[2][2][4][2], const Unit& u, int wr, int wc, int fr, int fq) const {
        float* base = P + (size_t)u.pk * kstride + (size_t)((u.pm / 33) * BM + wr * 64 + fr) * ldc + u.pn * BM + wc * 32 + 4 * fq;
#pragma unroll
        for (int ai = 0; ai < 2; ++ai)
#pragma unroll
            for (int m = 0; m < 4; ++m)
#pragma unroll
                for (int bj = 0; bj < 2; ++bj)
#pragma unroll
                    for (int n = 0; n < 2; ++n) *(f32x4*)(base + (size_t)(ai * HALF + m * 16) * ldc + bj * HALF + n * 16) = acc[ai][bj][m][n];
    }
};
template <class Epi, class Sched, bool ALIGN_EPI = false, bool SP2 = false>
__device__ __forceinline__ void gemm_phase(PG8_LAS unsigned char* lds, const Gemm g, const Sched& S, const Epi& E, const int wave_in) {
    const int tid_l_ = wave_in * 64 + lane_id_asm();
    const int tid = tid_l_, wid = __builtin_amdgcn_readfirstlane(tid >> 6), lane = tid & 63, wr = wid >> 2, wc = wid & 3, fr = lane & 15, fq = lane >> 4;
    const int K = g.K, nt = K / BK;
    unsigned voffA[2], voffB[2];
#pragma unroll
    for (int i = 0; i < 2; ++i) { int R, C; stage_rc(tid * 16 + i * 8192, R, C); const int Rb = Epi::PERM ? ((R & ~31) + perm32(R & 31)) : R;
        voffA[i] = (unsigned)(R * g.ld + C) * 2u; voffB[i] = (unsigned)(Rb * g.ld + C) * 2u; }
    const size_t kstep = (size_t)(BK * 2);
    const size_t hstep = (size_t)HALF * g.ld * 2;
    const size_t tstep = 2 * hstep;
    const unsigned ldsw = (unsigned)wid * 1024u;
    const int aoff = lds_byte(wr * 64 + fr, fq * 8), boff = lds_byte(wc * 32 + fr, fq * 8);
#define PG8_SA(b, h) (((b) * 2 + (h)) * HTB)
#define PG8_SB(b, h) ((4 + (b) * 2 + (h)) * HTB)
#define PG8_STAGE(bufoff, gbase, voff) do { _Pragma("unroll") for (int _i = 0; _i < 2; ++_i) \
        __builtin_amdgcn_global_load_lds((const unsigned*)((const char*)(gbase) + (voff)[_i]), (PG8_LAS unsigned*)(lds + (bufoff) + ldsw + _i * 8192), 16, 0, 0); } while (0)
#define PG8_LDA(dst, b, h) do { _Pragma("unroll") for (int m = 0; m < 4; ++m) _Pragma("unroll") for (int k = 0; k < 2; ++k) dst[m][k] = *(const PG8_LAS bf16x8*)(lds + PG8_SA(b, h) + aoff + m * 2048 + k * 1024); } while (0)
#define PG8_LDB(dst, b, h) do { _Pragma("unroll") for (int n = 0; n < 2; ++n) _Pragma("unroll") for (int k = 0; k < 2; ++k) dst[n][k] = *(const PG8_LAS bf16x8*)(lds + PG8_SB(b, h) + boff + n * 2048 + k * 1024); } while (0)
#define PG8_MMA(ai, bj, At, Bt) do { __builtin_amdgcn_s_setprio(1); _Pragma("unroll") for (int m = 0; m < 4; ++m) _Pragma("unroll") for (int n = 0; n < 2; ++n) _Pragma("unroll") for (int k = 0; k < 2; ++k) \
        acc[ai][bj][m][n] = __builtin_amdgcn_mfma_f32_16x16x32_bf16(Bt[n][k], At[m][k], acc[ai][bj][m][n], 0, 0, 0); __builtin_amdgcn_s_setprio(0); } while (0)
#define PG8_WAIT_V(n) asm volatile("s_waitcnt vmcnt(" #n ")" ::: "memory")
#define PG8_WAIT_L(n) asm volatile("s_waitcnt lgkmcnt(" #n ")" ::: "memory")
#define PG8_BAR __builtin_amdgcn_s_barrier()
#define PG8_SCHED __builtin_amdgcn_sched_barrier(0)
    Unit cur, nxt; int ui = 0;
    if (!S.next(0, cur)) return;
    f32x4 acc[2][2][4][2];
#pragma unroll
    for (int a = 0; a < 2; ++a)
#pragma unroll
        for (int b = 0; b < 2; ++b)
#pragma unroll
            for (int m = 0; m < 4; ++m)
#pragma unroll
                for (int n = 0; n < 2; ++n) acc[a][b][m][n] = (f32x4){0.f, 0.f, 0.f, 0.f};
    bf16x8 At[4][2], B0[2][2], B1[2][2];
    const char* cA = (const char*)g.A + (size_t)cur.pm * tstep + (size_t)cur.pk * K * 2; const char* cB = (const char*)g.Bt + (size_t)cur.pn * tstep + (size_t)cur.pk * K * 2;
    S.a_ready(cur);
    if constexpr (SP2) {
        PG8_STAGE(PG8_SB(0, 0), cB, voffB); PG8_STAGE(PG8_SB(0, 1), cB + hstep, voffB); PG8_STAGE(PG8_SA(0, 0), cA, voffA); PG8_STAGE(PG8_SA(0, 1), cA + hstep, voffA);
        if (wr == 1) PG8_BAR;
        PG8_WAIT_V(2); PG8_BAR;
        PG8_STAGE(PG8_SB(1, 0), cB + kstep, voffB); PG8_STAGE(PG8_SA(1, 0), cA + kstep, voffA); PG8_STAGE(PG8_SB(1, 1), cB + hstep + kstep, voffB);
        PG8_WAIT_V(6); PG8_BAR;
    } else {
        PG8_STAGE(PG8_SB(0, 0), cB, voffB); PG8_STAGE(PG8_SA(0, 0), cA, voffA); PG8_STAGE(PG8_SB(0, 1), cB + hstep, voffB); PG8_STAGE(PG8_SA(0, 1), cA + hstep, voffA);
        if (wr == 1) PG8_BAR;
        PG8_WAIT_V(4); PG8_BAR;
        PG8_STAGE(PG8_SB(1, 0), cB + kstep, voffB); PG8_STAGE(PG8_SA(1, 0), cA + kstep, voffA); PG8_STAGE(PG8_SB(1, 1), cB + hstep + kstep, voffB);
        PG8_WAIT_V(6); PG8_BAR;
    }
    for (;;) {
        const bool has_next = S.next(ui + 1, nxt);
        const char* nA = has_next ? (const char*)g.A + (size_t)nxt.pm * tstep + (size_t)nxt.pk * K * 2 : cA; const char* nB = has_next ? (const char*)g.Bt + (size_t)nxt.pn * tstep + (size_t)nxt.pk * K * 2 : cB;
        for (int t = 0; t < nt; t += 2) {
            const bool last = (t == nt - 2);
            const char* a1 = cA + (size_t)(t + 1) * kstep;
            const char* a2 = last ? nA : cA + (size_t)(t + 2) * kstep; const char* b2 = last ? nB : cB + (size_t)(t + 2) * kstep;
            const char* a3 = a2 + kstep; const char* b3 = b2 + kstep;
            if (last && has_next) S.a_ready(nxt);
            if constexpr (SP2) {
            PG8_LDB(B0, 0, 0); PG8_LDB(B1, 0, 1); PG8_SCHED; PG8_LDA(At, 0, 0); PG8_STAGE(PG8_SA(1, 1), a1 + hstep, voffA);
            PG8_WAIT_V(8); PG8_WAIT_L(0); PG8_BAR; PG8_MMA(0, 0, At, B0); PG8_MMA(0, 1, At, B1); PG8_BAR; PG8_SCHED;
            PG8_LDA(At, 0, 1); PG8_STAGE(PG8_SB(0, 0), b2, voffB); PG8_STAGE(PG8_SB(0, 1), b2 + hstep, voffB); PG8_STAGE(PG8_SA(0, 0), a2, voffA);
            PG8_WAIT_V(8); PG8_WAIT_L(0); PG8_BAR; PG8_MMA(1, 0, At, B0); PG8_MMA(1, 1, At, B1); PG8_BAR; PG8_SCHED;
            PG8_LDB(B0, 1, 0); PG8_LDB(B1, 1, 1); PG8_SCHED; PG8_LDA(At, 1, 0); PG8_STAGE(PG8_SA(0, 1), a2 + hstep, voffA);
            PG8_WAIT_V(8); PG8_WAIT_L(0); PG8_BAR; PG8_MMA(0, 0, At, B0); PG8_MMA(0, 1, At, B1); PG8_BAR; PG8_SCHED;
            PG8_LDA(At, 1, 1); PG8_STAGE(PG8_SB(1, 0), b3, voffB); PG8_STAGE(PG8_SB(1, 1), b3 + hstep, voffB); PG8_STAGE(PG8_SA(1, 0), a3, voffA);
            PG8_WAIT_V(8); PG8_WAIT_L(0); PG8_BAR; PG8_MMA(1, 0, At, B0); PG8_MMA(1, 1, At, B1); PG8_BAR; PG8_SCHED;
            } else {
            PG8_LDB(B0, 0, 0); PG8_SCHED; PG8_LDA(At, 0, 0); PG8_STAGE(PG8_SA(1, 1), a1 + hstep, voffA);
            PG8_WAIT_L(8); PG8_BAR; PG8_WAIT_L(0); PG8_MMA(0, 0, At, B0); PG8_BAR; PG8_SCHED;
            PG8_LDB(B1, 0, 1); PG8_STAGE(PG8_SB(0, 0), b2, voffB);
            PG8_BAR; PG8_WAIT_L(0); PG8_MMA(0, 1, At, B1); PG8_BAR;
            PG8_LDA(At, 0, 1); PG8_STAGE(PG8_SA(0, 0), a2, voffA);
            PG8_BAR; PG8_WAIT_L(0); PG8_MMA(1, 0, At, B0); PG8_BAR; PG8_SCHED;
            PG8_STAGE(PG8_SB(0, 1), b2 + hstep, voffB);
            PG8_WAIT_V(6); PG8_BAR; PG8_MMA(1, 1, At, B1); PG8_BAR;
            PG8_LDB(B0, 1, 0); PG8_SCHED; PG8_LDA(At, 1, 0); PG8_STAGE(PG8_SA(0, 1), a2 + hstep, voffA);
            PG8_WAIT_L(8); PG8_BAR; PG8_WAIT_L(0); PG8_MMA(0, 0, At, B0); PG8_BAR; PG8_SCHED;
            PG8_LDB(B1, 1, 1); PG8_STAGE(PG8_SB(1, 0), b3, voffB);
            PG8_BAR; PG8_WAIT_L(0); PG8_MMA(0, 1, At, B1); PG8_BAR;
            PG8_LDA(At, 1, 1); PG8_STAGE(PG8_SA(1, 0), a3, voffA);
            PG8_BAR; PG8_WAIT_L(0); PG8_MMA(1, 0, At, B0); PG8_BAR; PG8_SCHED;
            PG8_STAGE(PG8_SB(1, 1), b3 + hstep, voffB);
            PG8_WAIT_V(6); PG8_BAR; PG8_MMA(1, 1, At, B1); PG8_BAR;
            }
        }
        if constexpr (ALIGN_EPI) { if (wr == 0) PG8_BAR; }
        if constexpr (!Epi::AFTER_DRAIN) { const int le_ = lane_id_asm(); E(acc, cur, wr, wc, le_ & 15, le_ >> 4); S.done(cur); }
        if (!has_next) break;
#pragma unroll
        for (int a = 0; a < 2; ++a)
#pragma unroll
            for (int b = 0; b < 2; ++b)
#pragma unroll
                for (int m = 0; m < 4; ++m)
#pragma unroll
                    for (int n = 0; n < 2; ++n) acc[a][b][m][n] = (f32x4){0.f, 0.f, 0.f, 0.f};
        cur = nxt; cA = nA; cB = nB; ++ui;
        if constexpr (ALIGN_EPI) { if (wr == 1) PG8_BAR; }
    }
    PG8_WAIT_V(0);
    if constexpr (!ALIGN_EPI) { if (wr == 0) PG8_BAR; }
    PG8_BAR;
    if constexpr (Epi::AFTER_DRAIN) { E.fused(acc, cur, wr, wc, fr, fq, lds, wid, lane); S.done(cur); }
#undef PG8_SA
#undef PG8_SB
#undef PG8_STAGE
#undef PG8_LDA
#undef PG8_LDB
#undef PG8_MMA
#undef PG8_WAIT_V
#undef PG8_WAIT_L
#undef PG8_BAR
#undef PG8_SCHED
}
}

namespace att {
typedef unsigned short bf16_t;
using bf16x8 = __attribute__((ext_vector_type(8))) short;
using s16x4  = __attribute__((ext_vector_type(4))) short;
using f32x16 = __attribute__((ext_vector_type(16))) float;
using u32x4  = __attribute__((ext_vector_type(4))) unsigned;
constexpr int NW = 8, QBLK = 32, KVBLK = 64;
constexpr float THR = 8.f;
constexpr int SHM_V = 16384, SHM_K = 16384;
#define KSWZ(row, colB) ((row) * 256 + ((colB) ^ (((row) & 15) << 4)))
#define SBAR() __builtin_amdgcn_sched_barrier(0)
__device__ __forceinline__ int crow(int r, int hi) { return (r & 3) + 8 * (r >> 2) + 4 * hi; }
__device__ __forceinline__ unsigned cvtpk(float lo, float hi) { unsigned r; asm volatile("v_cvt_pk_bf16_f32 %0, %1, %2" : "=v"(r) : "v"(lo), "v"(hi)); return r; }

constexpr float THRL = 11.0f;
template <bool FIRST> __device__ __forceinline__ void partialSM(f32x16& p0, f32x16& p1, float& m_reg, f32x16& negm, float& alpha) {
  float pmax = fmaxf(fmaxf(p0[0], p0[1]), p1[0]);
#pragma unroll
  for (int r = 2; r < 16; r += 2) pmax = fmaxf(fmaxf(pmax, p0[r]), p0[r + 1]);
#pragma unroll
  for (int r = 1; r < 15; r += 2) pmax = fmaxf(fmaxf(pmax, p1[r]), p1[r + 1]);
  pmax = fmaxf(pmax, p1[15]);
  { auto rr = __builtin_amdgcn_permlane32_swap(__float_as_uint(pmax), __float_as_uint(pmax), false, false);
    pmax = fmaxf(__uint_as_float(rr[0]), __uint_as_float(rr[1])); }
  alpha = 1.f;
  if (FIRST || !__builtin_expect(__all(pmax <= THRL), 1)) {
    const float dl = FIRST ? pmax : fmaxf(pmax, 0.f);
    m_reg += dl;
#pragma unroll
    for (int r = 0; r < 16; ++r) { p0[r] -= dl; p1[r] -= dl; }
#pragma unroll
    for (int r = 0; r < 16; ++r) negm[r] = -m_reg;
    if (!FIRST) alpha = __builtin_amdgcn_exp2f(-dl);
  }
#pragma unroll
  for (int r = 0; r < 16; ++r) p0[r] = __builtin_amdgcn_exp2f(p0[r]);
}
__device__ __forceinline__ void finishSM(f32x16& p0, f32x16& p1, float alpha, float& l_reg, bf16x8& pa0, bf16x8& pa1, bf16x8& pa2, bf16x8& pa3) {
#pragma unroll
  for (int r = 0; r < 16; ++r) p1[r] = __builtin_amdgcn_exp2f(p1[r]);
  float ps = 0;
#pragma unroll
  for (int r = 0; r < 16; ++r) ps += p0[r];
#pragma unroll
  for (int r = 0; r < 16; ++r) ps += p1[r];
  { auto rr = __builtin_amdgcn_permlane32_swap(__float_as_uint(ps), __float_as_uint(ps), false, false);
    ps = __uint_as_float(rr[0]) + __uint_as_float(rr[1]); }
  l_reg = l_reg * alpha + ps;
#define PK4(P, BASE, OUT) do { unsigned a0 = cvtpk(P[BASE + 0], P[BASE + 1]), a1 = cvtpk(P[BASE + 2], P[BASE + 3]);   \
    unsigned b0 = cvtpk(P[BASE + 4], P[BASE + 5]), b1 = cvtpk(P[BASE + 6], P[BASE + 7]);                              \
    auto r0 = __builtin_amdgcn_permlane32_swap(a0, b0, false, false); auto r1 = __builtin_amdgcn_permlane32_swap(a1, b1, false, false); \
    u32x4 w = {r0[0], r1[0], r0[1], r1[1]}; OUT = *reinterpret_cast<bf16x8*>(&w); } while (0)
  PK4(p0, 0, pa0); PK4(p0, 8, pa1); PK4(p1, 0, pa2); PK4(p1, 8, pa3);
#undef PK4
}
#define SBVS() __builtin_amdgcn_sched_barrier(0x6)
template <int DQ> __device__ __forceinline__ void qkt(f32x16& p0, f32x16& p1, const char* Ks, const bf16x8* qr, const f32x16& negm, int r32, int hi) {
  constexpr int ND = DQ / 16;
  const char* k0p = Ks + r32 * 256; const char* k1p = Ks + (32 + r32) * 256; const int sw = (r32 & 15) << 4;
  bf16x8 a0, a1, b0, b1;
#define KLD(x0, x1, d0) do { const int cb_ = (((d0) * 16 + hi * 8) * 2) ^ sw; x0 = *reinterpret_cast<const bf16x8*>(k0p + cb_); x1 = *reinterpret_cast<const bf16x8*>(k1p + cb_); } while (0)
  KLD(a0, a1, 0); KLD(b0, b1, 1); SBVS();
  p0 = __builtin_amdgcn_mfma_f32_32x32x16_bf16(a0, qr[0], negm, 0, 0, 0); p1 = __builtin_amdgcn_mfma_f32_32x32x16_bf16(a1, qr[0], negm, 0, 0, 0); SBVS();
#pragma unroll
  for (int d0 = 1; d0 < ND; ++d0) {
    if (d0 & 1) { if (d0 + 1 < ND) { KLD(a0, a1, d0 + 1); SBVS(); }
      p0 = __builtin_amdgcn_mfma_f32_32x32x16_bf16(b0, qr[d0], p0, 0, 0, 0); p1 = __builtin_amdgcn_mfma_f32_32x32x16_bf16(b1, qr[d0], p1, 0, 0, 0); SBVS(); }
    else { if (d0 + 1 < ND) { KLD(b0, b1, d0 + 1); SBVS(); }
      p0 = __builtin_amdgcn_mfma_f32_32x32x16_bf16(a0, qr[d0], p0, 0, 0, 0); p1 = __builtin_amdgcn_mfma_f32_32x32x16_bf16(a1, qr[d0], p1, 0, 0, 0); SBVS(); }
  }
#undef KLD
}
__device__ __forceinline__ int v_st(int k, int c) { const int kk = (k & ~0xC) | ((k & 4) << 1) | ((k & 8) >> 1); return ((kk >> 3) * 4 + (c >> 5)) * 512 + ((kk & 7) * 32 + (c & 31)) * 2; }
__device__ __forceinline__ int v_rd_base(int lane) { return ((lane & 3) << 3) | (((lane >> 2) & 3) << 6) | (((lane >> 4) & 1) << 5) | (((lane >> 5) & 1) << 8); }
constexpr int v_rd_off(int d0, int ks, int half) { return d0 * 512 + ks * 4096 + half * 2048; }
template <int OFF> __device__ __forceinline__ s16x4 tr_read(int vb) {
  s16x4 r; asm volatile("ds_read_b64_tr_b16 %0, %1 offset:%2" : "=&v"(r) : "v"(vb), "i"(OFF) : "memory"); return r;
}
template <int D0> __device__ __forceinline__ void pv_one(f32x16& od, int vb, bf16x8 pa0, bf16x8 pa1, bf16x8 pa2, bf16x8 pa3) {
  const s16x4 l0 = tr_read<v_rd_off(D0, 0, 0)>(vb), h0 = tr_read<v_rd_off(D0, 0, 1)>(vb), l1 = tr_read<v_rd_off(D0, 1, 0)>(vb), h1 = tr_read<v_rd_off(D0, 1, 1)>(vb);
  const s16x4 l2 = tr_read<v_rd_off(D0, 2, 0)>(vb), h2 = tr_read<v_rd_off(D0, 2, 1)>(vb), l3 = tr_read<v_rd_off(D0, 3, 0)>(vb), h3 = tr_read<v_rd_off(D0, 3, 1)>(vb);
  asm volatile("s_waitcnt lgkmcnt(0)" ::: "memory"); SBAR();
#define PK(L, H) (bf16x8){L[0], L[1], L[2], L[3], H[0], H[1], H[2], H[3]}
  od = __builtin_amdgcn_mfma_f32_32x32x16_bf16(pa0, PK(l0, h0), od, 0, 0, 0);
  od = __builtin_amdgcn_mfma_f32_32x32x16_bf16(pa1, PK(l1, h1), od, 0, 0, 0);
  od = __builtin_amdgcn_mfma_f32_32x32x16_bf16(pa2, PK(l2, h2), od, 0, 0, 0);
  od = __builtin_amdgcn_mfma_f32_32x32x16_bf16(pa3, PK(l3, h3), od, 0, 0, 0);
#undef PK
}
__device__ __forceinline__ void pv_d0(f32x16* o, int vb, bf16x8 pa0, bf16x8 pa1, bf16x8 pa2, bf16x8 pa3) {
  pv_one<0>(o[0], vb, pa0, pa1, pa2, pa3); pv_one<1>(o[1], vb, pa0, pa1, pa2, pa3);
}
struct VFrag { s16x4 l[2][4], h[2][4]; };
__device__ __forceinline__ void v_load(VFrag& f, int vb) {
  f.l[0][0] = tr_read<v_rd_off(0, 0, 0)>(vb); f.h[0][0] = tr_read<v_rd_off(0, 0, 1)>(vb); f.l[0][1] = tr_read<v_rd_off(0, 1, 0)>(vb); f.h[0][1] = tr_read<v_rd_off(0, 1, 1)>(vb);
  f.l[0][2] = tr_read<v_rd_off(0, 2, 0)>(vb); f.h[0][2] = tr_read<v_rd_off(0, 2, 1)>(vb); f.l[0][3] = tr_read<v_rd_off(0, 3, 0)>(vb); f.h[0][3] = tr_read<v_rd_off(0, 3, 1)>(vb);
  f.l[1][0] = tr_read<v_rd_off(1, 0, 0)>(vb); f.h[1][0] = tr_read<v_rd_off(1, 0, 1)>(vb); f.l[1][1] = tr_read<v_rd_off(1, 1, 0)>(vb); f.h[1][1] = tr_read<v_rd_off(1, 1, 1)>(vb);
  f.l[1][2] = tr_read<v_rd_off(1, 2, 0)>(vb); f.h[1][2] = tr_read<v_rd_off(1, 2, 1)>(vb); f.l[1][3] = tr_read<v_rd_off(1, 3, 0)>(vb); f.h[1][3] = tr_read<v_rd_off(1, 3, 1)>(vb);
}
__device__ __forceinline__ void pv_mma(f32x16* o, const VFrag& f, bf16x8 pa0, bf16x8 pa1, bf16x8 pa2, bf16x8 pa3) {
#define PK(L, H) (bf16x8){L[0], L[1], L[2], L[3], H[0], H[1], H[2], H[3]}
  asm volatile("s_waitcnt lgkmcnt(0)" ::: "memory"); SBAR();
  o[0] = __builtin_amdgcn_mfma_f32_32x32x16_bf16(pa0, PK(f.l[0][0], f.h[0][0]), o[0], 0, 0, 0);
  o[0] = __builtin_amdgcn_mfma_f32_32x32x16_bf16(pa1, PK(f.l[0][1], f.h[0][1]), o[0], 0, 0, 0);
  o[0] = __builtin_amdgcn_mfma_f32_32x32x16_bf16(pa2, PK(f.l[0][2], f.h[0][2]), o[0], 0, 0, 0);
  o[0] = __builtin_amdgcn_mfma_f32_32x32x16_bf16(pa3, PK(f.l[0][3], f.h[0][3]), o[0], 0, 0, 0);
  o[1] = __builtin_amdgcn_mfma_f32_32x32x16_bf16(pa0, PK(f.l[1][0], f.h[1][0]), o[1], 0, 0, 0);
  o[1] = __builtin_amdgcn_mfma_f32_32x32x16_bf16(pa1, PK(f.l[1][1], f.h[1][1]), o[1], 0, 0, 0);
  o[1] = __builtin_amdgcn_mfma_f32_32x32x16_bf16(pa2, PK(f.l[1][2], f.h[1][2]), o[1], 0, 0, 0);
  o[1] = __builtin_amdgcn_mfma_f32_32x32x16_bf16(pa3, PK(f.l[1][3], f.h[1][3]), o[1], 0, 0, 0);
#undef PK
}

template <int DQ>
__device__ __forceinline__ void attn_unit(const bf16_t* __restrict__ Qb, const bf16_t* __restrict__ Kh, const bf16_t* __restrict__ Kpe, const bf16_t* __restrict__ Vh,
                                          bf16_t* __restrict__ Ob, int seq, char* lds, const int wave_in) {
  constexpr int LDQ = (DQ == 96) ? 576 : 384, LDK = (DQ == 96) ? 384 : 128, LDO = 1024, ND = DQ / 16;
  const int tid = wave_in * 64 + pg8::lane_id_asm(), wid = wave_in, lane = tid & 63, r32 = lane & 31, hi = lane >> 5;
  char* V_lds = lds; char* K_lds = lds + 2 * SHM_V;
  float* ws = (float*)(lds + 2 * SHM_V + 2 * SHM_K) + wid * 64; float* li_l = ws; float* al_l = ws + 32;
  float m_reg = 0.f, l_reg = 0; f32x16 o[2] = {}; f32x16 negm = {}; bf16x8 qr[ND];
  const bf16_t* Qw = Qb + (unsigned)((wid * QBLK + r32) * LDQ + hi * 8);
#pragma unroll
  for (int d0 = 0; d0 < ND; ++d0) qr[d0] = *reinterpret_cast<const bf16x8*>(Qw + d0 * 16);
  const int sr = tid >> 3, sc = (tid & 7) * 8;
  const int pr = (tid >> 2) & 63, pc = (tid & 3) * 8;
  const int vst = v_st(sr, sc), kst = KSWZ(sr, sc * 2), pst = KSWZ(pr, (64 + pc) * 2);
  const int vb0 = (int)(uintptr_t)V_lds + v_rd_base(lane);
  struct { bf16x8 vs, ks, ps; } sr_[2];
  const unsigned voff = (unsigned)(sr * LDK + sc), poff = (unsigned)(pr * 32 + pc);
#define SLOAD(i, k0) do { const bf16_t* Vt_ = Vh + (size_t)(k0) * LDK; const bf16_t* Kt_ = Kh + (size_t)(k0) * LDK; \
    sr_[i].vs = *reinterpret_cast<const bf16x8*>(Vt_ + voff); sr_[i].ks = *reinterpret_cast<const bf16x8*>(Kt_ + voff); \
    if constexpr (DQ == 96) { const bf16_t* Pt_ = Kpe + (size_t)(k0) * 32; sr_[i].ps = *reinterpret_cast<const bf16x8*>(Pt_ + poff); } } while (0)
#define SWRITE(b, i) do { *(bf16x8*)(V_lds + (b) * SHM_V + vst) = sr_[i].vs; *(bf16x8*)(K_lds + (b) * SHM_K + kst) = sr_[i].ks; \
    if constexpr (DQ == 96) { if (tid < 256) *(bf16x8*)(K_lds + (b) * SHM_K + pst) = sr_[i].ps; } } while (0)
#define SWAIT() do { if constexpr (DQ == 96) asm volatile("s_waitcnt vmcnt(3)" ::: "memory"); else asm volatile("s_waitcnt vmcnt(2)" ::: "memory"); } while (0)
#define RESC(a) do { if (__any((a) < 1.f)) { if (hi == 0) al_l[r32] = (a); asm volatile("s_waitcnt lgkmcnt(0)" ::: "memory"); \
    _Pragma("unroll") for (int d = 0; d < 2; ++d) _Pragma("unroll") for (int r = 0; r < 16; ++r) o[d][r] *= al_l[crow(r, hi)]; } } while (0)
  f32x16 pA0, pA1, pB0, pB1; float alA, alB; bf16x8 pa0, pa1, pa2, pa3; const int NT = seq / KVBLK;
  constexpr int SE = 0, SO = 1;
  SLOAD(SE, 0); asm volatile("s_waitcnt vmcnt(0)" ::: "memory"); SWRITE(0, SE); __syncthreads();
  qkt<DQ>(pA0, pA1, K_lds, qr, negm, r32, hi); partialSM<true>(pA0, pA1, m_reg, negm, alA);
  SLOAD(SO, KVBLK); if (2 < NT) SLOAD(SE, 2 * KVBLK);
  SWAIT(); SWRITE(1, SO); __syncthreads();
  for (int j = 1; j + 1 < NT; j += 2) {
    SBAR(); qkt<DQ>(pB0, pB1, K_lds + SHM_K, qr, negm, r32, hi);
    finishSM(pA0, pA1, alA, l_reg, pa0, pa1, pa2, pa3); SBAR();
    SLOAD(SO, (j + 2) * KVBLK); SBAR();
    pv_d0(o, vb0, pa0, pa1, pa2, pa3); partialSM<false>(pB0, pB1, m_reg, negm, alB);
    __syncthreads(); SWAIT(); SWRITE(0, SE);
    RESC(alB); __syncthreads();
    SBAR(); qkt<DQ>(pA0, pA1, K_lds, qr, negm, r32, hi);
    finishSM(pB0, pB1, alB, l_reg, pa0, pa1, pa2, pa3); SBAR();
    if (j + 3 < NT) SLOAD(SE, (j + 3) * KVBLK); SBAR();
    pv_d0(o, vb0 + SHM_V, pa0, pa1, pa2, pa3); partialSM<false>(pA0, pA1, m_reg, negm, alA);
    __syncthreads(); SWAIT(); SWRITE(1, SO);
    RESC(alA); __syncthreads();
  }
  SBAR(); qkt<DQ>(pB0, pB1, K_lds + SHM_K, qr, negm, r32, hi);
  finishSM(pA0, pA1, alA, l_reg, pa0, pa1, pa2, pa3); SBAR();
  pv_d0(o, vb0, pa0, pa1, pa2, pa3); partialSM<false>(pB0, pB1, m_reg, negm, alB);
  __syncthreads(); RESC(alB);
  finishSM(pB0, pB1, alB, l_reg, pa0, pa1, pa2, pa3); SBAR();
  pv_d0(o, vb0 + SHM_V, pa0, pa1, pa2, pa3);
  if (hi == 0) li_l[r32] = l_reg; asm volatile("s_waitcnt lgkmcnt(0)" ::: "memory");
  float rli[16];
#pragma unroll
  for (int r = 0; r < 16; ++r) rli[r] = __builtin_amdgcn_rcpf(li_l[crow(r, hi)]);
  bf16_t* Ow = Ob + (long)(wid * QBLK) * LDO;
#pragma unroll
  for (int r = 0; r < 16; ++r) { int orow = crow(r, hi);
#pragma unroll
    for (int d0 = 0; d0 < 2; ++d0) { const float v = o[d0][r] * rli[r]; Ow[(long)orow * LDO + d0 * 32 + r32] = (bf16_t)(cvtpk(v, v) & 0xffffu); } }
  __syncthreads();
#undef SLOAD
#undef SWRITE
#undef SWAIT
#undef RESC
}
#undef SBAR
}

namespace d64 {
using bf16=__hip_bfloat16;
using bf16x8=__attribute__((ext_vector_type(8)))short;
using s16x4=__attribute__((ext_vector_type(4)))short;
using f32x16=__attribute__((ext_vector_type(16)))float;
using u32x4=__attribute__((ext_vector_type(4)))unsigned;
constexpr int D=64,LDQ=384,LDK=128,LDO=1024;
constexpr int NW=8,QBLK=32,QB=QBLK*NW,KVBLK=64;
__device__ __forceinline__ int crow(int r,int hi){return (r&3)+8*(r>>2)+4*hi;}
#define SBAR() __builtin_amdgcn_sched_barrier(0)
constexpr int NSLOT=3, SLOTB=8192;
constexpr int LDS_K=0, LDS_V=NSLOT*SLOTB, LDS_WS=2*NSLOT*SLOTB, LDS_OST=LDS_WS+NW*64*4, LDS_BYTES=LDS_OST+NW*4096;
constexpr float C2=0.125f*1.4426950408889634f;
__device__ __forceinline__ void glds16(const void*gsrc,unsigned lds_dst){unsigned keep;
  asm volatile("s_mov_b32 %0, m0\n\ts_mov_b32 m0, %2\n\ts_nop 0\n\tglobal_load_lds_dwordx4 %1, off\n\ts_mov_b32 m0, %0":"=&s"(keep):"v"(gsrc),"s"(lds_dst):"memory");}
__device__ __forceinline__ float max3f(float a,float b,float c){float r;asm("v_max3_f32 %0, %1, %2, %3":"=v"(r):"v"(a),"v"(b),"v"(c));return r;}
__device__ __forceinline__ float max2f(float a,float b){float r;asm("v_max_f32_e32 %0, %1, %2":"=v"(r):"v"(a),"v"(b));return r;}
__device__ __forceinline__ float fadd_s(float a,float b){float r;asm("v_add_f32_e32 %0, %1, %2":"=v"(r):"v"(a),"v"(b));return r;}
__device__ __forceinline__ float fsub_s(float a,float b){float r;asm("v_sub_f32_e32 %0, %1, %2":"=v"(r):"v"(a),"v"(b));return r;}
typedef float f32x2_t __attribute__((ext_vector_type(2))); typedef __bf16 bf16x2_t __attribute__((ext_vector_type(2)));
__device__ __forceinline__ unsigned cvtpk_s(float lo,float hi){f32x2_t v={lo,hi};bf16x2_t b=__builtin_convertvector(v,bf16x2_t);return __builtin_bit_cast(unsigned,b);}
#define WAIT_BAR(N) asm volatile("s_waitcnt vmcnt(" #N ") lgkmcnt(0)\n\ts_barrier":::"memory")

__device__ __forceinline__ void qkt(f32x16&p0,f32x16&p1,const char*Kslot,const bf16x8*qr,const f32x16&negm,int r32,int hi){
  const char*kb=Kslot+hi*1024+r32*16;
  #pragma unroll
  for(int d0=0;d0<4;++d0){
    const bf16x8 b0=*reinterpret_cast<const bf16x8*>(kb+d0*2048);
    const bf16x8 b1=*reinterpret_cast<const bf16x8*>(kb+d0*2048+512);
    if(d0==0){p0=__builtin_amdgcn_mfma_f32_32x32x16_bf16(b0,qr[0],negm,0,0,0);p1=__builtin_amdgcn_mfma_f32_32x32x16_bf16(b1,qr[0],negm,0,0,0);}
    else{p0=__builtin_amdgcn_mfma_f32_32x32x16_bf16(b0,qr[d0],p0,0,0,0);p1=__builtin_amdgcn_mfma_f32_32x32x16_bf16(b1,qr[d0],p1,0,0,0);}}
}
typedef __attribute__((address_space(3))) const char* lds_cptr;
typedef short v4i16_t __attribute__((ext_vector_type(4)));
__device__ __forceinline__ void kload8(bf16x8*kf,lds_cptr kp){
  kf[0]=*(const __attribute__((address_space(3))) bf16x8*)(kp);      kf[1]=*(const __attribute__((address_space(3))) bf16x8*)(kp+512);
  kf[2]=*(const __attribute__((address_space(3))) bf16x8*)(kp+2048); kf[3]=*(const __attribute__((address_space(3))) bf16x8*)(kp+2560);
  kf[4]=*(const __attribute__((address_space(3))) bf16x8*)(kp+4096); kf[5]=*(const __attribute__((address_space(3))) bf16x8*)(kp+4608);
  kf[6]=*(const __attribute__((address_space(3))) bf16x8*)(kp+6144); kf[7]=*(const __attribute__((address_space(3))) bf16x8*)(kp+6656);
}
__device__ __forceinline__ void kload2(bf16x8*kf,lds_cptr kp,int j){ kf[2*j]=*(const __attribute__((address_space(3))) bf16x8*)(kp+j*2048); kf[2*j+1]=*(const __attribute__((address_space(3))) bf16x8*)(kp+j*2048+512); }
__device__ __forceinline__ s16x4 vtr(lds_cptr p){ return __builtin_bit_cast(s16x4,__builtin_amdgcn_ds_read_tr16_b64_v4i16((__attribute__((address_space(3))) v4i16_t*)p)); }
__device__ __forceinline__ float rowmax(const f32x16&p0,const f32x16&p1){
  float a=max3f(p0[0],p0[1],p1[0]),b=max3f(p0[2],p0[3],p1[1]);a=max3f(a,p1[2],p1[3]);
  #pragma unroll
  for(int r=4;r<16;r+=4){a=max3f(a,p0[r],p0[r+1]);b=max3f(b,p0[r+2],p0[r+3]);a=max3f(a,p1[r],p1[r+1]);b=max3f(b,p1[r+2],p1[r+3]);}
  const float m=max2f(a,b);
  auto rr=__builtin_amdgcn_permlane32_swap(__float_as_uint(m),__float_as_uint(m),false,false);
  return max2f(__uint_as_float(rr[0]),__uint_as_float(rr[1]));
}
__device__ __forceinline__ void pv(f32x16*o,int vb,bf16x8 pa0,bf16x8 pa1,bf16x8 pa2,bf16x8 pa3){
  #pragma unroll
  for(int d0=0;d0<2;++d0){s16x4 lo[4],hi[4];
    #pragma unroll
    for(int ks=0;ks<4;++ks){
      asm volatile("ds_read_b64_tr_b16 %0,%1 offset:%c2":"=&v"(lo[ks]):"v"(vb),"i"(d0*4096+ks*1024):"memory");
      asm volatile("ds_read_b64_tr_b16 %0,%1 offset:%c2":"=&v"(hi[ks]):"v"(vb),"i"(d0*4096+ks*1024+512):"memory");}
    asm volatile("s_waitcnt lgkmcnt(0)":::"memory");SBAR();
    #define PK(k) (bf16x8){lo[k][0],lo[k][1],lo[k][2],lo[k][3],hi[k][0],hi[k][1],hi[k][2],hi[k][3]}
    o[d0]=__builtin_amdgcn_mfma_f32_32x32x16_bf16(pa0,PK(0),o[d0],0,0,0);
    o[d0]=__builtin_amdgcn_mfma_f32_32x32x16_bf16(pa1,PK(1),o[d0],0,0,0);
    o[d0]=__builtin_amdgcn_mfma_f32_32x32x16_bf16(pa2,PK(2),o[d0],0,0,0);
    o[d0]=__builtin_amdgcn_mfma_f32_32x32x16_bf16(pa3,PK(3),o[d0],0,0,0);
    #undef PK
  }
}

#ifndef ATTN_STORE16
#define ATTN_STORE16(p,v) (*(u32x4*)(p)=(v))
#endif
template<int THRL,bool PE> __device__ __forceinline__ void attn_unit(const bf16*Qu,const bf16*__restrict__ Kh,const bf16*__restrict__ Kpe,const bf16*__restrict__ Vh,bf16*Ou,const int NT,char*shm,const int wave_in){
  constexpr int LDQ_=PE?576:384, LDK_=PE?384:128, NDQ=PE?6:4, LDS_KPE=LDS_BYTES;
  const int lane=pg8::lane_id_asm(),tid=wave_in*64+lane,r32=lane&31,hi=lane>>5; const int wid=wave_in; (void)tid;
  const bf16*Qw=Qu+(long)(wid*QBLK)*LDQ_;
  const unsigned lds0=(unsigned)(uintptr_t)shm;
  float*wsf=(float*)(shm+LDS_WS)+wid*64;
  const bf16*ksrc=Kh+(long)lane*LDK_+wid*8; const bf16*psrc=PE?Kpe+(long)lane*32+(wid&3)*8:nullptr;
  const bf16*vsrc=Vh+(long)(16*(wid&3)+(lane>>2))*LDK_+(wid>>2)*32+(lane&3)*8;
  const unsigned kdst=lds0+LDS_K+wid*1024, vdst=lds0+LDS_V+wid*1024, pdst=lds0+LDS_KPE+(wid&3)*1024;
  #define DMA_K(t,slot) do{ glds16(ksrc+(long)(t)*KVBLK*LDK_,(unsigned)__builtin_amdgcn_readfirstlane(kdst+(slot))); \
    if constexpr(PE) glds16(psrc+(long)(t)*KVBLK*32,(unsigned)__builtin_amdgcn_readfirstlane(pdst+((slot)>>1))); }while(0)
  #define DMA_V(t,slot) glds16(vsrc+(long)(t)*KVBLK*LDK_,(unsigned)__builtin_amdgcn_readfirstlane(vdst+(slot)))
  const int vb0=(int)(lds0+LDS_V)+((lane>>4)&1)*32+(lane&3)*8+(4*hi+((lane&15)>>2))*64;
  const char*Kbase=shm+LDS_K; bf16x8 kf[8]; bf16x8 kpf[4];
  const lds_cptr shm3=(lds_cptr)shm; const lds_cptr kp0=shm3+LDS_K+hi*1024+r32*16; const lds_cptr pp0=shm3+LDS_KPE+hi*1024+r32*16; const lds_cptr vp0=shm3+LDS_V+((lane>>4)&1)*32+(lane&3)*8+(4*hi+((lane&15)>>2))*64;
  DMA_K(0,0);DMA_V(0,0);DMA_K(1,SLOTB);
  bf16x8 qr[NDQ];
  #pragma unroll
  for(int d0=0;d0<NDQ;++d0)qr[d0]=*reinterpret_cast<const bf16x8*>(&Qw[(long)r32*LDQ_+d0*16+hi*8]);
  float mhat=0.f,l_reg=0.f;f32x16 o[2];o[0]=f32x16{};o[1]=f32x16{};f32x16 negm=f32x16{};asm volatile("":"+v"(negm));
  #define CMASK(P0,P1,t) do{}while(0)
  bool resc=false;
  #define START(P0,P1) do{ const float rm=rowmax(P0,P1); resc=false; \
    { const float dl=rm; mhat=fadd_s(mhat,dl); \
      _Pragma("unroll") for(int r=0;r<16;++r){P0[r]=fsub_s(P0[r],dl);P1[r]=fsub_s(P1[r],dl);} \
      _Pragma("unroll") for(int r=0;r<16;++r)negm[r]=-mhat; asm volatile("":"+v"(negm)); } \
    _Pragma("unroll") for(int r=0;r<16;++r)P0[r]=__builtin_amdgcn_exp2f(P0[r]); }while(0)
  #define RESC() do{ if(resc){ asm volatile("s_waitcnt lgkmcnt(0)":::"memory"); \
      _Pragma("unroll") for(int d_=0;d_<2;++d_) _Pragma("unroll") for(int r=0;r<16;++r)o[d_][r]*=wsf[crow(r,hi)]; } }while(0)
  f32x16 pA0,pA1,pB0,pB1;
  int sl_prev=0,sl_cur=0,sl_next=SLOTB;
  #define ROT() do{sl_prev=sl_cur;sl_cur=sl_next;sl_next=(sl_next==(NSLOT-1)*SLOTB)?0:sl_next+SLOTB;}while(0)
  DMA_K(2,2*SLOTB);
  if constexpr(PE){WAIT_BAR(5);}else{WAIT_BAR(3);}
  qkt(pA0,pA1,Kbase,qr,negm,r32,hi);
  if constexpr(PE){ const char*pb=shm+LDS_KPE+hi*1024+r32*16;
    _Pragma("unroll") for(int j=0;j<2;++j){ const bf16x8 b0=*reinterpret_cast<const bf16x8*>(pb+j*2048), b1=*reinterpret_cast<const bf16x8*>(pb+j*2048+512);
      pA0=__builtin_amdgcn_mfma_f32_32x32x16_bf16(b0,qr[4+j],pA0,0,0,0); pA1=__builtin_amdgcn_mfma_f32_32x32x16_bf16(b1,qr[4+j],pA1,0,0,0);} }
  asm volatile("s_nop 15\n\ts_nop 7":"+v"(pA0),"+v"(pA1));CMASK(pA0,pA1,0);
  START(pA0,pA1);
  _Pragma("unroll") for(int r=0;r<16;++r)pA1[r]=__builtin_amdgcn_exp2f(pA1[r]);
  WAIT_BAR(0);
  DMA_K(3,0);DMA_V(1,SLOTB);
  ROT();
  kload8(kf,kp0+sl_cur); if constexpr(PE){ kload2(kpf,pp0+(sl_cur>>1),0); kload2(kpf,pp0+(sl_cur>>1),1); }
  if constexpr(PE){WAIT_BAR(3);}else{WAIT_BAR(2);}
  s16x4 vlo[8],vhi[8]; u32x4 pw0,pw1,pw2,pw3;
  #define PKW(P,B) cvtpk_s(P[B],P[B+1])
  #define PAF(k) __builtin_bit_cast(bf16x8,pw##k)
  #define VFR(i) (bf16x8){vlo[i][0],vlo[i][1],vlo[i][2],vlo[i][3],vhi[i][0],vhi[i][1],vhi[i][2],vhi[i][3]}
  #define PIN(x) asm volatile("":"+v"(x))
  #define MX3(a,b,c) __builtin_fmaxf(__builtin_fmaxf((a),(b)),(c))
  #define GAPA(MF,A0,A1,A2,A3,W0,W1,PW) do{ MF; sacc+=A0; sacc+=A1; sacc+=A2; sacc+=A3; PIN(sacc); W0; W1; PIN(PW); SBAR(); }while(0)
  #define EX(v) __builtin_amdgcn_exp2f(v)
  #define GAPB(MF,X,B) do{ MF; X[B]=EX(X[B]); X[B+1]=EX(X[B+1]); X[B+2]=EX(X[B+2]); X[B+3]=EX(X[B+3]); PIN(X); SBAR(); }while(0)
  #define VRD(i) do{ vlo[i]=vtr(vp_+(((i)>>2)*4096+((i)&3)*1024)); vhi[i]=vtr(vp_+(((i)>>2)*4096+((i)&3)*1024+512)); }while(0)
  #define KRD(G,j) do{ if(G){ kload2(kf,kp0+sl_next,j); if constexpr(PE){ if((j)<2) kload2(kpf,pp0+(sl_next>>1),j); } SBAR(); } }while(0)
  #define STEP(C0,C1,P0,P1,t,GK,GV,GL) do{ SBAR(); \
    const lds_cptr vp_=vp0+sl_prev; \
    VRD(0); SBAR(); float sacc=(P0[0]+P0[1]); \
    GAPA(C0=__builtin_amdgcn_mfma_f32_32x32x16_bf16(kf[0],qr[0],negm,0,0,0), P0[2],P0[3],P0[4],P0[5],     pw0[0]=PKW(P0,0), pw0[1]=PKW(P0,2), pw0); \
    VRD(4); SBAR(); GAPA(C1=__builtin_amdgcn_mfma_f32_32x32x16_bf16(kf[1],qr[0],negm,0,0,0), P0[6],P0[7],P0[8],P0[9],     pw0[2]=PKW(P0,4), pw0[3]=PKW(P0,6), pw0); \
    VRD(1); SBAR(); GAPA(C0=__builtin_amdgcn_mfma_f32_32x32x16_bf16(kf[2],qr[1],C0,0,0,0),   P0[10],P0[11],P0[12],P0[13], pw1[0]=PKW(P0,8), pw1[1]=PKW(P0,10), pw1); \
    VRD(5); SBAR(); GAPA(C1=__builtin_amdgcn_mfma_f32_32x32x16_bf16(kf[3],qr[1],C1,0,0,0),   P0[14],P0[15],P1[0],P1[1],   pw1[2]=PKW(P0,12),pw1[3]=PKW(P0,14), pw1); \
    VRD(2); SBAR(); GAPA(C0=__builtin_amdgcn_mfma_f32_32x32x16_bf16(kf[4],qr[2],C0,0,0,0),   P1[2],P1[3],P1[4],P1[5],     pw2[0]=PKW(P1,0), pw2[1]=PKW(P1,2), pw2); \
    VRD(6); SBAR(); GAPA(C1=__builtin_amdgcn_mfma_f32_32x32x16_bf16(kf[5],qr[2],C1,0,0,0),   P1[6],P1[7],P1[8],P1[9],     pw2[2]=PKW(P1,4), pw2[3]=PKW(P1,6), pw2); \
    VRD(3); SBAR(); GAPA(C0=__builtin_amdgcn_mfma_f32_32x32x16_bf16(kf[6],qr[3],C0,0,0,0),   P1[10],P1[11],P1[12],P1[13], pw3[0]=PKW(P1,8), pw3[1]=PKW(P1,10), pw3); \
    VRD(7); SBAR(); GAPA(C1=__builtin_amdgcn_mfma_f32_32x32x16_bf16(kf[7],qr[3],C1,0,0,0),   P1[14],P1[15],0.f,0.f,       pw3[2]=PKW(P1,12),pw3[3]=PKW(P1,14), pw3); \
    if constexpr(PE){ C0=__builtin_amdgcn_mfma_f32_32x32x16_bf16(kpf[0],qr[4],C0,0,0,0); C1=__builtin_amdgcn_mfma_f32_32x32x16_bf16(kpf[1],qr[4],C1,0,0,0); \
      C0=__builtin_amdgcn_mfma_f32_32x32x16_bf16(kpf[2],qr[5],C0,0,0,0); C1=__builtin_amdgcn_mfma_f32_32x32x16_bf16(kpf[3],qr[5],C1,0,0,0); } \
    l_reg+=sacc; \
    if(GK){DMA_K((t)+3,sl_cur);} if(GV){DMA_V((t)+1,sl_next);} \
    CMASK(C0,C1,t); \
    { float a=MX3(C0[0],C0[1],C1[0]),b=MX3(C0[2],C0[3],C1[1]); a=MX3(a,C1[2],C1[3]); \
      _Pragma("unroll") for(int r=4;r<16;r+=4){a=MX3(a,C0[r],C0[r+1]);b=MX3(b,C0[r+2],C0[r+3]);a=MX3(a,C1[r],C1[r+1]);b=MX3(b,C1[r+2],C1[r+3]);} \
      float rm=__builtin_fmaxf(a,b); { auto rr=__builtin_amdgcn_permlane32_swap(__float_as_uint(rm),__float_as_uint(rm),false,false); rm=__builtin_fmaxf(__uint_as_float(rr[0]),__uint_as_float(rr[1])); } \
      resc=false; \
      if(__builtin_expect(__any(rm>(float)THRL),0)){ const float dl=__builtin_fmaxf(rm,0.f); mhat+=dl; \
        _Pragma("unroll") for(int r=0;r<16;++r){C0[r]-=dl;C1[r]-=dl;} \
        _Pragma("unroll") for(int r=0;r<16;++r)negm[r]=-mhat; asm volatile("":"+v"(negm)); \
        const float f=__builtin_amdgcn_exp2f(-dl); l_reg*=f; if(hi==0)wsf[r32]=f; resc=true; } } \
    SBAR(); \
    GAPB(o[0]=__builtin_amdgcn_mfma_f32_32x32x16_bf16(PAF(0),VFR(0),o[0],0,0,0), C0,0); \
    GAPB(o[1]=__builtin_amdgcn_mfma_f32_32x32x16_bf16(PAF(0),VFR(4),o[1],0,0,0), C0,4); \
    KRD(GL,0); GAPB(o[0]=__builtin_amdgcn_mfma_f32_32x32x16_bf16(PAF(1),VFR(1),o[0],0,0,0), C0,8); \
    KRD(GL,1); GAPB(o[1]=__builtin_amdgcn_mfma_f32_32x32x16_bf16(PAF(1),VFR(5),o[1],0,0,0), C0,12); \
    KRD(GL,2); GAPB(o[0]=__builtin_amdgcn_mfma_f32_32x32x16_bf16(PAF(2),VFR(2),o[0],0,0,0), C1,0); \
    KRD(GL,3); GAPB(o[1]=__builtin_amdgcn_mfma_f32_32x32x16_bf16(PAF(2),VFR(6),o[1],0,0,0), C1,4); \
    GAPB(o[0]=__builtin_amdgcn_mfma_f32_32x32x16_bf16(PAF(3),VFR(3),o[0],0,0,0), C1,8); \
    GAPB(o[1]=__builtin_amdgcn_mfma_f32_32x32x16_bf16(PAF(3),VFR(7),o[1],0,0,0), C1,12); \
    }while(0)
  int t=1;
  #undef CMASK
  #define CMASK(P0,P1,t) do{}while(0)
  for(;t+5<NT;t+=2){
    STEP(pB0,pB1,pA0,pA1,t,true,true,true);     if constexpr(PE){WAIT_BAR(3);}else{WAIT_BAR(2);} RESC(); ROT();
    STEP(pA0,pA1,pB0,pB1,t+1,true,true,true);   if constexpr(PE){WAIT_BAR(3);}else{WAIT_BAR(2);} RESC(); ROT();
  }
  #undef CMASK
  #define CMASK(P0,P1,t) do{}while(0)
  #define ENDW(tt) do{ if((tt)+3<NT){ if constexpr(PE){WAIT_BAR(3);}else{WAIT_BAR(2);} } else if((tt)+2<NT){WAIT_BAR(1);} else {WAIT_BAR(0);} }while(0)
  for(;t+1<NT;t+=2){
    STEP(pB0,pB1,pA0,pA1,t,(t+3<NT),(t+1<NT),(t+1<NT));       ENDW(t);   RESC(); ROT();
    STEP(pA0,pA1,pB0,pB1,t+1,(t+4<NT),(t+2<NT),(t+2<NT));     ENDW(t+1); RESC(); ROT();
  }
  STEP(pB0,pB1,pA0,pA1,NT-1,false,false,false); RESC();
  { float sacc=pB0[0]+pB0[1]; _Pragma("unroll") for(int r=2;r<16;++r)sacc+=pB0[r]; _Pragma("unroll") for(int r=0;r<16;++r)sacc+=pB1[r]; l_reg+=sacc;
    pw0=(u32x4){PKW(pB0,0),PKW(pB0,2),PKW(pB0,4),PKW(pB0,6)};pw1=(u32x4){PKW(pB0,8),PKW(pB0,10),PKW(pB0,12),PKW(pB0,14)};pw2=(u32x4){PKW(pB1,0),PKW(pB1,2),PKW(pB1,4),PKW(pB1,6)};pw3=(u32x4){PKW(pB1,8),PKW(pB1,10),PKW(pB1,12),PKW(pB1,14)};
    SBAR(); pv(o,vb0+sl_cur,PAF(0),PAF(1),PAF(2),PAF(3)); }
  #undef PKW
  #undef PAF
  #undef VFR
  #undef PIN
  #undef MX3
  #undef GAPA
  #undef GAPB
  #undef EX
  #undef VRD
  #undef KRD
  #undef STEP
  #undef ENDW
  {auto rr=__builtin_amdgcn_permlane32_swap(__float_as_uint(l_reg),__float_as_uint(l_reg),false,false);l_reg=__uint_as_float(rr[0])+__uint_as_float(rr[1]);}
  if(hi==0)wsf[32+r32]=l_reg;asm volatile("s_waitcnt lgkmcnt(0)":::"memory");
  float rli[16];
  #pragma unroll
  for(int r=0;r<16;++r)rli[r]=__builtin_amdgcn_rcpf(wsf[32+crow(r,hi)]);
  bf16*Ow=Ou+(long)(wid*QBLK)*LDO;
  { bf16*stg=(bf16*)(shm+LDS_OST)+wid*2048;
    #pragma unroll
    for(int r=0;r<16;++r){const int orow=crow(r,hi);
      #pragma unroll
      for(int d0=0;d0<2;++d0)stg[orow*64+d0*32+r32]=__float2bfloat16(o[d0][r]*rli[r]);}
    asm volatile("s_waitcnt lgkmcnt(0)":::"memory");
    #pragma unroll
    for(int i=0;i<4;++i){const int row=i*8+(lane>>3),ch=lane&7; const u32x4 v=*(const u32x4*)(stg+row*64+ch*8); ATTN_STORE16(Ow+(long)row*LDO+ch*8,v);} }
  asm volatile("s_waitcnt lgkmcnt(0)\n\ts_barrier":::"memory");
  #undef DMA_K
  #undef DMA_V
  #undef CMASK
  #undef START
  #undef RESC
  #undef ROT
}
#undef SBAR
#undef WAIT_BAR
}

typedef unsigned short bf16_t;
typedef float f32x4 __attribute__((ext_vector_type(4)));
typedef float f32x2 __attribute__((ext_vector_type(2)));
typedef unsigned u32x2 __attribute__((ext_vector_type(2)));
typedef unsigned u32x4 __attribute__((ext_vector_type(4)));
#define LAS __attribute__((address_space(3)))
typedef _Float16 h16x8 __attribute__((ext_vector_type(8)));
#define XB_TMO      128
#define XB_XCNT(j)  (256  + 64 * (j))
#define XB_XSUB(j)  (1280 + 64 * (j))
#define XB_XGEN(j)  (2304 + 64 * (j))
#define XB_TOP      3328
#define XB_TOPGEN   3392
#define XCD_BAR_WORDS 3456
#define XB_SPIN_CAP (1u << 18)

__device__ __forceinline__ unsigned xb_ld(unsigned* p)              { return __hip_atomic_load(p, __ATOMIC_RELAXED, __HIP_MEMORY_SCOPE_AGENT); }
__device__ __forceinline__ unsigned xb_add(unsigned* p, unsigned v) { return __hip_atomic_fetch_add(p, v, __ATOMIC_RELAXED, __HIP_MEMORY_SCOPE_AGENT); }
__device__ __forceinline__ unsigned xb_xcc_id() { return (unsigned)__builtin_amdgcn_s_getreg((3 << 11) | 20) & 0xFu; }
#define XB_SPIN(cond, bar) do { unsigned _sp = 0; while (cond) { __builtin_amdgcn_s_sleep(1); \
    if ((++_sp & 255u) == 0u) { if (xb_ld(&(bar)[XB_TMO])) break; if (_sp > XB_SPIN_CAP) { atomicAdd(&(bar)[XB_TMO], 1u); break; } } } } while (0)

struct XcdBarrier {
    unsigned* bar; unsigned x;
    volatile LAS unsigned* st;
};

__device__ __forceinline__ XcdBarrier xcd_barrier_post(unsigned* bar, volatile LAS unsigned* st, const bool t0) {
    XcdBarrier b; b.bar = bar; b.x = xb_xcc_id(); b.st = st;
    if (t0) (void)xb_add(&bar[XB_XCNT(b.x)], 1u);
    return b;
}
__device__ __forceinline__ void xcd_barrier_complete(unsigned* bar, unsigned x, unsigned& nloc, unsigned& nx) {
    const unsigned G = gridDim.x * gridDim.y * gridDim.z;
    unsigned sum, cnt, mine, sp = 0u;
    for (;;) {
        sum = 0u; cnt = 0u; mine = 0u;
#pragma unroll
        for (unsigned j = 0; j < 16; ++j) { const unsigned c = xb_ld(&bar[XB_XCNT(j)]); sum += c; cnt += (c > 0u) ? 1u : 0u; mine = (j == x) ? c : mine; }
        if (sum == G) break;
        __builtin_amdgcn_s_sleep(1);
        if ((++sp & 255u) == 0u) { if (xb_ld(&bar[XB_TMO])) break; if (sp > XB_SPIN_CAP) { atomicAdd(&bar[XB_TMO], 1u); break; } }
    }
    nloc = mine > 0u ? mine : 1u; nx = cnt > 0u ? cnt : 1u;
}

__device__ __forceinline__ void xcd_barrier(const XcdBarrier& b, const bool t0) {
    asm volatile("s_waitcnt vmcnt(0)" ::: "memory");
    __syncthreads();
    if (t0) {
        unsigned* bar = b.bar;
        __builtin_amdgcn_s_waitcnt(0);
        unsigned nloc = b.st[0], nx = b.st[1];
        if (nloc == 0u) { xcd_barrier_complete(bar, b.x, nloc, nx); b.st[0] = nloc; b.st[1] = nx; }
        const unsigned old = xb_add(&bar[XB_XSUB(b.x)], 1u);
        const unsigned gen = old / nloc;
        if (old + 1u == (gen + 1u) * nloc) {
            __builtin_amdgcn_fence(__ATOMIC_RELEASE, "agent");
            asm volatile("s_waitcnt vmcnt(0)" ::: "memory");
            const unsigned og = xb_add(&bar[XB_TOP], 1u);
            const unsigned tg = og / nx;
            if (og + 1u == (tg + 1u) * nx) xb_add(&bar[XB_TOPGEN], 1u);
            else XB_SPIN(xb_ld(&bar[XB_TOPGEN]) == tg, bar);
            __builtin_amdgcn_fence(__ATOMIC_ACQUIRE, "agent");
            xb_add(&bar[XB_XGEN(b.x)], 1u);
            asm volatile("s_waitcnt vmcnt(0)" ::: "memory");
        } else {
            XB_SPIN(xb_ld(&bar[XB_XGEN(b.x)]) == gen, bar);
            __builtin_amdgcn_fence(__ATOMIC_ACQUIRE, "agent");
            asm volatile("s_waitcnt vmcnt(0)" ::: "memory");
        }
    }
    __syncthreads();
}

constexpr size_t MiB = 1u << 20;
constexpr size_t WS_MOD = 1 * MiB, WS_ROPEM = 2 * MiB, WS_ROPEG = 3 * MiB, WS_Z = 5 * MiB;
constexpr size_t WS_WIN = 10 * MiB, WS_WUQ = 26 * MiB, WS_WUKV = 28 * MiB, WS_WO = 29 * MiB, WS_W1 = 37 * MiB, WS_W2 = 69 * MiB;
constexpr size_t WS_U = 101 * MiB, WS_Y = WS_U  , WS_PART = 167 * MiB  , WS_OV = 233 * MiB;
constexpr size_t WS_HM = WS_OV, WS_H = WS_OV, WS_MQ = WS_OV, WS_MK = 271 * MiB, WS_MV = 296 * MiB;
constexpr size_t WS_CKV = 365 * MiB, WS_CQ = 374 * MiB, WS_KPE = 391 * MiB, WS_GK = 394 * MiB, WS_GV = 403 * MiB, WS_GQ = 412 * MiB, WS_O = 437 * MiB, WS_END = 503 * MiB;
static_assert(WS_MQ + (size_t)MROWS * 576 * 2 <= WS_MK && WS_MK + (size_t)MROWS * 384 * 2 <= WS_MV && WS_MV + (size_t)MROWS * 384 * 2 <= WS_H + (size_t)MROWS * HP * 2, "overlay");
static_assert(WS_H + (size_t)MROWS * HP * 2 <= WS_CKV && WS_CKV + (size_t)MROWS * 256 <= WS_CQ && WS_CQ + (size_t)MROWS * 512 <= WS_KPE && WS_KPE + (size_t)MROWS * 64 <= WS_GK, "map1");
static_assert(WS_GK + (size_t)MROWS * 256 <= WS_GV && WS_GV + (size_t)MROWS * 256 <= WS_GQ && WS_GQ + (size_t)MROWS * 768 <= WS_O && WS_O + (size_t)MROWS * 2048 <= WS_END, "map2");
static_assert(WS_HM + (size_t)MROWS * DFF * 2 <= WS_END, "map3");
#ifndef ATT_REPS
#define ATT_REPS 1
#endif
#ifndef TDIV
#define TDIV 1
#endif
#ifndef TSEL
#define TSEL -1
#endif
constexpr float QSC64 = 0.125f * 1.4426950408889634f, QSC96 = 0.10206207261596575f * 1.4426950408889634f;
constexpr int LDS_BYTES = 135168;

struct Params { const float* in[21]; float* out; unsigned char* ws; };
enum { I_X = 0, I_C, I_CTX, I_CCTX, I_WADA, I_BADA, I_WIN, I_GCQ, I_WUQ, I_GCKV, I_WUKV, I_GQN, I_GKN, I_WCONV, I_WO, I_LN1G, I_LN1B, I_W1, I_W2, I_LN2G, I_LN2B };

template <int CTRL> __device__ __forceinline__ float dppf(float v) { return __int_as_float(__builtin_amdgcn_update_dpp(0, __float_as_int(v), CTRL, 0xf, 0xf, true)); }
__device__ __forceinline__ float half_sum(float v) {
    v += dppf<0xB1>(v); v += dppf<0x4E>(v); v += dppf<0x141>(v); v += dppf<0x140>(v);
    auto r = __builtin_amdgcn_permlane16_swap(__float_as_uint(v), __float_as_uint(v), false, false);
    return __uint_as_float(r[0]) + __uint_as_float(r[1]);
}
__device__ __forceinline__ float wave_sum(float v) {
    v = half_sum(v);
    auto r = __builtin_amdgcn_permlane32_swap(__float_as_uint(v), __float_as_uint(v), false, false);
    return __uint_as_float(r[0]) + __uint_as_float(r[1]);
}
__device__ __forceinline__ unsigned pk2(float lo, float hi) { unsigned r; asm volatile("v_cvt_pk_bf16_f32 %0, %1, %2" : "=v"(r) : "v"(lo), "v"(hi)); return r; }
__device__ __forceinline__ float bflo(unsigned w) { return __uint_as_float(w << 16); }
__device__ __forceinline__ float bfhi(unsigned w) { return __uint_as_float(w & 0xffff0000u); }

__device__ __forceinline__ void transpose_item(const float* W, int K, int N, bf16_t* WT, LAS float* scr, int item, int lane) {
    const int nblk = N / 32, kb = item / nblk, nb = item % nblk, k0 = 64 * kb, n0 = 32 * nb;
#pragma unroll 8
    for (int i = 0; i < 32; ++i) { const int kk = 2 * i + (lane >> 5); scr[kk * 33 + (lane & 31)] = W[(size_t)(k0 + kk) * N + n0 + (lane & 31)]; }
    asm volatile("s_waitcnt lgkmcnt(0)" ::: "memory");
    const int c = lane & 7;
#pragma unroll
    for (int j = 0; j < 4; ++j) { const int n = (lane >> 3) + 8 * j; const LAS float* s = scr + (8 * c) * 33 + n;
        u32x4 o; o.x = pk2(s[0 * 33], s[1 * 33]); o.y = pk2(s[2 * 33], s[3 * 33]); o.z = pk2(s[4 * 33], s[5 * 33]); o.w = pk2(s[6 * 33], s[7 * 33]);
        *(u32x4*)(WT + (size_t)(n0 + n) * K + k0 + 8 * c) = o; }
    asm volatile("s_waitcnt lgkmcnt(0)" ::: "memory");
}

struct RowInfo { int b, i, v; bool isctx; };
__device__ __forceinline__ RowInfo row_info(int m) { RowInfo r; r.b = m / LTOK; r.i = m - r.b * LTOK; r.isctx = r.i < CTX; r.v = r.isctx ? 4 : r.b; return r; }

__global__ void __launch_bounds__(512, 2) fwd_megakernel(Params p) {
    extern __shared__ __attribute__((aligned(16))) unsigned char lds[];
    cg::grid_group grid = cg::this_grid();
#if TSEL >= 0
#define TSL ((unsigned*)(lds + 133120))
#define TST (blockIdx.x == 0 && wave == 0 && pg8::lane_id_asm() == 0)
#define TINIT() do { if (TST) { for (int k = 0; k < 16; ++k) TSL[k] = 0; TSL[12] = (unsigned)__builtin_amdgcn_s_memrealtime(); } } while (0)
#define TBODY(k) do { if (TST) { const unsigned t_ = (unsigned)__builtin_amdgcn_s_memrealtime(); const unsigned d_ = t_ - TSL[12]; TSL[k] += d_; TSL[11] += d_; TSL[12] = t_; } } while (0)
#define TSYNC() do { if (TST) { const unsigned t_ = (unsigned)__builtin_amdgcn_s_memrealtime(); const unsigned d_ = t_ - TSL[12]; TSL[10] += d_; TSL[11] += d_; TSL[12] = t_; } } while (0)
#else
#define TINIT() do {} while (0)
#define TBODY(k) do {} while (0)
#define TSYNC() do {} while (0)
#endif
#define XB_T0 (wave == 0 && pg8::lane_id_asm() == 0)
#define XB_ST ((volatile LAS unsigned*)((LAS unsigned char*)lds + 133376))
#define XB_BAR ((unsigned*)WSB())
#define GSYNC_CG(k) do { TBODY(k); grid.sync(); TSYNC(); } while (0)
#define GSYNC(k) do { TBODY(k); { XcdBarrier xb_; xb_.bar = XB_BAR; xb_.x = xb_xcc_id(); xb_.st = XB_ST; xcd_barrier(xb_, XB_T0); } TSYNC(); } while (0)
    const int wave = __builtin_amdgcn_readfirstlane(threadIdx.x >> 6);
    TINIT();
    if (XB_T0) { XB_ST[0] = 0u; XB_ST[1] = 0u; }
    __syncthreads();
#define G ((int)gridDim.x)
#define bx ((int)blockIdx.x)
#define vcu ((G % 8 == 0) ? (bx % 8) * (G / 8) + bx / 8 : bx)
#define gw (bx * 8 + wave)
#define NGW (G * 8)
#define LAUN3() int G_ = G, bx_ = bx, wave_ = wave; asm volatile("" : "+s"(G_), "+s"(bx_), "+s"(wave_))
#define KP() ({ const __attribute__((address_space(4))) Params* k_ = (const __attribute__((address_space(4))) Params*)__builtin_amdgcn_kernarg_segment_ptr(); asm volatile("" : "+s"(k_)); k_; })
#define WSB() ((unsigned char*)KP()->ws)
#define DEFWS(w) \
    float* MOD = (float*)((w) + WS_MOD); float* ROPEM = (float*)((w) + WS_ROPEM); float* ROPEG = (float*)((w) + WS_ROPEG); float* Z = (float*)((w) + WS_Z); \
    bf16_t* WIN = (bf16_t*)((w) + WS_WIN); bf16_t* WUQ = (bf16_t*)((w) + WS_WUQ); bf16_t* WUKV = (bf16_t*)((w) + WS_WUKV); bf16_t* WO = (bf16_t*)((w) + WS_WO); \
    bf16_t* W1 = (bf16_t*)((w) + WS_W1); bf16_t* W2 = (bf16_t*)((w) + WS_W2); \
    bf16_t* U = (bf16_t*)((w) + WS_U); bf16_t* Y = (bf16_t*)((w) + WS_Y); bf16_t* HM = (bf16_t*)((w) + WS_HM); bf16_t* H = (bf16_t*)((w) + WS_H); \
    bf16_t* MQ = (bf16_t*)((w) + WS_MQ); bf16_t* MK = (bf16_t*)((w) + WS_MK); bf16_t* MV = (bf16_t*)((w) + WS_MV); \
    bf16_t* CKV = (bf16_t*)((w) + WS_CKV); bf16_t* CQ = (bf16_t*)((w) + WS_CQ); bf16_t* KPE = (bf16_t*)((w) + WS_KPE); \
    bf16_t* GK = (bf16_t*)((w) + WS_GK); bf16_t* GV = (bf16_t*)((w) + WS_GV); bf16_t* GQ = (bf16_t*)((w) + WS_GQ); bf16_t* OC = (bf16_t*)((w) + WS_O); float* PART = (float*)((w) + WS_PART); (void)PART; \
    (void)MOD; (void)ROPEM; (void)ROPEG; (void)Z; (void)WIN; (void)WUQ; (void)WUKV; (void)WO; (void)W1; (void)W2; (void)U; (void)Y; (void)HM; (void)H; (void)MQ; (void)MK; (void)MV; \
    (void)CKV; (void)CQ; (void)KPE; (void)GK; (void)GV; (void)GQ; (void)OC;

    {
        unsigned char* ws_b_ = WSB(); DEFWS(ws_b_)
        const int lane = pg8::lane_id_asm(), tid = wave * 64 + lane;
        if (bx == 0) { unsigned* bar_ = (unsigned*)ws_b_; for (int i = tid; i < XCD_BAR_WORDS; i += 512) bar_[i] = 0u; }
        LAS float* scr = (LAS float*)((LAS unsigned char*)lds + wave * 16384);
        constexpr int I_IN = 16 * 57, I_UQ = 4 * 18, I_UKV = 2 * 24, I_O = 16 * 32, I_1 = 16 * 128, I_2 = 64 * 32, PER = I_IN + I_UQ + I_UKV + I_O + I_1 + I_2;
        for (int it = gw; it < DEPTH * PER; it += NGW) {
            const int l = it / PER; int r = it - l * PER;
            if (r < I_IN) { transpose_item(KP()->in[I_WIN] + (size_t)l * DM * IN_COLS, DM, IN_COLS, WIN + (size_t)l * HP * DM, scr, r, lane); continue; } r -= I_IN;
            if (r < I_UQ) { transpose_item(KP()->in[I_WUQ] + (size_t)l * 256 * 576, 256, 576, WUQ + (size_t)l * 768 * 256, scr, r, lane); continue; } r -= I_UQ;
            if (r < I_UKV) { transpose_item(KP()->in[I_WUKV] + (size_t)l * 128 * 768, 128, 768, WUKV + (size_t)l * 768 * 128, scr, r, lane); continue; } r -= I_UKV;
            if (r < I_O) { transpose_item(KP()->in[I_WO] + (size_t)l * DM * DM, DM, DM, WO + (size_t)l * DM * DM, scr, r, lane); continue; } r -= I_O;
            if (r < I_1) { transpose_item(KP()->in[I_W1] + (size_t)l * DM * DFF, DM, DFF, W1 + (size_t)l * DFF * DM, scr, r, lane); continue; } r -= I_1;
            transpose_item(KP()->in[I_W2] + (size_t)l * DFF * DM, DFF, DM, W2 + (size_t)l * DM * DFF, scr, r, lane);
        }
        const int gt = bx * 512 + tid, NGT = G * 512;
        for (int idx = gt; idx < DEPTH * 224 * 128; idx += NGT) { const int l = idx / (224 * 128), r = idx % (224 * 128);
            *(u32x4*)(WIN + ((size_t)l * HP + IN_COLS) * DM + (size_t)r * 8) = (u32x4){0u, 0u, 0u, 0u}; }
        for (int idx = gt; idx < DEPTH * 192 * 32; idx += NGT) { const int l = idx / (192 * 32), r = idx % (192 * 32);
            *(u32x4*)(WUQ + ((size_t)l * 768 + 576) * 256 + (size_t)r * 8) = (u32x4){0u, 0u, 0u, 0u}; }
        for (int idx = gt; idx < SEQ * 16; idx += NGT) { const int pos = idx >> 4, i = idx & 15; const int rw = pos >> 6, cl = pos & 63;
            const float inv = powf(10000.f, -(float)(i & 7) / 8.f); const float ang = (float)(i < 8 ? rw : cl) * inv;
            ROPEM[2 * idx] = cosf(ang); ROPEM[2 * idx + 1] = sinf(ang); }
        for (int idx = gt; idx < SEQ * 32; idx += NGT) { const int pos = idx >> 5, i = idx & 31; const int rw = pos >> 6, cl = pos & 63;
            const float inv = powf(10000.f, -(float)(i & 15) / 16.f); const float ang = (float)(i < 16 ? rw : cl) * inv;
            ROPEG[2 * idx] = cosf(ang); ROPEG[2 * idx + 1] = sinf(ang); }
        __syncthreads();
        float* sil = (float*)lds;
        float* part = (float*)lds + 5 * 1024;
        { const float* c_in = KP()->in[I_C]; const float* cc_in = KP()->in[I_CCTX];
        for (int idx = tid; idx < 5 * 1024; idx += 512) { const int v = idx >> 10, k = idx & 1023; const float c = (v < 4) ? c_in[v * 1024 + k] : cc_in[k]; sil[idx] = c / (1.f + __expf(-c)); } }
        const float* wada_ = KP()->in[I_WADA]; const float* bada_ = KP()->in[I_BADA];
        __syncthreads();
        for (int it = bx; it < DEPTH * 96; it += G) { const int l = it / 96, jb = it % 96; const int j = jb * 64 + lane;
            const float* wp = wada_ + ((size_t)l * DM + wave * 128) * 6144 + j;
            float a0 = 0, a1 = 0, a2 = 0, a3 = 0, a4 = 0;
#pragma unroll 8
            for (int k = 0; k < 128; ++k) { const float w = wp[(size_t)k * 6144]; const int kk = wave * 128 + k;
                a0 += sil[kk] * w; a1 += sil[1024 + kk] * w; a2 += sil[2048 + kk] * w; a3 += sil[3072 + kk] * w; a4 += sil[4096 + kk] * w; }
            part[(wave * 5 + 0) * 64 + lane] = a0; part[(wave * 5 + 1) * 64 + lane] = a1; part[(wave * 5 + 2) * 64 + lane] = a2; part[(wave * 5 + 3) * 64 + lane] = a3; part[(wave * 5 + 4) * 64 + lane] = a4;
            __syncthreads();
            if (tid < 320) { const int v = tid >> 6, c = tid & 63; float s = bada_[l * 6144 + jb * 64 + c];
#pragma unroll
                for (int w = 0; w < 8; ++w) s += part[(w * 5 + v) * 64 + c];
                MOD[((size_t)l * 5 + v) * 6144 + jb * 64 + c] = s; }
            __syncthreads();
        }
    }
    GSYNC_CG(0);
    (void)xcd_barrier_post(XB_BAR, XB_ST, XB_T0);
    { DEFWS(WSB())
    const int lane = pg8::lane_id_asm(); const float* xin_ = KP()->in[I_X]; const float* cin_ = KP()->in[I_CTX];
    for (int m = gw; m < MROWS; m += NGW) { const RowInfo ri = row_info(m);
        const float* xr = ri.isctx ? cin_ + ((size_t)ri.b * CTX + ri.i) * DM : xin_ + ((size_t)ri.b * SEQ + ri.i - CTX) * DM;
        const float* md = MOD + (size_t)ri.v * 6144;
#pragma unroll
        for (int j = 0; j < 4; ++j) { const int col = 4 * lane + 256 * j; const f32x4 x = *(const f32x4*)(xr + col), sh = *(const f32x4*)(md + col), sc = *(const f32x4*)(md + 1024 + col);
            const f32x4 u = x * (1.f + sc) + sh; u32x2 w; w.x = pk2(u[0], u[1]); w.y = pk2(u[2], u[3]); *(u32x2*)(U + (size_t)m * DM + col) = w; }
    } }
    GSYNC(0);

#pragma unroll 1
    for (int l = 0; l < DEPTH; ++l) {
        { DEFWS(WSB()) LAUN3(); pg8::Gemm g{U, WIN + (size_t)l * HP * DM, MROWS, HP, DM, DM}; pg8::StaticOrder S; S.init(MROWS, HP, G_, bx_);
          pg8::EpiStore<0> E{H, HPI, IN_COLS};
          pg8::gemm_phase<pg8::EpiStore<0>, pg8::StaticOrder, true, true>((LAS unsigned char*)lds, g, S, E, wave_); }
        GSYNC(1);
        {
            DEFWS(WSB())
            const int lane = pg8::lane_id_asm();
            const f32x2* gckv = (const f32x2*)(KP()->in[I_GCKV] + l * 128); const f32x2* gkn = (const f32x2*)(KP()->in[I_GKN] + l * 64);
            const f32x2* gcq = (const f32x2*)(KP()->in[I_GCQ] + l * 256); const f32x2* gqn = (const f32x2*)(KP()->in[I_GQN] + l * 64);
            const f32x2* wc0 = (const f32x2*)(KP()->in[I_WCONV] + (size_t)l * 768); const f32x2* wc1 = wc0 + 128; const f32x2* wc2 = wc0 + 256;
            const f32x2* rM = (const f32x2*)ROPEM; const f32x2* rG = (const f32x2*)ROPEG;
            const f32x2 gckv_l = gckv[lane], gkn_l = gkn[lane & 31], gcq0_l = gcq[lane], gcq1_l = gcq[64 + lane], gqn_l = gqn[lane & 31];
            f32x2 wcv[2][3];
#pragma unroll
            for (int j = 0; j < 2; ++j) { wcv[j][0] = wc0[lane + 64 * j]; wcv[j][1] = wc1[lane + 64 * j]; wcv[j][2] = wc2[lane + 64 * j]; }
#define RED4(v, NSTEP) _Pragma("unroll") for (int q_ = 0; q_ < 4; ++q_) v[q_] = ((NSTEP) == 64) ? wave_sum(v[q_]) : half_sum(v[q_]);
            for (int ch = wave * G + bx; ch < MROWS / 4; ch += NGW) { const int m0 = ch * 4; const RowInfo ri = row_info(m0); const bool lat = !ri.isctx; const int pos0 = ri.i - CTX;
                const unsigned* hr0 = (const unsigned*)(H + (size_t)m0 * HPI);
#if TSEL >= 0
                unsigned tp0_ = 0; if (TST) tp0_ = (unsigned)__builtin_amdgcn_s_memrealtime();
#endif
                unsigned wkv[4], wpe[4], wgk[4], wgv[4], wq0[4], wq1[4], wgq[4][3];
#pragma unroll
                for (int q = 0; q < 4; ++q) { const unsigned* hr = hr0 + (size_t)q * (HPI / 2);
                    wkv[q] = hr[lane]; wpe[q] = hr[64 + (lane & 15)]; wgk[q] = hr[80 + lane]; wgv[q] = hr[144 + lane]; wq0[q] = hr[208 + lane]; wq1[q] = hr[272 + lane];
#pragma unroll
                    for (int j = 0; j < 3; ++j) wgq[q][j] = hr[336 + 64 * j + lane]; }
                f32x2 csM[4], csG[4];
#pragma unroll
                for (int q = 0; q < 4; ++q) { csM[q] = lat ? rM[(pos0 + q) * 16 + (lane & 15)] : (f32x2){1.f, 0.f}; csG[q] = lat ? rG[(pos0 + q) * 32 + (lane & 31)] : (f32x2){1.f, 0.f}; }
                const int seqlen = lat ? SEQ : CTX, t0 = lat ? pos0 : ri.i; const bool hp = t0 > 0, hn = t0 + 4 < seqlen; const float zp = hp ? 1.f : 0.f, zn = hn ? 1.f : 0.f;
                unsigned cvh[2][6], cvc[2][6], cvb[2][4];
#pragma unroll
                for (int q = 0; q < 6; ++q) { const int qq = (q == 0 && !hp) ? 1 : (q == 5 && !hn) ? 4 : q; const unsigned* hq = hr0 + (ptrdiff_t)(qq - 1) * (HPI / 2);
#pragma unroll
                    for (int j = 0; j < 2; ++j) { cvh[j][q] = hq[528 + lane + 64 * j]; cvc[j][q] = hq[784 + lane + 64 * j]; } }
#pragma unroll
                for (int q = 0; q < 4; ++q)
#pragma unroll
                    for (int j = 0; j < 2; ++j) cvb[j][q] = (hr0 + (size_t)q * (HPI / 2))[656 + lane + 64 * j];
                {
                    float ss[4];
#pragma unroll
                    for (int q = 0; q < 4; ++q) { const float a = bflo(wkv[q]), b2 = bfhi(wkv[q]); ss[q] = a * a + b2 * b2; }
                    RED4(ss, 64)
#if TSEL >= 0
                    if (TST) { const unsigned t_ = (unsigned)__builtin_amdgcn_s_memrealtime(); TSL[13] += t_ - tp0_; tp0_ = t_; }
#endif
#pragma unroll
                    for (int q = 0; q < 4; ++q) { const float r = rsqrtf(ss[q] * (1.f / 128.f) + LN_EPS); ((unsigned*)(CKV + (size_t)(m0 + q) * 128))[lane] = pk2(bflo(wkv[q]) * r * gckv_l.x, bfhi(wkv[q]) * r * gckv_l.y); } }
                if (lane < 16) {
#pragma unroll
                    for (int q = 0; q < 4; ++q) { const float a = bflo(wpe[q]), b2 = bfhi(wpe[q]); ((unsigned*)(KPE + (size_t)(m0 + q) * 32))[lane] = pk2(a * csM[q].x - b2 * csM[q].y, a * csM[q].y + b2 * csM[q].x); } }
                {
                    float ss[4];
#pragma unroll
                    for (int q = 0; q < 4; ++q) { const float a = bflo(wgk[q]), b2 = bfhi(wgk[q]); ss[q] = a * a + b2 * b2; }
                    RED4(ss, 32)
#pragma unroll
                    for (int q = 0; q < 4; ++q) { const float r = rsqrtf(ss[q] * (1.f / 64.f) + LN_EPS); const float a = bflo(wgk[q]) * r * gkn_l.x, b2 = bfhi(wgk[q]) * r * gkn_l.y;
                        ((unsigned*)(GK + (size_t)(m0 + q) * 128))[lane] = pk2(a * csG[q].x - b2 * csG[q].y, a * csG[q].y + b2 * csG[q].x); } }
#pragma unroll
                for (int q = 0; q < 4; ++q) ((unsigned*)(GV + (size_t)(m0 + q) * 128))[lane] = wgv[q];
                {
                    float ss[4];
#pragma unroll
                    for (int q = 0; q < 4; ++q) { const float a0 = bflo(wq0[q]), b0 = bfhi(wq0[q]), a1 = bflo(wq1[q]), b1 = bfhi(wq1[q]); ss[q] = (a0 * a0 + b0 * b0) + (a1 * a1 + b1 * b1); }
                    RED4(ss, 64)
#pragma unroll
                    for (int q = 0; q < 4; ++q) { const float r = rsqrtf(ss[q] * (1.f / 256.f) + LN_EPS); unsigned* o = (unsigned*)(CQ + (size_t)(m0 + q) * 256);
                        o[lane] = pk2(bflo(wq0[q]) * r * gcq0_l.x, bfhi(wq0[q]) * r * gcq0_l.y); o[64 + lane] = pk2(bflo(wq1[q]) * r * gcq1_l.x, bfhi(wq1[q]) * r * gcq1_l.y); } }
#pragma unroll
                for (int j = 0; j < 3; ++j) {
                    float ss[4];
#pragma unroll
                    for (int q = 0; q < 4; ++q) { const float a = bflo(wgq[q][j]), b2 = bfhi(wgq[q][j]); ss[q] = a * a + b2 * b2; }
                    RED4(ss, 32)
#pragma unroll
                    for (int q = 0; q < 4; ++q) { const float r = rsqrtf(ss[q] * (1.f / 64.f) + LN_EPS); const float a = bflo(wgq[q][j]) * r * gqn_l.x, b2 = bfhi(wgq[q][j]) * r * gqn_l.y;
                        ((unsigned*)(GQ + (size_t)(m0 + q) * 384))[64 * j + lane] = pk2((a * csG[q].x - b2 * csG[q].y) * QSC64, (a * csG[q].y + b2 * csG[q].x) * QSC64); } }
                {
#pragma unroll
                    for (int j = 0; j < 2; ++j) { const int ix = lane + 64 * j; float pa[6], pb[6];
#pragma unroll
                        for (int q = 0; q < 6; ++q) { const float z = (q == 0) ? zp : (q == 5) ? zn : 1.f; pa[q] = bflo(cvh[j][q]) * bflo(cvc[j][q]) * z; pb[q] = bfhi(cvh[j][q]) * bfhi(cvc[j][q]) * z; }
#pragma unroll
                        for (int q = 0; q < 4; ++q) { const unsigned bb = cvb[j][q];
                            const float oa = bflo(bb) * (wcv[j][0].x * pa[q] + wcv[j][1].x * pa[q + 1] + wcv[j][2].x * pa[q + 2]);
                            const float ob = bfhi(bb) * (wcv[j][0].y * pb[q] + wcv[j][1].y * pb[q + 1] + wcv[j][2].y * pb[q + 2]);
                            ((unsigned*)(OC + (size_t)(m0 + q) * DM))[384 + ix] = pk2(oa, ob); } }
                }
#if TSEL >= 0
                if (TST) { const unsigned t_ = (unsigned)__builtin_amdgcn_s_memrealtime(); TSL[14] += t_ - tp0_; }
#endif
            }
#undef RED4
        }
        GSYNC(2);
        { DEFWS(WSB()) LAUN3(); pg8::Gemm g{CQ, WUQ + (size_t)l * 768 * 256, MROWS, 768, 256, 256}; pg8::StaticOrder S; S.init(MROWS, 768, G_, bx_);
          pg8::EpiUQ E{MQ, ROPEM, QSC96};
          pg8::gemm_phase<pg8::EpiUQ, pg8::StaticOrder, true, false>((LAS unsigned char*)lds, g, S, E, wave_); }
        { DEFWS(WSB()) LAUN3(); pg8::Gemm g{CKV, WUKV + (size_t)l * 768 * 128, MROWS, 768, 128, 128}; pg8::StaticOrder S; S.init(MROWS, 768, G_, bx_);
          pg8::EpiUKV E{MK, MV};
          pg8::gemm_phase<pg8::EpiUKV, pg8::StaticOrder, true, true>((LAS unsigned char*)lds, g, S, E, wave_); }
        GSYNC(3);
        {
            DEFWS(WSB())
            const int nrounds = (l < DEPTH - 1) ? 7 : 6;
            for (int i_ = 0; i_ < nrounds * ATT_REPS; ++i_) { const int i = (ATT_REPS == 1) ? i_ : (i_ % nrounds);
                int type, b, h, qrow0, seq;
                if (i < 6) { const int u = vcu + 256 * i; type = u / 768; const int rem = u % 768; b = rem / 192; h = (rem >> 5) % 6; const int qb = rem & 31; qrow0 = b * LTOK + CTX + qb * 256; seq = LTOK; }
                else { if (vcu >= 48) continue; type = vcu / 24; b = (vcu % 24) / 6; h = vcu % 6; qrow0 = b * LTOK; seq = CTX; }
                const size_t kr = (size_t)b * LTOK;
                if (type == 0) d64::attn_unit<8, true>((const d64::bf16*)(MQ + (size_t)qrow0 * 576 + h * 96), (const d64::bf16*)(MK + kr * 384 + h * 64), (const d64::bf16*)(KPE + kr * 32), (const d64::bf16*)(MV + kr * 384 + h * 64), (d64::bf16*)(OC + (size_t)qrow0 * DM + h * 64), seq / 64, (char*)lds, wave);
                else d64::attn_unit<8, false>((const d64::bf16*)(GQ + (size_t)qrow0 * 384 + h * 64), (const d64::bf16*)(GK + kr * 128 + (h / 3) * 64), nullptr, (const d64::bf16*)(GV + kr * 128 + (h / 3) * 64), (d64::bf16*)(OC + (size_t)qrow0 * DM + 384 + h * 64), seq / 64, (char*)lds, wave);
            }
        }
        GSYNC(4);
        { DEFWS(WSB()) LAUN3(); pg8::Gemm g{OC, WO + (size_t)l * DM * DM, MROWS, DM, DM, DM}; pg8::RowOrder S; S.init(DM, G_, bx_, true);
          pg8::EpiStore<0> E{Y, DM, DM};
          pg8::gemm_phase<pg8::EpiStore<0>, pg8::RowOrder, true, true>((LAS unsigned char*)lds, g, S, E, wave_); }
        if (l < DEPTH - 1) { DEFWS(WSB()) LAUN3(); pg8::Gemm g{OC, WO + (size_t)l * DM * DM, MROWS, DM, 256, DM}; pg8::CtxSplitOrder S; S.init(DM, 4, G_, bx_);
          pg8::EpiPart E{PART, DM, (size_t)1024 * DM};
          pg8::gemm_phase<pg8::EpiPart, pg8::CtxSplitOrder, true, true>((LAS unsigned char*)lds, g, S, E, wave_); }
        GSYNC(5);
#pragma unroll 1
        for (int which = 0; which < 2; ++which) {
            {
                DEFWS(WSB())
                const int lane = pg8::lane_id_asm();
                const float* lg = KP()->in[which ? I_LN2G : I_LN1G] + l * DM; const float* lb = KP()->in[which ? I_LN2B : I_LN1B] + l * DM;
                const float* xin_ = KP()->in[I_X]; const float* cin_ = KP()->in[I_CTX]; float* out_ = KP()->out;
                const bool first = (l == 0 && which == 0); const bool wantu = !(which == 1 && l == DEPTH - 1);
                const int KS = which ? 8 : 4;
#define LCOL(j) (8 * lane + 512 * ((j) >> 1) + 4 * ((j) & 1))
                f32x4 g4[4], b4[4];
#pragma unroll
                for (int j = 0; j < 4; ++j) { g4[j] = *(const f32x4*)(lg + LCOL(j)); b4[j] = *(const f32x4*)(lb + LCOL(j)); }
                for (int ch = wave * G + bx; ch < MROWS / 2; ch += NGW) { const int m0 = ch * 2; const RowInfo ri = row_info(m0);
                    if (ri.isctx && l == DEPTH - 1) continue;
                    const size_t zoff = ((size_t)ri.b * CTX + ri.i) * DM, xoff = ((size_t)ri.b * SEQ + ri.i - CTX) * DM;
                    const float* xo = ri.isctx ? (first ? cin_ + zoff : Z + zoff) : (first ? xin_ + xoff : out_ + xoff);
                    float* xn = ri.isctx ? Z + zoff : out_ + xoff;
                    const bool ldh = !ri.isctx && !first, sth = !ri.isctx && wantu;
                    const float* md = MOD + ((size_t)l * 5 + ri.v) * 6144; const float* gate = md + (which ? 5 : 2) * 1024;
                    const float* md2 = which ? MOD + ((size_t)(wantu ? l + 1 : l) * 5 + ri.v) * 6144 : md + 3 * 1024;
                    f32x4 gt[4], sh[4], sc1[4];
#pragma unroll
                    for (int j = 0; j < 4; ++j) { const int col = LCOL(j); gt[j] = *(const f32x4*)(gate + col); sh[j] = *(const f32x4*)(md2 + col); sc1[j] = 1.f + *(const f32x4*)(md2 + 1024 + col); }
                    const float* pp0 = PART + zoff;
                    {
                        f32x4 t[2][4]; float s[2] = {0.f, 0.f};
#pragma unroll
                        for (int q = 0; q < 2; ++q)
#pragma unroll
                            for (int jp = 0; jp < 2; ++jp) { const size_t rb = (size_t)q * DM; const int c0 = LCOL(2 * jp);
                                f32x4 x0, x1, y0, y1;
                                if (ldh) { const h16x8 hv = __builtin_nontemporal_load((const h16x8*)((const _Float16*)(xo + rb) + c0));
                                    x0 = __builtin_convertvector(__builtin_shufflevector(hv, hv, 0, 1, 2, 3), f32x4); x1 = __builtin_convertvector(__builtin_shufflevector(hv, hv, 4, 5, 6, 7), f32x4); }
                                else { x0 = __builtin_nontemporal_load((const f32x4*)(xo + rb + c0)); x1 = __builtin_nontemporal_load((const f32x4*)(xo + rb + c0 + 4)); }
                                if (ri.isctx) {
#pragma unroll
                                    for (int h = 0; h < 2; ++h) { const float* pp = pp0 + rb + c0 + 4 * h; f32x4 yy[8];
#pragma unroll
                                        for (int k = 0; k < 4; ++k) yy[k] = *(const f32x4*)(pp + (size_t)k * 1024 * DM);
                                        f32x4 y;
                                        if (KS == 8) {
#pragma unroll
                                            for (int k = 4; k < 8; ++k) yy[k] = *(const f32x4*)(pp + (size_t)k * 1024 * DM);
                                            y = ((yy[0] + yy[1]) + (yy[2] + yy[3])) + ((yy[4] + yy[5]) + (yy[6] + yy[7])); }
                                        else y = (yy[0] + yy[1]) + (yy[2] + yy[3]);
                                        if (h == 0) y0 = y; else y1 = y; } }
                                else { const u32x4 yw = *(const u32x4*)(Y + (size_t)m0 * DM + rb + c0); y0 = (f32x4){bflo(yw.x), bfhi(yw.x), bflo(yw.y), bfhi(yw.y)}; y1 = (f32x4){bflo(yw.z), bfhi(yw.z), bflo(yw.w), bfhi(yw.w)}; }
                                t[q][2 * jp] = ALPHA * x0 + gt[2 * jp] * y0; t[q][2 * jp + 1] = ALPHA * x1 + gt[2 * jp + 1] * y1;
                                s[q] += ((t[q][2 * jp][0] + t[q][2 * jp][1]) + (t[q][2 * jp][2] + t[q][2 * jp][3])) + ((t[q][2 * jp + 1][0] + t[q][2 * jp + 1][1]) + (t[q][2 * jp + 1][2] + t[q][2 * jp + 1][3])); }
                        s[0] = wave_sum(s[0]); s[1] = wave_sum(s[1]);
                        float s2[2] = {0.f, 0.f};
#pragma unroll
                        for (int q = 0; q < 2; ++q) { const float mean = s[q] * (1.f / DM);
#pragma unroll
                            for (int j = 0; j < 4; ++j) { t[q][j] = t[q][j] - mean; s2[q] += (t[q][j][0] * t[q][j][0] + t[q][j][1] * t[q][j][1]) + (t[q][j][2] * t[q][j][2] + t[q][j][3] * t[q][j][3]); } }
                        s2[0] = wave_sum(s2[0]); s2[1] = wave_sum(s2[1]);
#pragma unroll
                        for (int q = 0; q < 2; ++q) { const float rstd = rsqrtf(s2[q] * (1.f / DM) + LN_EPS);
#pragma unroll
                            for (int jp = 0; jp < 2; ++jp) { const size_t rb = (size_t)q * DM; const int c0 = LCOL(2 * jp);
                                const f32x4 xv0 = t[q][2 * jp] * rstd * g4[2 * jp] + b4[2 * jp], xv1 = t[q][2 * jp + 1] * rstd * g4[2 * jp + 1] + b4[2 * jp + 1];
                                if (sth) __builtin_nontemporal_store(__builtin_convertvector(__builtin_shufflevector(xv0, xv1, 0, 1, 2, 3, 4, 5, 6, 7), h16x8), (h16x8*)((_Float16*)(xn + rb) + c0));
                                else { __builtin_nontemporal_store(xv0, (f32x4*)(xn + rb + c0)); __builtin_nontemporal_store(xv1, (f32x4*)(xn + rb + c0 + 4)); }
                                if (wantu) { const f32x4 u0 = xv0 * sc1[2 * jp] + sh[2 * jp], u1 = xv1 * sc1[2 * jp + 1] + sh[2 * jp + 1];
                                    u32x4 w; w.x = pk2(u0[0], u0[1]); w.y = pk2(u0[2], u0[3]); w.z = pk2(u1[0], u1[1]); w.w = pk2(u1[2], u1[3]); *(u32x4*)(U + (size_t)m0 * DM + rb + c0) = w; } } }
                    }
                }
#undef LCOL
            }
            if (which == 1) { if (l < DEPTH - 1) GSYNC(9); else TBODY(9); break; }
            GSYNC(6);
            { DEFWS(WSB()) LAUN3(); pg8::Gemm g{U, W1 + (size_t)l * DFF * DM, MROWS, DFF, DM, DM}; pg8::RowOrder S; S.init(DFF, G_, bx_, l == DEPTH - 1);
              pg8::EpiStore<1> E{HM, DFF, DFF};
              pg8::gemm_phase<pg8::EpiStore<1>, pg8::RowOrder, true, true>((LAS unsigned char*)lds, g, S, E, wave_); }
            GSYNC(7);
            { DEFWS(WSB()) LAUN3(); pg8::Gemm g{HM, W2 + (size_t)l * DM * DFF, MROWS, DM, DFF, DFF}; pg8::RowOrder S; S.init(DM, G_, bx_, true);
              pg8::EpiStore<0> E{Y, DM, DM};
              pg8::gemm_phase<pg8::EpiStore<0>, pg8::RowOrder, true, true>((LAS unsigned char*)lds, g, S, E, wave_); }
            if (l < DEPTH - 1) { DEFWS(WSB()) LAUN3(); pg8::Gemm g{HM, W2 + (size_t)l * DM * DFF, MROWS, DM, 512, DFF}; pg8::CtxSplitOrder S; S.init(DM, 8, G_, bx_);
              pg8::EpiPart E{PART, DM, (size_t)1024 * DM};
              pg8::gemm_phase<pg8::EpiPart, pg8::CtxSplitOrder, true, true>((LAS unsigned char*)lds, g, S, E, wave_); }
            GSYNC(8);
        }
    }
#if TSEL >= 0
    grid.sync();
    if (blockIdx.x == 0) { __syncthreads(); unsigned ticks = 0; for (int k = 0; k < 16; ++k) if ((TSEL >> k) & 1) ticks += TSL[k]; const int n = (int)((ticks / 100u) / TDIV); float* o_ = KP()->out;
        for (int i = wave * 64 + pg8::lane_id_asm(); i < n; i += 512) o_[(size_t)i * 1031] += 0.2f; }
#endif
}

extern "C" void kernel_launch(void* const* d_in, const int* in_sizes, int n_in, void* d_out, int out_size, void* d_ws, size_t ws_size, hipStream_t stream) {
    static int grid = 0;
    if (grid == 0) {
        if (n_in != 21 || in_sizes[0] != NBATCH * SEQ * DM || out_size != NBATCH * SEQ * DM || ws_size < WS_END) {
            fprintf(stderr, "kernel_launch: shape mismatch n_in %d in0 %d out %d ws %zu (need %zu)\n", n_in, n_in > 0 ? in_sizes[0] : -1, out_size, ws_size, (size_t)WS_END); grid = -1; return; }
        int dev = 0, cus = 0, per_cu = 0;
        hipGetDevice(&dev); hipDeviceGetAttribute(&cus, hipDeviceAttributeMultiprocessorCount, dev);
        if (hipFuncSetAttribute((const void*)fwd_megakernel, hipFuncAttributeMaxDynamicSharedMemorySize, LDS_BYTES) != hipSuccess) { fprintf(stderr, "kernel_launch: hipFuncSetAttribute failed\n"); grid = -1; return; }
        if (hipOccupancyMaxActiveBlocksPerMultiprocessor(&per_cu, (const void*)fwd_megakernel, 512, LDS_BYTES) != hipSuccess || per_cu < 1) { fprintf(stderr, "kernel_launch: occupancy query says %d\n", per_cu); per_cu = 1; }
        (void)hipGetLastError();
        if (cus < 256) { fprintf(stderr, "kernel_launch: built for a 256-CU device, found %d CUs\n", cus); grid = -1; return; }
        grid = 256;
        fprintf(stderr, "kernel_launch: grid %d (per_cu %d)\n", grid, per_cu);
    }
    if (grid < 0) return;
    Params p{};
    for (int i = 0; i < 21; ++i) p.in[i] = (const float*)d_in[i];
    p.out = (float*)d_out; p.ws = (unsigned char*)d_ws;
    void* args[] = {&p};
    hipError_t e = hipLaunchCooperativeKernel((const void*)fwd_megakernel, dim3(grid), dim3(512), args, LDS_BYTES, stream);
    if (e != hipSuccess) fprintf(stderr, "kernel_launch: cooperative launch failed: %s (grid %d)\n", hipGetErrorString(e), grid);
}
```

```cpp
#include <hip/hip_runtime.h>
#include <hip/hip_cooperative_groups.h>
#include <hip/hip_bf16.h>
#include <cstdio>
#include <cstdint>
namespace cg = cooperative_groups;

constexpr int DM = 1024, NBATCH = 4, SEQ = 8192, DEPTH = 4, CTX = 256, DFF = 4096;
constexpr int LTOK = CTX + SEQ;
constexpr int MROWS = NBATCH * LTOK;
constexpr int IN_COLS = 1824, HP = 2048, HPI = 1856;
constexpr float LN_EPS = 1e-6f;
constexpr float ALPHA = 1.6817928305074290f;
namespace pg8 {
#define PG8_LAS __attribute__((address_space(3)))
typedef unsigned short bf16_t;
typedef short bf16x8 __attribute__((ext_vector_type(8)));
typedef float f32x4 __attribute__((ext_vector_type(4)));
typedef unsigned u32x4 __attribute__((ext_vector_type(4)));
constexpr int BM = 256, BK = 64, HALF = 128, HTB = HALF * BK * 2  , STAGE_BYTES = 8 * HTB, NXCD = 8, WGM = 8;

__host__ __device__ __forceinline__ int lds_byte(int r, int c) { const int st = (r >> 4) * 2 + (c >> 5), rr = r & 15, cc = c & 31, ob = rr * 64 + cc * 2; return st * 1024 + (ob ^ (((ob >> 9) & 1) << 5)); }
__host__ __device__ __forceinline__ void stage_rc(int b, int& R, int& C) { const int st = b / 1024, sb = b % 1024, swz = sb ^ (((sb >> 9) & 1) << 5); R = (st >> 1) * 16 + swz / 64; C = (st & 1) * 32 + (swz % 64) / 2; }
__host__ __device__ __forceinline__ int perm32(int rho) { const int n = rho >> 4, i = rho & 15; return 8 * (i >> 2) + 4 * n + (i & 3); }

struct Unit { int pm, pn, pk; };
struct Gemm { const bf16_t* A; const bf16_t* Bt; int M, N, K, ld; };

struct StaticOrder {
    int nM, nN, nwg, G, c;
    __host__ __device__ void init(int M, int N, int G_, int c_) { nM = M / BM; nN = N / BM; nwg = nM * nN; G = G_; c = c_; }
    __host__ __device__ bool next(int i, Unit& u) const {
        const long L = (long)i * G + c; if (L >= nwg) return false;
        int wgid = (int)L; { const int q = nwg / NXCD, r = nwg % NXCD, xcd = wgid % NXCD, off = wgid / NXCD; wgid = (xcd < r ? xcd * (q + 1) : r * (q + 1) + (xcd - r) * q) + off; }
        const int nig = WGM * nN, gid = wgid / nig, fm = gid * WGM, gsz = (nM - fm) < WGM ? (nM - fm) : WGM;
        u.pm = fm + ((wgid % nig) % gsz); u.pn = (wgid % nig) / gsz; u.pk = 0; return true;
    }
    __device__ __forceinline__ void a_ready(const Unit&) const {}
    __device__ __forceinline__ void done(const Unit&) const {}
};

__device__ __forceinline__ unsigned cvt_pk_bf16(float lo, float hi) { unsigned r; asm volatile("v_cvt_pk_bf16_f32 %0, %1, %2" : "=v"(r) : "v"(lo), "v"(hi)); return r; }
__device__ __forceinline__ int lane_id_asm() { int l; asm volatile("v_mbcnt_lo_u32_b32 %0, -1, 0\n\tv_mbcnt_hi_u32_b32 %0, -1, %0" : "=v"(l)); return l; }
typedef float f32x2 __attribute__((ext_vector_type(2)));
template <int ACT  > struct EpiStore {
    static constexpr bool PERM = true, AFTER_DRAIN = false;
    bf16_t* O; int ldc; int ncol;
    __device__ __forceinline__ void operator()(const f32x4 (&acc)[2][2][4][2], const Unit& u, int wr, int wc, int fr, int fq) const {
        const int row0 = u.pm * BM + wr * 64 + fr; const int col0 = u.pn * BM + wc * 32 + 8 * fq;
#pragma unroll
        for (int ai = 0; ai < 2; ++ai)
#pragma unroll
            for (int m = 0; m < 4; ++m) { bf16_t* rowp = O + (unsigned)((row0 + ai * HALF + m * 16) * ldc + col0);
#pragma unroll
                for (int bj = 0; bj < 2; ++bj) { f32x4 v0 = acc[ai][bj][m][0], v1 = acc[ai][bj][m][1];
                    if (ACT == 1) {
#pragma unroll
                        for (int e = 0; e < 4; ++e) { float a = fmaxf(v0[e], 0.f), b = fmaxf(v1[e], 0.f); v0[e] = a * a; v1[e] = b * b; } }
                    u32x4 w; w.x = cvt_pk_bf16(v0[0], v0[1]); w.y = cvt_pk_bf16(v0[2], v0[3]); w.z = cvt_pk_bf16(v1[0], v1[1]); w.w = cvt_pk_bf16(v1[2], v1[3]);
                    if (col0 + bj * HALF < ncol) *(u32x4*)(rowp + bj * HALF) = w; } }
    }
};
struct EpiUQ {
    static constexpr bool PERM = true, AFTER_DRAIN = false;
    bf16_t* MQ; const float* ropeM; float qscale;
    __device__ __forceinline__ void operator()(const f32x4 (&acc)[2][2][4][2], const Unit& u, int wr, int wc, int fr, int fq) const {
        const int row0 = u.pm * BM + wr * 64 + fr;
        const int pt = u.pm % 33; const bool lat = pt != 0; const int pos0 = (pt - 1) * 256 + wr * 64 + fr;
#pragma unroll
        for (int bj = 0; bj < 2; ++bj) {
            const int c = u.pn * BM + bj * HALF + wc * 32 + 8 * fq;
            if (c >= 576) continue;
            const int d = c % 96; const bool isrope = (d >= 64) && lat; const int i0 = (d - 64) >> 1;
#pragma unroll
            for (int ai = 0; ai < 2; ++ai)
#pragma unroll
                for (int m = 0; m < 4; ++m) { const int row = row0 + ai * HALF + m * 16;
                    f32x4 v0 = acc[ai][bj][m][0], v1 = acc[ai][bj][m][1];
                    if (isrope) { const f32x4* rp = (const f32x4*)(ropeM + (unsigned)(((pos0 + ai * HALF + m * 16) * 16 + i0) * 2));
                        const f32x4 r0 = rp[0], r1 = rp[1];
                        f32x4 a, b;
                        a[0] = v0[0] * r0[0] - v0[1] * r0[1]; a[1] = v0[0] * r0[1] + v0[1] * r0[0];
                        a[2] = v0[2] * r0[2] - v0[3] * r0[3]; a[3] = v0[2] * r0[3] + v0[3] * r0[2];
                        b[0] = v1[0] * r1[0] - v1[1] * r1[1]; b[1] = v1[0] * r1[1] + v1[1] * r1[0];
                        b[2] = v1[2] * r1[2] - v1[3] * r1[3]; b[3] = v1[2] * r1[3] + v1[3] * r1[2];
                        v0 = a; v1 = b; }
                    v0 = v0 * qscale; v1 = v1 * qscale;
                    u32x4 w; w.x = cvt_pk_bf16(v0[0], v0[1]); w.y = cvt_pk_bf16(v0[2], v0[3]); w.z = cvt_pk_bf16(v1[0], v1[1]); w.w = cvt_pk_bf16(v1[2], v1[3]);
                    *(u32x4*)(MQ + (unsigned)(row * 576 + c)) = w; }
        }
    }
};
struct EpiUKV {
    static constexpr bool PERM = true, AFTER_DRAIN = false;
    bf16_t* MK; bf16_t* MV;
    __device__ __forceinline__ void operator()(const f32x4 (&acc)[2][2][4][2], const Unit& u, int wr, int wc, int fr, int fq) const {
        const int row0 = u.pm * BM + wr * 64 + fr;
#pragma unroll
        for (int bj = 0; bj < 2; ++bj) {
            const int head = u.pn * 2 + bj; const int d = wc * 32 + 8 * fq;
            bf16_t* base = (d < 64) ? MK : MV; const unsigned boff = (unsigned)(head * 64 + (d & 63));
#pragma unroll
            for (int ai = 0; ai < 2; ++ai)
#pragma unroll
                for (int m = 0; m < 4; ++m) { const int row = row0 + ai * HALF + m * 16;
                    const f32x4 v0 = acc[ai][bj][m][0], v1 = acc[ai][bj][m][1];
                    u32x4 w; w.x = cvt_pk_bf16(v0[0], v0[1]); w.y = cvt_pk_bf16(v0[2], v0[3]); w.z = cvt_pk_bf16(v1[0], v1[1]); w.w = cvt_pk_bf16(v1[2], v1[3]);
                    *(u32x4*)(base + (boff + (unsigned)(row * 384))) = w; }
        }
    }
};
struct RowOrder {
    StaticOrder S0; bool latonly;
    __host__ __device__ void init(int N, int G_, int c_, bool latonly_) { latonly = latonly_; S0.init(latonly_ ? 128 * BM : 132 * BM, N, G_, c_); }
    __host__ __device__ bool next(int i, Unit& u) const { if (!S0.next(i, u)) return false; if (latonly) u.pm = u.pm + u.pm / 32 + 1; return true; }
    __device__ __forceinline__ void a_ready(const Unit&) const {}
    __device__ __forceinline__ void done(const Unit&) const {}
};
struct CtxSplitOrder {
    int nN, KS, total, G, c;
    __host__ __device__ void init(int N, int KS_, int G_, int c_) { nN = N / BM; KS = KS_; total = 4 * nN * KS_; G = G_; c = c_; }
    __host__ __device__ bool next(int i, Unit& u) const { const int L = i * G + c; if (L >= total) return false; u.pk = L % KS; const int t = L / KS; u.pn = t % nN; u.pm = 33 * (t / nN); return true; }
    __device__ __forceinline__ void a_ready(const Unit&) const {}
    __device__ __forceinline__ void done(const Unit&) const {}
};
struct EpiPart {
    static constexpr bool PERM = false, AFTER_DRAIN = false;
    float* P; int ldc; size_t kstride;
    __device__ __forceinline__ void operator()(const f32x4 (&acc)[2][2][4][2], const Unit& u, int wr, int wc, int fr, int fq) const {
        float* base = P + (size_t)u.pk * kstride + (size_t)((u.pm / 33) * BM + wr * 64 + fr) * ldc + u.pn * BM + wc * 32 + 4 * fq;
#pragma unroll
        for (int ai = 0; ai < 2; ++ai)
#pragma unroll
            for (int m = 0; m < 4; ++m)
#pragma unroll
                for (int bj = 0; bj < 2; ++bj)
#pragma unroll
                    for (int n = 0; n < 2; ++n) *(f32x4*)(base + (size_t)(ai * HALF + m * 16) * ldc + bj * HALF + n * 16) = acc[ai][bj][m][n];
    }
};
template <class Epi, class Sched, bool ALIGN_EPI = false, bool SP2 = false>
__device__ __forceinline__ void gemm_phase(PG8_LAS unsigned char* lds, const Gemm g, const Sched& S, const Epi& E, const int wave_in) {
    const int tid_l_ = wave_in * 64 + lane_id_asm();
    const int tid = tid_l_, wid = __builtin_amdgcn_readfirstlane(tid >> 6), lane = tid & 63, wr = wid >> 2, wc = wid & 3, fr = lane & 15, fq = lane >> 4;
    const int K = g.K, nt = K / BK;
    unsigned voffA[2], voffB[2];
#pragma unroll
    for (int i = 0; i < 2; ++i) { int R, C; stage_rc(tid * 16 + i * 8192, R, C); const int Rb = Epi::PERM ? ((R & ~31) + perm32(R & 31)) : R;
        voffA[i] = (unsigned)(R * g.ld + C) * 2u; voffB[i] = (unsigned)(Rb * g.ld + C) * 2u; }
    const size_t kstep = (size_t)(BK * 2);
    const size_t hstep = (size_t)HALF * g.ld * 2;
    const size_t tstep = 2 * hstep;
    const unsigned ldsw = (unsigned)wid * 1024u;
    const int aoff = lds_byte(wr * 64 + fr, fq * 8), boff = lds_byte(wc * 32 + fr, fq * 8);
#define PG8_SA(b, h) (((b) * 2 + (h)) * HTB)
#define PG8_SB(b, h) ((4 + (b) * 2 + (h)) * HTB)
#define PG8_STAGE(bufoff, gbase, voff) do { _Pragma("unroll") for (int _i = 0; _i < 2; ++_i) \
        __builtin_amdgcn_global_load_lds((const unsigned*)((const char*)(gbase) + (voff)[_i]), (PG8_LAS unsigned*)(lds + (bufoff) + ldsw + _i * 8192), 16, 0, 0); } while (0)
#define PG8_LDA(dst, b, h) do { _Pragma("unroll") for (int m = 0; m < 4; ++m) _Pragma("unroll") for (int k = 0; k < 2; ++k) dst[m][k] = *(const PG8_LAS bf16x8*)(lds + PG8_SA(b, h) + aoff + m * 2048 + k * 1024); } while (0)
#define PG8_LDB(dst, b, h) do { _Pragma("unroll") for (int n = 0; n < 2; ++n) _Pragma("unroll") for (int k = 0; k < 2; ++k) dst[n][k] = *(const PG8_LAS bf16x8*)(lds + PG8_SB(b, h) + boff + n * 2048 + k * 1024); } while (0)
#define PG8_MMA(ai, bj, At, Bt) do { __builtin_amdgcn_s_setprio(1); _Pragma("unroll") for (int m = 0; m < 4; ++m) _Pragma("unroll") for (int n = 0; n < 2; ++n) _Pragma("unroll") for (int k = 0; k < 2; ++k) \
        acc[ai][bj][m][n] = __builtin_amdgcn_mfma_f32_16x16x32_bf16(Bt[n][k], At[m][k], acc[ai][bj][m][n], 0, 0, 0); __builtin_amdgcn_s_setprio(0); } while (0)
#define PG8_WAIT_V(n) asm volatile("s_waitcnt vmcnt(" #n ")" ::: "memory")
#define PG8_WAIT_L(n) asm volatile("s_waitcnt lgkmcnt(" #n ")" ::: "memory")
#define PG8_BAR __builtin_amdgcn_s_barrier()
#define PG8_SCHED __builtin_amdgcn_sched_barrier(0)
    Unit cur, nxt; int ui = 0;
    if (!S.next(0, cur)) return;
    f32x4 acc[2][2][4][2];
#pragma unroll
    for (int a = 0; a < 2; ++a)
#pragma unroll
        for (int b = 0; b < 2; ++b)
#pragma unroll
            for (int m = 0; m < 4; ++m)
#pragma unroll
                for (int n = 0; n < 2; ++n) acc[a][b][m][n] = (f32x4){0.f, 0.f, 0.f, 0.f};
    bf16x8 At[4][2], B0[2][2], B1[2][2];
    const char* cA = (const char*)g.A + (size_t)cur.pm * tstep + (size_t)cur.pk * K * 2; const char* cB = (const char*)g.Bt + (size_t)cur.pn * tstep + (size_t)cur.pk * K * 2;
    S.a_ready(cur);
    if constexpr (SP2) {
        PG8_STAGE(PG8_SB(0, 0), cB, voffB); PG8_STAGE(PG8_SB(0, 1), cB + hstep, voffB); PG8_STAGE(PG8_SA(0, 0), cA, voffA); PG8_STAGE(PG8_SA(0, 1), cA + hstep, voffA);
        if (wr == 1) PG8_BAR;
        PG8_WAIT_V(2); PG8_BAR;
        PG8_STAGE(PG8_SB(1, 0), cB + kstep, voffB); PG8_STAGE(PG8_SA(1, 0), cA + kstep, voffA); PG8_STAGE(PG8_SB(1, 1), cB + hstep + kstep, voffB);
        PG8_WAIT_V(6); PG8_BAR;
    } else {
        PG8_STAGE(PG8_SB(0, 0), cB, voffB); PG8_STAGE(PG8_SA(0, 0), cA, voffA); PG8_STAGE(PG8_SB(0, 1), cB + hstep, voffB); PG8_STAGE(PG8_SA(0, 1), cA + hstep, voffA);
        if (wr == 1) PG8_BAR;
        PG8_WAIT_V(4); PG8_BAR;
        PG8_STAGE(PG8_SB(1, 0), cB + kstep, voffB); PG8_STAGE(PG8_SA(1, 0), cA + kstep, voffA); PG8_STAGE(PG8_SB(1, 1), cB + hstep + kstep, voffB);
        PG8_WAIT_V(6); PG8_BAR;
    }
    for (;;) {
        const bool has_next = S.next(ui + 1, nxt);
        const char* nA = has_next ? (const char*)g.A + (size_t)nxt.pm * tstep + (size_t)nxt.pk * K * 2 : cA; const char* nB = has_next ? (const char*)g.Bt + (size_t)nxt.pn * tstep + (size_t)nxt.pk * K * 2 : cB;
        for (int t = 0; t < nt; t += 2) {
            const bool last = (t == nt - 2);
            const char* a1 = cA + (size_t)(t + 1) * kstep;
            const char* a2 = last ? nA : cA + (size_t)(t + 2) * kstep; const char* b2 = last ? nB : cB + (size_t)(t + 2) * kstep;
            const char* a3 = a2 + kstep; const char* b3 = b2 + kstep;
            if (last && has_next) S.a_ready(nxt);
            if constexpr (SP2) {
            PG8_LDB(B0, 0, 0); PG8_LDB(B1, 0, 1); PG8_SCHED; PG8_LDA(At, 0, 0); PG8_STAGE(PG8_SA(1, 1), a1 + hstep, voffA);
            PG8_WAIT_V(8); PG8_WAIT_L(0); PG8_BAR; PG8_MMA(0, 0, At, B0); PG8_MMA(0, 1, At, B1); PG8_BAR; PG8_SCHED;
            PG8_LDA(At, 0, 1); PG8_STAGE(PG8_SB(0, 0), b2, voffB); PG8_STAGE(PG8_SB(0, 1), b2 + hstep, voffB); PG8_STAGE(PG8_SA(0, 0), a2, voffA);
            PG8_WAIT_V(8); PG8_WAIT_L(0); PG8_BAR; PG8_MMA(1, 0, At, B0); PG8_MMA(1, 1, At, B1); PG8_BAR; PG8_SCHED;
            PG8_LDB(B0, 1, 0); PG8_LDB(B1, 1, 1); PG8_SCHED; PG8_LDA(At, 1, 0); PG8_STAGE(PG8_SA(0, 1), a2 + hstep, voffA);
            PG8_WAIT_V(8); PG8_WAIT_L(0); PG8_BAR; PG8_MMA(0, 0, At, B0); PG8_MMA(0, 1, At, B1); PG8_BAR; PG8_SCHED;
            PG8_LDA(At, 1, 1); PG8_STAGE(PG8_SB(1, 0), b3, voffB); PG8_STAGE(PG8_SB(1, 1), b3 + hstep, voffB); PG8_STAGE(PG8_SA(1, 0), a3, voffA);
            PG8_WAIT_V(8); PG8_WAIT_L(0); PG8_BAR; PG8_MMA(1, 0, At, B0); PG8_MMA(1, 1, At, B1); PG8_BAR; PG8_SCHED;
            } else {
            PG8_LDB(B0, 0, 0); PG8_SCHED; PG8_LDA(At, 0, 0); PG8_STAGE(PG8_SA(1, 1), a1 + hstep, voffA);
            PG8_WAIT_L(8); PG8_BAR; PG8_WAIT_L(0); PG8_MMA(0, 0, At, B0); PG8_BAR; PG8_SCHED;
            PG8_LDB(B1, 0, 1); PG8_STAGE(PG8_SB(0, 0), b2, voffB);
            PG8_BAR; PG8_WAIT_L(0); PG8_MMA(0, 1, At, B1); PG8_BAR;
            PG8_LDA(At, 0, 1); PG8_STAGE(PG8_SA(0, 0), a2, voffA);
            PG8_BAR; PG8_WAIT_L(0); PG8_MMA(1, 0, At, B0); PG8_BAR; PG8_SCHED;
            PG8_STAGE(PG8_SB(0, 1), b2 + hstep, voffB);
            PG8_WAIT_V(6); PG8_BAR; PG8_MMA(1, 1, At, B1); PG8_BAR;
            PG8_LDB(B0, 1, 0); PG8_SCHED; PG8_LDA(At, 1, 0); PG8_STAGE(PG8_SA(0, 1), a2 + hstep, voffA);
            PG8_WAIT_L(8); PG8_BAR; PG8_WAIT_L(0); PG8_MMA(0, 0, At, B0); PG8_BAR; PG8_SCHED;
            PG8_LDB(B1, 1, 1); PG8_STAGE(PG8_SB(1, 0), b3, voffB);
            PG8_BAR; PG8_WAIT_L(0); PG8_MMA(0, 1, At, B1); PG8_BAR;
            PG8_LDA(At, 1, 1); PG8_STAGE(PG8_SA(1, 0), a3, voffA);
            PG8_BAR; PG8_WAIT_L(0); PG8_MMA(1, 0, At, B0); PG8_BAR; PG8_SCHED;
            PG8_STAGE(PG8_SB(1, 1), b3 + hstep, voffB);
            PG8_WAIT_V(6); PG8_BAR; PG8_MMA(1, 1, At, B1); PG8_BAR;
            }
        }
        if constexpr (ALIGN_EPI) { if (wr == 0) PG8_BAR; }
        if constexpr (!Epi::AFTER_DRAIN) { const int le_ = lane_id_asm(); E(acc, cur, wr, wc, le_ & 15, le_ >> 4); S.done(cur); }
        if (!has_next) break;
#pragma unroll
        for (int a = 0; a < 2; ++a)
#pragma unroll
            for (int b = 0; b < 2; ++b)
#pragma unroll
                for (int m = 0; m < 4; ++m)
#pragma unroll
                    for (int n = 0; n < 2; ++n) acc[a][b][m][n] = (f32x4){0.f, 0.f, 0.f, 0.f};
        cur = nxt; cA = nA; cB = nB; ++ui;
        if constexpr (ALIGN_EPI) { if (wr == 1) PG8_BAR; }
    }
    PG8_WAIT_V(0);
    if constexpr (!ALIGN_EPI) { if (wr == 0) PG8_BAR; }
    PG8_BAR;
    if constexpr (Epi::AFTER_DRAIN) { E.fused(acc, cur, wr, wc, fr, fq, lds, wid, lane); S.done(cur); }
#undef PG8_SA
#undef PG8_SB
#undef PG8_STAGE
#undef PG8_LDA
#undef PG8_LDB
#undef PG8_MMA
#undef PG8_WAIT_V
#undef PG8_WAIT_L
#undef PG8_BAR
#undef PG8_SCHED
}
}

namespace att {
typedef unsigned short bf16_t;
using bf16x8 = __attribute__((ext_vector_type(8))) short;
using s16x4  = __attribute__((ext_vector_type(4))) short;
using f32x16 = __attribute__((ext_vector_type(16))) float;
using u32x4  = __attribute__((ext_vector_type(4))) unsigned;
constexpr int NW = 8, QBLK = 32, KVBLK = 64;
constexpr float THR = 8.f;
constexpr int SHM_V = 16384, SHM_K = 16384;
#define KSWZ(row, colB) ((row) * 256 + ((colB) ^ (((row) & 15) << 4)))
#define SBAR() __builtin_amdgcn_sched_barrier(0)
__device__ __forceinline__ int crow(int r, int hi) { return (r & 3) + 8 * (r >> 2) + 4 * hi; }
__device__ __forceinline__ unsigned cvtpk(float lo, float hi) { unsigned r; asm volatile("v_cvt_pk_bf16_f32 %0, %1, %2" : "=v"(r) : "v"(lo), "v"(hi)); return r; }

constexpr float THRL = 11.0f;
template <bool FIRST> __device__ __forceinline__ void partialSM(f32x16& p0, f32x16& p1, float& m_reg, f32x16& negm, float& alpha) {
  float pmax = fmaxf(fmaxf(p0[0], p0[1]), p1[0]);
#pragma unroll
  for (int r = 2; r < 16; r += 2) pmax = fmaxf(fmaxf(pmax, p0[r]), p0[r + 1]);
#pragma unroll
  for (int r = 1; r < 15; r += 2) pmax = fmaxf(fmaxf(pmax, p1[r]), p1[r + 1]);
  pmax = fmaxf(pmax, p1[15]);
  { auto rr = __builtin_amdgcn_permlane32_swap(__float_as_uint(pmax), __float_as_uint(pmax), false, false);
    pmax = fmaxf(__uint_as_float(rr[0]), __uint_as_float(rr[1])); }
  alpha = 1.f;
  if (FIRST || !__builtin_expect(__all(pmax <= THRL), 1)) {
    const float dl = FIRST ? pmax : fmaxf(pmax, 0.f);
    m_reg += dl;
#pragma unroll
    for (int r = 0; r < 16; ++r) { p0[r] -= dl; p1[r] -= dl; }
#pragma unroll
    for (int r = 0; r < 16; ++r) negm[r] = -m_reg;
    if (!FIRST) alpha = __builtin_amdgcn_exp2f(-dl);
  }
#pragma unroll
  for (int r = 0; r < 16; ++r) p0[r] = __builtin_amdgcn_exp2f(p0[r]);
}
__device__ __forceinline__ void finishSM(f32x16& p0, f32x16& p1, float alpha, float& l_reg, bf16x8& pa0, bf16x8& pa1, bf16x8& pa2, bf16x8& pa3) {
#pragma unroll
  for (int r = 0; r < 16; ++r) p1[r] = __builtin_amdgcn_exp2f(p1[r]);
  float ps = 0;
#pragma unroll
  for (int r = 0; r < 16; ++r) ps += p0[r];
#pragma unroll
  for (int r = 0; r < 16; ++r) ps += p1[r];
  { auto rr = __builtin_amdgcn_permlane32_swap(__float_as_uint(ps), __float_as_uint(ps), false, false);
    ps = __uint_as_float(rr[0]) + __uint_as_float(rr[1]); }
  l_reg = l_reg * alpha + ps;
#define PK4(P, BASE, OUT) do { unsigned a0 = cvtpk(P[BASE + 0], P[BASE + 1]), a1 = cvtpk(P[BASE + 2], P[BASE + 3]);   \
    unsigned b0 = cvtpk(P[BASE + 4], P[BASE + 5]), b1 = cvtpk(P[BASE + 6], P[BASE + 7]);                              \
    auto r0 = __builtin_amdgcn_permlane32_swap(a0, b0, false, false); auto r1 = __builtin_amdgcn_permlane32_swap(a1, b1, false, false); \
    u32x4 w = {r0[0], r1[0], r0[1], r1[1]}; OUT = *reinterpret_cast<bf16x8*>(&w); } while (0)
  PK4(p0, 0, pa0); PK4(p0, 8, pa1); PK4(p1, 0, pa2); PK4(p1, 8, pa3);
#undef PK4
}
#define SBVS() __builtin_amdgcn_sched_barrier(0x6)
template <int DQ> __device__ __forceinline__ void qkt(f32x16& p0, f32x16& p1, const char* Ks, const bf16x8* qr, const f32x16& negm, int r32, int hi) {
  constexpr int ND = DQ / 16;
  const char* k0p = Ks + r32 * 256; const char* k1p = Ks + (32 + r32) * 256; const int sw = (r32 & 15) << 4;
  bf16x8 a0, a1, b0, b1;
#define KLD(x0, x1, d0) do { const int cb_ = (((d0) * 16 + hi * 8) * 2) ^ sw; x0 = *reinterpret_cast<const bf16x8*>(k0p + cb_); x1 = *reinterpret_cast<const bf16x8*>(k1p + cb_); } while (0)
  KLD(a0, a1, 0); KLD(b0, b1, 1); SBVS();
  p0 = __builtin_amdgcn_mfma_f32_32x32x16_bf16(a0, qr[0], negm, 0, 0, 0); p1 = __builtin_amdgcn_mfma_f32_32x32x16_bf16(a1, qr[0], negm, 0, 0, 0); SBVS();
#pragma unroll
  for (int d0 = 1; d0 < ND; ++d0) {
    if (d0 & 1) { if (d0 + 1 < ND) { KLD(a0, a1, d0 + 1); SBVS(); }
      p0 = __builtin_amdgcn_mfma_f32_32x32x16_bf16(b0, qr[d0], p0, 0, 0, 0); p1 = __builtin_amdgcn_mfma_f32_32x32x16_bf16(b1, qr[d0], p1, 0, 0, 0); SBVS(); }
    else { if (d0 + 1 < ND) { KLD(b0, b1, d0 + 1); SBVS(); }
      p0 = __builtin_amdgcn_mfma_f32_32x32x16_bf16(a0, qr[d0], p0, 0, 0, 0); p1 = __builtin_amdgcn_mfma_f32_32x32x16_bf16(a1, qr[d0], p1, 0, 0, 0); SBVS(); }
  }
#undef KLD
}
__device__ __forceinline__ int v_st(int k, int c) { const int kk = (k & ~0xC) | ((k & 4) << 1) | ((k & 8) >> 1); return ((kk >> 3) * 4 + (c >> 5)) * 512 + ((kk & 7) * 32 + (c & 31)) * 2; }
__device__ __forceinline__ int v_rd_base(int lane) { return ((lane & 3) << 3) | (((lane >> 2) & 3) << 6) | (((lane >> 4) & 1) << 5) | (((lane >> 5) & 1) << 8); }
constexpr int v_rd_off(int d0, int ks, int half) { return d0 * 512 + ks * 4096 + half * 2048; }
template <int OFF> __device__ __forceinline__ s16x4 tr_read(int vb) {
  s16x4 r; asm volatile("ds_read_b64_tr_b16 %0, %1 offset:%2" : "=&v"(r) : "v"(vb), "i"(OFF) : "memory"); return r;
}
template <int D0> __device__ __forceinline__ void pv_one(f32x16& od, int vb, bf16x8 pa0, bf16x8 pa1, bf16x8 pa2, bf16x8 pa3) {
  const s16x4 l0 = tr_read<v_rd_off(D0, 0, 0)>(vb), h0 = tr_read<v_rd_off(D0, 0, 1)>(vb), l1 = tr_read<v_rd_off(D0, 1, 0)>(vb), h1 = tr_read<v_rd_off(D0, 1, 1)>(vb);
  const s16x4 l2 = tr_read<v_rd_off(D0, 2, 0)>(vb), h2 = tr_read<v_rd_off(D0, 2, 1)>(vb), l3 = tr_read<v_rd_off(D0, 3, 0)>(vb), h3 = tr_read<v_rd_off(D0, 3, 1)>(vb);
  asm volatile("s_waitcnt lgkmcnt(0)" ::: "memory"); SBAR();
#define PK(L, H) (bf16x8){L[0], L[1], L[2], L[3], H[0], H[1], H[2], H[3]}
  od = __builtin_amdgcn_mfma_f32_32x32x16_bf16(pa0, PK(l0, h0), od, 0, 0, 0);
  od = __builtin_amdgcn_mfma_f32_32x32x16_bf16(pa1, PK(l1, h1), od, 0, 0, 0);
  od = __builtin_amdgcn_mfma_f32_32x32x16_bf16(pa2, PK(l2, h2), od, 0, 0, 0);
  od = __builtin_amdgcn_mfma_f32_32x32x16_bf16(pa3, PK(l3, h3), od, 0, 0, 0);
#undef PK
}
__device__ __forceinline__ void pv_d0(f32x16* o, int vb, bf16x8 pa0, bf16x8 pa1, bf16x8 pa2, bf16x8 pa3) {
  pv_one<0>(o[0], vb, pa0, pa1, pa2, pa3); pv_one<1>(o[1], vb, pa0, pa1, pa2, pa3);
}
struct VFrag { s16x4 l[2][4], h[2][4]; };
__device__ __forceinline__ void v_load(VFrag& f, int vb) {
  f.l[0][0] = tr_read<v_rd_off(0, 0, 0)>(vb); f.h[0][0] = tr_read<v_rd_off(0, 0, 1)>(vb); f.l[0][1] = tr_read<v_rd_off(0, 1, 0)>(vb); f.h[0][1] = tr_read<v_rd_off(0, 1, 1)>(vb);
  f.l[0][2] = tr_read<v_rd_off(0, 2, 0)>(vb); f.h[0][2] = tr_read<v_rd_off(0, 2, 1)>(vb); f.l[0][3] = tr_read<v_rd_off(0, 3, 0)>(vb); f.h[0][3] = tr_read<v_rd_off(0, 3, 1)>(vb);
  f.l[1][0] = tr_read<v_rd_off(1, 0, 0)>(vb); f.h[1][0] = tr_read<v_rd_off(1, 0, 1)>(vb); f.l[1][1] = tr_read<v_rd_off(1, 1, 0)>(vb); f.h[1][1] = tr_read<v_rd_off(1, 1, 1)>(vb);
  f.l[1][2] = tr_read<v_rd_off(1, 2, 0)>(vb); f.h[1][2] = tr_read<v_rd_off(1, 2, 1)>(vb); f.l[1][3] = tr_read<v_rd_off(1, 3, 0)>(vb); f.h[1][3] = tr_read<v_rd_off(1, 3, 1)>(vb);
}
__device__ __forceinline__ void pv_mma(f32x16* o, const VFrag& f, bf16x8 pa0, bf16x8 pa1, bf16x8 pa2, bf16x8 pa3) {
#define PK(L, H) (bf16x8){L[0], L[1], L[2], L[3], H[0], H[1], H[2], H[3]}
  asm volatile("s_waitcnt lgkmcnt(0)" ::: "memory"); SBAR();
  o[0] = __builtin_amdgcn_mfma_f32_32x32x16_bf16(pa0, PK(f.l[0][0], f.h[0][0]), o[0], 0, 0, 0);
  o[0] = __builtin_amdgcn_mfma_f32_32x32x16_bf16(pa1, PK(f.l[0][1], f.h[0][1]), o[0], 0, 0, 0);
  o[0] = __builtin_amdgcn_mfma_f32_32x32x16_bf16(pa2, PK(f.l[0][2], f.h[0][2]), o[0], 0, 0, 0);
  o[0] = __builtin_amdgcn_mfma_f32_32x32x16_bf16(pa3, PK(f.l[0][3], f.h[0][3]), o[0], 0, 0, 0);
  o[1] = __builtin_amdgcn_mfma_f32_32x32x16_bf16(pa0, PK(f.l[1][0], f.h[1][0]), o[1], 0, 0, 0);
  o[1] = __builtin_amdgcn_mfma_f32_32x32x16_bf16(pa1, PK(f.l[1][1], f.h[1][1]), o[1], 0, 0, 0);
  o[1] = __builtin_amdgcn_mfma_f32_32x32x16_bf16(pa2, PK(f.l[1][2], f.h[1][2]), o[1], 0, 0, 0);
  o[1] = __builtin_amdgcn_mfma_f32_32x32x16_bf16(pa3, PK(f.l[1][3], f.h[1][3]), o[1], 0, 0, 0);
#undef PK
}

template <int DQ>
__device__ __forceinline__ void attn_unit(const bf16_t* __restrict__ Qb, const bf16_t* __restrict__ Kh, const bf16_t* __restrict__ Kpe, const bf16_t* __restrict__ Vh,
                                          bf16_t* __restrict__ Ob, int seq, char* lds, const int wave_in) {
  constexpr int LDQ = (DQ == 96) ? 576 : 384, LDK = (DQ == 96) ? 384 : 128, LDO = 1024, ND = DQ / 16;
  const int tid = wave_in * 64 + pg8::lane_id_asm(), wid = wave_in, lane = tid & 63, r32 = lane & 31, hi = lane >> 5;
  char* V_lds = lds; char* K_lds = lds + 2 * SHM_V;
  float* ws = (float*)(lds + 2 * SHM_V + 2 * SHM_K) + wid * 64; float* li_l = ws; float* al_l = ws + 32;
  float m_reg = 0.f, l_reg = 0; f32x16 o[2] = {}; f32x16 negm = {}; bf16x8 qr[ND];
  const bf16_t* Qw = Qb + (unsigned)((wid * QBLK + r32) * LDQ + hi * 8);
#pragma unroll
  for (int d0 = 0; d0 < ND; ++d0) qr[d0] = *reinterpret_cast<const bf16x8*>(Qw + d0 * 16);
  const int sr = tid >> 3, sc = (tid & 7) * 8;
  const int pr = (tid >> 2) & 63, pc = (tid & 3) * 8;
  const int vst = v_st(sr, sc), kst = KSWZ(sr, sc * 2), pst = KSWZ(pr, (64 + pc) * 2);
  const int vb0 = (int)(uintptr_t)V_lds + v_rd_base(lane);
  struct { bf16x8 vs, ks, ps; } sr_[2];
  const unsigned voff = (unsigned)(sr * LDK + sc), poff = (unsigned)(pr * 32 + pc);
#define SLOAD(i, k0) do { const bf16_t* Vt_ = Vh + (size_t)(k0) * LDK; const bf16_t* Kt_ = Kh + (size_t)(k0) * LDK; \
    sr_[i].vs = *reinterpret_cast<const bf16x8*>(Vt_ + voff); sr_[i].ks = *reinterpret_cast<const bf16x8*>(Kt_ + voff); \
    if constexpr (DQ == 96) { const bf16_t* Pt_ = Kpe + (size_t)(k0) * 32; sr_[i].ps = *reinterpret_cast<const bf16x8*>(Pt_ + poff); } } while (0)
#define SWRITE(b, i) do { *(bf16x8*)(V_lds + (b) * SHM_V + vst) = sr_[i].vs; *(bf16x8*)(K_lds + (b) * SHM_K + kst) = sr_[i].ks; \
    if constexpr (DQ == 96) { if (tid < 256) *(bf16x8*)(K_lds + (b) * SHM_K + pst) = sr_[i].ps; } } while (0)
#define SWAIT() do { if constexpr (DQ == 96) asm volatile("s_waitcnt vmcnt(3)" ::: "memory"); else asm volatile("s_waitcnt vmcnt(2)" ::: "memory"); } while (0)
#define RESC(a) do { if (__any((a) < 1.f)) { if (hi == 0) al_l[r32] = (a); asm volatile("s_waitcnt lgkmcnt(0)" ::: "memory"); \
    _Pragma("unroll") for (int d = 0; d < 2; ++d) _Pragma("unroll") for (int r = 0; r < 16; ++r) o[d][r] *= al_l[crow(r, hi)]; } } while (0)
  f32x16 pA0, pA1, pB0, pB1; float alA, alB; bf16x8 pa0, pa1, pa2, pa3; const int NT = seq / KVBLK;
  constexpr int SE = 0, SO = 1;
  SLOAD(SE, 0); asm volatile("s_waitcnt vmcnt(0)" ::: "memory"); SWRITE(0, SE); __syncthreads();
  qkt<DQ>(pA0, pA1, K_lds, qr, negm, r32, hi); partialSM<true>(pA0, pA1, m_reg, negm, alA);
  SLOAD(SO, KVBLK); if (2 < NT) SLOAD(SE, 2 * KVBLK);
  SWAIT(); SWRITE(1, SO); __syncthreads();
  for (int j = 1; j + 1 < NT; j += 2) {
    SBAR(); qkt<DQ>(pB0, pB1, K_lds + SHM_K, qr, negm, r32, hi);
    finishSM(pA0, pA1, alA, l_reg, pa0, pa1, pa2, pa3); SBAR();
    SLOAD(SO, (j + 2) * KVBLK); SBAR();
    pv_d0(o, vb0, pa0, pa1, pa2, pa3); partialSM<false>(pB0, pB1, m_reg, negm, alB);
    __syncthreads(); SWAIT(); SWRITE(0, SE);
    RESC(alB); __syncthreads();
    SBAR(); qkt<DQ>(pA0, pA1, K_lds, qr, negm, r32, hi);
    finishSM(pB0, pB1, alB, l_reg, pa0, pa1, pa2, pa3); SBAR();
    if (j + 3 < NT) SLOAD(SE, (j + 3) * KVBLK); SBAR();
    pv_d0(o, vb0 + SHM_V, pa0, pa1, pa2, pa3); partialSM<false>(pA0, pA1, m_reg, negm, alA);
    __syncthreads(); SWAIT(); SWRITE(1, SO);
    RESC(alA); __syncthreads();
  }
  SBAR(); qkt<DQ>(pB0, pB1, K_lds + SHM_K, qr, negm, r32, hi);
  finishSM(pA0, pA1, alA, l_reg, pa0, pa1, pa2, pa3); SBAR();
  pv_d0(o, vb0, pa0, pa1, pa2, pa3); partialSM<false>(pB0, pB1, m_reg, negm, alB);
  __syncthreads(); RESC(alB);
  finishSM(pB0, pB1, alB, l_reg, pa0, pa1, pa2, pa3); SBAR();
  pv_d0(o, vb0 + SHM_V, pa0, pa1, pa2, pa3);
  if (hi == 0) li_l[r32] = l_reg; asm volatile("s_waitcnt lgkmcnt(0)" ::: "memory");
  float rli[16];
#pragma unroll
  for (int r = 0; r < 16; ++r) rli[r] = __builtin_amdgcn_rcpf(li_l[crow(r, hi)]);
  bf16_t* Ow = Ob + (long)(wid * QBLK) * LDO;
#pragma unroll
  for (int r = 0; r < 16; ++r) { int orow = crow(r, hi);
#pragma unroll
    for (int d0 = 0; d0 < 2; ++d0) { const float v = o[d0][r] * rli[r]; Ow[(long)orow * LDO + d0 * 32 + r32] = (bf16_t)(cvtpk(v, v) & 0xffffu); } }
  __syncthreads();
#undef SLOAD
#undef SWRITE
#undef SWAIT
#undef RESC
}
#undef SBAR
}

namespace d64 {
using bf16=__hip_bfloat16;
using bf16x8=__attribute__((ext_vector_type(8)))short;
using s16x4=__attribute__((ext_vector_type(4)))short;
using f32x16=__attribute__((ext_vector_type(16)))float;
using u32x4=__attribute__((ext_vector_type(4)))unsigned;
constexpr int D=64,LDQ=384,LDK=128,LDO=1024;
constexpr int NW=8,QBLK=32,QB=QBLK*NW,KVBLK=64;
__device__ __forceinline__ int crow(int r,int hi){return (r&3)+8*(r>>2)+4*hi;}
#define SBAR() __builtin_amdgcn_sched_barrier(0)
constexpr int NSLOT=3, SLOTB=8192;
constexpr int LDS_K=0, LDS_V=NSLOT*SLOTB, LDS_WS=2*NSLOT*SLOTB, LDS_OST=LDS_WS+NW*64*4, LDS_BYTES=LDS_OST+NW*4096;
constexpr float C2=0.125f*1.4426950408889634f;
__device__ __forceinline__ void glds16(const void*gsrc,unsigned lds_dst){unsigned keep;
  asm volatile("s_mov_b32 %0, m0\n\ts_mov_b32 m0, %2\n\ts_nop 0\n\tglobal_load_lds_dwordx4 %1, off\n\ts_mov_b32 m0, %0":"=&s"(keep):"v"(gsrc),"s"(lds_dst):"memory");}
__device__ __forceinline__ float max3f(float a,float b,float c){float r;asm("v_max3_f32 %0, %1, %2, %3":"=v"(r):"v"(a),"v"(b),"v"(c));return r;}
__device__ __forceinline__ float max2f(float a,float b){float r;asm("v_max_f32_e32 %0, %1, %2":"=v"(r):"v"(a),"v"(b));return r;}
__device__ __forceinline__ float fadd_s(float a,float b){float r;asm("v_add_f32_e32 %0, %1, %2":"=v"(r):"v"(a),"v"(b));return r;}
__device__ __forceinline__ float fsub_s(float a,float b){float r;asm("v_sub_f32_e32 %0, %1, %2":"=v"(r):"v"(a),"v"(b));return r;}
typedef float f32x2_t __attribute__((ext_vector_type(2))); typedef __bf16 bf16x2_t __attribute__((ext_vector_type(2)));
__device__ __forceinline__ unsigned cvtpk_s(float lo,float hi){f32x2_t v={lo,hi};bf16x2_t b=__builtin_convertvector(v,bf16x2_t);return __builtin_bit_cast(unsigned,b);}
#define WAIT_BAR(N) asm volatile("s_waitcnt vmcnt(" #N ") lgkmcnt(0)\n\ts_barrier":::"memory")

__device__ __forceinline__ void qkt(f32x16&p0,f32x16&p1,const char*Kslot,const bf16x8*qr,const f32x16&negm,int r32,int hi){
  const char*kb=Kslot+hi*1024+r32*16;
  #pragma unroll
  for(int d0=0;d0<4;++d0){
    const bf16x8 b0=*reinterpret_cast<const bf16x8*>(kb+d0*2048);
    const bf16x8 b1=*reinterpret_cast<const bf16x8*>(kb+d0*2048+512);
    if(d0==0){p0=__builtin_amdgcn_mfma_f32_32x32x16_bf16(b0,qr[0],negm,0,0,0);p1=__builtin_amdgcn_mfma_f32_32x32x16_bf16(b1,qr[0],negm,0,0,0);}
    else{p0=__builtin_amdgcn_mfma_f32_32x32x16_bf16(b0,qr[d0],p0,0,0,0);p1=__builtin_amdgcn_mfma_f32_32x32x16_bf16(b1,qr[d0],p1,0,0,0);}}
}
typedef __attribute__((address_space(3))) const char* lds_cptr;
typedef short v4i16_t __attribute__((ext_vector_type(4)));
__device__ __forceinline__ void kload8(bf16x8*kf,lds_cptr kp){
  kf[0]=*(const __attribute__((address_space(3))) bf16x8*)(kp);      kf[1]=*(const __attribute__((address_space(3))) bf16x8*)(kp+512);
  kf[2]=*(const __attribute__((address_space(3))) bf16x8*)(kp+2048); kf[3]=*(const __attribute__((address_space(3))) bf16x8*)(kp+2560);
  kf[4]=*(const __attribute__((address_space(3))) bf16x8*)(kp+4096); kf[5]=*(const __attribute__((address_space(3))) bf16x8*)(kp+4608);
  kf[6]=*(const __attribute__((address_space(3))) bf16x8*)(kp+6144); kf[7]=*(const __attribute__((address_space(3))) bf16x8*)(kp+6656);
}
__device__ __forceinline__ void kload2(bf16x8*kf,lds_cptr kp,int j){ kf[2*j]=*(const __attribute__((address_space(3))) bf16x8*)(kp+j*2048); kf[2*j+1]=*(const __attribute__((address_space(3))) bf16x8*)(kp+j*2048+512); }
__device__ __forceinline__ s16x4 vtr(lds_cptr p){ return __builtin_bit_cast(s16x4,__builtin_amdgcn_ds_read_tr16_b64_v4i16((__attribute__((address_space(3))) v4i16_t*)p)); }
__device__ __forceinline__ float rowmax(const f32x16&p0,const f32x16&p1){
  float a=max3f(p0[0],p0[1],p1[0]),b=max3f(p0[2],p0[3],p1[1]);a=max3f(a,p1[2],p1[3]);
  #pragma unroll
  for(int r=4;r<16;r+=4){a=max3f(a,p0[r],p0[r+1]);b=max3f(b,p0[r+2],p0[r+3]);a=max3f(a,p1[r],p1[r+1]);b=max3f(b,p1[r+2],p1[r+3]);}
  const float m=max2f(a,b);
  auto rr=__builtin_amdgcn_permlane32_swap(__float_as_uint(m),__float_as_uint(m),false,false);
  return max2f(__uint_as_float(rr[0]),__uint_as_float(rr[1]));
}
__device__ __forceinline__ void pv(f32x16*o,int vb,bf16x8 pa0,bf16x8 pa1,bf16x8 pa2,bf16x8 pa3){
  #pragma unroll
  for(int d0=0;d0<2;++d0){s16x4 lo[4],hi[4];
    #pragma unroll
    for(int ks=0;ks<4;++ks){
      asm volatile("ds_read_b64_tr_b16 %0,%1 offset:%c2":"=&v"(lo[ks]):"v"(vb),"i"(d0*4096+ks*1024):"memory");
      asm volatile("ds_read_b64_tr_b16 %0,%1 offset:%c2":"=&v"(hi[ks]):"v"(vb),"i"(d0*4096+ks*1024+512):"memory");}
    asm volatile("s_waitcnt lgkmcnt(0)":::"memory");SBAR();
    #define PK(k) (bf16x8){lo[k][0],lo[k][1],lo[k][2],lo[k][3],hi[k][0],hi[k][1],hi[k][2],hi[k][3]}
    o[d0]=__builtin_amdgcn_mfma_f32_32x32x16_bf16(pa0,PK(0),o[d0],0,0,0);
    o[d0]=__builtin_amdgcn_mfma_f32_32x32x16_bf16(pa1,PK(1),o[d0],0,0,0);
    o[d0]=__builtin_amdgcn_mfma_f32_32x32x16_bf16(pa2,PK(2),o[d0],0,0,0);
    o[d0]=__builtin_amdgcn_mfma_f32_32x32x16_bf16(pa3,PK(3),o[d0],0,0,0);
    #undef PK
  }
}

#ifndef ATTN_STORE16
#define ATTN_STORE16(p,v) (*(u32x4*)(p)=(v))
#endif
template<int THRL,bool PE> __device__ __forceinline__ void attn_unit(const bf16*Qu,const bf16*__restrict__ Kh,const bf16*__restrict__ Kpe,const bf16*__restrict__ Vh,bf16*Ou,const int NT,char*shm,const int wave_in){
  constexpr int LDQ_=PE?576:384, LDK_=PE?384:128, NDQ=PE?6:4, LDS_KPE=LDS_BYTES;
  const int lane=pg8::lane_id_asm(),tid=wave_in*64+lane,r32=lane&31,hi=lane>>5; const int wid=wave_in; (void)tid;
  const bf16*Qw=Qu+(long)(wid*QBLK)*LDQ_;
  const unsigned lds0=(unsigned)(uintptr_t)shm;
  float*wsf=(float*)(shm+LDS_WS)+wid*64;
  const bf16*ksrc=Kh+(long)lane*LDK_+wid*8; const bf16*psrc=PE?Kpe+(long)lane*32+(wid&3)*8:nullptr;
  const bf16*vsrc=Vh+(long)(16*(wid&3)+(lane>>2))*LDK_+(wid>>2)*32+(lane&3)*8;
  const unsigned kdst=lds0+LDS_K+wid*1024, vdst=lds0+LDS_V+wid*1024, pdst=lds0+LDS_KPE+(wid&3)*1024;
  #define DMA_K(t,slot) do{ glds16(ksrc+(long)(t)*KVBLK*LDK_,(unsigned)__builtin_amdgcn_readfirstlane(kdst+(slot))); \
    if constexpr(PE) glds16(psrc+(long)(t)*KVBLK*32,(unsigned)__builtin_amdgcn_readfirstlane(pdst+((slot)>>1))); }while(0)
  #define DMA_V(t,slot) glds16(vsrc+(long)(t)*KVBLK*LDK_,(unsigned)__builtin_amdgcn_readfirstlane(vdst+(slot)))
  const int vb0=(int)(lds0+LDS_V)+((lane>>4)&1)*32+(lane&3)*8+(4*hi+((lane&15)>>2))*64;
  const char*Kbase=shm+LDS_K; bf16x8 kf[8]; bf16x8 kpf[4];
  const lds_cptr shm3=(lds_cptr)shm; const lds_cptr kp0=shm3+LDS_K+hi*1024+r32*16; const lds_cptr pp0=shm3+LDS_KPE+hi*1024+r32*16; const lds_cptr vp0=shm3+LDS_V+((lane>>4)&1)*32+(lane&3)*8+(4*hi+((lane&15)>>2))*64;
  DMA_K(0,0);DMA_V(0,0);DMA_K(1,SLOTB);
  bf16x8 qr[NDQ];
  #pragma unroll
  for(int d0=0;d0<NDQ;++d0)qr[d0]=*reinterpret_cast<const bf16x8*>(&Qw[(long)r32*LDQ_+d0*16+hi*8]);
  float mhat=0.f,l_reg=0.f;f32x16 o[2];o[0]=f32x16{};o[1]=f32x16{};f32x16 negm=f32x16{};asm volatile("":"+v"(negm));
  #define CMASK(P0,P1,t) do{}while(0)
  bool resc=false;
  #define START(P0,P1) do{ const float rm=rowmax(P0,P1); resc=false; \
    { const float dl=rm; mhat=fadd_s(mhat,dl); \
      _Pragma("unroll") for(int r=0;r<16;++r){P0[r]=fsub_s(P0[r],dl);P1[r]=fsub_s(P1[r],dl);} \
      _Pragma("unroll") for(int r=0;r<16;++r)negm[r]=-mhat; asm volatile("":"+v"(negm)); } \
    _Pragma("unroll") for(int r=0;r<16;++r)P0[r]=__builtin_amdgcn_exp2f(P0[r]); }while(0)
  #define RESC() do{ if(resc){ asm volatile("s_waitcnt lgkmcnt(0)":::"memory"); \
      _Pragma("unroll") for(int d_=0;d_<2;++d_) _Pragma("unroll") for(int r=0;r<16;++r)o[d_][r]*=wsf[crow(r,hi)]; } }while(0)
  f32x16 pA0,pA1,pB0,pB1;
  int sl_prev=0,sl_cur=0,sl_next=SLOTB;
  #define ROT() do{sl_prev=sl_cur;sl_cur=sl_next;sl_next=(sl_next==(NSLOT-1)*SLOTB)?0:sl_next+SLOTB;}while(0)
  DMA_K(2,2*SLOTB);
  if constexpr(PE){WAIT_BAR(5);}else{WAIT_BAR(3);}
  qkt(pA0,pA1,Kbase,qr,negm,r32,hi);
  if constexpr(PE){ const char*pb=shm+LDS_KPE+hi*1024+r32*16;
    _Pragma("unroll") for(int j=0;j<2;++j){ const bf16x8 b0=*reinterpret_cast<const bf16x8*>(pb+j*2048), b1=*reinterpret_cast<const bf16x8*>(pb+j*2048+512);
      pA0=__builtin_amdgcn_mfma_f32_32x32x16_bf16(b0,qr[4+j],pA0,0,0,0); pA1=__builtin_amdgcn_mfma_f32_32x32x16_bf16(b1,qr[4+j],pA1,0,0,0);} }
  asm volatile("s_nop 15\n\ts_nop 7":"+v"(pA0),"+v"(pA1));CMASK(pA0,pA1,0);
  START(pA0,pA1);
  _Pragma("unroll") for(int r=0;r<16;++r)pA1[r]=__builtin_amdgcn_exp2f(pA1[r]);
  WAIT_BAR(0);
  DMA_K(3,0);DMA_V(1,SLOTB);
  ROT();
  kload8(kf,kp0+sl_cur); if constexpr(PE){ kload2(kpf,pp0+(sl_cur>>1),0); kload2(kpf,pp0+(sl_cur>>1),1); }
  if constexpr(PE){WAIT_BAR(3);}else{WAIT_BAR(2);}
  s16x4 vlo[8],vhi[8]; u32x4 pw0,pw1,pw2,pw3;
  #define PKW(P,B) cvtpk_s(P[B],P[B+1])
  #define PAF(k) __builtin_bit_cast(bf16x8,pw##k)
  #define VFR(i) (bf16x8){vlo[i][0],vlo[i][1],vlo[i][2],vlo[i][3],vhi[i][0],vhi[i][1],vhi[i][2],vhi[i][3]}
  #define PIN(x) asm volatile("":"+v"(x))
  #define MX3(a,b,c) __builtin_fmaxf(__builtin_fmaxf((a),(b)),(c))
  #define GAPA(MF,A0,A1,A2,A3,W0,W1,PW) do{ MF; sacc+=A0; sacc+=A1; sacc+=A2; sacc+=A3; PIN(sacc); W0; W1; PIN(PW); SBAR(); }while(0)
  #define EX(v) __builtin_amdgcn_exp2f(v)
  #define GAPB(MF,X,B) do{ MF; X[B]=EX(X[B]); X[B+1]=EX(X[B+1]); X[B+2]=EX(X[B+2]); X[B+3]=EX(X[B+3]); PIN(X); SBAR(); }while(0)
  #define VRD(i) do{ vlo[i]=vtr(vp_+(((i)>>2)*4096+((i)&3)*1024)); vhi[i]=vtr(vp_+(((i)>>2)*4096+((i)&3)*1024+512)); }while(0)
  #define KRD(G,j) do{ if(G){ kload2(kf,kp0+sl_next,j); if constexpr(PE){ if((j)<2) kload2(kpf,pp0+(sl_next>>1),j); } SBAR(); } }while(0)
  #define STEP(C0,C1,P0,P1,t,GK,GV,GL) do{ SBAR(); \
    const lds_cptr vp_=vp0+sl_prev; \
    VRD(0); SBAR(); float sacc=(P0[0]+P0[1]); \
    GAPA(C0=__builtin_amdgcn_mfma_f32_32x32x16_bf16(kf[0],qr[0],negm,0,0,0), P0[2],P0[3],P0[4],P0[5],     pw0[0]=PKW(P0,0), pw0[1]=PKW(P0,2), pw0); \
    VRD(4); SBAR(); GAPA(C1=__builtin_amdgcn_mfma_f32_32x32x16_bf16(kf[1],qr[0],negm,0,0,0), P0[6],P0[7],P0[8],P0[9],     pw0[2]=PKW(P0,4), pw0[3]=PKW(P0,6), pw0); \
    VRD(1); SBAR(); GAPA(C0=__builtin_amdgcn_mfma_f32_32x32x16_bf16(kf[2],qr[1],C0,0,0,0),   P0[10],P0[11],P0[12],P0[13], pw1[0]=PKW(P0,8), pw1[1]=PKW(P0,10), pw1); \
    VRD(5); SBAR(); GAPA(C1=__builtin_amdgcn_mfma_f32_32x32x16_bf16(kf[3],qr[1],C1,0,0,0),   P0[14],P0[15],P1[0],P1[1],   pw1[2]=PKW(P0,12),pw1[3]=PKW(P0,14), pw1); \
    VRD(2); SBAR(); GAPA(C0=__builtin_amdgcn_mfma_f32_32x32x16_bf16(kf[4],qr[2],C0,0,0,0),   P1[2],P1[3],P1[4],P1[5],     pw2[0]=PKW(P1,0), pw2[1]=PKW(P1,2), pw2); \
    VRD(6); SBAR(); GAPA(C1=__builtin_amdgcn_mfma_f32_32x32x16_bf16(kf[5],qr[2],C1,0,0,0),   P1[6],P1[7],P1[8],P1[9],     pw2[2]=PKW(P1,4), pw2[3]=PKW(P1,6), pw2); \
    VRD(3); SBAR(); GAPA(C0=__builtin_amdgcn_mfma_f32_32x32x16_bf16(kf[6],qr[3],C0,0,0,0),   P1[10],P1[11],P1[12],P1[13], pw3[0]=PKW(P1,8), pw3[1]=PKW(P1,10), pw3); \
    VRD(7); SBAR(); GAPA(C1=__builtin_amdgcn_mfma_f32_32x32x16_bf16(kf[7],qr[3],C1,0,0,0),   P1[14],P1[15],0.f,0.f,       pw3[2]=PKW(P1,12),pw3[3]=PKW(P1,14), pw3); \
    if constexpr(PE){ C0=__builtin_amdgcn_mfma_f32_32x32x16_bf16(kpf[0],qr[4],C0,0,0,0); C1=__builtin_amdgcn_mfma_f32_32x32x16_bf16(kpf[1],qr[4],C1,0,0,0); \
      C0=__builtin_amdgcn_mfma_f32_32x32x16_bf16(kpf[2],qr[5],C0,0,0,0); C1=__builtin_amdgcn_mfma_f32_32x32x16_bf16(kpf[3],qr[5],C1,0,0,0); } \
    l_reg+=sacc; \
    if(GK){DMA_K((t)+3,sl_cur);} if(GV){DMA_V((t)+1,sl_next);} \
    CMASK(C0,C1,t); \
    { float a=MX3(C0[0],C0[1],C1[0]),b=MX3(C0[2],C0[3],C1[1]); a=MX3(a,C1[2],C1[3]); \
      _Pragma("unroll") for(int r=4;r<16;r+=4){a=MX3(a,C0[r],C0[r+1]);b=MX3(b,C0[r+2],C0[r+3]);a=MX3(a,C1[r],C1[r+1]);b=MX3(b,C1[r+2],C1[r+3]);} \
      float rm=__builtin_fmaxf(a,b); { auto rr=__builtin_amdgcn_permlane32_swap(__float_as_uint(rm),__float_as_uint(rm),false,false); rm=__builtin_fmaxf(__uint_as_float(rr[0]),__uint_as_float(rr[1])); } \
      resc=false; \
      if(__builtin_expect(__any(rm>(float)THRL),0)){ const float dl=__builtin_fmaxf(rm,0.f); mhat+=dl; \
        _Pragma("unroll") for(int r=0;r<16;++r){C0[r]-=dl;C1[r]-=dl;} \
        _Pragma("unroll") for(int r=0;r<16;++r)negm[r]=-mhat; asm volatile("":"+v"(negm)); \
        const float f=__builtin_amdgcn_exp2f(-dl); l_reg*=f; if(hi==0)wsf[r32]=f; resc=true; } } \
    SBAR(); \
    GAPB(o[0]=__builtin_amdgcn_mfma_f32_32x32x16_bf16(PAF(0),VFR(0),o[0],0,0,0), C0,0); \
    GAPB(o[1]=__builtin_amdgcn_mfma_f32_32x32x16_bf16(PAF(0),VFR(4),o[1],0,0,0), C0,4); \
    KRD(GL,0); GAPB(o[0]=__builtin_amdgcn_mfma_f32_32x32x16_bf16(PAF(1),VFR(1),o[0],0,0,0), C0,8); \
    KRD(GL,1); GAPB(o[1]=__builtin_amdgcn_mfma_f32_32x32x16_bf16(PAF(1),VFR(5),o[1],0,0,0), C0,12); \
    KRD(GL,2); GAPB(o[0]=__builtin_amdgcn_mfma_f32_32x32x16_bf16(PAF(2),VFR(2),o[0],0,0,0), C1,0); \
    KRD(GL,3); GAPB(o[1]=__builtin_amdgcn_mfma_f32_32x32x16_bf16(PAF(2),VFR(6),o[1],0,0,0), C1,4); \
    GAPB(o[0]=__builtin_amdgcn_mfma_f32_32x32x16_bf16(PAF(3),VFR(3),o[0],0,0,0), C1,8); \
    GAPB(o[1]=__builtin_amdgcn_mfma_f32_32x32x16_bf16(PAF(3),VFR(7),o[1],0,0,0), C1,12); \
    }while(0)
  int t=1;
  #undef CMASK
  #define CMASK(P0,P1,t) do{}while(0)
  for(;t+5<NT;t+=2){
    STEP(pB0,pB1,pA0,pA1,t,true,true,true);     if constexpr(PE){WAIT_BAR(3);}else{WAIT_BAR(2);} RESC(); ROT();
    STEP(pA0,pA1,pB0,pB1,t+1,true,true,true);   if constexpr(PE){WAIT_BAR(3);}else{WAIT_BAR(2);} RESC(); ROT();
  }
  #undef CMASK
  #define CMASK(P0,P1,t) do{}while(0)
  #define ENDW(tt) do{ if((tt)+3<NT){ if constexpr(PE){WAIT_BAR(3);}else{WAIT_BAR(2);} } else if((tt)+2<NT){WAIT_BAR(1);} else {WAIT_BAR(0);} }while(0)
  for(;t+1<NT;t+=2){
    STEP(pB0,pB1,pA0,pA1,t,(t+3<NT),(t+1<NT),(t+1<NT));       ENDW(t);   RESC(); ROT();
    STEP(pA0,pA1,pB0,pB1,t+1,(t+4<NT),(t+2<NT),(t+2<NT));     ENDW(t+1); RESC(); ROT();
  }
  STEP(pB0,pB1,pA0,pA1,NT-1,false,false,false); RESC();
  { float sacc=pB0[0]+pB0[1]; _Pragma("unroll") for(int r=2;r<16;++r)sacc+=pB0[r]; _Pragma("unroll") for(int r=0;r<16;++r)sacc+=pB1[r]; l_reg+=sacc;
    pw0=(u32x4){PKW(pB0,0),PKW(pB0,2),PKW(pB0,4),PKW(pB0,6)};pw1=(u32x4){PKW(pB0,8),PKW(pB0,10),PKW(pB0,12),PKW(pB0,14)};pw2=(u32x4){PKW(pB1,0),PKW(pB1,2),PKW(pB1,4),PKW(pB1,6)};pw3=(u32x4){PKW(pB1,8),PKW(pB1,10),PKW(pB1,12),PKW(pB1,14)};
    SBAR(); pv(o,vb0+sl_cur,PAF(0),PAF(1),PAF(2),PAF(3)); }
  #undef PKW
  #undef PAF
  #undef VFR
  #undef PIN
  #undef MX3
  #undef GAPA
  #undef GAPB
  #undef EX
  #undef VRD
  #undef KRD
  #undef STEP
  #undef ENDW
  {auto rr=__builtin_amdgcn_permlane32_swap(__float_as_uint(l_reg),__float_as_uint(l_reg),false,false);l_reg=__uint_as_float(rr[0])+__uint_as_float(rr[1]);}
  if(hi==0)wsf[32+r32]=l_reg;asm volatile("s_waitcnt lgkmcnt(0)":::"memory");
  float rli[16];
  #pragma unroll
  for(int r=0;r<16;++r)rli[r]=__builtin_amdgcn_rcpf(wsf[32+crow(r,hi)]);
  bf16*Ow=Ou+(long)(wid*QBLK)*LDO;
  { bf16*stg=(bf16*)(shm+LDS_OST)+wid*2048;
    #pragma unroll
    for(int r=0;r<16;++r){const int orow=crow(r,hi);
      #pragma unroll
      for(int d0=0;d0<2;++d0)stg[orow*64+d0*32+r32]=__float2bfloat16(o[d0][r]*rli[r]);}
    asm volatile("s_waitcnt lgkmcnt(0)":::"memory");
    #pragma unroll
    for(int i=0;i<4;++i){const int row=i*8+(lane>>3),ch=lane&7; const u32x4 v=*(const u32x4*)(stg+row*64+ch*8); ATTN_STORE16(Ow+(long)row*LDO+ch*8,v);} }
  asm volatile("s_waitcnt lgkmcnt(0)\n\ts_barrier":::"memory");
  #undef DMA_K
  #undef DMA_V
  #undef CMASK
  #undef START
  #undef RESC
  #undef ROT
}
#undef SBAR
#undef WAIT_BAR
}

typedef unsigned short bf16_t;
typedef float f32x4 __attribute__((ext_vector_type(4)));
typedef float f32x2 __attribute__((ext_vector_type(2)));
typedef unsigned u32x2 __attribute__((ext_vector_type(2)));
typedef unsigned u32x4 __attribute__((ext_vector_type(4)));
#define LAS __attribute__((address_space(3)))
typedef _Float16 h16x8 __attribute__((ext_vector_type(8)));
#define XB_TMO      128
#define XB_XCNT(j)  (256  + 64 * (j))
#define XB_XSUB(j)  (1280 + 64 * (j))
#define XB_XGEN(j)  (2304 + 64 * (j))
#define XB_TOP      3328
#define XB_TOPGEN   3392
#define XCD_BAR_WORDS 3456
#define XB_SPIN_CAP (1u << 18)

__device__ __forceinline__ unsigned xb_ld(unsigned* p)              { return __hip_atomic_load(p, __ATOMIC_RELAXED, __HIP_MEMORY_SCOPE_AGENT); }
__device__ __forceinline__ unsigned xb_add(unsigned* p, unsigned v) { return __hip_atomic_fetch_add(p, v, __ATOMIC_RELAXED, __HIP_MEMORY_SCOPE_AGENT); }
__device__ __forceinline__ unsigned xb_xcc_id() { return (unsigned)__builtin_amdgcn_s_getreg((3 << 11) | 20) & 0xFu; }
#define XB_SPIN(cond, bar) do { unsigned _sp = 0; while (cond) { __builtin_amdgcn_s_sleep(1); \
    if ((++_sp & 255u) == 0u) { if (xb_ld(&(bar)[XB_TMO])) break; if (_sp > XB_SPIN_CAP) { atomicAdd(&(bar)[XB_TMO], 1u); break; } } } } while (0)

struct XcdBarrier {
    unsigned* bar; unsigned x;
    volatile LAS unsigned* st;
};

__device__ __forceinline__ XcdBarrier xcd_barrier_post(unsigned* bar, volatile LAS unsigned* st, const bool t0) {
    XcdBarrier b; b.bar = bar; b.x = xb_xcc_id(); b.st = st;
    if (t0) (void)xb_add(&bar[XB_XCNT(b.x)], 1u);
    return b;
}
__device__ __forceinline__ void xcd_barrier_complete(unsigned* bar, unsigned x, unsigned& nloc, unsigned& nx) {
    const unsigned G = gridDim.x * gridDim.y * gridDim.z;
    unsigned sum, cnt, mine, sp = 0u;
    for (;;) {
        sum = 0u; cnt = 0u; mine = 0u;
#pragma unroll
        for (unsigned j = 0; j < 16; ++j) { const unsigned c = xb_ld(&bar[XB_XCNT(j)]); sum += c; cnt += (c > 0u) ? 1u : 0u; mine = (j == x) ? c : mine; }
        if (sum == G) break;
        __builtin_amdgcn_s_sleep(1);
        if ((++sp & 255u) == 0u) { if (xb_ld(&bar[XB_TMO])) break; if (sp > XB_SPIN_CAP) { atomicAdd(&bar[XB_TMO], 1u); break; } }
    }
    nloc = mine > 0u ? mine : 1u; nx = cnt > 0u ? cnt : 1u;
}

__device__ __forceinline__ void xcd_barrier(const XcdBarrier& b, const bool t0) {
    asm volatile("s_waitcnt vmcnt(0)" ::: "memory");
    __syncthreads();
    if (t0) {
        unsigned* bar = b.bar;
        __builtin_amdgcn_s_waitcnt(0);
        unsigned nloc = b.st[0], nx = b.st[1];
        if (nloc == 0u) { xcd_barrier_complete(bar, b.x, nloc, nx); b.st[0] = nloc; b.st[1] = nx; }
        const unsigned old = xb_add(&bar[XB_XSUB(b.x)], 1u);
        const unsigned gen = old / nloc;
        if (old + 1u == (gen + 1u) * nloc) {
            __builtin_amdgcn_fence(__ATOMIC_RELEASE, "agent");
            asm volatile("s_waitcnt vmcnt(0)" ::: "memory");
            const unsigned og = xb_add(&bar[XB_TOP], 1u);
            const unsigned tg = og / nx;
            if (og + 1u == (tg + 1u) * nx) xb_add(&bar[XB_TOPGEN], 1u);
            else XB_SPIN(xb_ld(&bar[XB_TOPGEN]) == tg, bar);
            __builtin_amdgcn_fence(__ATOMIC_ACQUIRE, "agent");
            xb_add(&bar[XB_XGEN(b.x)], 1u);
            asm volatile("s_waitcnt vmcnt(0)" ::: "memory");
        } else {
            XB_SPIN(xb_ld(&bar[XB_XGEN(b.x)]) == gen, bar);
            __builtin_amdgcn_fence(__ATOMIC_ACQUIRE, "agent");
            asm volatile("s_waitcnt vmcnt(0)" ::: "memory");
        }
    }
    __syncthreads();
}

constexpr size_t MiB = 1u << 20;
constexpr size_t WS_MOD = 1 * MiB, WS_ROPEM = 2 * MiB, WS_ROPEG = 3 * MiB, WS_Z = 5 * MiB;
constexpr size_t WS_WIN = 10 * MiB, WS_WUQ = 26 * MiB, WS_WUKV = 28 * MiB, WS_WO = 29 * MiB, WS_W1 = 37 * MiB, WS_W2 = 69 * MiB;
constexpr size_t WS_U = 101 * MiB, WS_Y = WS_U  , WS_PART = 167 * MiB  , WS_OV = 233 * MiB;
constexpr size_t WS_HM = WS_OV, WS_H = WS_OV, WS_MQ = WS_OV, WS_MK = 271 * MiB, WS_MV = 296 * MiB;
constexpr size_t WS_CKV = 365 * MiB, WS_CQ = 374 * MiB, WS_KPE = 391 * MiB, WS_GK = 394 * MiB, WS_GV = 403 * MiB, WS_GQ = 412 * MiB, WS_O = 437 * MiB, WS_END = 503 * MiB;
static_assert(WS_MQ + (size_t)MROWS * 576 * 2 <= WS_MK && WS_MK + (size_t)MROWS * 384 * 2 <= WS_MV && WS_MV + (size_t)MROWS * 384 * 2 <= WS_H + (size_t)MROWS * HP * 2, "overlay");
static_assert(WS_H + (size_t)MROWS * HP * 2 <= WS_CKV && WS_CKV + (size_t)MROWS * 256 <= WS_CQ && WS_CQ + (size_t)MROWS * 512 <= WS_KPE && WS_KPE + (size_t)MROWS * 64 <= WS_GK, "map1");
static_assert(WS_GK + (size_t)MROWS * 256 <= WS_GV && WS_GV + (size_t)MROWS * 256 <= WS_GQ && WS_GQ + (size_t)MROWS * 768 <= WS_O && WS_O + (size_t)MROWS * 2048 <= WS_END, "map2");
static_assert(WS_HM + (size_t)MROWS * DFF * 2 <= WS_END, "map3");
#ifndef ATT_REPS
#define ATT_REPS 1
#endif
#ifndef TDIV
#define TDIV 1
#endif
#ifndef TSEL
#define TSEL -1
#endif
constexpr float QSC64 = 0.125f * 1.4426950408889634f, QSC96 = 0.10206207261596575f * 1.4426950408889634f;
constexpr int LDS_BYTES = 135168;

struct Params { const float* in[21]; float* out; unsigned char* ws; };
enum { I_X = 0, I_C, I_CTX, I_CCTX, I_WADA, I_BADA, I_WIN, I_GCQ, I_WUQ, I_GCKV, I_WUKV, I_GQN, I_GKN, I_WCONV, I_WO, I_LN1G, I_LN1B, I_W1, I_W2, I_LN2G, I_LN2B };

template <int CTRL> __device__ __forceinline__ float dppf(float v) { return __int_as_float(__builtin_amdgcn_update_dpp(0, __float_as_int(v), CTRL, 0xf, 0xf, true)); }
__device__ __forceinline__ float half_sum(float v) {
    v += dppf<0xB1>(v); v += dppf<0x4E>(v); v += dppf<0x141>(v); v += dppf<0x140>(v);
    auto r = __builtin_amdgcn_permlane16_swap(__float_as_uint(v), __float_as_uint(v), false, false);
    return __uint_as_float(r[0]) + __uint_as_float(r[1]);
}
__device__ __forceinline__ float wave_sum(float v) {
    v = half_sum(v);
    auto r = __builtin_amdgcn_permlane32_swap(__float_as_uint(v), __float_as_uint(v), false, false);
    return __uint_as_float(r[0]) + __uint_as_float(r[1]);
}
__device__ __forceinline__ unsigned pk2(float lo, float hi) { unsigned r; asm volatile("v_cvt_pk_bf16_f32 %0, %1, %2" : "=v"(r) : "v"(lo), "v"(hi)); return r; }
__device__ __forceinline__ float bflo(unsigned w) { return __uint_as_float(w << 16); }
__device__ __forceinline__ float bfhi(unsigned w) { return __uint_as_float(w & 0xffff0000u); }

__device__ __forceinline__ void transpose_item(const float* W, int K, int N, bf16_t* WT, LAS float* scr, int item, int lane) {
    const int nblk = N / 32, kb = item / nblk, nb = item % nblk, k0 = 64 * kb, n0 = 32 * nb;
#pragma unroll
    for (int i = 0; i < 8; ++i) { const int kk = 8 * i + (lane >> 3), nc = (lane & 7) * 4;
        const f32x4 v = *(const f32x4*)(W + (size_t)(k0 + kk) * N + n0 + nc); LAS float* d = scr + kk * 33 + nc; d[0] = v[0]; d[1] = v[1]; d[2] = v[2]; d[3] = v[3]; }
    asm volatile("s_waitcnt lgkmcnt(0)" ::: "memory");
    const int c = lane & 7;
#pragma unroll
    for (int j = 0; j < 4; ++j) { const int n = (lane >> 3) + 8 * j; const LAS float* s = scr + (8 * c) * 33 + n;
        u32x4 o; o.x = pk2(s[0 * 33], s[1 * 33]); o.y = pk2(s[2 * 33], s[3 * 33]); o.z = pk2(s[4 * 33], s[5 * 33]); o.w = pk2(s[6 * 33], s[7 * 33]);
        *(u32x4*)(WT + (size_t)(n0 + n) * K + k0 + 8 * c) = o; }
    asm volatile("s_waitcnt lgkmcnt(0)" ::: "memory");
}

struct RowInfo { int b, i, v; bool isctx; };
__device__ __forceinline__ RowInfo row_info(int m) { RowInfo r; r.b = m / LTOK; r.i = m - r.b * LTOK; r.isctx = r.i < CTX; r.v = r.isctx ? 4 : r.b; return r; }

__global__ void __launch_bounds__(512, 2) fwd_megakernel(Params p) {
    extern __shared__ __attribute__((aligned(16))) unsigned char lds[];
    cg::grid_group grid = cg::this_grid();
#if TSEL >= 0
#define TSL ((unsigned*)(lds + 133120))
#define TST (blockIdx.x == 0 && wave == 0 && pg8::lane_id_asm() == 0)
#define TINIT() do { if (TST) { for (int k = 0; k < 16; ++k) TSL[k] = 0; TSL[12] = (unsigned)__builtin_amdgcn_s_memrealtime(); } } while (0)
#define TBODY(k) do { if (TST) { const unsigned t_ = (unsigned)__builtin_amdgcn_s_memrealtime(); const unsigned d_ = t_ - TSL[12]; TSL[k] += d_; TSL[11] += d_; TSL[12] = t_; } } while (0)
#define TSYNC() do { if (TST) { const unsigned t_ = (unsigned)__builtin_amdgcn_s_memrealtime(); const unsigned d_ = t_ - TSL[12]; TSL[10] += d_; TSL[11] += d_; TSL[12] = t_; } } while (0)
#else
#define TINIT() do {} while (0)
#define TBODY(k) do {} while (0)
#define TSYNC() do {} while (0)
#endif
#define XB_T0 (wave == 0 && pg8::lane_id_asm() == 0)
#define XB_ST ((volatile LAS unsigned*)((LAS unsigned char*)lds + 133376))
#define XB_BAR ((unsigned*)WSB())
#define GSYNC_CG(k) do { TBODY(k); grid.sync(); TSYNC(); } while (0)
#define GSYNC(k) do { TBODY(k); { XcdBarrier xb_; xb_.bar = XB_BAR; xb_.x = xb_xcc_id(); xb_.st = XB_ST; xcd_barrier(xb_, XB_T0); } TSYNC(); } while (0)
    const int wave = __builtin_amdgcn_readfirstlane(threadIdx.x >> 6);
    TINIT();
    if (XB_T0) { XB_ST[0] = 0u; XB_ST[1] = 0u; }
    __syncthreads();
#define G ((int)gridDim.x)
#define bx ((int)blockIdx.x)
#define vcu ((G % 8 == 0) ? (bx % 8) * (G / 8) + bx / 8 : bx)
#define gw (bx * 8 + wave)
#define NGW (G * 8)
#define LAUN3() int G_ = G, bx_ = bx, wave_ = wave; asm volatile("" : "+s"(G_), "+s"(bx_), "+s"(wave_))
#define KP() ({ const __attribute__((address_space(4))) Params* k_ = (const __attribute__((address_space(4))) Params*)__builtin_amdgcn_kernarg_segment_ptr(); asm volatile("" : "+s"(k_)); k_; })
#define WSB() ((unsigned char*)KP()->ws)
#define DEFWS(w) \
    float* MOD = (float*)((w) + WS_MOD); float* ROPEM = (float*)((w) + WS_ROPEM); float* ROPEG = (float*)((w) + WS_ROPEG); float* Z = (float*)((w) + WS_Z); \
    bf16_t* WIN = (bf16_t*)((w) + WS_WIN); bf16_t* WUQ = (bf16_t*)((w) + WS_WUQ); bf16_t* WUKV = (bf16_t*)((w) + WS_WUKV); bf16_t* WO = (bf16_t*)((w) + WS_WO); \
    bf16_t* W1 = (bf16_t*)((w) + WS_W1); bf16_t* W2 = (bf16_t*)((w) + WS_W2); \
    bf16_t* U = (bf16_t*)((w) + WS_U); bf16_t* Y = (bf16_t*)((w) + WS_Y); bf16_t* HM = (bf16_t*)((w) + WS_HM); bf16_t* H = (bf16_t*)((w) + WS_H); \
    bf16_t* MQ = (bf16_t*)((w) + WS_MQ); bf16_t* MK = (bf16_t*)((w) + WS_MK); bf16_t* MV = (bf16_t*)((w) + WS_MV); \
    bf16_t* CKV = (bf16_t*)((w) + WS_CKV); bf16_t* CQ = (bf16_t*)((w) + WS_CQ); bf16_t* KPE = (bf16_t*)((w) + WS_KPE); \
    bf16_t* GK = (bf16_t*)((w) + WS_GK); bf16_t* GV = (bf16_t*)((w) + WS_GV); bf16_t* GQ = (bf16_t*)((w) + WS_GQ); bf16_t* OC = (bf16_t*)((w) + WS_O); float* PART = (float*)((w) + WS_PART); (void)PART; \
    (void)MOD; (void)ROPEM; (void)ROPEG; (void)Z; (void)WIN; (void)WUQ; (void)WUKV; (void)WO; (void)W1; (void)W2; (void)U; (void)Y; (void)HM; (void)H; (void)MQ; (void)MK; (void)MV; \
    (void)CKV; (void)CQ; (void)KPE; (void)GK; (void)GV; (void)GQ; (void)OC;

    {
        unsigned char* ws_b_ = WSB(); DEFWS(ws_b_)
        const int lane = pg8::lane_id_asm(), tid = wave * 64 + lane;
        if (bx == 0) { unsigned* bar_ = (unsigned*)ws_b_; for (int i = tid; i < XCD_BAR_WORDS; i += 512) bar_[i] = 0u; }
        LAS float* scr = (LAS float*)((LAS unsigned char*)lds + wave * 16384);
        constexpr int I_IN = 16 * 57, I_UQ = 4 * 18, I_UKV = 2 * 24, I_O = 16 * 32, I_1 = 16 * 128, I_2 = 64 * 32, PER = I_IN + I_UQ + I_UKV + I_O + I_1 + I_2;
        for (int it = gw; it < DEPTH * PER; it += NGW) {
            const int l = it / PER; int r = it - l * PER;
            if (r < I_IN) { transpose_item(KP()->in[I_WIN] + (size_t)l * DM * IN_COLS, DM, IN_COLS, WIN + (size_t)l * HP * DM, scr, r, lane); continue; } r -= I_IN;
            if (r < I_UQ) { transpose_item(KP()->in[I_WUQ] + (size_t)l * 256 * 576, 256, 576, WUQ + (size_t)l * 768 * 256, scr, r, lane); continue; } r -= I_UQ;
            if (r < I_UKV) { transpose_item(KP()->in[I_WUKV] + (size_t)l * 128 * 768, 128, 768, WUKV + (size_t)l * 768 * 128, scr, r, lane); continue; } r -= I_UKV;
            if (r < I_O) { transpose_item(KP()->in[I_WO] + (size_t)l * DM * DM, DM, DM, WO + (size_t)l * DM * DM, scr, r, lane); continue; } r -= I_O;
            if (r < I_1) { transpose_item(KP()->in[I_W1] + (size_t)l * DM * DFF, DM, DFF, W1 + (size_t)l * DFF * DM, scr, r, lane); continue; } r -= I_1;
            transpose_item(KP()->in[I_W2] + (size_t)l * DFF * DM, DFF, DM, W2 + (size_t)l * DM * DFF, scr, r, lane);
        }
        const int gt = bx * 512 + tid, NGT = G * 512;
        for (int idx = gt; idx < DEPTH * 224 * 128; idx += NGT) { const int l = idx / (224 * 128), r = idx % (224 * 128);
            *(u32x4*)(WIN + ((size_t)l * HP + IN_COLS) * DM + (size_t)r * 8) = (u32x4){0u, 0u, 0u, 0u}; }
        for (int idx = gt; idx < DEPTH * 192 * 32; idx += NGT) { const int l = idx / (192 * 32), r = idx % (192 * 32);
            *(u32x4*)(WUQ + ((size_t)l * 768 + 576) * 256 + (size_t)r * 8) = (u32x4){0u, 0u, 0u, 0u}; }
        for (int idx = gt; idx < SEQ * 16; idx += NGT) { const int pos = idx >> 4, i = idx & 15; const int rw = pos >> 6, cl = pos & 63;
            const float inv = powf(10000.f, -(float)(i & 7) / 8.f); const float ang = (float)(i < 8 ? rw : cl) * inv;
            ROPEM[2 * idx] = cosf(ang); ROPEM[2 * idx + 1] = sinf(ang); }
        for (int idx = gt; idx < SEQ * 32; idx += NGT) { const int pos = idx >> 5, i = idx & 31; const int rw = pos >> 6, cl = pos & 63;
            const float inv = powf(10000.f, -(float)(i & 15) / 16.f); const float ang = (float)(i < 16 ? rw : cl) * inv;
            ROPEG[2 * idx] = cosf(ang); ROPEG[2 * idx + 1] = sinf(ang); }
        __syncthreads();
        float* sil = (float*)lds;
        float* part = (float*)lds + 5 * 1024;
        { const float* c_in = KP()->in[I_C]; const float* cc_in = KP()->in[I_CCTX];
        for (int idx = tid; idx < 5 * 1024; idx += 512) { const int v = idx >> 10, k = idx & 1023; const float c = (v < 4) ? c_in[v * 1024 + k] : cc_in[k]; sil[idx] = c / (1.f + __expf(-c)); } }
        const float* wada_ = KP()->in[I_WADA]; const float* bada_ = KP()->in[I_BADA];
        __syncthreads();
        for (int it = bx; it < DEPTH * 96; it += G) { const int l = it / 96, jb = it % 96; const int j = jb * 64 + lane;
            const float* wp = wada_ + ((size_t)l * DM + wave * 128) * 6144 + j;
            float a0 = 0, a1 = 0, a2 = 0, a3 = 0, a4 = 0;
#pragma unroll 8
            for (int k = 0; k < 128; ++k) { const float w = wp[(size_t)k * 6144]; const int kk = wave * 128 + k;
                a0 += sil[kk] * w; a1 += sil[1024 + kk] * w; a2 += sil[2048 + kk] * w; a3 += sil[3072 + kk] * w; a4 += sil[4096 + kk] * w; }
            part[(wave * 5 + 0) * 64 + lane] = a0; part[(wave * 5 + 1) * 64 + lane] = a1; part[(wave * 5 + 2) * 64 + lane] = a2; part[(wave * 5 + 3) * 64 + lane] = a3; part[(wave * 5 + 4) * 64 + lane] = a4;
            __syncthreads();
            if (tid < 320) { const int v = tid >> 6, c = tid & 63; float s = bada_[l * 6144 + jb * 64 + c];
#pragma unroll
                for (int w = 0; w < 8; ++w) s += part[(w * 5 + v) * 64 + c];
                MOD[((size_t)l * 5 + v) * 6144 + jb * 64 + c] = s; }
            __syncthreads();
        }
    }
    GSYNC_CG(0);
    (void)xcd_barrier_post(XB_BAR, XB_ST, XB_T0);
    { DEFWS(WSB())
    const int lane = pg8::lane_id_asm(); const float* xin_ = KP()->in[I_X]; const float* cin_ = KP()->in[I_CTX];
    for (int m = gw; m < MROWS; m += NGW) { const RowInfo ri = row_info(m);
        const float* xr = ri.isctx ? cin_ + ((size_t)ri.b * CTX + ri.i) * DM : xin_ + ((size_t)ri.b * SEQ + ri.i - CTX) * DM;
        const float* md = MOD + (size_t)ri.v * 6144;
#pragma unroll
        for (int jp = 0; jp < 2; ++jp) { const int col = 8 * lane + 512 * jp;
            const f32x4 x0 = *(const f32x4*)(xr + col), x1 = *(const f32x4*)(xr + col + 4), sh0 = *(const f32x4*)(md + col), sh1 = *(const f32x4*)(md + col + 4), sc0 = *(const f32x4*)(md + 1024 + col), sc1 = *(const f32x4*)(md + 1024 + col + 4);
            const f32x4 u0 = x0 * (1.f + sc0) + sh0, u1 = x1 * (1.f + sc1) + sh1; u32x4 w; w.x = pk2(u0[0], u0[1]); w.y = pk2(u0[2], u0[3]); w.z = pk2(u1[0], u1[1]); w.w = pk2(u1[2], u1[3]); *(u32x4*)(U + (size_t)m * DM + col) = w; }
    } }
    GSYNC(0);

#pragma unroll 1
    for (int l = 0; l < DEPTH; ++l) {
        { DEFWS(WSB()) LAUN3(); pg8::Gemm g{U, WIN + (size_t)l * HP * DM, MROWS, HP, DM, DM}; pg8::StaticOrder S; S.init(MROWS, HP, G_, bx_);
          pg8::EpiStore<0> E{H, HPI, IN_COLS};
          pg8::gemm_phase<pg8::EpiStore<0>, pg8::StaticOrder, true, true>((LAS unsigned char*)lds, g, S, E, wave_); }
        GSYNC(1);
        {
            DEFWS(WSB())
            const int lane = pg8::lane_id_asm();
            const f32x2* gckv = (const f32x2*)(KP()->in[I_GCKV] + l * 128); const f32x2* gkn = (const f32x2*)(KP()->in[I_GKN] + l * 64);
            const f32x2* gcq = (const f32x2*)(KP()->in[I_GCQ] + l * 256); const f32x2* gqn = (const f32x2*)(KP()->in[I_GQN] + l * 64);
            const f32x2* wc0 = (const f32x2*)(KP()->in[I_WCONV] + (size_t)l * 768); const f32x2* wc1 = wc0 + 128; const f32x2* wc2 = wc0 + 256;
            const f32x2* rM = (const f32x2*)ROPEM; const f32x2* rG = (const f32x2*)ROPEG;
            const f32x2 gckv_l = gckv[lane], gkn_l = gkn[lane & 31], gcq0_l = gcq[lane], gcq1_l = gcq[64 + lane], gqn_l = gqn[lane & 31];
            f32x2 wcv[2][3];
#pragma unroll
            for (int j = 0; j < 2; ++j) { wcv[j][0] = wc0[lane + 64 * j]; wcv[j][1] = wc1[lane + 64 * j]; wcv[j][2] = wc2[lane + 64 * j]; }
#define RED4(v, NSTEP) _Pragma("unroll") for (int q_ = 0; q_ < 4; ++q_) v[q_] = ((NSTEP) == 64) ? wave_sum(v[q_]) : half_sum(v[q_]);
            for (int ch = wave * G + bx; ch < MROWS / 4; ch += NGW) { const int m0 = ch * 4; const RowInfo ri = row_info(m0); const bool lat = !ri.isctx; const int pos0 = ri.i - CTX;
                const unsigned* hr0 = (const unsigned*)(H + (size_t)m0 * HPI);
#if TSEL >= 0
                unsigned tp0_ = 0; if (TST) tp0_ = (unsigned)__builtin_amdgcn_s_memrealtime();
#endif
                unsigned wkv[4], wpe[4], wgk[4], wgv[4], wq0[4], wq1[4], wgq[4][3];
#pragma unroll
                for (int q = 0; q < 4; ++q) { const unsigned* hr = hr0 + (size_t)q * (HPI / 2);
                    wkv[q] = hr[lane]; wpe[q] = hr[64 + (lane & 15)]; wgk[q] = hr[80 + lane]; wgv[q] = hr[144 + lane]; wq0[q] = hr[208 + lane]; wq1[q] = hr[272 + lane];
#pragma unroll
                    for (int j = 0; j < 3; ++j) wgq[q][j] = hr[336 + 64 * j + lane]; }
                f32x2 csM[4], csG[4];
#pragma unroll
                for (int q = 0; q < 4; ++q) { csM[q] = lat ? rM[(pos0 + q) * 16 + (lane & 15)] : (f32x2){1.f, 0.f}; csG[q] = lat ? rG[(pos0 + q) * 32 + (lane & 31)] : (f32x2){1.f, 0.f}; }
                const int seqlen = lat ? SEQ : CTX, t0 = lat ? pos0 : ri.i; const bool hp = t0 > 0, hn = t0 + 4 < seqlen; const float zp = hp ? 1.f : 0.f, zn = hn ? 1.f : 0.f;
                unsigned cvh[2][6], cvc[2][6], cvb[2][4];
#pragma unroll
                for (int q = 0; q < 6; ++q) { const int qq = (q == 0 && !hp) ? 1 : (q == 5 && !hn) ? 4 : q; const unsigned* hq = hr0 + (ptrdiff_t)(qq - 1) * (HPI / 2);
#pragma unroll
                    for (int j = 0; j < 2; ++j) { cvh[j][q] = hq[528 + lane + 64 * j]; cvc[j][q] = hq[784 + lane + 64 * j]; } }
#pragma unroll
                for (int q = 0; q < 4; ++q)
#pragma unroll
                    for (int j = 0; j < 2; ++j) cvb[j][q] = (hr0 + (size_t)q * (HPI / 2))[656 + lane + 64 * j];
                {
                    float ss[4];
#pragma unroll
                    for (int q = 0; q < 4; ++q) { const float a = bflo(wkv[q]), b2 = bfhi(wkv[q]); ss[q] = a * a + b2 * b2; }
                    RED4(ss, 64)
#if TSEL >= 0
                    if (TST) { const unsigned t_ = (unsigned)__builtin_amdgcn_s_memrealtime(); TSL[13] += t_ - tp0_; tp0_ = t_; }
#endif
#pragma unroll
                    for (int q = 0; q < 4; ++q) { const float r = rsqrtf(ss[q] * (1.f / 128.f) + LN_EPS); ((unsigned*)(CKV + (size_t)(m0 + q) * 128))[lane] = pk2(bflo(wkv[q]) * r * gckv_l.x, bfhi(wkv[q]) * r * gckv_l.y); } }
                if (lane < 16) {
#pragma unroll
                    for (int q = 0; q < 4; ++q) { const float a = bflo(wpe[q]), b2 = bfhi(wpe[q]); ((unsigned*)(KPE + (size_t)(m0 + q) * 32))[lane] = pk2(a * csM[q].x - b2 * csM[q].y, a * csM[q].y + b2 * csM[q].x); } }
                {
                    float ss[4];
#pragma unroll
                    for (int q = 0; q < 4; ++q) { const float a = bflo(wgk[q]), b2 = bfhi(wgk[q]); ss[q] = a * a + b2 * b2; }
                    RED4(ss, 32)
#pragma unroll
                    for (int q = 0; q < 4; ++q) { const float r = rsqrtf(ss[q] * (1.f / 64.f) + LN_EPS); const float a = bflo(wgk[q]) * r * gkn_l.x, b2 = bfhi(wgk[q]) * r * gkn_l.y;
                        ((unsigned*)(GK + (size_t)(m0 + q) * 128))[lane] = pk2(a * csG[q].x - b2 * csG[q].y, a * csG[q].y + b2 * csG[q].x); } }
#pragma unroll
                for (int q = 0; q < 4; ++q) ((unsigned*)(GV + (size_t)(m0 + q) * 128))[lane] = wgv[q];
                {
                    float ss[4];
#pragma unroll
                    for (int q = 0; q < 4; ++q) { const float a0 = bflo(wq0[q]), b0 = bfhi(wq0[q]), a1 = bflo(wq1[q]), b1 = bfhi(wq1[q]); ss[q] = (a0 * a0 + b0 * b0) + (a1 * a1 + b1 * b1); }
                    RED4(ss, 64)
#pragma unroll
                    for (int q = 0; q < 4; ++q) { const float r = rsqrtf(ss[q] * (1.f / 256.f) + LN_EPS); unsigned* o = (unsigned*)(CQ + (size_t)(m0 + q) * 256);
                        o[lane] = pk2(bflo(wq0[q]) * r * gcq0_l.x, bfhi(wq0[q]) * r * gcq0_l.y); o[64 + lane] = pk2(bflo(wq1[q]) * r * gcq1_l.x, bfhi(wq1[q]) * r * gcq1_l.y); } }
#pragma unroll
                for (int j = 0; j < 3; ++j) {
                    float ss[4];
#pragma unroll
                    for (int q = 0; q < 4; ++q) { const float a = bflo(wgq[q][j]), b2 = bfhi(wgq[q][j]); ss[q] = a * a + b2 * b2; }
                    RED4(ss, 32)
#pragma unroll
                    for (int q = 0; q < 4; ++q) { const float r = rsqrtf(ss[q] * (1.f / 64.f) + LN_EPS); const float a = bflo(wgq[q][j]) * r * gqn_l.x, b2 = bfhi(wgq[q][j]) * r * gqn_l.y;
                        ((unsigned*)(GQ + (size_t)(m0 + q) * 384))[64 * j + lane] = pk2((a * csG[q].x - b2 * csG[q].y) * QSC64, (a * csG[q].y + b2 * csG[q].x) * QSC64); } }
                {
#pragma unroll
                    for (int j = 0; j < 2; ++j) { const int ix = lane + 64 * j; float pa[6], pb[6];
#pragma unroll
                        for (int q = 0; q < 6; ++q) { const float z = (q == 0) ? zp : (q == 5) ? zn : 1.f; pa[q] = bflo(cvh[j][q]) * bflo(cvc[j][q]) * z; pb[q] = bfhi(cvh[j][q]) * bfhi(cvc[j][q]) * z; }
#pragma unroll
                        for (int q = 0; q < 4; ++q) { const unsigned bb = cvb[j][q];
                            const float oa = bflo(bb) * (wcv[j][0].x * pa[q] + wcv[j][1].x * pa[q + 1] + wcv[j][2].x * pa[q + 2]);
                            const float ob = bfhi(bb) * (wcv[j][0].y * pb[q] + wcv[j][1].y * pb[q + 1] + wcv[j][2].y * pb[q + 2]);
                            ((unsigned*)(OC + (size_t)(m0 + q) * DM))[384 + ix] = pk2(oa, ob); } }
                }
#if TSEL >= 0
                if (TST) { const unsigned t_ = (unsigned)__builtin_amdgcn_s_memrealtime(); TSL[14] += t_ - tp0_; }
#endif
            }
#undef RED4
        }
        GSYNC(2);
        { DEFWS(WSB()) LAUN3(); pg8::Gemm g{CQ, WUQ + (size_t)l * 768 * 256, MROWS, 768, 256, 256}; pg8::StaticOrder S; S.init(MROWS, 768, G_, bx_);
          pg8::EpiUQ E{MQ, ROPEM, QSC96};
          pg8::gemm_phase<pg8::EpiUQ, pg8::StaticOrder, true, false>((LAS unsigned char*)lds, g, S, E, wave_); }
        { DEFWS(WSB()) LAUN3(); pg8::Gemm g{CKV, WUKV + (size_t)l * 768 * 128, MROWS, 768, 128, 128}; pg8::StaticOrder S; S.init(MROWS, 768, G_, bx_);
          pg8::EpiUKV E{MK, MV};
          pg8::gemm_phase<pg8::EpiUKV, pg8::StaticOrder, true, true>((LAS unsigned char*)lds, g, S, E, wave_); }
        GSYNC(3);
        {
            DEFWS(WSB())
            const int nrounds = (l < DEPTH - 1) ? 7 : 6;
            for (int i_ = 0; i_ < nrounds * ATT_REPS; ++i_) { const int i = (ATT_REPS == 1) ? i_ : (i_ % nrounds);
                int type, b, h, qrow0, seq;
                if (i < 6) { const int u = vcu + 256 * i; type = u / 768; const int rem = u % 768; b = rem / 192; h = (rem >> 5) % 6; const int qb = rem & 31; qrow0 = b * LTOK + CTX + qb * 256; seq = LTOK; }
                else { if (vcu >= 48) continue; type = vcu / 24; b = (vcu % 24) / 6; h = vcu % 6; qrow0 = b * LTOK; seq = CTX; }
                const size_t kr = (size_t)b * LTOK;
                if (type == 0) d64::attn_unit<8, true>((const d64::bf16*)(MQ + (size_t)qrow0 * 576 + h * 96), (const d64::bf16*)(MK + kr * 384 + h * 64), (const d64::bf16*)(KPE + kr * 32), (const d64::bf16*)(MV + kr * 384 + h * 64), (d64::bf16*)(OC + (size_t)qrow0 * DM + h * 64), seq / 64, (char*)lds, wave);
                else d64::attn_unit<8, false>((const d64::bf16*)(GQ + (size_t)qrow0 * 384 + h * 64), (const d64::bf16*)(GK + kr * 128 + (h / 3) * 64), nullptr, (const d64::bf16*)(GV + kr * 128 + (h / 3) * 64), (d64::bf16*)(OC + (size_t)qrow0 * DM + 384 + h * 64), seq / 64, (char*)lds, wave);
            }
        }
        GSYNC(4);
        { DEFWS(WSB()) LAUN3(); pg8::Gemm g{OC, WO + (size_t)l * DM * DM, MROWS, DM, DM, DM}; pg8::RowOrder S; S.init(DM, G_, bx_, true);
          pg8::EpiStore<0> E{Y, DM, DM};
          pg8::gemm_phase<pg8::EpiStore<0>, pg8::RowOrder, true, true>((LAS unsigned char*)lds, g, S, E, wave_); }
        if (l < DEPTH - 1) { DEFWS(WSB()) LAUN3(); pg8::Gemm g{OC, WO + (size_t)l * DM * DM, MROWS, DM, 256, DM}; pg8::CtxSplitOrder S; S.init(DM, 4, G_, bx_);
          pg8::EpiPart E{PART, DM, (size_t)1024 * DM};
          pg8::gemm_phase<pg8::EpiPart, pg8::CtxSplitOrder, true, true>((LAS unsigned char*)lds, g, S, E, wave_); }
        GSYNC(5);
#pragma unroll 1
        for (int which = 0; which < 2; ++which) {
            {
                DEFWS(WSB())
                const int lane = pg8::lane_id_asm();
                const float* lg = KP()->in[which ? I_LN2G : I_LN1G] + l * DM; const float* lb = KP()->in[which ? I_LN2B : I_LN1B] + l * DM;
                const float* xin_ = KP()->in[I_X]; const float* cin_ = KP()->in[I_CTX]; float* out_ = KP()->out;
                const bool first = (l == 0 && which == 0); const bool wantu = !(which == 1 && l == DEPTH - 1);
                const int KS = which ? 8 : 4;
#define LCOL(j) (8 * lane + 512 * ((j) >> 1) + 4 * ((j) & 1))
                f32x4 g4[4], b4[4];
#pragma unroll
                for (int j = 0; j < 4; ++j) { g4[j] = *(const f32x4*)(lg + LCOL(j)); b4[j] = *(const f32x4*)(lb + LCOL(j)); }
                for (int ch = wave * G + bx; ch < MROWS / 2; ch += NGW) { const int m0 = ch * 2; const RowInfo ri = row_info(m0);
                    if (ri.isctx && l == DEPTH - 1) continue;
                    const size_t zoff = ((size_t)ri.b * CTX + ri.i) * DM, xoff = ((size_t)ri.b * SEQ + ri.i - CTX) * DM;
                    const float* xo = ri.isctx ? (first ? cin_ + zoff : Z + zoff) : (first ? xin_ + xoff : out_ + xoff);
                    float* xn = ri.isctx ? Z + zoff : out_ + xoff;
                    const bool ldh = !ri.isctx && !first, sth = !ri.isctx && wantu;
                    const float* md = MOD + ((size_t)l * 5 + ri.v) * 6144; const float* gate = md + (which ? 5 : 2) * 1024;
                    const float* md2 = which ? MOD + ((size_t)(wantu ? l + 1 : l) * 5 + ri.v) * 6144 : md + 3 * 1024;
                    f32x4 gt[4], sh[4], sc1[4];
#pragma unroll
                    for (int j = 0; j < 4; ++j) { const int col = LCOL(j); gt[j] = *(const f32x4*)(gate + col); sh[j] = *(const f32x4*)(md2 + col); sc1[j] = 1.f + *(const f32x4*)(md2 + 1024 + col); }
                    const float* pp0 = PART + zoff;
                    {
                        f32x4 t[2][4]; float s[2] = {0.f, 0.f};
#pragma unroll
                        for (int q = 0; q < 2; ++q)
#pragma unroll
                            for (int jp = 0; jp < 2; ++jp) { const size_t rb = (size_t)q * DM; const int c0 = LCOL(2 * jp);
                                f32x4 x0, x1, y0, y1;
                                if (ldh) { const h16x8 hv = __builtin_nontemporal_load((const h16x8*)((const _Float16*)(xo + rb) + c0));
                                    x0 = __builtin_convertvector(__builtin_shufflevector(hv, hv, 0, 1, 2, 3), f32x4); x1 = __builtin_convertvector(__builtin_shufflevector(hv, hv, 4, 5, 6, 7), f32x4); }
                                else { x0 = __builtin_nontemporal_load((const f32x4*)(xo + rb + c0)); x1 = __builtin_nontemporal_load((const f32x4*)(xo + rb + c0 + 4)); }
                                if (ri.isctx) {
#pragma unroll
                                    for (int h = 0; h < 2; ++h) { const float* pp = pp0 + rb + c0 + 4 * h; f32x4 yy[8];
#pragma unroll
                                        for (int k = 0; k < 4; ++k) yy[k] = *(const f32x4*)(pp + (size_t)k * 1024 * DM);
                                        f32x4 y;
                                        if (KS == 8) {
#pragma unroll
                                            for (int k = 4; k < 8; ++k) yy[k] = *(const f32x4*)(pp + (size_t)k * 1024 * DM);
                                            y = ((yy[0] + yy[1]) + (yy[2] + yy[3])) + ((yy[4] + yy[5]) + (yy[6] + yy[7])); }
                                        else y = (yy[0] + yy[1]) + (yy[2] + yy[3]);
                                        if (h == 0) y0 = y; else y1 = y; } }
                                else { const u32x4 yw = *(const u32x4*)(Y + (size_t)m0 * DM + rb + c0); y0 = (f32x4){bflo(yw.x), bfhi(yw.x), bflo(yw.y), bfhi(yw.y)}; y1 = (f32x4){bflo(yw.z), bfhi(yw.z), bflo(yw.w), bfhi(yw.w)}; }
                                t[q][2 * jp] = ALPHA * x0 + gt[2 * jp] * y0; t[q][2 * jp + 1] = ALPHA * x1 + gt[2 * jp + 1] * y1;
                                s[q] += ((t[q][2 * jp][0] + t[q][2 * jp][1]) + (t[q][2 * jp][2] + t[q][2 * jp][3])) + ((t[q][2 * jp + 1][0] + t[q][2 * jp + 1][1]) + (t[q][2 * jp + 1][2] + t[q][2 * jp + 1][3])); }
                        s[0] = wave_sum(s[0]); s[1] = wave_sum(s[1]);
                        float s2[2] = {0.f, 0.f};
#pragma unroll
                        for (int q = 0; q < 2; ++q) { const float mean = s[q] * (1.f / DM);
#pragma unroll
                            for (int j = 0; j < 4; ++j) { t[q][j] = t[q][j] - mean; s2[q] += (t[q][j][0] * t[q][j][0] + t[q][j][1] * t[q][j][1]) + (t[q][j][2] * t[q][j][2] + t[q][j][3] * t[q][j][3]); } }
                        s2[0] = wave_sum(s2[0]); s2[1] = wave_sum(s2[1]);
#pragma unroll
                        for (int q = 0; q < 2; ++q) { const float rstd = rsqrtf(s2[q] * (1.f / DM) + LN_EPS);
#pragma unroll
                            for (int jp = 0; jp < 2; ++jp) { const size_t rb = (size_t)q * DM; const int c0 = LCOL(2 * jp);
                                const f32x4 xv0 = t[q][2 * jp] * rstd * g4[2 * jp] + b4[2 * jp], xv1 = t[q][2 * jp + 1] * rstd * g4[2 * jp + 1] + b4[2 * jp + 1];
                                if (sth) __builtin_nontemporal_store(__builtin_convertvector(__builtin_shufflevector(xv0, xv1, 0, 1, 2, 3, 4, 5, 6, 7), h16x8), (h16x8*)((_Float16*)(xn + rb) + c0));
                                else { __builtin_nontemporal_store(xv0, (f32x4*)(xn + rb + c0)); __builtin_nontemporal_store(xv1, (f32x4*)(xn + rb + c0 + 4)); }
                                if (wantu) { const f32x4 u0 = xv0 * sc1[2 * jp] + sh[2 * jp], u1 = xv1 * sc1[2 * jp + 1] + sh[2 * jp + 1];
                                    u32x4 w; w.x = pk2(u0[0], u0[1]); w.y = pk2(u0[2], u0[3]); w.z = pk2(u1[0], u1[1]); w.w = pk2(u1[2], u1[3]); *(u32x4*)(U + (size_t)m0 * DM + rb + c0) = w; } } }
                    }
                }
#undef LCOL
            }
            if (which == 1) { if (l < DEPTH - 1) GSYNC(9); else TBODY(9); break; }
            GSYNC(6);
            { DEFWS(WSB()) LAUN3(); pg8::Gemm g{U, W1 + (size_t)l * DFF * DM, MROWS, DFF, DM, DM}; pg8::RowOrder S; S.init(DFF, G_, bx_, l == DEPTH - 1);
              pg8::EpiStore<1> E{HM, DFF, DFF};
              pg8::gemm_phase<pg8::EpiStore<1>, pg8::RowOrder, true, true>((LAS unsigned char*)lds, g, S, E, wave_); }
            GSYNC(7);
            { DEFWS(WSB()) LAUN3(); pg8::Gemm g{HM, W2 + (size_t)l * DM * DFF, MROWS, DM, DFF, DFF}; pg8::RowOrder S; S.init(DM, G_, bx_, true);
              pg8::EpiStore<0> E{Y, DM, DM};
              pg8::gemm_phase<pg8::EpiStore<0>, pg8::RowOrder, true, true>((LAS unsigned char*)lds, g, S, E, wave_); }
            if (l < DEPTH - 1) { DEFWS(WSB()) LAUN3(); pg8::Gemm g{HM, W2 + (size_t)l * DM * DFF, MROWS, DM, 512, DFF}; pg8::CtxSplitOrder S; S.init(DM, 8, G_, bx_);
              pg8::EpiPart E{PART, DM, (size_t)1024 * DM};
              pg8::gemm_phase<pg8::EpiPart, pg8::CtxSplitOrder, true, true>((LAS unsigned char*)lds, g, S, E, wave_); }
            GSYNC(8);
        }
    }
#if TSEL >= 0
    grid.sync();
    if (blockIdx.x == 0) { __syncthreads(); unsigned ticks = 0; for (int k = 0; k < 16; ++k) if ((TSEL >> k) & 1) ticks += TSL[k]; const int n = (int)((ticks / 100u) / TDIV); float* o_ = KP()->out;
        for (int i = wave * 64 + pg8::lane_id_asm(); i < n; i += 512) o_[(size_t)i * 1031] += 0.2f; }
#endif
}

extern "C" void kernel_launch(void* const* d_in, const int* in_sizes, int n_in, void* d_out, int out_size, void* d_ws, size_t ws_size, hipStream_t stream) {
    static int grid = 0;
    if (grid == 0) {
        if (n_in != 21 || in_sizes[0] != NBATCH * SEQ * DM || out_size != NBATCH * SEQ * DM || ws_size < WS_END) {
            fprintf(stderr, "kernel_launch: shape mismatch n_in %d in0 %d out %d ws %zu (need %zu)\n", n_in, n_in > 0 ? in_sizes[0] : -1, out_size, ws_size, (size_t)WS_END); grid = -1; return; }
        int dev = 0, cus = 0, per_cu = 0;
        hipGetDevice(&dev); hipDeviceGetAttribute(&cus, hipDeviceAttributeMultiprocessorCount, dev);
        if (hipFuncSetAttribute((const void*)fwd_megakernel, hipFuncAttributeMaxDynamicSharedMemorySize, LDS_BYTES) != hipSuccess) { fprintf(stderr, "kernel_launch: hipFuncSetAttribute failed\n"); grid = -1; return; }
        if (hipOccupancyMaxActiveBlocksPerMultiprocessor(&per_cu, (const void*)fwd_megakernel, 512, LDS_BYTES) != hipSuccess || per_cu < 1) { fprintf(stderr, "kernel_launch: occupancy query says %d\n", per_cu); per_cu = 1; }
        (void)hipGetLastError();
        if (cus < 256) { fprintf(stderr, "kernel_launch: built for a 256-CU device, found %d CUs\n", cus); grid = -1; return; }
        grid = 256;
        fprintf(stderr, "kernel_launch: grid %d (per_cu %d)\n", grid, per_cu);
    }
    if (grid < 0) return;
    Params p{};
    for (int i = 0; i < 21; ++i) p.in[i] = (const float*)d_in[i];
    p.out = (float*)d_out; p.ws = (unsigned char*)d_ws;
    void* args[] = {&p};
    hipError_t e = hipLaunchCooperativeKernel((const void*)fwd_megakernel, dim3(grid), dim3(512), args, LDS_BYTES, stream);
    if (e != hipSuccess) fprintf(stderr, "kernel_launch: cooperative launch failed: %s (grid %d)\n", hipGetErrorString(e), grid);
}
```

```cpp
#include <hip/hip_runtime.h>
#include <hip/hip_cooperative_groups.h>
#include <hip/hip_bf16.h>
#include <cstdio>
#include <cstdint>
namespace cg = cooperative_groups;

constexpr int DM = 1024, NBATCH = 4, SEQ = 8192, DEPTH = 4, CTX = 256, DFF = 4096;
constexpr int LTOK = CTX + SEQ;
constexpr int MROWS = NBATCH * LTOK;
constexpr int IN_COLS = 1824, HP = 2048, HPI = 1856;
constexpr float LN_EPS = 1e-6f;
constexpr float ALPHA = 1.6817928305074290f;
namespace pg8 {
#define PG8_LAS __attribute__((address_space(3)))
typedef unsigned short bf16_t;
typedef short bf16x8 __attribute__((ext_vector_type(8)));
typedef float f32x4 __attribute__((ext_vector_type(4)));
typedef unsigned u32x4 __attribute__((ext_vector_type(4)));
constexpr int BM = 256, BK = 64, HALF = 128, HTB = HALF * BK * 2  , STAGE_BYTES = 8 * HTB, NXCD = 8, WGM = 8;

__host__ __device__ __forceinline__ int lds_byte(int r, int c) { const int st = (r >> 4) * 2 + (c >> 5), rr = r & 15, cc = c & 31, ob = rr * 64 + cc * 2; return st * 1024 + (ob ^ (((ob >> 9) & 1) << 5)); }
__host__ __device__ __forceinline__ void stage_rc(int b, int& R, int& C) { const int st = b / 1024, sb = b % 1024, swz = sb ^ (((sb >> 9) & 1) << 5); R = (st >> 1) * 16 + swz / 64; C = (st & 1) * 32 + (swz % 64) / 2; }
__host__ __device__ __forceinline__ int perm32(int rho) { const int n = rho >> 4, i = rho & 15; return 8 * (i >> 2) + 4 * n + (i & 3); }

struct Unit { int pm, pn, pk; };
struct Gemm { const bf16_t* A; const bf16_t* Bt; int M, N, K, ld; };

struct StaticOrder {
    int nM, nN, nwg, G, c;
    __host__ __device__ void init(int M, int N, int G_, int c_) { nM = M / BM; nN = N / BM; nwg = nM * nN; G = G_; c = c_; }
    __host__ __device__ bool next(int i, Unit& u) const {
        const long L = (long)i * G + c; if (L >= nwg) return false;
        int wgid = (int)L; { const int q = nwg / NXCD, r = nwg % NXCD, xcd = wgid % NXCD, off = wgid / NXCD; wgid = (xcd < r ? xcd * (q + 1) : r * (q + 1) + (xcd - r) * q) + off; }
        const int nig = WGM * nN, gid = wgid / nig, fm = gid * WGM, gsz = (nM - fm) < WGM ? (nM - fm) : WGM;
        u.pm = fm + ((wgid % nig) % gsz); u.pn = (wgid % nig) / gsz; u.pk = 0; return true;
    }
    __device__ __forceinline__ void a_ready(const Unit&) const {}
    __device__ __forceinline__ void done(const Unit&) const {}
};

__device__ __forceinline__ unsigned cvt_pk_bf16(float lo, float hi) { unsigned r; asm volatile("v_cvt_pk_bf16_f32 %0, %1, %2" : "=v"(r) : "v"(lo), "v"(hi)); return r; }
__device__ __forceinline__ int lane_id_asm() { int l; asm volatile("v_mbcnt_lo_u32_b32 %0, -1, 0\n\tv_mbcnt_hi_u32_b32 %0, -1, %0" : "=v"(l)); return l; }
typedef float f32x2 __attribute__((ext_vector_type(2)));
template <int ACT  > struct EpiStore {
    static constexpr bool PERM = true, AFTER_DRAIN = false;
    bf16_t* O; int ldc; int ncol;
    __device__ __forceinline__ void operator()(const f32x4 (&acc)[2][2][4][2], const Unit& u, int wr, int wc, int fr, int fq) const {
        const int row0 = u.pm * BM + wr * 64 + fr; const int col0 = u.pn * BM + wc * 32 + 8 * fq;
#pragma unroll
        for (int ai = 0; ai < 2; ++ai)
#pragma unroll
            for (int m = 0; m < 4; ++m) { bf16_t* rowp = O + (unsigned)((row0 + ai * HALF + m * 16) * ldc + col0);
#pragma unroll
                for (int bj = 0; bj < 2; ++bj) { f32x4 v0 = acc[ai][bj][m][0], v1 = acc[ai][bj][m][1];
                    if (ACT == 1) {
#pragma unroll
                        for (int e = 0; e < 4; ++e) { float a = fmaxf(v0[e], 0.f), b = fmaxf(v1[e], 0.f); v0[e] = a * a; v1[e] = b * b; } }
                    u32x4 w; w.x = cvt_pk_bf16(v0[0], v0[1]); w.y = cvt_pk_bf16(v0[2], v0[3]); w.z = cvt_pk_bf16(v1[0], v1[1]); w.w = cvt_pk_bf16(v1[2], v1[3]);
                    if (col0 + bj * HALF < ncol) *(u32x4*)(rowp + bj * HALF) = w; } }
    }
};
struct EpiUQ {
    static constexpr bool PERM = true, AFTER_DRAIN = false;
    bf16_t* MQ; const float* ropeM; float qscale;
    __device__ __forceinline__ void operator()(const f32x4 (&acc)[2][2][4][2], const Unit& u, int wr, int wc, int fr, int fq) const {
        const int row0 = u.pm * BM + wr * 64 + fr;
        const int pt = u.pm % 33; const bool lat = pt != 0; const int pos0 = (pt - 1) * 256 + wr * 64 + fr;
#pragma unroll
        for (int bj = 0; bj < 2; ++bj) {
            const int c = u.pn * BM + bj * HALF + wc * 32 + 8 * fq;
            if (c >= 576) continue;
            const int d = c % 96; const bool isrope = (d >= 64) && lat; const int i0 = (d - 64) >> 1;
#pragma unroll
            for (int ai = 0; ai < 2; ++ai)
#pragma unroll
                for (int m = 0; m < 4; ++m) { const int row = row0 + ai * HALF + m * 16;
                    f32x4 v0 = acc[ai][bj][m][0], v1 = acc[ai][bj][m][1];
                    if (isrope) { const f32x4* rp = (const f32x4*)(ropeM + (unsigned)(((pos0 + ai * HALF + m * 16) * 16 + i0) * 2));
                        const f32x4 r0 = rp[0], r1 = rp[1];
                        f32x4 a, b;
                        a[0] = v0[0] * r0[0] - v0[1] * r0[1]; a[1] = v0[0] * r0[1] + v0[1] * r0[0];
                        a[2] = v0[2] * r0[2] - v0[3] * r0[3]; a[3] = v0[2] * r0[3] + v0[3] * r0[2];
                        b[0] = v1[0] * r1[0] - v1[1] * r1[1]; b[1] = v1[0] * r1[1] + v1[1] * r1[0];
                        b[2] = v1[2] * r1[2] - v1[3] * r1[3]; b[3] = v1[2] * r1[3] + v1[3] * r1[2];
                        v0 = a; v1 = b; }
                    v0 = v0 * qscale; v1 = v1 * qscale;
                    u32x4 w; w.x = cvt_pk_bf16(v0[0], v0[1]); w.y = cvt_pk_bf16(v0[2], v0[3]); w.z = cvt_pk_bf16(v1[0], v1[1]); w.w = cvt_pk_bf16(v1[2], v1[3]);
                    *(u32x4*)(MQ + (unsigned)(row * 576 + c)) = w; }
        }
    }
};
struct EpiUKV {
    static constexpr bool PERM = true, AFTER_DRAIN = false;
    bf16_t* MK; bf16_t* MV;
    __device__ __forceinline__ void operator()(const f32x4 (&acc)[2][2][4][2], const Unit& u, int wr, int wc, int fr, int fq) const {
        const int row0 = u.pm * BM + wr * 64 + fr;
#pragma unroll
        for (int bj = 0; bj < 2; ++bj) {
            const int head = u.pn * 2 + bj; const int d = wc * 32 + 8 * fq;
            bf16_t* base = (d < 64) ? MK : MV; const unsigned boff = (unsigned)(head * 64 + (d & 63));
#pragma unroll
            for (int ai = 0; ai < 2; ++ai)
#pragma unroll
                for (int m = 0; m < 4; ++m) { const int row = row0 + ai * HALF + m * 16;
                    const f32x4 v0 = acc[ai][bj][m][0], v1 = acc[ai][bj][m][1];
                    u32x4 w; w.x = cvt_pk_bf16(v0[0], v0[1]); w.y = cvt_pk_bf16(v0[2], v0[3]); w.z = cvt_pk_bf16(v1[0], v1[1]); w.w = cvt_pk_bf16(v1[2], v1[3]);
                    *(u32x4*)(base + (boff + (unsigned)(row * 384))) = w; }
        }
    }
};
struct RowOrder {
    StaticOrder S0; bool latonly;
    __host__ __device__ void init(int N, int G_, int c_, bool latonly_) { latonly = latonly_; S0.init(latonly_ ? 128 * BM : 132 * BM, N, G_, c_); }
    __host__ __device__ bool next(int i, Unit& u) const { if (!S0.next(i, u)) return false; if (latonly) u.pm = u.pm + u.pm / 32 + 1; return true; }
    __device__ __forceinline__ void a_ready(const Unit&) const {}
    __device__ __forceinline__ void done(const Unit&) const {}
};
struct CtxSplitOrder {
    int nN, KS, total, G, c;
    __host__ __device__ void init(int N, int KS_, int G_, int c_) { nN = N / BM; KS = KS_; total = 4 * nN * KS_; G = G_; c = c_; }
    __host__ __device__ bool next(int i, Unit& u) const { const int L = i * G + c; if (L >= total) return false; u.pk = L % KS; const int t = L / KS; u.pn = t % nN; u.pm = 33 * (t / nN); return true; }
    __device__ __forceinline__ void a_ready(const Unit&) const {}
    __device__ __forceinline__ void done(const Unit&) const {}
};
struct EpiPart {
    static constexpr bool PERM = false, AFTER_DRAIN = false;
    float* P; int ldc; size_t kstride;
    __device__ __forceinline__ void operator()(const f32x4 (&acc)[2][2][4][2], const Unit& u, int wr, int wc, int fr, int fq) const {
        float* base = P + (size_t)u.pk * kstride + (size_t)((u.pm / 33) * BM + wr * 64 + fr) * ldc + u.pn * BM + wc * 32 + 4 * fq;
#pragma unroll
        for (int ai = 0; ai < 2; ++ai)
#pragma unroll
            for (int m = 0; m < 4; ++m)
#pragma unroll
                for (int bj = 0; bj < 2; ++bj)
#pragma unroll
                    for (int n = 0; n < 2; ++n) *(f32x4*)(base + (size_t)(ai * HALF + m * 16) * ldc + bj * HALF + n * 16) = acc[ai][bj][m][n];
    }
};
template <class Epi, class Sched, bool ALIGN_EPI = false, bool SP2 = false>
__device__ __forceinline__ void gemm_phase(PG8_LAS unsigned char* lds, const Gemm g, const Sched& S, const Epi& E, const int wave_in) {
    const int tid_l_ = wave_in * 64 + lane_id_asm();
    const int tid = tid_l_, wid = __builtin_amdgcn_readfirstlane(tid >> 6), lane = tid & 63, wr = wid >> 2, wc = wid & 3, fr = lane & 15, fq = lane >> 4;
    const int K = g.K, nt = K / BK;
    unsigned voffA[2], voffB[2];
#pragma unroll
    for (int i = 0; i < 2; ++i) { int R, C; stage_rc(tid * 16 + i * 8192, R, C); const int Rb = Epi::PERM ? ((R & ~31) + perm32(R & 31)) : R;
        voffA[i] = (unsigned)(R * g.ld + C) * 2u; voffB[i] = (unsigned)(Rb * g.ld + C) * 2u; }
    const size_t kstep = (size_t)(BK * 2);
    const size_t hstep = (size_t)HALF * g.ld * 2;
    const size_t tstep = 2 * hstep;
    const unsigned ldsw = (unsigned)wid * 1024u;
    const int aoff = lds_byte(wr * 64 + fr, fq * 8), boff = lds_byte(wc * 32 + fr, fq * 8);
#define PG8_SA(b, h) (((b) * 2 + (h)) * HTB)
#define PG8_SB(b, h) ((4 + (b) * 2 + (h)) * HTB)
#define PG8_STAGE(bufoff, gbase, voff) do { _Pragma("unroll") for (int _i = 0; _i < 2; ++_i) \
        __builtin_amdgcn_global_load_lds((const unsigned*)((const char*)(gbase) + (voff)[_i]), (PG8_LAS unsigned*)(lds + (bufoff) + ldsw + _i * 8192), 16, 0, 0); } while (0)
#define PG8_LDA(dst, b, h) do { _Pragma("unroll") for (int m = 0; m < 4; ++m) _Pragma("unroll") for (int k = 0; k < 2; ++k) dst[m][k] = *(const PG8_LAS bf16x8*)(lds + PG8_SA(b, h) + aoff + m * 2048 + k * 1024); } while (0)
#define PG8_LDB(dst, b, h) do { _Pragma("unroll") for (int n = 0; n < 2; ++n) _Pragma("unroll") for (int k = 0; k < 2; ++k) dst[n][k] = *(const PG8_LAS bf16x8*)(lds + PG8_SB(b, h) + boff + n * 2048 + k * 1024); } while (0)
#define PG8_MMA(ai, bj, At, Bt) do { __builtin_amdgcn_s_setprio(1); _Pragma("unroll") for (int m = 0; m < 4; ++m) _Pragma("unroll") for (int n = 0; n < 2; ++n) _Pragma("unroll") for (int k = 0; k < 2; ++k) \
        acc[ai][bj][m][n] = __builtin_amdgcn_mfma_f32_16x16x32_bf16(Bt[n][k], At[m][k], acc[ai][bj][m][n], 0, 0, 0); __builtin_amdgcn_s_setprio(0); } while (0)
#define PG8_WAIT_V(n) asm volatile("s_waitcnt vmcnt(" #n ")" ::: "memory")
#define PG8_WAIT_L(n) asm volatile("s_waitcnt lgkmcnt(" #n ")" ::: "memory")
#define PG8_BAR __builtin_amdgcn_s_barrier()
#define PG8_SCHED __builtin_amdgcn_sched_barrier(0)
    Unit cur, nxt; int ui = 0;
    if (!S.next(0, cur)) return;
    f32x4 acc[2][2][4][2];
#pragma unroll
    for (int a = 0; a < 2; ++a)
#pragma unroll
        for (int b = 0; b < 2; ++b)
#pragma unroll
            for (int m = 0; m < 4; ++m)
#pragma unroll
                for (int n = 0; n < 2; ++n) acc[a][b][m][n] = (f32x4){0.f, 0.f, 0.f, 0.f};
    bf16x8 At[4][2], B0[2][2], B1[2][2];
    const char* cA = (const char*)g.A + (size_t)cur.pm * tstep + (size_t)cur.pk * K * 2; const char* cB = (const char*)g.Bt + (size_t)cur.pn * tstep + (size_t)cur.pk * K * 2;
    S.a_ready(cur);
    if constexpr (SP2) {
        PG8_STAGE(PG8_SB(0, 0), cB, voffB); PG8_STAGE(PG8_SB(0, 1), cB + hstep, voffB); PG8_STAGE(PG8_SA(0, 0), cA, voffA); PG8_STAGE(PG8_SA(0, 1), cA + hstep, voffA);
        if (wr == 1) PG8_BAR;
        PG8_WAIT_V(2); PG8_BAR;
        PG8_STAGE(PG8_SB(1, 0), cB + kstep, voffB); PG8_STAGE(PG8_SA(1, 0), cA + kstep, voffA); PG8_STAGE(PG8_SB(1, 1), cB + hstep + kstep, voffB);
        PG8_WAIT_V(6); PG8_BAR;
    } else {
        PG8_STAGE(PG8_SB(0, 0), cB, voffB); PG8_STAGE(PG8_SA(0, 0), cA, voffA); PG8_STAGE(PG8_SB(0, 1), cB + hstep, voffB); PG8_STAGE(PG8_SA(0, 1), cA + hstep, voffA);
        if (wr == 1) PG8_BAR;
        PG8_WAIT_V(4); PG8_BAR;
        PG8_STAGE(PG8_SB(1, 0), cB + kstep, voffB); PG8_STAGE(PG8_SA(1, 0), cA + kstep, voffA); PG8_STAGE(PG8_SB(1, 1), cB + hstep + kstep, voffB);
        PG8_WAIT_V(6); PG8_BAR;
    }
    for (;;) {
        const bool has_next = S.next(ui + 1, nxt);
        const char* nA = has_next ? (const char*)g.A + (size_t)nxt.pm * tstep + (size_t)nxt.pk * K * 2 : cA; const char* nB = has_next ? (const char*)g.Bt + (size_t)nxt.pn * tstep + (size_t)nxt.pk * K * 2 : cB;
        for (int t = 0; t < nt; t += 2) {
            const bool last = (t == nt - 2);
            const char* a1 = cA + (size_t)(t + 1) * kstep;
            const char* a2 = last ? nA : cA + (size_t)(t + 2) * kstep; const char* b2 = last ? nB : cB + (size_t)(t + 2) * kstep;
            const char* a3 = a2 + kstep; const char* b3 = b2 + kstep;
            if (last && has_next) S.a_ready(nxt);
            if constexpr (SP2) {
            PG8_LDB(B0, 0, 0); PG8_LDB(B1, 0, 1); PG8_SCHED; PG8_LDA(At, 0, 0); PG8_STAGE(PG8_SA(1, 1), a1 + hstep, voffA);
            PG8_WAIT_V(8); PG8_WAIT_L(0); PG8_BAR; PG8_MMA(0, 0, At, B0); PG8_MMA(0, 1, At, B1); PG8_BAR; PG8_SCHED;
            PG8_LDA(At, 0, 1); PG8_STAGE(PG8_SB(0, 0), b2, voffB); PG8_STAGE(PG8_SB(0, 1), b2 + hstep, voffB); PG8_STAGE(PG8_SA(0, 0), a2, voffA);
            PG8_WAIT_V(8); PG8_WAIT_L(0); PG8_BAR; PG8_MMA(1, 0, At, B0); PG8_MMA(1, 1, At, B1); PG8_BAR; PG8_SCHED;
            PG8_LDB(B0, 1, 0); PG8_LDB(B1, 1, 1); PG8_SCHED; PG8_LDA(At, 1, 0); PG8_STAGE(PG8_SA(0, 1), a2 + hstep, voffA);
            PG8_WAIT_V(8); PG8_WAIT_L(0); PG8_BAR; PG8_MMA(0, 0, At, B0); PG8_MMA(0, 1, At, B1); PG8_BAR; PG8_SCHED;
            PG8_LDA(At, 1, 1); PG8_STAGE(PG8_SB(1, 0), b3, voffB); PG8_STAGE(PG8_SB(1, 1), b3 + hstep, voffB); PG8_STAGE(PG8_SA(1, 0), a3, voffA);
            PG8_WAIT_V(8); PG8_WAIT_L(0); PG8_BAR; PG8_MMA(1, 0, At, B0); PG8_MMA(1, 1, At, B1); PG8_BAR; PG8_SCHED;
            } else {
            PG8_LDB(B0, 0, 0); PG8_SCHED; PG8_LDA(At, 0, 0); PG8_STAGE(PG8_SA(1, 1), a1 + hstep, voffA);
            PG8_WAIT_L(8); PG8_BAR; PG8_WAIT_L(0); PG8_MMA(0, 0, At, B0); PG8_BAR; PG8_SCHED;
            PG8_LDB(B1, 0, 1); PG8_STAGE(PG8_SB(0, 0), b2, voffB);
            PG8_BAR; PG8_WAIT_L(0); PG8_MMA(0, 1, At, B1); PG8_BAR;
            PG8_LDA(At, 0, 1); PG8_STAGE(PG8_SA(0, 0), a2, voffA);
            PG8_BAR; PG8_WAIT_L(0); PG8_MMA(1, 0, At, B0); PG8_BAR; PG8_SCHED;
            PG8_STAGE(PG8_SB(0, 1), b2 + hstep, voffB);
            PG8_WAIT_V(6); PG8_BAR; PG8_MMA(1, 1, At, B1); PG8_BAR;
            PG8_LDB(B0, 1, 0); PG8_SCHED; PG8_LDA(At, 1, 0); PG8_STAGE(PG8_SA(0, 1), a2 + hstep, voffA);
            PG8_WAIT_L(8); PG8_BAR; PG8_WAIT_L(0); PG8_MMA(0, 0, At, B0); PG8_BAR; PG8_SCHED;
            PG8_LDB(B1, 1, 1); PG8_STAGE(PG8_SB(1, 0), b3, voffB);
            PG8_BAR; PG8_WAIT_L(0); PG8_MMA(0, 1, At, B1); PG8_BAR;
            PG8_LDA(At, 1, 1); PG8_STAGE(PG8_SA(1, 0), a3, voffA);
            PG8_BAR; PG8_WAIT_L(0); PG8_MMA(1, 0, At, B0); PG8_BAR; PG8_SCHED;
            PG8_STAGE(PG8_SB(1, 1), b3 + hstep, voffB);
            PG8_WAIT_V(6); PG8_BAR; PG8_MMA(1, 1, At, B1); PG8_BAR;
            }
        }
        if constexpr (ALIGN_EPI) { if (wr == 0) PG8_BAR; }
        if constexpr (!Epi::AFTER_DRAIN) { const int le_ = lane_id_asm(); E(acc, cur, wr, wc, le_ & 15, le_ >> 4); S.done(cur); }
        if (!has_next) break;
#pragma unroll
        for (int a = 0; a < 2; ++a)
#pragma unroll
            for (int b = 0; b < 2; ++b)
#pragma unroll
                for (int m = 0; m < 4; ++m)
#pragma unroll
                    for (int n = 0; n < 2; ++n) acc[a][b][m][n] = (f32x4){0.f, 0.f, 0.f, 0.f};
        cur = nxt; cA = nA; cB = nB; ++ui;
        if constexpr (ALIGN_EPI) { if (wr == 1) PG8_BAR; }
    }
    PG8_WAIT_V(0);
    if constexpr (!ALIGN_EPI) { if (wr == 0) PG8_BAR; }
    PG8_BAR;
    if constexpr (Epi::AFTER_DRAIN) { E.fused(acc, cur, wr, wc, fr, fq, lds, wid, lane); S.done(cur); }
#undef PG8_SA
#undef PG8_SB
#undef PG8_STAGE
#undef PG8_LDA
#undef PG8_LDB
#undef PG8_MMA
#undef PG8_WAIT_V
#undef PG8_WAIT_L
#undef PG8_BAR
#undef PG8_SCHED
}
}

namespace att {
typedef unsigned short bf16_t;
using bf16x8 = __attribute__((ext_vector_type(8))) short;
using s16x4  = __attribute__((ext_vector_type(4))) short;
using f32x16 = __attribute__((ext_vector_type(16))) float;
using u32x4  = __attribute__((ext_vector_type(4))) unsigned;
constexpr int NW = 8, QBLK = 32, KVBLK = 64;
constexpr float THR = 8.f;
constexpr int SHM_V = 16384, SHM_K = 16384;
#define KSWZ(row, colB) ((row) * 256 + ((colB) ^ (((row) & 15) << 4)))
#define SBAR() __builtin_amdgcn_sched_barrier(0)
__device__ __forceinline__ int crow(int r, int hi) { return (r & 3) + 8 * (r >> 2) + 4 * hi; }
__device__ __forceinline__ unsigned cvtpk(float lo, float hi) { unsigned r; asm volatile("v_cvt_pk_bf16_f32 %0, %1, %2" : "=v"(r) : "v"(lo), "v"(hi)); return r; }

constexpr float THRL = 11.0f;
template <bool FIRST> __device__ __forceinline__ void partialSM(f32x16& p0, f32x16& p1, float& m_reg, f32x16& negm, float& alpha) {
  float pmax = fmaxf(fmaxf(p0[0], p0[1]), p1[0]);
#pragma unroll
  for (int r = 2; r < 16; r += 2) pmax = fmaxf(fmaxf(pmax, p0[r]), p0[r + 1]);
#pragma unroll
  for (int r = 1; r < 15; r += 2) pmax = fmaxf(fmaxf(pmax, p1[r]), p1[r + 1]);
  pmax = fmaxf(pmax, p1[15]);
  { auto rr = __builtin_amdgcn_permlane32_swap(__float_as_uint(pmax), __float_as_uint(pmax), false, false);
    pmax = fmaxf(__uint_as_float(rr[0]), __uint_as_float(rr[1])); }
  alpha = 1.f;
  if (FIRST || !__builtin_expect(__all(pmax <= THRL), 1)) {
    const float dl = FIRST ? pmax : fmaxf(pmax, 0.f);
    m_reg += dl;
#pragma unroll
    for (int r = 0; r < 16; ++r) { p0[r] -= dl; p1[r] -= dl; }
#pragma unroll
    for (int r = 0; r < 16; ++r) negm[r] = -m_reg;
    if (!FIRST) alpha = __builtin_amdgcn_exp2f(-dl);
  }
#pragma unroll
  for (int r = 0; r < 16; ++r) p0[r] = __builtin_amdgcn_exp2f(p0[r]);
}
__device__ __forceinline__ void finishSM(f32x16& p0, f32x16& p1, float alpha, float& l_reg, bf16x8& pa0, bf16x8& pa1, bf16x8& pa2, bf16x8& pa3) {
#pragma unroll
  for (int r = 0; r < 16; ++r) p1[r] = __builtin_amdgcn_exp2f(p1[r]);
  float ps = 0;
#pragma unroll
  for (int r = 0; r < 16; ++r) ps += p0[r];
#pragma unroll
  for (int r = 0; r < 16; ++r) ps += p1[r];
  { auto rr = __builtin_amdgcn_permlane32_swap(__float_as_uint(ps), __float_as_uint(ps), false, false);
    ps = __uint_as_float(rr[0]) + __uint_as_float(rr[1]); }
  l_reg = l_reg * alpha + ps;
#define PK4(P, BASE, OUT) do { unsigned a0 = cvtpk(P[BASE + 0], P[BASE + 1]), a1 = cvtpk(P[BASE + 2], P[BASE + 3]);   \
    unsigned b0 = cvtpk(P[BASE + 4], P[BASE + 5]), b1 = cvtpk(P[BASE + 6], P[BASE + 7]);                              \
    auto r0 = __builtin_amdgcn_permlane32_swap(a0, b0, false, false); auto r1 = __builtin_amdgcn_permlane32_swap(a1, b1, false, false); \
    u32x4 w = {r0[0], r1[0], r0[1], r1[1]}; OUT = *reinterpret_cast<bf16x8*>(&w); } while (0)
  PK4(p0, 0, pa0); PK4(p0, 8, pa1); PK4(p1, 0, pa2); PK4(p1, 8, pa3);
#undef PK4
}
#define SBVS() __builtin_amdgcn_sched_barrier(0x6)
template <int DQ> __device__ __forceinline__ void qkt(f32x16& p0, f32x16& p1, const char* Ks, const bf16x8* qr, const f32x16& negm, int r32, int hi) {
  constexpr int ND = DQ / 16;
  const char* k0p = Ks + r32 * 256; const char* k1p = Ks + (32 + r32) * 256; const int sw = (r32 & 15) << 4;
  bf16x8 a0, a1, b0, b1;
#define KLD(x0, x1, d0) do { const int cb_ = (((d0) * 16 + hi * 8) * 2) ^ sw; x0 = *reinterpret_cast<const bf16x8*>(k0p + cb_); x1 = *reinterpret_cast<const bf16x8*>(k1p + cb_); } while (0)
  KLD(a0, a1, 0); KLD(b0, b1, 1); SBVS();
  p0 = __builtin_amdgcn_mfma_f32_32x32x16_bf16(a0, qr[0], negm, 0, 0, 0); p1 = __builtin_amdgcn_mfma_f32_32x32x16_bf16(a1, qr[0], negm, 0, 0, 0); SBVS();
#pragma unroll
  for (int d0 = 1; d0 < ND; ++d0) {
    if (d0 & 1) { if (d0 + 1 < ND) { KLD(a0, a1, d0 + 1); SBVS(); }
      p0 = __builtin_amdgcn_mfma_f32_32x32x16_bf16(b0, qr[d0], p0, 0, 0, 0); p1 = __builtin_amdgcn_mfma_f32_32x32x16_bf16(b1, qr[d0], p1, 0, 0, 0); SBVS(); }
    else { if (d0 + 1 < ND) { KLD(b0, b1, d0 + 1); SBVS(); }
      p0 = __builtin_amdgcn_mfma_f32_32x32x16_bf16(a0, qr[d0], p0, 0, 0, 0); p1 = __builtin_amdgcn_mfma_f32_32x32x16_bf16(a1, qr[d0], p1, 0, 0, 0); SBVS(); }
  }
#undef KLD
}
__device__ __forceinline__ int v_st(int k, int c) { const int kk = (k & ~0xC) | ((k & 4) << 1) | ((k & 8) >> 1); return ((kk >> 3) * 4 + (c >> 5)) * 512 + ((kk & 7) * 32 + (c & 31)) * 2; }
__device__ __forceinline__ int v_rd_base(int lane) { return ((lane & 3) << 3) | (((lane >> 2) & 3) << 6) | (((lane >> 4) & 1) << 5) | (((lane >> 5) & 1) << 8); }
constexpr int v_rd_off(int d0, int ks, int half) { return d0 * 512 + ks * 4096 + half * 2048; }
template <int OFF> __device__ __forceinline__ s16x4 tr_read(int vb) {
  s16x4 r; asm volatile("ds_read_b64_tr_b16 %0, %1 offset:%2" : "=&v"(r) : "v"(vb), "i"(OFF) : "memory"); return r;
}
template <int D0> __device__ __forceinline__ void pv_one(f32x16& od, int vb, bf16x8 pa0, bf16x8 pa1, bf16x8 pa2, bf16x8 pa3) {
  const s16x4 l0 = tr_read<v_rd_off(D0, 0, 0)>(vb), h0 = tr_read<v_rd_off(D0, 0, 1)>(vb), l1 = tr_read<v_rd_off(D0, 1, 0)>(vb), h1 = tr_read<v_rd_off(D0, 1, 1)>(vb);
  const s16x4 l2 = tr_read<v_rd_off(D0, 2, 0)>(vb), h2 = tr_read<v_rd_off(D0, 2, 1)>(vb), l3 = tr_read<v_rd_off(D0, 3, 0)>(vb), h3 = tr_read<v_rd_off(D0, 3, 1)>(vb);
  asm volatile("s_waitcnt lgkmcnt(0)" ::: "memory"); SBAR();
#define PK(L, H) (bf16x8){L[0], L[1], L[2], L[3], H[0], H[1], H[2], H[3]}
  od = __builtin_amdgcn_mfma_f32_32x32x16_bf16(pa0, PK(l0, h0), od, 0, 0, 0);
  od = __builtin_amdgcn_mfma_f32_32x32x16_bf16(pa1, PK(l1, h1), od, 0, 0, 0);
  od = __builtin_amdgcn_mfma_f32_32x32x16_bf16(pa2, PK(l2, h2), od, 0, 0, 0);
  od = __builtin_amdgcn_mfma_f32_32x32x16_bf16(pa3, PK(l3, h3), od, 0, 0, 0);
#undef PK
}
__device__ __forceinline__ void pv_d0(f32x16* o, int vb, bf16x8 pa0, bf16x8 pa1, bf16x8 pa2, bf16x8 pa3) {
  pv_one<0>(o[0], vb, pa0, pa1, pa2, pa3); pv_one<1>(o[1], vb, pa0, pa1, pa2, pa3);
}
struct VFrag { s16x4 l[2][4], h[2][4]; };
__device__ __forceinline__ void v_load(VFrag& f, int vb) {
  f.l[0][0] = tr_read<v_rd_off(0, 0, 0)>(vb); f.h[0][0] = tr_read<v_rd_off(0, 0, 1)>(vb); f.l[0][1] = tr_read<v_rd_off(0, 1, 0)>(vb); f.h[0][1] = tr_read<v_rd_off(0, 1, 1)>(vb);
  f.l[0][2] = tr_read<v_rd_off(0, 2, 0)>(vb); f.h[0][2] = tr_read<v_rd_off(0, 2, 1)>(vb); f.l[0][3] = tr_read<v_rd_off(0, 3, 0)>(vb); f.h[0][3] = tr_read<v_rd_off(0, 3, 1)>(vb);
  f.l[1][0] = tr_read<v_rd_off(1, 0, 0)>(vb); f.h[1][0] = tr_read<v_rd_off(1, 0, 1)>(vb); f.l[1][1] = tr_read<v_rd_off(1, 1, 0)>(vb); f.h[1][1] = tr_read<v_rd_off(1, 1, 1)>(vb);
  f.l[1][2] = tr_read<v_rd_off(1, 2, 0)>(vb); f.h[1][2] = tr_read<v_rd_off(1, 2, 1)>(vb); f.l[1][3] = tr_read<v_rd_off(1, 3, 0)>(vb); f.h[1][3] = tr_read<v_rd_off(1, 3, 1)>(vb);
}
__device__ __forceinline__ void pv_mma(f32x16* o, const VFrag& f, bf16x8 pa0, bf16x8 pa1, bf16x8 pa2, bf16x8 pa3) {
#define PK(L, H) (bf16x8){L[0], L[1], L[2], L[3], H[0], H[1], H[2], H[3]}
  asm volatile("s_waitcnt lgkmcnt(0)" ::: "memory"); SBAR();
  o[0] = __builtin_amdgcn_mfma_f32_32x32x16_bf16(pa0, PK(f.l[0][0], f.h[0][0]), o[0], 0, 0, 0);
  o[0] = __builtin_amdgcn_mfma_f32_32x32x16_bf16(pa1, PK(f.l[0][1], f.h[0][1]), o[0], 0, 0, 0);
  o[0] = __builtin_amdgcn_mfma_f32_32x32x16_bf16(pa2, PK(f.l[0][2], f.h[0][2]), o[0], 0, 0, 0);
  o[0] = __builtin_amdgcn_mfma_f32_32x32x16_bf16(pa3, PK(f.l[0][3], f.h[0][3]), o[0], 0, 0, 0);
  o[1] = __builtin_amdgcn_mfma_f32_32x32x16_bf16(pa0, PK(f.l[1][0], f.h[1][0]), o[1], 0, 0, 0);
  o[1] = __builtin_amdgcn_mfma_f32_32x32x16_bf16(pa1, PK(f.l[1][1], f.h[1][1]), o[1], 0, 0, 0);
  o[1] = __builtin_amdgcn_mfma_f32_32x32x16_bf16(pa2, PK(f.l[1][2], f.h[1][2]), o[1], 0, 0, 0);
  o[1] = __builtin_amdgcn_mfma_f32_32x32x16_bf16(pa3, PK(f.l[1][3], f.h[1][3]), o[1], 0, 0, 0);
#undef PK
}

template <int DQ>
__device__ __forceinline__ void attn_unit(const bf16_t* __restrict__ Qb, const bf16_t* __restrict__ Kh, const bf16_t* __restrict__ Kpe, const bf16_t* __restrict__ Vh,
                                          bf16_t* __restrict__ Ob, int seq, char* lds, const int wave_in) {
  constexpr int LDQ = (DQ == 96) ? 576 : 384, LDK = (DQ == 96) ? 384 : 128, LDO = 1024, ND = DQ / 16;
  const int tid = wave_in * 64 + pg8::lane_id_asm(), wid = wave_in, lane = tid & 63, r32 = lane & 31, hi = lane >> 5;
  char* V_lds = lds; char* K_lds = lds + 2 * SHM_V;
  float* ws = (float*)(lds + 2 * SHM_V + 2 * SHM_K) + wid * 64; float* li_l = ws; float* al_l = ws + 32;
  float m_reg = 0.f, l_reg = 0; f32x16 o[2] = {}; f32x16 negm = {}; bf16x8 qr[ND];
  const bf16_t* Qw = Qb + (unsigned)((wid * QBLK + r32) * LDQ + hi * 8);
#pragma unroll
  for (int d0 = 0; d0 < ND; ++d0) qr[d0] = *reinterpret_cast<const bf16x8*>(Qw + d0 * 16);
  const int sr = tid >> 3, sc = (tid & 7) * 8;
  const int pr = (tid >> 2) & 63, pc = (tid & 3) * 8;
  const int vst = v_st(sr, sc), kst = KSWZ(sr, sc * 2), pst = KSWZ(pr, (64 + pc) * 2);
  const int vb0 = (int)(uintptr_t)V_lds + v_rd_base(lane);
  struct { bf16x8 vs, ks, ps; } sr_[2];
  const unsigned voff = (unsigned)(sr * LDK + sc), poff = (unsigned)(pr * 32 + pc);
#define SLOAD(i, k0) do { const bf16_t* Vt_ = Vh + (size_t)(k0) * LDK; const bf16_t* Kt_ = Kh + (size_t)(k0) * LDK; \
    sr_[i].vs = *reinterpret_cast<const bf16x8*>(Vt_ + voff); sr_[i].ks = *reinterpret_cast<const bf16x8*>(Kt_ + voff); \
    if constexpr (DQ == 96) { const bf16_t* Pt_ = Kpe + (size_t)(k0) * 32; sr_[i].ps = *reinterpret_cast<const bf16x8*>(Pt_ + poff); } } while (0)
#define SWRITE(b, i) do { *(bf16x8*)(V_lds + (b) * SHM_V + vst) = sr_[i].vs; *(bf16x8*)(K_lds + (b) * SHM_K + kst) = sr_[i].ks; \
    if constexpr (DQ == 96) { if (tid < 256) *(bf16x8*)(K_lds + (b) * SHM_K + pst) = sr_[i].ps; } } while (0)
#define SWAIT() do { if constexpr (DQ == 96) asm volatile("s_waitcnt vmcnt(3)" ::: "memory"); else asm volatile("s_waitcnt vmcnt(2)" ::: "memory"); } while (0)
#define RESC(a) do { if (__any((a) < 1.f)) { if (hi == 0) al_l[r32] = (a); asm volatile("s_waitcnt lgkmcnt(0)" ::: "memory"); \
    _Pragma("unroll") for (int d = 0; d < 2; ++d) _Pragma("unroll") for (int r = 0; r < 16; ++r) o[d][r] *= al_l[crow(r, hi)]; } } while (0)
  f32x16 pA0, pA1, pB0, pB1; float alA, alB; bf16x8 pa0, pa1, pa2, pa3; const int NT = seq / KVBLK;
  constexpr int SE = 0, SO = 1;
  SLOAD(SE, 0); asm volatile("s_waitcnt vmcnt(0)" ::: "memory"); SWRITE(0, SE); __syncthreads();
  qkt<DQ>(pA0, pA1, K_lds, qr, negm, r32, hi); partialSM<true>(pA0, pA1, m_reg, negm, alA);
  SLOAD(SO, KVBLK); if (2 < NT) SLOAD(SE, 2 * KVBLK);
  SWAIT(); SWRITE(1, SO); __syncthreads();
  for (int j = 1; j + 1 < NT; j += 2) {
    SBAR(); qkt<DQ>(pB0, pB1, K_lds + SHM_K, qr, negm, r32, hi);
    finishSM(pA0, pA1, alA, l_reg, pa0, pa1, pa2, pa3); SBAR();
    SLOAD(SO, (j + 2) * KVBLK); SBAR();
    pv_d0(o, vb0, pa0, pa1, pa2, pa3); partialSM<false>(pB0, pB1, m_reg, negm, alB);
    __syncthreads(); SWAIT(); SWRITE(0, SE);
    RESC(alB); __syncthreads();
    SBAR(); qkt<DQ>(pA0, pA1, K_lds, qr, negm, r32, hi);
    finishSM(pB0, pB1, alB, l_reg, pa0, pa1, pa2, pa3); SBAR();
    if (j + 3 < NT) SLOAD(SE, (j + 3) * KVBLK); SBAR();
    pv_d0(o, vb0 + SHM_V, pa0, pa1, pa2, pa3); partialSM<false>(pA0, pA1, m_reg, negm, alA);
    __syncthreads(); SWAIT(); SWRITE(1, SO);
    RESC(alA); __syncthreads();
  }
  SBAR(); qkt<DQ>(pB0, pB1, K_lds + SHM_K, qr, negm, r32, hi);
  finishSM(pA0, pA1, alA, l_reg, pa0, pa1, pa2, pa3); SBAR();
  pv_d0(o, vb0, pa0, pa1, pa2, pa3); partialSM<false>(pB0, pB1, m_reg, negm, alB);
  __syncthreads(); RESC(alB);
  finishSM(pB0, pB1, alB, l_reg, pa0, pa1, pa2, pa3); SBAR();
  pv_d0(o, vb0 + SHM_V, pa0, pa1, pa2, pa3);
  if (hi == 0) li_l[r32] = l_reg; asm volatile("s_waitcnt lgkmcnt(0)" ::: "memory");
  float rli[16];
#pragma unroll
  for (int r = 0; r < 16; ++r) rli[r] = __builtin_amdgcn_rcpf(li_l[crow(r, hi)]);
  bf16_t* Ow = Ob + (long)(wid * QBLK) * LDO;
#pragma unroll
  for (int r = 0; r < 16; ++r) { int orow = crow(r, hi);
#pragma unroll
    for (int d0 = 0; d0 < 2; ++d0) { const float v = o[d0][r] * rli[r]; Ow[(long)orow * LDO + d0 * 32 + r32] = (bf16_t)(cvtpk(v, v) & 0xffffu); } }
  __syncthreads();
#undef SLOAD
#undef SWRITE
#undef SWAIT
#undef RESC
}
#undef SBAR
}

namespace d64 {
using bf16=__hip_bfloat16;
using bf16x8=__attribute__((ext_vector_type(8)))short;
using s16x4=__attribute__((ext_vector_type(4)))short;
using f32x16=__attribute__((ext_vector_type(16)))float;
using u32x4=__attribute__((ext_vector_type(4)))unsigned;
constexpr int D=64,LDQ=384,LDK=128,LDO=1024;
constexpr int NW=8,QBLK=32,QB=QBLK*NW,KVBLK=64;
__device__ __forceinline__ int crow(int r,int hi){return (r&3)+8*(r>>2)+4*hi;}
#define SBAR() __builtin_amdgcn_sched_barrier(0)
constexpr int NSLOT=3, SLOTB=8192;
constexpr int LDS_K=0, LDS_V=NSLOT*SLOTB, LDS_WS=2*NSLOT*SLOTB, LDS_OST=LDS_WS+NW*64*4, LDS_BYTES=LDS_OST+NW*4096;
constexpr float C2=0.125f*1.4426950408889634f;
__device__ __forceinline__ void glds16(const void*gsrc,unsigned lds_dst){unsigned keep;
  asm volatile("s_mov_b32 %0, m0\n\ts_mov_b32 m0, %2\n\ts_nop 0\n\tglobal_load_lds_dwordx4 %1, off\n\ts_mov_b32 m0, %0":"=&s"(keep):"v"(gsrc),"s"(lds_dst):"memory");}
__device__ __forceinline__ float max3f(float a,float b,float c){float r;asm("v_max3_f32 %0, %1, %2, %3":"=v"(r):"v"(a),"v"(b),"v"(c));return r;}
__device__ __forceinline__ float max2f(float a,float b){float r;asm("v_max_f32_e32 %0, %1, %2":"=v"(r):"v"(a),"v"(b));return r;}
__device__ __forceinline__ float fadd_s(float a,float b){float r;asm("v_add_f32_e32 %0, %1, %2":"=v"(r):"v"(a),"v"(b));return r;}
__device__ __forceinline__ float fsub_s(float a,float b){float r;asm("v_sub_f32_e32 %0, %1, %2":"=v"(r):"v"(a),"v"(b));return r;}
typedef float f32x2_t __attribute__((ext_vector_type(2))); typedef __bf16 bf16x2_t __attribute__((ext_vector_type(2)));
__device__ __forceinline__ unsigned cvtpk_s(float lo,float hi){f32x2_t v={lo,hi};bf16x2_t b=__builtin_convertvector(v,bf16x2_t);return __builtin_bit_cast(unsigned,b);}
#define WAIT_BAR(N) asm volatile("s_waitcnt vmcnt(" #N ") lgkmcnt(0)\n\ts_barrier":::"memory")

__device__ __forceinline__ void qkt(f32x16&p0,f32x16&p1,const char*Kslot,const bf16x8*qr,const f32x16&negm,int r32,int hi){
  const char*kb=Kslot+hi*1024+r32*16;
  #pragma unroll
  for(int d0=0;d0<4;++d0){
    const bf16x8 b0=*reinterpret_cast<const bf16x8*>(kb+d0*2048);
    const bf16x8 b1=*reinterpret_cast<const bf16x8*>(kb+d0*2048+512);
    if(d0==0){p0=__builtin_amdgcn_mfma_f32_32x32x16_bf16(b0,qr[0],negm,0,0,0);p1=__builtin_amdgcn_mfma_f32_32x32x16_bf16(b1,qr[0],negm,0,0,0);}
    else{p0=__builtin_amdgcn_mfma_f32_32x32x16_bf16(b0,qr[d0],p0,0,0,0);p1=__builtin_amdgcn_mfma_f32_32x32x16_bf16(b1,qr[d0],p1,0,0,0);}}
}
typedef __attribute__((address_space(3))) const char* lds_cptr;
typedef short v4i16_t __attribute__((ext_vector_type(4)));
__device__ __forceinline__ void kload8(bf16x8*kf,lds_cptr kp){
  kf[0]=*(const __attribute__((address_space(3))) bf16x8*)(kp);      kf[1]=*(const __attribute__((address_space(3))) bf16x8*)(kp+512);
  kf[2]=*(const __attribute__((address_space(3))) bf16x8*)(kp+2048); kf[3]=*(const __attribute__((address_space(3))) bf16x8*)(kp+2560);
  kf[4]=*(const __attribute__((address_space(3))) bf16x8*)(kp+4096); kf[5]=*(const __attribute__((address_space(3))) bf16x8*)(kp+4608);
  kf[6]=*(const __attribute__((address_space(3))) bf16x8*)(kp+6144); kf[7]=*(const __attribute__((address_space(3))) bf16x8*)(kp+6656);
}
__device__ __forceinline__ void kload2(bf16x8*kf,lds_cptr kp,int j){ kf[2*j]=*(const __attribute__((address_space(3))) bf16x8*)(kp+j*2048); kf[2*j+1]=*(const __attribute__((address_space(3))) bf16x8*)(kp+j*2048+512); }
__device__ __forceinline__ s16x4 vtr(lds_cptr p){ return __builtin_bit_cast(s16x4,__builtin_amdgcn_ds_read_tr16_b64_v4i16((__attribute__((address_space(3))) v4i16_t*)p)); }
__device__ __forceinline__ float rowmax(const f32x16&p0,const f32x16&p1){
  float a=max3f(p0[0],p0[1],p1[0]),b=max3f(p0[2],p0[3],p1[1]);a=max3f(a,p1[2],p1[3]);
  #pragma unroll
  for(int r=4;r<16;r+=4){a=max3f(a,p0[r],p0[r+1]);b=max3f(b,p0[r+2],p0[r+3]);a=max3f(a,p1[r],p1[r+1]);b=max3f(b,p1[r+2],p1[r+3]);}
  const float m=max2f(a,b);
  auto rr=__builtin_amdgcn_permlane32_swap(__float_as_uint(m),__float_as_uint(m),false,false);
  return max2f(__uint_as_float(rr[0]),__uint_as_float(rr[1]));
}
__device__ __forceinline__ void pv(f32x16*o,int vb,bf16x8 pa0,bf16x8 pa1,bf16x8 pa2,bf16x8 pa3){
  #pragma unroll
  for(int d0=0;d0<2;++d0){s16x4 lo[4],hi[4];
    #pragma unroll
    for(int ks=0;ks<4;++ks){
      asm volatile("ds_read_b64_tr_b16 %0,%1 offset:%c2":"=&v"(lo[ks]):"v"(vb),"i"(d0*4096+ks*1024):"memory");
      asm volatile("ds_read_b64_tr_b16 %0,%1 offset:%c2":"=&v"(hi[ks]):"v"(vb),"i"(d0*4096+ks*1024+512):"memory");}
    asm volatile("s_waitcnt lgkmcnt(0)":::"memory");SBAR();
    #define PK(k) (bf16x8){lo[k][0],lo[k][1],lo[k][2],lo[k][3],hi[k][0],hi[k][1],hi[k][2],hi[k][3]}
    o[d0]=__builtin_amdgcn_mfma_f32_32x32x16_bf16(pa0,PK(0),o[d0],0,0,0);
    o[d0]=__builtin_amdgcn_mfma_f32_32x32x16_bf16(pa1,PK(1),o[d0],0,0,0);
    o[d0]=__builtin_amdgcn_mfma_f32_32x32x16_bf16(pa2,PK(2),o[d0],0,0,0);
    o[d0]=__builtin_amdgcn_mfma_f32_32x32x16_bf16(pa3,PK(3),o[d0],0,0,0);
    #undef PK
  }
}

#ifndef ATTN_STORE16
#define ATTN_STORE16(p,v) (*(u32x4*)(p)=(v))
#endif
template<int THRL,bool PE> __device__ __forceinline__ void attn_unit(const bf16*Qu,const bf16*__restrict__ Kh,const bf16*__restrict__ Kpe,const bf16*__restrict__ Vh,bf16*Ou,const int NT,char*shm,const int wave_in){
  constexpr int LDQ_=PE?576:384, LDK_=PE?384:128, NDQ=PE?6:4, LDS_KPE=LDS_BYTES;
  const int lane=pg8::lane_id_asm(),tid=wave_in*64+lane,r32=lane&31,hi=lane>>5; const int wid=wave_in; (void)tid;
  const bf16*Qw=Qu+(long)(wid*QBLK)*LDQ_;
  const unsigned lds0=(unsigned)(uintptr_t)shm;
  float*wsf=(float*)(shm+LDS_WS)+wid*64;
  const bf16*ksrc=Kh+(long)lane*LDK_+wid*8; const bf16*psrc=PE?Kpe+(long)lane*32+(wid&3)*8:nullptr;
  const bf16*vsrc=Vh+(long)(16*(wid&3)+(lane>>2))*LDK_+(wid>>2)*32+(lane&3)*8;
  const unsigned kdst=lds0+LDS_K+wid*1024, vdst=lds0+LDS_V+wid*1024, pdst=lds0+LDS_KPE+(wid&3)*1024;
  #define DMA_K(t,slot) do{ glds16(ksrc+(long)(t)*KVBLK*LDK_,(unsigned)__builtin_amdgcn_readfirstlane(kdst+(slot))); \
    if constexpr(PE) glds16(psrc+(long)(t)*KVBLK*32,(unsigned)__builtin_amdgcn_readfirstlane(pdst+((slot)>>1))); }while(0)
  #define DMA_V(t,slot) glds16(vsrc+(long)(t)*KVBLK*LDK_,(unsigned)__builtin_amdgcn_readfirstlane(vdst+(slot)))
  const int vb0=(int)(lds0+LDS_V)+((lane>>4)&1)*32+(lane&3)*8+(4*hi+((lane&15)>>2))*64;
  const char*Kbase=shm+LDS_K; bf16x8 kf[8]; bf16x8 kpf[4];
  const lds_cptr shm3=(lds_cptr)shm; const lds_cptr kp0=shm3+LDS_K+hi*1024+r32*16; const lds_cptr pp0=shm3+LDS_KPE+hi*1024+r32*16; const lds_cptr vp0=shm3+LDS_V+((lane>>4)&1)*32+(lane&3)*8+(4*hi+((lane&15)>>2))*64;
  DMA_K(0,0);DMA_V(0,0);DMA_K(1,SLOTB);
  bf16x8 qr[NDQ];
  #pragma unroll
  for(int d0=0;d0<NDQ;++d0)qr[d0]=*reinterpret_cast<const bf16x8*>(&Qw[(long)r32*LDQ_+d0*16+hi*8]);
  float mhat=0.f,l_reg=0.f;f32x16 o[2];o[0]=f32x16{};o[1]=f32x16{};f32x16 negm=f32x16{};asm volatile("":"+v"(negm));
  #define CMASK(P0,P1,t) do{}while(0)
  bool resc=false;
  #define START(P0,P1) do{ const float rm=rowmax(P0,P1); resc=false; \
    { const float dl=rm; mhat=fadd_s(mhat,dl); \
      _Pragma("unroll") for(int r=0;r<16;++r){P0[r]=fsub_s(P0[r],dl);P1[r]=fsub_s(P1[r],dl);} \
      _Pragma("unroll") for(int r=0;r<16;++r)negm[r]=-mhat; asm volatile("":"+v"(negm)); } \
    _Pragma("unroll") for(int r=0;r<16;++r)P0[r]=__builtin_amdgcn_exp2f(P0[r]); }while(0)
  #define RESC() do{ if(resc){ asm volatile("s_waitcnt lgkmcnt(0)":::"memory"); \
      _Pragma("unroll") for(int d_=0;d_<2;++d_) _Pragma("unroll") for(int r=0;r<16;++r)o[d_][r]*=wsf[crow(r,hi)]; } }while(0)
  f32x16 pA0,pA1,pB0,pB1;
  int sl_prev=0,sl_cur=0,sl_next=SLOTB;
  #define ROT() do{sl_prev=sl_cur;sl_cur=sl_next;sl_next=(sl_next==(NSLOT-1)*SLOTB)?0:sl_next+SLOTB;}while(0)
  DMA_K(2,2*SLOTB);
  if constexpr(PE){WAIT_BAR(5);}else{WAIT_BAR(3);}
  qkt(pA0,pA1,Kbase,qr,negm,r32,hi);
  if constexpr(PE){ const char*pb=shm+LDS_KPE+hi*1024+r32*16;
    _Pragma("unroll") for(int j=0;j<2;++j){ const bf16x8 b0=*reinterpret_cast<const bf16x8*>(pb+j*2048), b1=*reinterpret_cast<const bf16x8*>(pb+j*2048+512);
      pA0=__builtin_amdgcn_mfma_f32_32x32x16_bf16(b0,qr[4+j],pA0,0,0,0); pA1=__builtin_amdgcn_mfma_f32_32x32x16_bf16(b1,qr[4+j],pA1,0,0,0);} }
  asm volatile("s_nop 15\n\ts_nop 7":"+v"(pA0),"+v"(pA1));CMASK(pA0,pA1,0);
  START(pA0,pA1);
  _Pragma("unroll") for(int r=0;r<16;++r)pA1[r]=__builtin_amdgcn_exp2f(pA1[r]);
  WAIT_BAR(0);
  DMA_K(3,0);DMA_V(1,SLOTB);
  ROT();
  kload8(kf,kp0+sl_cur); if constexpr(PE){ kload2(kpf,pp0+(sl_cur>>1),0); kload2(kpf,pp0+(sl_cur>>1),1); }
  if constexpr(PE){WAIT_BAR(3);}else{WAIT_BAR(2);}
  s16x4 vlo[8],vhi[8]; u32x4 pw0,pw1,pw2,pw3;
  #define PKW(P,B) cvtpk_s(P[B],P[B+1])
  #define PAF(k) __builtin_bit_cast(bf16x8,pw##k)
  #define VFR(i) (bf16x8){vlo[i][0],vlo[i][1],vlo[i][2],vlo[i][3],vhi[i][0],vhi[i][1],vhi[i][2],vhi[i][3]}
  #define PIN(x) asm volatile("":"+v"(x))
  #define MX3(a,b,c) __builtin_fmaxf(__builtin_fmaxf((a),(b)),(c))
  #define GAPA(MF,A0,A1,A2,A3,W0,W1,PW) do{ MF; sacc+=A0; sacc+=A1; sacc+=A2; sacc+=A3; PIN(sacc); W0; W1; PIN(PW); SBAR(); }while(0)
  #define EX(v) __builtin_amdgcn_exp2f(v)
  #define GAPB(MF,X,B) do{ MF; X[B]=EX(X[B]); X[B+1]=EX(X[B+1]); X[B+2]=EX(X[B+2]); X[B+3]=EX(X[B+3]); PIN(X); SBAR(); }while(0)
  #define VRD(i) do{ vlo[i]=vtr(vp_+(((i)>>2)*4096+((i)&3)*1024)); vhi[i]=vtr(vp_+(((i)>>2)*4096+((i)&3)*1024+512)); }while(0)
  #define KRD(G,j) do{ if(G){ kload2(kf,kp0+sl_next,j); if constexpr(PE){ if((j)<2) kload2(kpf,pp0+(sl_next>>1),j); } SBAR(); } }while(0)
  #define STEP(C0,C1,P0,P1,t,GK,GV,GL) do{ SBAR(); \
    const lds_cptr vp_=vp0+sl_prev; \
    VRD(0); SBAR(); float sacc=(P0[0]+P0[1]); \
    GAPA(C0=__builtin_amdgcn_mfma_f32_32x32x16_bf16(kf[0],qr[0],negm,0,0,0), P0[2],P0[3],P0[4],P0[5],     pw0[0]=PKW(P0,0), pw0[1]=PKW(P0,2), pw0); \
    VRD(4); SBAR(); GAPA(C1=__builtin_amdgcn_mfma_f32_32x32x16_bf16(kf[1],qr[0],negm,0,0,0), P0[6],P0[7],P0[8],P0[9],     pw0[2]=PKW(P0,4), pw0[3]=PKW(P0,6), pw0); \
    VRD(1); SBAR(); GAPA(C0=__builtin_amdgcn_mfma_f32_32x32x16_bf16(kf[2],qr[1],C0,0,0,0),   P0[10],P0[11],P0[12],P0[13], pw1[0]=PKW(P0,8), pw1[1]=PKW(P0,10), pw1); \
    VRD(5); SBAR(); GAPA(C1=__builtin_amdgcn_mfma_f32_32x32x16_bf16(kf[3],qr[1],C1,0,0,0),   P0[14],P0[15],P1[0],P1[1],   pw1[2]=PKW(P0,12),pw1[3]=PKW(P0,14), pw1); \
    VRD(2); SBAR(); GAPA(C0=__builtin_amdgcn_mfma_f32_32x32x16_bf16(kf[4],qr[2],C0,0,0,0),   P1[2],P1[3],P1[4],P1[5],     pw2[0]=PKW(P1,0), pw2[1]=PKW(P1,2), pw2); \
    VRD(6); SBAR(); GAPA(C1=__builtin_amdgcn_mfma_f32_32x32x16_bf16(kf[5],qr[2],C1,0,0,0),   P1[6],P1[7],P1[8],P1[9],     pw2[2]=PKW(P1,4), pw2[3]=PKW(P1,6), pw2); \
    VRD(3); SBAR(); GAPA(C0=__builtin_amdgcn_mfma_f32_32x32x16_bf16(kf[6],qr[3],C0,0,0,0),   P1[10],P1[11],P1[12],P1[13], pw3[0]=PKW(P1,8), pw3[1]=PKW(P1,10), pw3); \
    VRD(7); SBAR(); GAPA(C1=__builtin_amdgcn_mfma_f32_32x32x16_bf16(kf[7],qr[3],C1,0,0,0),   P1[14],P1[15],0.f,0.f,       pw3[2]=PKW(P1,12),pw3[3]=PKW(P1,14), pw3); \
    if constexpr(PE){ C0=__builtin_amdgcn_mfma_f32_32x32x16_bf16(kpf[0],qr[4],C0,0,0,0); C1=__builtin_amdgcn_mfma_f32_32x32x16_bf16(kpf[1],qr[4],C1,0,0,0); \
      C0=__builtin_amdgcn_mfma_f32_32x32x16_bf16(kpf[2],qr[5],C0,0,0,0); C1=__builtin_amdgcn_mfma_f32_32x32x16_bf16(kpf[3],qr[5],C1,0,0,0); } \
    l_reg+=sacc; \
    if(GK){DMA_K((t)+3,sl_cur);} if(GV){DMA_V((t)+1,sl_next);} \
    CMASK(C0,C1,t); \
    { float a=MX3(C0[0],C0[1],C1[0]),b=MX3(C0[2],C0[3],C1[1]); a=MX3(a,C1[2],C1[3]); \
      _Pragma("unroll") for(int r=4;r<16;r+=4){a=MX3(a,C0[r],C0[r+1]);b=MX3(b,C0[r+2],C0[r+3]);a=MX3(a,C1[r],C1[r+1]);b=MX3(b,C1[r+2],C1[r+3]);} \
      float rm=__builtin_fmaxf(a,b); { auto rr=__builtin_amdgcn_permlane32_swap(__float_as_uint(rm),__float_as_uint(rm),false,false); rm=__builtin_fmaxf(__uint_as_float(rr[0]),__uint_as_float(rr[1])); } \
      resc=false; \
      if(__builtin_expect(__any(rm>(float)THRL),0)){ const float dl=__builtin_fmaxf(rm,0.f); mhat+=dl; \
        _Pragma("unroll") for(int r=0;r<16;++r){C0[r]-=dl;C1[r]-=dl;} \
        _Pragma("unroll") for(int r=0;r<16;++r)negm[r]=-mhat; asm volatile("":"+v"(negm)); \
        const float f=__builtin_amdgcn_exp2f(-dl); l_reg*=f; if(hi==0)wsf[r32]=f; resc=true; } } \
    SBAR(); \
    GAPB(o[0]=__builtin_amdgcn_mfma_f32_32x32x16_bf16(PAF(0),VFR(0),o[0],0,0,0), C0,0); \
    GAPB(o[1]=__builtin_amdgcn_mfma_f32_32x32x16_bf16(PAF(0),VFR(4),o[1],0,0,0), C0,4); \
    KRD(GL,0); GAPB(o[0]=__builtin_amdgcn_mfma_f32_32x32x16_bf16(PAF(1),VFR(1),o[0],0,0,0), C0,8); \
    KRD(GL,1); GAPB(o[1]=__builtin_amdgcn_mfma_f32_32x32x16_bf16(PAF(1),VFR(5),o[1],0,0,0), C0,12); \
    KRD(GL,2); GAPB(o[0]=__builtin_amdgcn_mfma_f32_32x32x16_bf16(PAF(2),VFR(2),o[0],0,0,0), C1,0); \
    KRD(GL,3); GAPB(o[1]=__builtin_amdgcn_mfma_f32_32x32x16_bf16(PAF(2),VFR(6),o[1],0,0,0), C1,4); \
    GAPB(o[0]=__builtin_amdgcn_mfma_f32_32x32x16_bf16(PAF(3),VFR(3),o[0],0,0,0), C1,8); \
    GAPB(o[1]=__builtin_amdgcn_mfma_f32_32x32x16_bf16(PAF(3),VFR(7),o[1],0,0,0), C1,12); \
    }while(0)
  int t=1;
  #undef CMASK
  #define CMASK(P0,P1,t) do{}while(0)
  for(;t+5<NT;t+=2){
    STEP(pB0,pB1,pA0,pA1,t,true,true,true);     if constexpr(PE){WAIT_BAR(3);}else{WAIT_BAR(2);} RESC(); ROT();
    STEP(pA0,pA1,pB0,pB1,t+1,true,true,true);   if constexpr(PE){WAIT_BAR(3);}else{WAIT_BAR(2);} RESC(); ROT();
  }
  #undef CMASK
  #define CMASK(P0,P1,t) do{}while(0)
  #define ENDW(tt) do{ if((tt)+3<NT){ if constexpr(PE){WAIT_BAR(3);}else{WAIT_BAR(2);} } else if((tt)+2<NT){WAIT_BAR(1);} else {WAIT_BAR(0);} }while(0)
  for(;t+1<NT;t+=2){
    STEP(pB0,pB1,pA0,pA1,t,(t+3<NT),(t+1<NT),(t+1<NT));       ENDW(t);   RESC(); ROT();
    STEP(pA0,pA1,pB0,pB1,t+1,(t+4<NT),(t+2<NT),(t+2<NT));     ENDW(t+1); RESC(); ROT();
  }
  STEP(pB0,pB1,pA0,pA1,NT-1,false,false,false); RESC();
  { float sacc=pB0[0]+pB0[1]; _Pragma("unroll") for(int r=2;r<16;++r)sacc+=pB0[r]; _Pragma("unroll") for(int r=0;r<16;++r)sacc+=pB1[r]; l_reg+=sacc;
    pw0=(u32x4){PKW(pB0,0),PKW(pB0,2),PKW(pB0,4),PKW(pB0,6)};pw1=(u32x4){PKW(pB0,8),PKW(pB0,10),PKW(pB0,12),PKW(pB0,14)};pw2=(u32x4){PKW(pB1,0),PKW(pB1,2),PKW(pB1,4),PKW(pB1,6)};pw3=(u32x4){PKW(pB1,8),PKW(pB1,10),PKW(pB1,12),PKW(pB1,14)};
    SBAR(); pv(o,vb0+sl_cur,PAF(0),PAF(1),PAF(2),PAF(3)); }
  #undef PKW
  #undef PAF
  #undef VFR
  #undef PIN
  #undef MX3
  #undef GAPA
  #undef GAPB
  #undef EX
  #undef VRD
  #undef KRD
  #undef STEP
  #undef ENDW
  {auto rr=__builtin_amdgcn_permlane32_swap(__float_as_uint(l_reg),__float_as_uint(l_reg),false,false);l_reg=__uint_as_float(rr[0])+__uint_as_float(rr[1]);}
  if(hi==0)wsf[32+r32]=l_reg;asm volatile("s_waitcnt lgkmcnt(0)":::"memory");
  float rli[16];
  #pragma unroll
  for(int r=0;r<16;++r)rli[r]=__builtin_amdgcn_rcpf(wsf[32+crow(r,hi)]);
  bf16*Ow=Ou+(long)(wid*QBLK)*LDO;
  { bf16*stg=(bf16*)(shm+LDS_OST)+wid*2048;
    #pragma unroll
    for(int r=0;r<16;++r){const int orow=crow(r,hi);
      #pragma unroll
      for(int d0=0;d0<2;++d0)stg[orow*64+d0*32+r32]=__float2bfloat16(o[d0][r]*rli[r]);}
    asm volatile("s_waitcnt lgkmcnt(0)":::"memory");
    #pragma unroll
    for(int i=0;i<4;++i){const int row=i*8+(lane>>3),ch=lane&7; const u32x4 v=*(const u32x4*)(stg+row*64+ch*8); ATTN_STORE16(Ow+(long)row*LDO+ch*8,v);} }
  asm volatile("s_waitcnt lgkmcnt(0)\n\ts_barrier":::"memory");
  #undef DMA_K
  #undef DMA_V
  #undef CMASK
  #undef START
  #undef RESC
  #undef ROT
}
#undef SBAR
#undef WAIT_BAR
}

typedef unsigned short bf16_t;
typedef float f32x4 __attribute__((ext_vector_type(4)));
typedef float f32x2 __attribute__((ext_vector_type(2)));
typedef unsigned u32x2 __attribute__((ext_vector_type(2)));
typedef unsigned u32x4 __attribute__((ext_vector_type(4)));
#define LAS __attribute__((address_space(3)))
typedef _Float16 h16x8 __attribute__((ext_vector_type(8)));
#define XB_TMO      128
#define XB_XCNT(j)  (256  + 64 * (j))
#define XB_XSUB(j)  (1280 + 64 * (j))
#define XB_XGEN(j)  (2304 + 64 * (j))
#define XB_TOP      3328
#define XB_TOPGEN   3392
#define XCD_BAR_WORDS 3456
#define XB_SPIN_CAP (1u << 18)

__device__ __forceinline__ unsigned xb_ld(unsigned* p)              { return __hip_atomic_load(p, __ATOMIC_RELAXED, __HIP_MEMORY_SCOPE_AGENT); }
__device__ __forceinline__ unsigned xb_add(unsigned* p, unsigned v) { return __hip_atomic_fetch_add(p, v, __ATOMIC_RELAXED, __HIP_MEMORY_SCOPE_AGENT); }
__device__ __forceinline__ unsigned xb_xcc_id() { return (unsigned)__builtin_amdgcn_s_getreg((3 << 11) | 20) & 0xFu; }
#define XB_SPIN(cond, bar) do { unsigned _sp = 0; while (cond) { __builtin_amdgcn_s_sleep(1); \
    if ((++_sp & 255u) == 0u) { if (xb_ld(&(bar)[XB_TMO])) break; if (_sp > XB_SPIN_CAP) { atomicAdd(&(bar)[XB_TMO], 1u); break; } } } } while (0)

struct XcdBarrier {
    unsigned* bar; unsigned x;
    volatile LAS unsigned* st;
};

__device__ __forceinline__ XcdBarrier xcd_barrier_post(unsigned* bar, volatile LAS unsigned* st, const bool t0) {
    XcdBarrier b; b.bar = bar; b.x = xb_xcc_id(); b.st = st;
    if (t0) (void)xb_add(&bar[XB_XCNT(b.x)], 1u);
    return b;
}
__device__ __forceinline__ void xcd_barrier_complete(unsigned* bar, unsigned x, unsigned& nloc, unsigned& nx) {
    const unsigned G = gridDim.x * gridDim.y * gridDim.z;
    unsigned sum, cnt, mine, sp = 0u;
    for (;;) {
        sum = 0u; cnt = 0u; mine = 0u;
#pragma unroll
        for (unsigned j = 0; j < 16; ++j) { const unsigned c = xb_ld(&bar[XB_XCNT(j)]); sum += c; cnt += (c > 0u) ? 1u : 0u; mine = (j == x) ? c : mine; }
        if (sum == G) break;
        __builtin_amdgcn_s_sleep(1);
        if ((++sp & 255u) == 0u) { if (xb_ld(&bar[XB_TMO])) break; if (sp > XB_SPIN_CAP) { atomicAdd(&bar[XB_TMO], 1u); break; } }
    }
    nloc = mine > 0u ? mine : 1u; nx = cnt > 0u ? cnt : 1u;
}

__device__ __forceinline__ void xcd_barrier(const XcdBarrier& b, const bool t0) {
    asm volatile("s_waitcnt vmcnt(0)" ::: "memory");
    __syncthreads();
    if (t0) {
        unsigned* bar = b.bar;
        __builtin_amdgcn_s_waitcnt(0);
        unsigned nloc = b.st[0], nx = b.st[1];
        if (nloc == 0u) { xcd_barrier_complete(bar, b.x, nloc, nx); b.st[0] = nloc; b.st[1] = nx; }
        const unsigned old = xb_add(&bar[XB_XSUB(b.x)], 1u);
        const unsigned gen = old / nloc;
        if (old + 1u == (gen + 1u) * nloc) {
            __builtin_amdgcn_fence(__ATOMIC_RELEASE, "agent");
            asm volatile("s_waitcnt vmcnt(0)" ::: "memory");
            const unsigned og = xb_add(&bar[XB_TOP], 1u);
            const unsigned tg = og / nx;
            if (og + 1u == (tg + 1u) * nx) xb_add(&bar[XB_TOPGEN], 1u);
            else XB_SPIN(xb_ld(&bar[XB_TOPGEN]) == tg, bar);
            __builtin_amdgcn_fence(__ATOMIC_ACQUIRE, "agent");
            xb_add(&bar[XB_XGEN(b.x)], 1u);
            asm volatile("s_waitcnt vmcnt(0)" ::: "memory");
        } else {
            XB_SPIN(xb_ld(&bar[XB_XGEN(b.x)]) == gen, bar);
            __builtin_amdgcn_fence(__ATOMIC_ACQUIRE, "agent");
            asm volatile("s_waitcnt vmcnt(0)" ::: "memory");
        }
    }
    __syncthreads();
}

constexpr size_t MiB = 1u << 20;
constexpr size_t WS_MOD = 1 * MiB, WS_ROPEM = 2 * MiB, WS_ROPEG = 3 * MiB, WS_Z = 5 * MiB;
constexpr size_t WS_WIN = 10 * MiB, WS_WUQ = 26 * MiB, WS_WUKV = 28 * MiB, WS_WO = 29 * MiB, WS_W1 = 37 * MiB, WS_W2 = 69 * MiB;
constexpr size_t WS_U = 101 * MiB, WS_Y = WS_U  , WS_PART = 167 * MiB  , WS_OV = 233 * MiB;
constexpr size_t WS_HM = WS_OV, WS_H = WS_OV, WS_MQ = WS_OV, WS_MK = 271 * MiB, WS_MV = 296 * MiB;
constexpr size_t WS_CKV = 365 * MiB, WS_CQ = 374 * MiB, WS_KPE = 391 * MiB, WS_GK = 394 * MiB, WS_GV = 403 * MiB, WS_GQ = 412 * MiB, WS_O = 437 * MiB, WS_END = 503 * MiB;
static_assert(WS_MQ + (size_t)MROWS * 576 * 2 <= WS_MK && WS_MK + (size_t)MROWS * 384 * 2 <= WS_MV && WS_MV + (size_t)MROWS * 384 * 2 <= WS_H + (size_t)MROWS * HP * 2, "overlay");
static_assert(WS_H + (size_t)MROWS * HP * 2 <= WS_CKV && WS_CKV + (size_t)MROWS * 256 <= WS_CQ && WS_CQ + (size_t)MROWS * 512 <= WS_KPE && WS_KPE + (size_t)MROWS * 64 <= WS_GK, "map1");
static_assert(WS_GK + (size_t)MROWS * 256 <= WS_GV && WS_GV + (size_t)MROWS * 256 <= WS_GQ && WS_GQ + (size_t)MROWS * 768 <= WS_O && WS_O + (size_t)MROWS * 2048 <= WS_END, "map2");
static_assert(WS_HM + (size_t)MROWS * DFF * 2 <= WS_END, "map3");
#ifndef ATT_REPS
#define ATT_REPS 1
#endif
#ifndef TDIV
#define TDIV 1
#endif
#ifndef TSEL
#define TSEL -1
#endif
constexpr float QSC64 = 0.125f * 1.4426950408889634f, QSC96 = 0.10206207261596575f * 1.4426950408889634f;
constexpr int LDS_BYTES = 135168;

struct Params { const float* in[21]; float* out; unsigned char* ws; };
enum { I_X = 0, I_C, I_CTX, I_CCTX, I_WADA, I_BADA, I_WIN, I_GCQ, I_WUQ, I_GCKV, I_WUKV, I_GQN, I_GKN, I_WCONV, I_WO, I_LN1G, I_LN1B, I_W1, I_W2, I_LN2G, I_LN2B };

template <int CTRL> __device__ __forceinline__ float dppf(float v) { return __int_as_float(__builtin_amdgcn_update_dpp(0, __float_as_int(v), CTRL, 0xf, 0xf, true)); }
__device__ __forceinline__ float half_sum(float v) {
    v += dppf<0xB1>(v); v += dppf<0x4E>(v); v += dppf<0x141>(v); v += dppf<0x140>(v);
    auto r = __builtin_amdgcn_permlane16_swap(__float_as_uint(v), __float_as_uint(v), false, false);
    return __uint_as_float(r[0]) + __uint_as_float(r[1]);
}
__device__ __forceinline__ float wave_sum(float v) {
    v = half_sum(v);
    auto r = __builtin_amdgcn_permlane32_swap(__float_as_uint(v), __float_as_uint(v), false, false);
    return __uint_as_float(r[0]) + __uint_as_float(r[1]);
}
__device__ __forceinline__ unsigned pk2(float lo, float hi) { unsigned r; asm volatile("v_cvt_pk_bf16_f32 %0, %1, %2" : "=v"(r) : "v"(lo), "v"(hi)); return r; }
__device__ __forceinline__ float bflo(unsigned w) { return __uint_as_float(w << 16); }
__device__ __forceinline__ float bfhi(unsigned w) { return __uint_as_float(w & 0xffff0000u); }

__device__ __forceinline__ void transpose_item(const float* W, int K, int N, bf16_t* WT, LAS float* scr, int item, int lane) {
    const int nblk = N / 32, kb = item / nblk, nb = item % nblk, k0 = 64 * kb, n0 = 32 * nb;
#pragma unroll
    for (int i = 0; i < 8; ++i) { const int kk = 8 * i + (lane >> 3), nc = (lane & 7) * 4;
        const f32x4 v = *(const f32x4*)(W + (size_t)(k0 + kk) * N + n0 + nc); LAS float* d = scr + kk * 33 + nc; d[0] = v[0]; d[1] = v[1]; d[2] = v[2]; d[3] = v[3]; }
    asm volatile("s_waitcnt lgkmcnt(0)" ::: "memory");
    const int c = lane & 7;
#pragma unroll
    for (int j = 0; j < 4; ++j) { const int n = (lane >> 3) + 8 * j; const LAS float* s = scr + (8 * c) * 33 + n;
        u32x4 o; o.x = pk2(s[0 * 33], s[1 * 33]); o.y = pk2(s[2 * 33], s[3 * 33]); o.z = pk2(s[4 * 33], s[5 * 33]); o.w = pk2(s[6 * 33], s[7 * 33]);
        *(u32x4*)(WT + (size_t)(n0 + n) * K + k0 + 8 * c) = o; }
    asm volatile("s_waitcnt lgkmcnt(0)" ::: "memory");
}

struct RowInfo { int b, i, v; bool isctx; };
__device__ __forceinline__ RowInfo row_info(int m) { RowInfo r; r.b = m / LTOK; r.i = m - r.b * LTOK; r.isctx = r.i < CTX; r.v = r.isctx ? 4 : r.b; return r; }

__global__ void __launch_bounds__(512, 2) fwd_megakernel(Params p) {
    extern __shared__ __attribute__((aligned(16))) unsigned char lds[];
    cg::grid_group grid = cg::this_grid();
#if TSEL >= 0
#define TSL ((unsigned*)(lds + 133120))
#define TST (blockIdx.x == 0 && wave == 0 && pg8::lane_id_asm() == 0)
#define TINIT() do { if (TST) { for (int k = 0; k < 16; ++k) TSL[k] = 0; TSL[12] = (unsigned)__builtin_amdgcn_s_memrealtime(); } } while (0)
#define TBODY(k) do { if (TST) { const unsigned t_ = (unsigned)__builtin_amdgcn_s_memrealtime(); const unsigned d_ = t_ - TSL[12]; TSL[k] += d_; TSL[11] += d_; TSL[12] = t_; } } while (0)
#define TSYNC() do { if (TST) { const unsigned t_ = (unsigned)__builtin_amdgcn_s_memrealtime(); const unsigned d_ = t_ - TSL[12]; TSL[10] += d_; TSL[11] += d_; TSL[12] = t_; } } while (0)
#else
#define TINIT() do {} while (0)
#define TBODY(k) do {} while (0)
#define TSYNC() do {} while (0)
#endif
#define XB_T0 (wave == 0 && pg8::lane_id_asm() == 0)
#define XB_ST ((volatile LAS unsigned*)((LAS unsigned char*)lds + 133376))
#define XB_BAR ((unsigned*)WSB())
#define GSYNC_CG(k) do { TBODY(k); grid.sync(); TSYNC(); } while (0)
#define GSYNC(k) do { TBODY(k); { XcdBarrier xb_; xb_.bar = XB_BAR; xb_.x = xb_xcc_id(); xb_.st = XB_ST; xcd_barrier(xb_, XB_T0); } TSYNC(); } while (0)
    const int wave = __builtin_amdgcn_readfirstlane(threadIdx.x >> 6);
    TINIT();
    if (XB_T0) { XB_ST[0] = 0u; XB_ST[1] = 0u; }
    __syncthreads();
#define G ((int)gridDim.x)
#define bx ((int)blockIdx.x)
#define vcu ((G % 8 == 0) ? (bx % 8) * (G / 8) + bx / 8 : bx)
#define gw (bx * 8 + wave)
#define NGW (G * 8)
#define LAUN3() int G_ = G, bx_ = bx, wave_ = wave; asm volatile("" : "+s"(G_), "+s"(bx_), "+s"(wave_))
#define KP() ({ const __attribute__((address_space(4))) Params* k_ = (const __attribute__((address_space(4))) Params*)__builtin_amdgcn_kernarg_segment_ptr(); asm volatile("" : "+s"(k_)); k_; })
#define WSB() ((unsigned char*)KP()->ws)
#define DEFWS(w) \
    float* MOD = (float*)((w) + WS_MOD); float* ROPEM = (float*)((w) + WS_ROPEM); float* ROPEG = (float*)((w) + WS_ROPEG); float* Z = (float*)((w) + WS_Z); \
    bf16_t* WIN = (bf16_t*)((w) + WS_WIN); bf16_t* WUQ = (bf16_t*)((w) + WS_WUQ); bf16_t* WUKV = (bf16_t*)((w) + WS_WUKV); bf16_t* WO = (bf16_t*)((w) + WS_WO); \
    bf16_t* W1 = (bf16_t*)((w) + WS_W1); bf16_t* W2 = (bf16_t*)((w) + WS_W2); \
    bf16_t* U = (bf16_t*)((w) + WS_U); bf16_t* Y = (bf16_t*)((w) + WS_Y); bf16_t* HM = (bf16_t*)((w) + WS_HM); bf16_t* H = (bf16_t*)((w) + WS_H); \
    bf16_t* MQ = (bf16_t*)((w) + WS_MQ); bf16_t* MK = (bf16_t*)((w) + WS_MK); bf16_t* MV = (bf16_t*)((w) + WS_MV); \
    bf16_t* CKV = (bf16_t*)((w) + WS_CKV); bf16_t* CQ = (bf16_t*)((w) + WS_CQ); bf16_t* KPE = (bf16_t*)((w) + WS_KPE); \
    bf16_t* GK = (bf16_t*)((w) + WS_GK); bf16_t* GV = (bf16_t*)((w) + WS_GV); bf16_t* GQ = (bf16_t*)((w) + WS_GQ); bf16_t* OC = (bf16_t*)((w) + WS_O); float* PART = (float*)((w) + WS_PART); (void)PART; \
    (void)MOD; (void)ROPEM; (void)ROPEG; (void)Z; (void)WIN; (void)WUQ; (void)WUKV; (void)WO; (void)W1; (void)W2; (void)U; (void)Y; (void)HM; (void)H; (void)MQ; (void)MK; (void)MV; \
    (void)CKV; (void)CQ; (void)KPE; (void)GK; (void)GV; (void)GQ; (void)OC;

    {
        unsigned char* ws_b_ = WSB(); DEFWS(ws_b_)
        const int lane = pg8::lane_id_asm(), tid = wave * 64 + lane;
        if (bx == 0) { unsigned* bar_ = (unsigned*)ws_b_; for (int i = tid; i < XCD_BAR_WORDS; i += 512) bar_[i] = 0u; }
        LAS float* scr = (LAS float*)((LAS unsigned char*)lds + wave * 16384);
        constexpr int I_IN = 16 * 57, I_UQ = 4 * 18, I_UKV = 2 * 24, I_O = 16 * 32, I_1 = 16 * 128, I_2 = 64 * 32, PER = I_IN + I_UQ + I_UKV + I_O + I_1 + I_2;
        for (int it = gw; it < DEPTH * PER; it += NGW) {
            const int l = it / PER; int r = it - l * PER;
            if (r < I_IN) { transpose_item(KP()->in[I_WIN] + (size_t)l * DM * IN_COLS, DM, IN_COLS, WIN + (size_t)l * HP * DM, scr, r, lane); continue; } r -= I_IN;
            if (r < I_UQ) { transpose_item(KP()->in[I_WUQ] + (size_t)l * 256 * 576, 256, 576, WUQ + (size_t)l * 768 * 256, scr, r, lane); continue; } r -= I_UQ;
            if (r < I_UKV) { transpose_item(KP()->in[I_WUKV] + (size_t)l * 128 * 768, 128, 768, WUKV + (size_t)l * 768 * 128, scr, r, lane); continue; } r -= I_UKV;
            if (r < I_O) { transpose_item(KP()->in[I_WO] + (size_t)l * DM * DM, DM, DM, WO + (size_t)l * DM * DM, scr, r, lane); continue; } r -= I_O;
            if (r < I_1) { transpose_item(KP()->in[I_W1] + (size_t)l * DM * DFF, DM, DFF, W1 + (size_t)l * DFF * DM, scr, r, lane); continue; } r -= I_1;
            transpose_item(KP()->in[I_W2] + (size_t)l * DFF * DM, DFF, DM, W2 + (size_t)l * DM * DFF, scr, r, lane);
        }
        const int gt = bx * 512 + tid, NGT = G * 512;
        for (int idx = gt; idx < DEPTH * 224 * 128; idx += NGT) { const int l = idx / (224 * 128), r = idx % (224 * 128);
            *(u32x4*)(WIN + ((size_t)l * HP + IN_COLS) * DM + (size_t)r * 8) = (u32x4){0u, 0u, 0u, 0u}; }
        for (int idx = gt; idx < DEPTH * 192 * 32; idx += NGT) { const int l = idx / (192 * 32), r = idx % (192 * 32);
            *(u32x4*)(WUQ + ((size_t)l * 768 + 576) * 256 + (size_t)r * 8) = (u32x4){0u, 0u, 0u, 0u}; }
        for (int idx = gt; idx < SEQ * 16; idx += NGT) { const int pos = idx >> 4, i = idx & 15; const int rw = pos >> 6, cl = pos & 63;
            const float inv = powf(10000.f, -(float)(i & 7) / 8.f); const float ang = (float)(i < 8 ? rw : cl) * inv;
            ROPEM[2 * idx] = cosf(ang); ROPEM[2 * idx + 1] = sinf(ang); }
        for (int idx = gt; idx < SEQ * 32; idx += NGT) { const int pos = idx >> 5, i = idx & 31; const int rw = pos >> 6, cl = pos & 63;
            const float inv = powf(10000.f, -(float)(i & 15) / 16.f); const float ang = (float)(i < 16 ? rw : cl) * inv;
            ROPEG[2 * idx] = cosf(ang); ROPEG[2 * idx + 1] = sinf(ang); }
        __syncthreads();
        float* sil = (float*)lds;
        float* part = (float*)lds + 5 * 1024;
        { const float* c_in = KP()->in[I_C]; const float* cc_in = KP()->in[I_CCTX];
        for (int idx = tid; idx < 5 * 1024; idx += 512) { const int v = idx >> 10, k = idx & 1023; const float c = (v < 4) ? c_in[v * 1024 + k] : cc_in[k]; sil[idx] = c / (1.f + __expf(-c)); } }
        const float* wada_ = KP()->in[I_WADA]; const float* bada_ = KP()->in[I_BADA];
        __syncthreads();
        for (int it = bx; it < DEPTH * 96; it += G) { const int l = it / 96, jb = it % 96; const int j = jb * 64 + lane;
            const float* wp = wada_ + ((size_t)l * DM + wave * 128) * 6144 + j;
            float a0 = 0, a1 = 0, a2 = 0, a3 = 0, a4 = 0;
#pragma unroll 8
            for (int k = 0; k < 128; ++k) { const float w = wp[(size_t)k * 6144]; const int kk = wave * 128 + k;
                a0 += sil[kk] * w; a1 += sil[1024 + kk] * w; a2 += sil[2048 + kk] * w; a3 += sil[3072 + kk] * w; a4 += sil[4096 + kk] * w; }
            part[(wave * 5 + 0) * 64 + lane] = a0; part[(wave * 5 + 1) * 64 + lane] = a1; part[(wave * 5 + 2) * 64 + lane] = a2; part[(wave * 5 + 3) * 64 + lane] = a3; part[(wave * 5 + 4) * 64 + lane] = a4;
            __syncthreads();
            if (tid < 320) { const int v = tid >> 6, c = tid & 63; float s = bada_[l * 6144 + jb * 64 + c];
#pragma unroll
                for (int w = 0; w < 8; ++w) s += part[(w * 5 + v) * 64 + c];
                MOD[((size_t)l * 5 + v) * 6144 + jb * 64 + c] = s; }
            __syncthreads();
        }
    }
    GSYNC_CG(0);
    (void)xcd_barrier_post(XB_BAR, XB_ST, XB_T0);
    { DEFWS(WSB())
    const int lane = pg8::lane_id_asm(); const float* xin_ = KP()->in[I_X]; const float* cin_ = KP()->in[I_CTX];
    for (int m = gw; m < MROWS; m += NGW) { const RowInfo ri = row_info(m);
        const float* xr = ri.isctx ? cin_ + ((size_t)ri.b * CTX + ri.i) * DM : xin_ + ((size_t)ri.b * SEQ + ri.i - CTX) * DM;
        const float* md = MOD + (size_t)ri.v * 6144;
#pragma unroll
        for (int jp = 0; jp < 2; ++jp) { const int col = 8 * lane + 512 * jp;
            const f32x4 x0 = *(const f32x4*)(xr + col), x1 = *(const f32x4*)(xr + col + 4), sh0 = *(const f32x4*)(md + col), sh1 = *(const f32x4*)(md + col + 4), sc0 = *(const f32x4*)(md + 1024 + col), sc1 = *(const f32x4*)(md + 1024 + col + 4);
            const f32x4 u0 = x0 * (1.f + sc0) + sh0, u1 = x1 * (1.f + sc1) + sh1; u32x4 w; w.x = pk2(u0[0], u0[1]); w.y = pk2(u0[2], u0[3]); w.z = pk2(u1[0], u1[1]); w.w = pk2(u1[2], u1[3]); *(u32x4*)(U + (size_t)m * DM + col) = w; }
    } }
    GSYNC(0);

#pragma unroll 1
    for (int l = 0; l < DEPTH; ++l) {
        { DEFWS(WSB()) LAUN3(); pg8::Gemm g{U, WIN + (size_t)l * HP * DM, MROWS, HP, DM, DM}; pg8::StaticOrder S; S.init(MROWS, HP, G_, bx_);
          pg8::EpiStore<0> E{H, HPI, IN_COLS};
          pg8::gemm_phase<pg8::EpiStore<0>, pg8::StaticOrder, true, true>((LAS unsigned char*)lds, g, S, E, wave_); }
        GSYNC(1);
        {
            DEFWS(WSB())
            const int lane = pg8::lane_id_asm();
            const f32x2* gckv = (const f32x2*)(KP()->in[I_GCKV] + l * 128); const f32x2* gkn = (const f32x2*)(KP()->in[I_GKN] + l * 64);
            const f32x2* gcq = (const f32x2*)(KP()->in[I_GCQ] + l * 256); const f32x2* gqn = (const f32x2*)(KP()->in[I_GQN] + l * 64);
            const f32x2* wc0 = (const f32x2*)(KP()->in[I_WCONV] + (size_t)l * 768); const f32x2* wc1 = wc0 + 128; const f32x2* wc2 = wc0 + 256;
            const f32x2* rM = (const f32x2*)ROPEM; const f32x2* rG = (const f32x2*)ROPEG;
            const f32x2 gckv_l = gckv[lane], gkn_l = gkn[lane & 31], gcq0_l = gcq[lane], gcq1_l = gcq[64 + lane], gqn_l = gqn[lane & 31];
            f32x2 wcv[2][3];
#pragma unroll
            for (int j = 0; j < 2; ++j) { wcv[j][0] = wc0[lane + 64 * j]; wcv[j][1] = wc1[lane + 64 * j]; wcv[j][2] = wc2[lane + 64 * j]; }
#define RED4(v, NSTEP) _Pragma("unroll") for (int q_ = 0; q_ < 4; ++q_) v[q_] = ((NSTEP) == 64) ? wave_sum(v[q_]) : half_sum(v[q_]);
            for (int ch = wave * G + bx; ch < MROWS / 4; ch += NGW) { const int m0 = ch * 4; const RowInfo ri = row_info(m0); const bool lat = !ri.isctx; const int pos0 = ri.i - CTX;
                const unsigned* hr0 = (const unsigned*)(H + (size_t)m0 * HPI);
#if TSEL >= 0
                unsigned tp0_ = 0; if (TST) tp0_ = (unsigned)__builtin_amdgcn_s_memrealtime();
#endif
                unsigned wkv[4], wpe[4], wgk[4], wgv[4], wq0[4], wq1[4], wgq[4][3];
#pragma unroll
                for (int q = 0; q < 4; ++q) { const unsigned* hr = hr0 + (size_t)q * (HPI / 2);
                    wkv[q] = hr[lane]; wpe[q] = hr[64 + (lane & 15)]; wgk[q] = hr[80 + lane]; wgv[q] = hr[144 + lane]; wq0[q] = hr[208 + lane]; wq1[q] = hr[272 + lane];
#pragma unroll
                    for (int j = 0; j < 3; ++j) wgq[q][j] = hr[336 + 64 * j + lane]; }
                f32x2 csM[4], csG[4];
#pragma unroll
                for (int q = 0; q < 4; ++q) { csM[q] = lat ? rM[(pos0 + q) * 16 + (lane & 15)] : (f32x2){1.f, 0.f}; csG[q] = lat ? rG[(pos0 + q) * 32 + (lane & 31)] : (f32x2){1.f, 0.f}; }
                const int seqlen = lat ? SEQ : CTX, t0 = lat ? pos0 : ri.i; const bool hp = t0 > 0, hn = t0 + 4 < seqlen; const float zp = hp ? 1.f : 0.f, zn = hn ? 1.f : 0.f;
                unsigned cvh[2][6], cvc[2][6], cvb[2][4];
#pragma unroll
                for (int q = 0; q < 6; ++q) { const int qq = (q == 0 && !hp) ? 1 : (q == 5 && !hn) ? 4 : q; const unsigned* hq = hr0 + (ptrdiff_t)(qq - 1) * (HPI / 2);
#pragma unroll
                    for (int j = 0; j < 2; ++j) { cvh[j][q] = hq[528 + lane + 64 * j]; cvc[j][q] = hq[784 + lane + 64 * j]; } }
#pragma unroll
                for (int q = 0; q < 4; ++q)
#pragma unroll
                    for (int j = 0; j < 2; ++j) cvb[j][q] = (hr0 + (size_t)q * (HPI / 2))[656 + lane + 64 * j];
                {
                    float ss[4];
#pragma unroll
                    for (int q = 0; q < 4; ++q) { const float a = bflo(wkv[q]), b2 = bfhi(wkv[q]); ss[q] = a * a + b2 * b2; }
                    RED4(ss, 64)
#if TSEL >= 0
                    if (TST) { const unsigned t_ = (unsigned)__builtin_amdgcn_s_memrealtime(); TSL[13] += t_ - tp0_; tp0_ = t_; }
#endif
#pragma unroll
                    for (int q = 0; q < 4; ++q) { const float r = rsqrtf(ss[q] * (1.f / 128.f) + LN_EPS); ((unsigned*)(CKV + (size_t)(m0 + q) * 128))[lane] = pk2(bflo(wkv[q]) * r * gckv_l.x, bfhi(wkv[q]) * r * gckv_l.y); } }
                if (lane < 16) {
#pragma unroll
                    for (int q = 0; q < 4; ++q) { const float a = bflo(wpe[q]), b2 = bfhi(wpe[q]); ((unsigned*)(KPE + (size_t)(m0 + q) * 32))[lane] = pk2(a * csM[q].x - b2 * csM[q].y, a * csM[q].y + b2 * csM[q].x); } }
                {
                    float ss[4];
#pragma unroll
                    for (int q = 0; q < 4; ++q) { const float a = bflo(wgk[q]), b2 = bfhi(wgk[q]); ss[q] = a * a + b2 * b2; }
                    RED4(ss, 32)
#pragma unroll
                    for (int q = 0; q < 4; ++q) { const float r = rsqrtf(ss[q] * (1.f / 64.f) + LN_EPS); const float a = bflo(wgk[q]) * r * gkn_l.x, b2 = bfhi(wgk[q]) * r * gkn_l.y;
                        ((unsigned*)(GK + (size_t)(m0 + q) * 128))[lane] = pk2(a * csG[q].x - b2 * csG[q].y, a * csG[q].y + b2 * csG[q].x); } }
#pragma unroll
                for (int q = 0; q < 4; ++q) ((unsigned*)(GV + (size_t)(m0 + q) * 128))[lane] = wgv[q];
                {
                    float ss[4];
#pragma unroll
                    for (int q = 0; q < 4; ++q) { const float a0 = bflo(wq0[q]), b0 = bfhi(wq0[q]), a1 = bflo(wq1[q]), b1 = bfhi(wq1[q]); ss[q] = (a0 * a0 + b0 * b0) + (a1 * a1 + b1 * b1); }
                    RED4(ss, 64)
#pragma unroll
                    for (int q = 0; q < 4; ++q) { const float r = rsqrtf(ss[q] * (1.f / 256.f) + LN_EPS); unsigned* o = (unsigned*)(CQ + (size_t)(m0 + q) * 256);
                        o[lane] = pk2(bflo(wq0[q]) * r * gcq0_l.x, bfhi(wq0[q]) * r * gcq0_l.y); o[64 + lane] = pk2(bflo(wq1[q]) * r * gcq1_l.x, bfhi(wq1[q]) * r * gcq1_l.y); } }
#pragma unroll
                for (int j = 0; j < 3; ++j) {
                    float ss[4];
#pragma unroll
                    for (int q = 0; q < 4; ++q) { const float a = bflo(wgq[q][j]), b2 = bfhi(wgq[q][j]); ss[q] = a * a + b2 * b2; }
                    RED4(ss, 32)
#pragma unroll
                    for (int q = 0; q < 4; ++q) { const float r = rsqrtf(ss[q] * (1.f / 64.f) + LN_EPS); const float a = bflo(wgq[q][j]) * r * gqn_l.x, b2 = bfhi(wgq[q][j]) * r * gqn_l.y;
                        ((unsigned*)(GQ + (size_t)(m0 + q) * 384))[64 * j + lane] = pk2((a * csG[q].x - b2 * csG[q].y) * QSC64, (a * csG[q].y + b2 * csG[q].x) * QSC64); } }
                {
#pragma unroll
                    for (int j = 0; j < 2; ++j) { const int ix = lane + 64 * j; float pa[6], pb[6];
#pragma unroll
                        for (int q = 0; q < 6; ++q) { const float z = (q == 0) ? zp : (q == 5) ? zn : 1.f; pa[q] = bflo(cvh[j][q]) * bflo(cvc[j][q]) * z; pb[q] = bfhi(cvh[j][q]) * bfhi(cvc[j][q]) * z; }
#pragma unroll
                        for (int q = 0; q < 4; ++q) { const unsigned bb = cvb[j][q];
                            const float oa = bflo(bb) * (wcv[j][0].x * pa[q] + wcv[j][1].x * pa[q + 1] + wcv[j][2].x * pa[q + 2]);
                            const float ob = bfhi(bb) * (wcv[j][0].y * pb[q] + wcv[j][1].y * pb[q + 1] + wcv[j][2].y * pb[q + 2]);
                            ((unsigned*)(OC + (size_t)(m0 + q) * DM))[384 + ix] = pk2(oa, ob); } }
                }
#if TSEL >= 0
                if (TST) { const unsigned t_ = (unsigned)__builtin_amdgcn_s_memrealtime(); TSL[14] += t_ - tp0_; }
#endif
            }
#undef RED4
        }
        GSYNC(2);
        { DEFWS(WSB()) LAUN3(); pg8::Gemm g{CQ, WUQ + (size_t)l * 768 * 256, MROWS, 768, 256, 256}; pg8::StaticOrder S; S.init(MROWS, 768, G_, bx_);
          pg8::EpiUQ E{MQ, ROPEM, QSC96};
          pg8::gemm_phase<pg8::EpiUQ, pg8::StaticOrder, true, true>((LAS unsigned char*)lds, g, S, E, wave_); }
        { DEFWS(WSB()) LAUN3(); pg8::Gemm g{CKV, WUKV + (size_t)l * 768 * 128, MROWS, 768, 128, 128}; pg8::StaticOrder S; S.init(MROWS, 768, G_, bx_);
          pg8::EpiUKV E{MK, MV};
          pg8::gemm_phase<pg8::EpiUKV, pg8::StaticOrder, true, true>((LAS unsigned char*)lds, g, S, E, wave_); }
        GSYNC(3);
        {
            DEFWS(WSB())
            const int nrounds = (l < DEPTH - 1) ? 7 : 6;
            for (int i_ = 0; i_ < nrounds * ATT_REPS; ++i_) { const int i = (ATT_REPS == 1) ? i_ : (i_ % nrounds);
                int type, b, h, qrow0, seq;
                if (i < 6) { const int u = vcu + 256 * i; type = u / 768; const int rem = u % 768; b = rem / 192; h = (rem >> 5) % 6; const int qb = rem & 31; qrow0 = b * LTOK + CTX + qb * 256; seq = LTOK; }
                else { if (vcu >= 48) continue; type = vcu / 24; b = (vcu % 24) / 6; h = vcu % 6; qrow0 = b * LTOK; seq = CTX; }
                const size_t kr = (size_t)b * LTOK;
                if (type == 0) d64::attn_unit<8, true>((const d64::bf16*)(MQ + (size_t)qrow0 * 576 + h * 96), (const d64::bf16*)(MK + kr * 384 + h * 64), (const d64::bf16*)(KPE + kr * 32), (const d64::bf16*)(MV + kr * 384 + h * 64), (d64::bf16*)(OC + (size_t)qrow0 * DM + h * 64), seq / 64, (char*)lds, wave);
                else d64::attn_unit<8, false>((const d64::bf16*)(GQ + (size_t)qrow0 * 384 + h * 64), (const d64::bf16*)(GK + kr * 128 + (h / 3) * 64), nullptr, (const d64::bf16*)(GV + kr * 128 + (h / 3) * 64), (d64::bf16*)(OC + (size_t)qrow0 * DM + 384 + h * 64), seq / 64, (char*)lds, wave);
            }
        }
        GSYNC(4);
        { DEFWS(WSB()) LAUN3(); pg8::Gemm g{OC, WO + (size_t)l * DM * DM, MROWS, DM, DM, DM}; pg8::RowOrder S; S.init(DM, G_, bx_, true);
          pg8::EpiStore<0> E{Y, DM, DM};
          pg8::gemm_phase<pg8::EpiStore<0>, pg8::RowOrder, true, true>((LAS unsigned char*)lds, g, S, E, wave_); }
        if (l < DEPTH - 1) { DEFWS(WSB()) LAUN3(); pg8::Gemm g{OC, WO + (size_t)l * DM * DM, MROWS, DM, 256, DM}; pg8::CtxSplitOrder S; S.init(DM, 4, G_, bx_);
          pg8::EpiPart E{PART, DM, (size_t)1024 * DM};
          pg8::gemm_phase<pg8::EpiPart, pg8::CtxSplitOrder, true, true>((LAS unsigned char*)lds, g, S, E, wave_); }
        GSYNC(5);
#pragma unroll 1
        for (int which = 0; which < 2; ++which) {
            {
                DEFWS(WSB())
                const int lane = pg8::lane_id_asm();
                const float* lg = KP()->in[which ? I_LN2G : I_LN1G] + l * DM; const float* lb = KP()->in[which ? I_LN2B : I_LN1B] + l * DM;
                const float* xin_ = KP()->in[I_X]; const float* cin_ = KP()->in[I_CTX]; float* out_ = KP()->out;
                const bool first = (l == 0 && which == 0); const bool wantu = !(which == 1 && l == DEPTH - 1);
                const int KS = which ? 8 : 4;
#define LCOL(j) (8 * lane + 512 * ((j) >> 1) + 4 * ((j) & 1))
                f32x4 g4[4], b4[4];
#pragma unroll
                for (int j = 0; j < 4; ++j) { g4[j] = *(const f32x4*)(lg + LCOL(j)); b4[j] = *(const f32x4*)(lb + LCOL(j)); }
                for (int ch = wave * G + bx; ch < MROWS / 2; ch += NGW) { const int m0 = ch * 2; const RowInfo ri = row_info(m0);
                    if (ri.isctx && l == DEPTH - 1) continue;
                    const size_t zoff = ((size_t)ri.b * CTX + ri.i) * DM, xoff = ((size_t)ri.b * SEQ + ri.i - CTX) * DM;
                    const float* xo = ri.isctx ? (first ? cin_ + zoff : Z + zoff) : (first ? xin_ + xoff : out_ + xoff);
                    float* xn = ri.isctx ? Z + zoff : out_ + xoff;
                    const bool ldh = !ri.isctx && !first, sth = !ri.isctx && wantu;
                    const float* md = MOD + ((size_t)l * 5 + ri.v) * 6144; const float* gate = md + (which ? 5 : 2) * 1024;
                    const float* md2 = which ? MOD + ((size_t)(wantu ? l + 1 : l) * 5 + ri.v) * 6144 : md + 3 * 1024;
                    f32x4 gt[4], sh[4], sc1[4];
#pragma unroll
                    for (int j = 0; j < 4; ++j) { const int col = LCOL(j); gt[j] = *(const f32x4*)(gate + col); sh[j] = *(const f32x4*)(md2 + col); sc1[j] = 1.f + *(const f32x4*)(md2 + 1024 + col); }
                    const float* pp0 = PART + zoff;
                    {
                        f32x4 t[2][4]; float s[2] = {0.f, 0.f};
#pragma unroll
                        for (int q = 0; q < 2; ++q)
#pragma unroll
                            for (int jp = 0; jp < 2; ++jp) { const size_t rb = (size_t)q * DM; const int c0 = LCOL(2 * jp);
                                f32x4 x0, x1, y0, y1;
                                if (ldh) { const h16x8 hv = __builtin_nontemporal_load((const h16x8*)((const _Float16*)(xo + rb) + c0));
                                    x0 = __builtin_convertvector(__builtin_shufflevector(hv, hv, 0, 1, 2, 3), f32x4); x1 = __builtin_convertvector(__builtin_shufflevector(hv, hv, 4, 5, 6, 7), f32x4); }
                                else { x0 = __builtin_nontemporal_load((const f32x4*)(xo + rb + c0)); x1 = __builtin_nontemporal_load((const f32x4*)(xo + rb + c0 + 4)); }
                                if (ri.isctx) {
#pragma unroll
                                    for (int h = 0; h < 2; ++h) { const float* pp = pp0 + rb + c0 + 4 * h; f32x4 yy[8];
#pragma unroll
                                        for (int k = 0; k < 4; ++k) yy[k] = *(const f32x4*)(pp + (size_t)k * 1024 * DM);
                                        f32x4 y;
                                        if (KS == 8) {
#pragma unroll
                                            for (int k = 4; k < 8; ++k) yy[k] = *(const f32x4*)(pp + (size_t)k * 1024 * DM);
                                            y = ((yy[0] + yy[1]) + (yy[2] + yy[3])) + ((yy[4] + yy[5]) + (yy[6] + yy[7])); }
                                        else y = (yy[0] + yy[1]) + (yy[2] + yy[3]);
                                        if (h == 0) y0 = y; else y1 = y; } }
                                else { const u32x4 yw = *(const u32x4*)(Y + (size_t)m0 * DM + rb + c0); y0 = (f32x4){bflo(yw.x), bfhi(yw.x), bflo(yw.y), bfhi(yw.y)}; y1 = (f32x4){bflo(yw.z), bfhi(yw.z), bflo(yw.w), bfhi(yw.w)}; }
                                t[q][2 * jp] = ALPHA * x0 + gt[2 * jp] * y0; t[q][2 * jp + 1] = ALPHA * x1 + gt[2 * jp + 1] * y1;
                                s[q] += ((t[q][2 * jp][0] + t[q][2 * jp][1]) + (t[q][2 * jp][2] + t[q][2 * jp][3])) + ((t[q][2 * jp + 1][0] + t[q][2 * jp + 1][1]) + (t[q][2 * jp + 1][2] + t[q][2 * jp + 1][3])); }
                        s[0] = wave_sum(s[0]); s[1] = wave_sum(s[1]);
                        float s2[2] = {0.f, 0.f};
#pragma unroll
                        for (int q = 0; q < 2; ++q) { const float mean = s[q] * (1.f / DM);
#pragma unroll
                            for (int j = 0; j < 4; ++j) { t[q][j] = t[q][j] - mean; s2[q] += (t[q][j][0] * t[q][j][0] + t[q][j][1] * t[q][j][1]) + (t[q][j][2] * t[q][j][2] + t[q][j][3] * t[q][j][3]); } }
                        s2[0] = wave_sum(s2[0]); s2[1] = wave_sum(s2[1]);
#pragma unroll
                        for (int q = 0; q < 2; ++q) { const float rstd = rsqrtf(s2[q] * (1.f / DM) + LN_EPS);
#pragma unroll
                            for (int jp = 0; jp < 2; ++jp) { const size_t rb = (size_t)q * DM; const int c0 = LCOL(2 * jp);
                                const f32x4 xv0 = t[q][2 * jp] * rstd * g4[2 * jp] + b4[2 * jp], xv1 = t[q][2 * jp + 1] * rstd * g4[2 * jp + 1] + b4[2 * jp + 1];
                                if (sth) __builtin_nontemporal_store(__builtin_convertvector(__builtin_shufflevector(xv0, xv1, 0, 1, 2, 3, 4, 5, 6, 7), h16x8), (h16x8*)((_Float16*)(xn + rb) + c0));
                                else { __builtin_nontemporal_store(xv0, (f32x4*)(xn + rb + c0)); __builtin_nontemporal_store(xv1, (f32x4*)(xn + rb + c0 + 4)); }
                                if (wantu) { const f32x4 u0 = xv0 * sc1[2 * jp] + sh[2 * jp], u1 = xv1 * sc1[2 * jp + 1] + sh[2 * jp + 1];
                                    u32x4 w; w.x = pk2(u0[0], u0[1]); w.y = pk2(u0[2], u0[3]); w.z = pk2(u1[0], u1[1]); w.w = pk2(u1[2], u1[3]); *(u32x4*)(U + (size_t)m0 * DM + rb + c0) = w; } } }
                    }
                }
#undef LCOL
            }
            if (which == 1) { if (l < DEPTH - 1) GSYNC(9); else TBODY(9); break; }
            GSYNC(6);
            { DEFWS(WSB()) LAUN3(); pg8::Gemm g{U, W1 + (size_t)l * DFF * DM, MROWS, DFF, DM, DM}; pg8::RowOrder S; S.init(DFF, G_, bx_, l == DEPTH - 1);
              pg8::EpiStore<1> E{HM, DFF, DFF};
              pg8::gemm_phase<pg8::EpiStore<1>, pg8::RowOrder, true, true>((LAS unsigned char*)lds, g, S, E, wave_); }
            GSYNC(7);
            { DEFWS(WSB()) LAUN3(); pg8::Gemm g{HM, W2 + (size_t)l * DM * DFF, MROWS, DM, DFF, DFF}; pg8::RowOrder S; S.init(DM, G_, bx_, true);
              pg8::EpiStore<0> E{Y, DM, DM};
              pg8::gemm_phase<pg8::EpiStore<0>, pg8::RowOrder, true, true>((LAS unsigned char*)lds, g, S, E, wave_); }
            if (l < DEPTH - 1) { DEFWS(WSB()) LAUN3(); pg8::Gemm g{HM, W2 + (size_t)l * DM * DFF, MROWS, DM, 512, DFF}; pg8::CtxSplitOrder S; S.init(DM, 8, G_, bx_);
              pg8::EpiPart E{PART, DM, (size_t)1024 * DM};
              pg8::gemm_phase<pg8::EpiPart, pg8::CtxSplitOrder, true, true>((LAS unsigned char*)lds, g, S, E, wave_); }
            GSYNC(8);
        }
    }
#if TSEL >= 0
    grid.sync();
    if (blockIdx.x == 0) { __syncthreads(); unsigned ticks = 0; for (int k = 0; k < 16; ++k) if ((TSEL >> k) & 1) ticks += TSL[k]; const int n = (int)((ticks / 100u) / TDIV); float* o_ = KP()->out;
        for (int i = wave * 64 + pg8::lane_id_asm(); i < n; i += 512) o_[(size_t)i * 1031] += 0.2f; }
#endif
}

extern "C" void kernel_launch(void* const* d_in, const int* in_sizes, int n_in, void* d_out, int out_size, void* d_ws, size_t ws_size, hipStream_t stream) {
    static int grid = 0;
    if (grid == 0) {
        if (n_in != 21 || in_sizes[0] != NBATCH * SEQ * DM || out_size != NBATCH * SEQ * DM || ws_size < WS_END) {
            fprintf(stderr, "kernel_launch: shape mismatch n_in %d in0 %d out %d ws %zu (need %zu)\n", n_in, n_in > 0 ? in_sizes[0] : -1, out_size, ws_size, (size_t)WS_END); grid = -1; return; }
        int dev = 0, cus = 0, per_cu = 0;
        hipGetDevice(&dev); hipDeviceGetAttribute(&cus, hipDeviceAttributeMultiprocessorCount, dev);
        if (hipFuncSetAttribute((const void*)fwd_megakernel, hipFuncAttributeMaxDynamicSharedMemorySize, LDS_BYTES) != hipSuccess) { fprintf(stderr, "kernel_launch: hipFuncSetAttribute failed\n"); grid = -1; return; }
        if (hipOccupancyMaxActiveBlocksPerMultiprocessor(&per_cu, (const void*)fwd_megakernel, 512, LDS_BYTES) != hipSuccess || per_cu < 1) { fprintf(stderr, "kernel_launch: occupancy query says %d\n", per_cu); per_cu = 1; }
        (void)hipGetLastError();
        if (cus < 256) { fprintf(stderr, "kernel_launch: built for a 256-CU device, found %d CUs\n", cus); grid = -1; return; }
        grid = 256;
        fprintf(stderr, "kernel_launch: grid %d (per_cu %d)\n", grid, per_cu);
    }
    if (grid < 0) return;
    Params p{};
    for (int i = 0; i < 21; ++i) p.in[i] = (const float*)d_in[i];
    p.out = (float*)d_out; p.ws = (unsigned char*)d_ws;
    void* args[] = {&p};
    hipError_t e = hipLaunchCooperativeKernel((const void*)fwd_megakernel, dim3(grid), dim3(512), args, LDS_BYTES, stream);
    if (e != hipSuccess) fprintf(stderr, "kernel_launch: cooperative launch failed: %s (grid %d)\n", hipGetErrorString(e), grid);
}
```
